# Optimizing an MI355X kernel written in HIP

```python
import math
import jax, jax.numpy as jnp
from jax import lax
import numpy as np

D_MODEL = 2048
BATCH = 4
SEQ = 2048
DEPTH = 4
DEC_BATCH = 2
DEC_SEQ = 16384
PAST_LEN = 128

GRID_W = 64
NA_HEADS = 16
NA_HEAD_DIM = 64
NA_WIDTH = NA_HEADS * NA_HEAD_DIM
NA_KH_MAX = 8
NA_KW = 16
LRU_WIDTH = 512
LRU_BLOCKS = 8
LRU_BLOCK_DIM = LRU_WIDTH // LRU_BLOCKS
LRU_CONV = 4
LRU_C = 8.0
S5_WIDTH = 512
S5_GROUP = 16
S5_GROUPS = S5_WIDTH // S5_GROUP
S5_STATE = 64
MIX_WIDTH = NA_WIDTH + LRU_WIDTH + S5_WIDTH
IN_WIDTH = 3 * NA_WIDTH + 2 * LRU_WIDTH + S5_WIDTH
D_FF = 4 * D_MODEL
EPS = 1e-6

kernel_name = 'hybrid_natten_rglru_s5_encoder'


def _rmsnorm(x, g):
    xf = x.astype(jnp.float32)
    y = xf * lax.rsqrt(jnp.mean(xf * xf, axis=-1, keepdims=True) + EPS)
    return (y * g.astype(jnp.float32)).astype(x.dtype)


def _neighbourhood_attention(q, k, v, rpb):
    b, t, _ = q.shape
    rows = t // GRID_W
    kh = min(NA_KH_MAX, rows)
    shp = (b, rows, GRID_W, NA_HEADS, NA_HEAD_DIM)
    q = q.reshape(shp) * (NA_HEAD_DIM ** -0.5)
    k = k.reshape(shp)
    v = v.reshape(shp)
    cols = np.arange(GRID_W)
    col_start = np.clip(cols - NA_KW // 2, 0, GRID_W - NA_KW)
    col_idx = col_start[:, None] + np.arange(NA_KW)[None, :]
    dc_idx = col_idx - cols[:, None] + (NA_KW - 1)
    bias_cols = rpb[:, :, dc_idx]

    def row_block(r):
        rs = jnp.clip(r - kh // 2, 0, rows - kh)
        k_rows = lax.dynamic_slice_in_dim(k, rs, kh, axis=1)
        v_rows = lax.dynamic_slice_in_dim(v, rs, kh, axis=1)
        k_win = k_rows[:, :, col_idx]
        v_win = v_rows[:, :, col_idx]
        q_r = lax.dynamic_index_in_dim(q, r, axis=1, keepdims=False)
        s = jnp.einsum('bwhd,bawkhd->bwhak', q_r, k_win).astype(jnp.float32)
        dr = rs + jnp.arange(kh) - r + (NA_KH_MAX - 1)
        bias = jnp.take(bias_cols, dr, axis=1)
        s = s + jnp.transpose(bias, (2, 0, 1, 3)).astype(jnp.float32)[None]
        p = jax.nn.softmax(s.reshape(b, GRID_W, NA_HEADS, kh * NA_KW), axis=-1)
        p = p.reshape(b, GRID_W, NA_HEADS, kh, NA_KW).astype(v.dtype)
        return jnp.einsum('bwhak,bawkhd->bwhd', p, v_win)

    out = lax.map(row_block, jnp.arange(rows))
    return jnp.transpose(out, (1, 0, 2, 3, 4)).reshape(b, t, NA_WIDTH)


def _linear_scan(a, u, reverse):
    def combine(e1, e2):
        a1, b1 = e1
        a2, b2 = e2
        return a1 * a2, a2 * b1 + b2
    return lax.associative_scan(combine, (a, u), reverse=reverse, axis=1)[1]


def _rglru_direction(xc, w_a, b_a, w_x, b_x, lam, reverse):
    bsz, t, _ = xc.shape
    xb = xc.reshape(bsz, t, LRU_BLOCKS, LRU_BLOCK_DIM)
    r = jax.nn.sigmoid(jnp.einsum('btnj,njk->btnk', xb, w_a).reshape(bsz, t, LRU_WIDTH) + b_a)
    i = jax.nn.sigmoid(jnp.einsum('btnj,njk->btnk', xb, w_x).reshape(bsz, t, LRU_WIDTH) + b_x)
    log_a = LRU_C * r.astype(jnp.float32) * jax.nn.log_sigmoid(lam.astype(jnp.float32))
    a = jnp.exp(log_a)
    mult = jnp.sqrt(-jnp.expm1(2.0 * log_a))
    u = mult * (i * xc).astype(jnp.float32)
    return _linear_scan(a, u, reverse)


def _rglru_branch(xr, gate, conv_w, conv_b, w_a, b_a, w_x, b_x, lam):
    t = xr.shape[1]
    left = LRU_CONV // 2
    xp = jnp.pad(xr, ((0, 0), (left, LRU_CONV - 1 - left), (0, 0)))
    xc = sum(xp[:, j:j + t] * conv_w[j] for j in range(LRU_CONV)) + conv_b
    h = (_rglru_direction(xc, w_a[0], b_a[0], w_x[0], b_x[0], lam[0], False)
         + _rglru_direction(xc, w_a[1], b_a[1], w_x[1], b_x[1], lam[1], True))
    return h.astype(xr.dtype) * jax.nn.gelu(gate)


def _s5_direction(u, a_re, a_im, log_dt, b_re, b_im, c_re, c_im, reverse):
    f32 = jnp.float32
    a_re = a_re.astype(f32)
    a_im = a_im.astype(f32)
    b_re = b_re.astype(f32)
    b_im = b_im.astype(f32)
    dt = jnp.exp(log_dt.astype(f32))[:, None]
    mag = jnp.exp(a_re * dt)
    lb_re = mag * jnp.cos(a_im * dt)
    lb_im = mag * jnp.sin(a_im * dt)
    den = a_re * a_re + a_im * a_im
    n_re = lb_re - 1.0
    n_im = lb_im
    co_re = (n_re * a_re + n_im * a_im) / den
    co_im = (n_im * a_re - n_re * a_im) / den
    bb_re = co_re[..., None] * b_re - co_im[..., None] * b_im
    bb_im = co_re[..., None] * b_im + co_im[..., None] * b_re
    in_re = jnp.einsum('btgh,gph->btgp', u, bb_re)
    in_im = jnp.einsum('btgh,gph->btgp', u, bb_im)
    ar = jnp.broadcast_to(lb_re, in_re.shape)
    ai = jnp.broadcast_to(lb_im, in_re.shape)

    def combine(e1, e2):
        ar1, ai1, br1, bi1 = e1
        ar2, ai2, br2, bi2 = e2
        return (ar1 * ar2 - ai1 * ai2, ar1 * ai2 + ai1 * ar2,
                ar2 * br1 - ai2 * bi1 + br2, ar2 * bi1 + ai2 * br1 + bi2)

    _, _, s_re, s_im = lax.associative_scan(combine, (ar, ai, in_re, in_im), reverse=reverse, axis=1)
    return (jnp.einsum('btgp,ghp->btgh', s_re, c_re.astype(f32))
            - jnp.einsum('btgp,ghp->btgh', s_im, c_im.astype(f32)))


def _s5_branch(xs, a_re, a_im, log_dt, b_re, b_im, c_re, c_im, d, w_glu, b_glu):
    bsz, t, _ = xs.shape
    xf = xs.astype(jnp.float32)
    u = xf.reshape(bsz, t, S5_GROUPS, S5_GROUP)
    y = (_s5_direction(u, a_re[0], a_im[0], log_dt[0], b_re[0], b_im[0], c_re[0], c_im[0], False)
         + _s5_direction(u, a_re[1], a_im[1], log_dt[1], b_re[1], b_im[1], c_re[1], c_im[1], True))
    y = y.reshape(bsz, t, S5_WIDTH) + d.astype(jnp.float32) * xf
    y = jax.nn.gelu(y).astype(xs.dtype)
    return y * jax.nn.sigmoid(y @ w_glu + b_glu)


def _mixer(h, w_in, na_rpb, lru_conv_w, lru_conv_b, lru_w_a, lru_b_a, lru_w_x, lru_b_x, lru_lambda,
           s5_a_re, s5_a_im, s5_log_dt, s5_b_re, s5_b_im, s5_c_re, s5_c_im, s5_d, s5_w_glu, s5_b_glu,
           g_out, w_out):
    z = h @ w_in
    q, k, v, xr, gate, xs = jnp.split(
        z, [NA_WIDTH, 2 * NA_WIDTH, 3 * NA_WIDTH, 3 * NA_WIDTH + LRU_WIDTH, 3 * NA_WIDTH + 2 * LRU_WIDTH], axis=-1)
    ya = _neighbourhood_attention(q, k, v, na_rpb)
    yb = _rglru_branch(xr, gate, lru_conv_w, lru_conv_b, lru_w_a, lru_b_a, lru_w_x, lru_b_x, lru_lambda)
    yc = _s5_branch(xs, s5_a_re, s5_a_im, s5_log_dt, s5_b_re, s5_b_im, s5_c_re, s5_c_im, s5_d, s5_w_glu, s5_b_glu)
    ga, gb, gc = jnp.split(g_out, [NA_WIDTH, NA_WIDTH + LRU_WIDTH])
    y = jnp.concatenate([_rmsnorm(ya, ga), _rmsnorm(yb, gb), _rmsnorm(yc, gc)], axis=-1)
    return y @ w_out


def _trunk(x, norm_mix_g, w_in, na_rpb, lru_conv_w, lru_conv_b, lru_w_a, lru_b_a, lru_w_x, lru_b_x,
           lru_lambda, s5_a_re, s5_a_im, s5_log_dt, s5_b_re, s5_b_im, s5_c_re, s5_c_im, s5_d, s5_w_glu,
           s5_b_glu, g_out, w_out, norm_mlp_g, w_mlp_up, w_mlp_down, final_g):
    for l in range(DEPTH):
        h = _rmsnorm(x, norm_mix_g[l])
        x = x + _mixer(h, w_in[l], na_rpb[l], lru_conv_w[l], lru_conv_b[l], lru_w_a[l], lru_b_a[l],
                       lru_w_x[l], lru_b_x[l], lru_lambda[l], s5_a_re[l], s5_a_im[l], s5_log_dt[l],
                       s5_b_re[l], s5_b_im[l], s5_c_re[l], s5_c_im[l], s5_d[l], s5_w_glu[l], s5_b_glu[l],
                       g_out[l], w_out[l])
        h = _rmsnorm(x, norm_mlp_g[l])
        x = x + jnp.square(jax.nn.relu(h @ w_mlp_up[l])) @ w_mlp_down[l]
    return _rmsnorm(x, final_g)


def setup_inputs(seed: int = 0) -> dict:
    key = jax.random.key(seed)
    ks = jax.random.split(key, 32)
    f32 = jnp.float32
    L = DEPTH

    def nrm(k, shape, scale):
        return jax.random.normal(k, shape, f32) * scale

    x_prompt = nrm(ks[0], (BATCH, SEQ, D_MODEL), 1.0)
    x_sample = nrm(ks[1], (DEC_BATCH, DEC_SEQ, D_MODEL), 1.0)
    norm_mix_g = 1.0 + nrm(ks[2], (L, D_MODEL), 0.02)
    w_in = nrm(ks[3], (L, D_MODEL, IN_WIDTH), D_MODEL ** -0.5)
    na_rpb = nrm(ks[4], (L, NA_HEADS, 2 * NA_KH_MAX - 1, 2 * NA_KW - 1), 0.1)
    lru_conv_w = nrm(ks[5], (L, LRU_CONV, LRU_WIDTH), LRU_CONV ** -0.5)
    lru_conv_b = nrm(ks[6], (L, LRU_WIDTH), 0.01)
    lru_w_a = nrm(ks[7], (L, 2, LRU_BLOCKS, LRU_BLOCK_DIM, LRU_BLOCK_DIM), LRU_BLOCK_DIM ** -0.5)
    lru_b_a = nrm(ks[8], (L, 2, LRU_WIDTH), 0.01)
    lru_w_x = nrm(ks[9], (L, 2, LRU_BLOCKS, LRU_BLOCK_DIM, LRU_BLOCK_DIM), LRU_BLOCK_DIM ** -0.5)
    lru_b_x = nrm(ks[10], (L, 2, LRU_WIDTH), 0.01)
    a_pow = jax.random.uniform(ks[11], (L, 2, LRU_WIDTH), f32, 0.9, 0.999)
    s_l = a_pow ** (1.0 / LRU_C)
    lru_lambda = jnp.log(s_l) - jnp.log1p(-s_l)
    n_idx = jnp.arange(S5_STATE, dtype=f32)
    s5_a_re = -0.5 + nrm(ks[12], (L, 2, S5_GROUPS, S5_STATE), 0.01)
    s5_a_im = math.pi * n_idx + nrm(ks[13], (L, 2, S5_GROUPS, S5_STATE), 0.01)
    s5_log_dt = jax.random.uniform(ks[14], (L, 2, S5_GROUPS), f32, math.log(1e-3), math.log(1e-1))
    s5_b_re = nrm(ks[15], (L, 2, S5_GROUPS, S5_STATE, S5_GROUP), (2 * S5_GROUP) ** -0.5)
    s5_b_im = nrm(ks[16], (L, 2, S5_GROUPS, S5_STATE, S5_GROUP), (2 * S5_GROUP) ** -0.5)
    s5_c_re = nrm(ks[17], (L, 2, S5_GROUPS, S5_GROUP, S5_STATE), (2 * S5_STATE) ** -0.5)
    s5_c_im = nrm(ks[18], (L, 2, S5_GROUPS, S5_GROUP, S5_STATE), (2 * S5_STATE) ** -0.5)
    s5_d = nrm(ks[19], (L, S5_WIDTH), 1.0)
    s5_w_glu = nrm(ks[20], (L, S5_WIDTH, S5_WIDTH), S5_WIDTH ** -0.5)
    s5_b_glu = nrm(ks[21], (L, S5_WIDTH), 0.01)
    g_out = 1.0 + nrm(ks[22], (L, MIX_WIDTH), 0.02)
    w_out = nrm(ks[23], (L, MIX_WIDTH, D_MODEL), MIX_WIDTH ** -0.5)
    norm_mlp_g = 1.0 + nrm(ks[24], (L, D_MODEL), 0.02)
    w_mlp_up = nrm(ks[25], (L, D_MODEL, D_FF), D_MODEL ** -0.5)
    w_mlp_down = nrm(ks[26], (L, D_FF, D_MODEL), D_FF ** -0.5)
    final_g = 1.0 + nrm(ks[27], (D_MODEL,), 0.02)
    return {'x_prompt': x_prompt, 'x_sample': x_sample, 'norm_mix_g': norm_mix_g, 'w_in': w_in,
            'na_rpb': na_rpb, 'lru_conv_w': lru_conv_w, 'lru_conv_b': lru_conv_b, 'lru_w_a': lru_w_a,
            'lru_b_a': lru_b_a, 'lru_w_x': lru_w_x, 'lru_b_x': lru_b_x, 'lru_lambda': lru_lambda,
            's5_a_re': s5_a_re, 's5_a_im': s5_a_im, 's5_log_dt': s5_log_dt, 's5_b_re': s5_b_re,
            's5_b_im': s5_b_im, 's5_c_re': s5_c_re, 's5_c_im': s5_c_im, 's5_d': s5_d,
            's5_w_glu': s5_w_glu, 's5_b_glu': s5_b_glu, 'g_out': g_out, 'w_out': w_out,
            'norm_mlp_g': norm_mlp_g, 'w_mlp_up': w_mlp_up, 'w_mlp_down': w_mlp_down, 'final_g': final_g}


def reference(x_prompt, x_sample, norm_mix_g, w_in, na_rpb, lru_conv_w, lru_conv_b, lru_w_a, lru_b_a,
              lru_w_x, lru_b_x, lru_lambda, s5_a_re, s5_a_im, s5_log_dt, s5_b_re, s5_b_im, s5_c_re,
              s5_c_im, s5_d, s5_w_glu, s5_b_glu, g_out, w_out, norm_mlp_g, w_mlp_up, w_mlp_down, final_g):
    weights = (norm_mix_g, w_in, na_rpb, lru_conv_w, lru_conv_b, lru_w_a, lru_b_a, lru_w_x, lru_b_x,
               lru_lambda, s5_a_re, s5_a_im, s5_log_dt, s5_b_re, s5_b_im, s5_c_re, s5_c_im, s5_d,
               s5_w_glu, s5_b_glu, g_out, w_out, norm_mlp_g, w_mlp_up, w_mlp_down, final_g)
    y_prompt = _trunk(x_prompt, *weights)
    y_sample = _trunk(x_sample, *weights)
    return (y_prompt, y_sample)
```

```cpp
#include <hip/hip_runtime.h>
#include <cstdio>
#include <cstdint>
namespace pg8 {
#define PG8_LAS __attribute__((address_space(3)))
typedef unsigned short bf16_t;
typedef short bf16x8 __attribute__((ext_vector_type(8)));
typedef float f32x4 __attribute__((ext_vector_type(4)));
typedef unsigned u32x4 __attribute__((ext_vector_type(4)));
constexpr int BM = 256, BK = 64, HALF = 128, HTB = HALF * BK * 2  , STAGE_BYTES = 8 * HTB, NXCD = 8, WGM = 8;

__host__ __device__ __forceinline__ int lds_byte(int r, int c) { const int st = (r >> 4) * 2 + (c >> 5), rr = r & 15, cc = c & 31, ob = rr * 64 + cc * 2; return st * 1024 + (ob ^ (((ob >> 9) & 1) << 5)); }
__host__ __device__ __forceinline__ void stage_rc(int b, int& R, int& C) { const int st = b / 1024, sb = b % 1024, swz = sb ^ (((sb >> 9) & 1) << 5); R = (st >> 1) * 16 + swz / 64; C = (st & 1) * 32 + (swz % 64) / 2; }
__host__ __device__ __forceinline__ int perm32(int rho) { const int n = rho >> 4, i = rho & 15; return 8 * (i >> 2) + 4 * n + (i & 3); }

struct Unit { int pm, pn; };
struct Gemm { const bf16_t* A; const bf16_t* Bt; int M, N, K; };

struct StaticOrder {
    int nM, nN, nwg, G, c;
    __host__ __device__ void init(int M, int N, int G_, int c_) { nM = M / BM; nN = N / BM; nwg = nM * nN; G = G_; c = c_; }
    __host__ __device__ bool next(int i, Unit& u) const {
        const long L = (long)i * G + c; if (L >= nwg) return false;
        int wgid = (int)L; { const int q = nwg / NXCD, r = nwg % NXCD, xcd = wgid % NXCD, off = wgid / NXCD; wgid = (xcd < r ? xcd * (q + 1) : r * (q + 1) + (xcd - r) * q) + off; }
        const int nig = WGM * nN, gid = wgid / nig, fm = gid * WGM, gsz = (nM - fm) < WGM ? (nM - fm) : WGM;
        u.pm = fm + ((wgid % nig) % gsz); u.pn = (wgid % nig) / gsz; return true;
    }
    __device__ __forceinline__ void a_ready(const Unit&) const {}
    __device__ __forceinline__ void done(const Unit&) const {}
};
__device__ __forceinline__ unsigned cvt_pk_bf16(float lo, float hi) { unsigned r; asm volatile("v_cvt_pk_bf16_f32 %0, %1, %2" : "=v"(r) : "v"(lo), "v"(hi)); return r; }
template <int ACT> struct EpiBf16 {
    static constexpr bool PERM = true, AFTER_DRAIN = false, HAS_PRE = true;
    bf16_t* O; int ldc; const unsigned long long* SS; PG8_LAS float* tbl;
    template <class Sched> __device__ __forceinline__ void pre_all(const Sched& S, int tid) const {
        unsigned long long v[12]; Unit u;
#pragma unroll
        for (int i = 0; i < 12; ++i) { v[i] = 0ull; if (S.next(i, u)) v[i] = SS[u.pm * BM + (tid & 255)]; }
#pragma unroll
        for (int i = 0; i < 12; ++i) if (tid < 256 && S.next(i, u)) tbl[i * 256 + tid] = 1.f / sqrtf((float)v[i] * (1.f / 1048576.f / 2048.f) + 1e-6f);
    }
    __device__ __forceinline__ void operator()(const f32x4 (&acc)[2][2][4][2], const Unit& u, int wr, int wc, int fr, int fq, int slot) const {
        const int row0 = u.pm * BM + wr * 64 + fr; const int col0 = u.pn * BM + wc * 64 + 8 * fq;
        const unsigned ta = (unsigned)(size_t)(tbl + slot * 256 + wr * 64 + fr);
        float rs[2][4];
#pragma unroll
        for (int ai = 0; ai < 2; ++ai)
#pragma unroll
            for (int m = 0; m < 4; ++m) asm volatile("ds_read_b32 %0, %1 offset:%2" : "=v"(rs[ai][m]) : "v"(ta), "i"((ai * HALF + m * 16) * 4));
        asm volatile("s_waitcnt lgkmcnt(0)" : "+v"(rs[0][0]), "+v"(rs[0][1]), "+v"(rs[0][2]), "+v"(rs[0][3]), "+v"(rs[1][0]), "+v"(rs[1][1]), "+v"(rs[1][2]), "+v"(rs[1][3]));
#pragma unroll
        for (int ai = 0; ai < 2; ++ai)
#pragma unroll
            for (int m = 0; m < 4; ++m) { bf16_t* rowp = O + (size_t)(row0 + ai * HALF + m * 16) * ldc + col0; const float r = rs[ai][m];
#pragma unroll
                for (int bj = 0; bj < 2; ++bj) { f32x4 v0 = acc[ai][bj][m][0] * r, v1 = acc[ai][bj][m][1] * r;
                    if (ACT == 1) {
#pragma unroll
                        for (int j = 0; j < 4; ++j) { const float a = fmaxf(v0[j], 0.f), b = fmaxf(v1[j], 0.f); v0[j] = a * a; v1[j] = b * b; } }
                    u32x4 w; w.x = cvt_pk_bf16(v0[0], v0[1]); w.y = cvt_pk_bf16(v0[2], v0[3]); w.z = cvt_pk_bf16(v1[0], v1[1]); w.w = cvt_pk_bf16(v1[2], v1[3]);
                    *(u32x4*)(rowp + bj * 32) = w; } }
    }
};
struct EpiResid {
    static constexpr bool PERM = true, AFTER_DRAIN = false, HAS_PRE = false;
    const float* Xin0; const float* Xin1; int split; float* Xout; int ldc; bf16_t* XB; unsigned long long* SS;
    __device__ __forceinline__ void operator()(const f32x4 (&acc)[2][2][4][2], const Unit& u, int wr, int wc, int fr, int fq, int) const {
        const int row0 = u.pm * BM + wr * 64 + fr, col0 = u.pn * BM + wc * 64 + 8 * fq;
        const float* Xin = (u.pm * BM < split) ? Xin0 : Xin1 - (size_t)split * ldc;
#pragma unroll
        for (int am = 0; am < 4; ++am) { const int ai = am >> 1, m0 = (am & 1) * 2;
            f32x4 xf[2][2][2]; u32x4 xr[2][2];
            if (Xin0) {
#pragma unroll
                for (int mm = 0; mm < 2; ++mm) { const size_t ro = (size_t)(row0 + ai * HALF + (m0 + mm) * 16) * ldc + col0;
#pragma unroll
                    for (int bj = 0; bj < 2; ++bj) { xf[mm][bj][0] = *(const f32x4*)(Xin + ro + bj * 32); xf[mm][bj][1] = *(const f32x4*)(Xin + ro + bj * 32 + 4); } }
            } else {
#pragma unroll
                for (int mm = 0; mm < 2; ++mm)
#pragma unroll
                    for (int bj = 0; bj < 2; ++bj) xr[mm][bj] = *(const u32x4*)(XB + (size_t)(row0 + ai * HALF + (m0 + mm) * 16) * ldc + col0 + bj * 32);
            }
            asm volatile("" ::: "memory");
#pragma unroll
            for (int mm = 0; mm < 2; ++mm) { const int m = m0 + mm; const int row = row0 + ai * HALF + m * 16; const size_t ro = (size_t)row * ldc + col0; float ss = 0.f;
#pragma unroll
                for (int bj = 0; bj < 2; ++bj) { f32x4 x0, x1;
                    if (Xin0) { x0 = xf[mm][bj][0]; x1 = xf[mm][bj][1]; }
                    else { const u32x4 w = xr[mm][bj];
                        x0 = (f32x4){__uint_as_float(w.x << 16), __uint_as_float(w.x & 0xffff0000u), __uint_as_float(w.y << 16), __uint_as_float(w.y & 0xffff0000u)};
                        x1 = (f32x4){__uint_as_float(w.z << 16), __uint_as_float(w.z & 0xffff0000u), __uint_as_float(w.w << 16), __uint_as_float(w.w & 0xffff0000u)}; }
                    x0 = x0 + acc[ai][bj][m][0]; x1 = x1 + acc[ai][bj][m][1];
                    if (Xout) { *(f32x4*)(Xout + ro + bj * 32) = x0; *(f32x4*)(Xout + ro + bj * 32 + 4) = x1; }
                    else { u32x4 w; w.x = cvt_pk_bf16(x0[0], x0[1]); w.y = cvt_pk_bf16(x0[2], x0[3]); w.z = cvt_pk_bf16(x1[0], x1[1]); w.w = cvt_pk_bf16(x1[2], x1[3]); *(u32x4*)(XB + ro + bj * 32) = w;
#pragma unroll
                        for (int j = 0; j < 4; ++j) { const float lo = __uint_as_float(w[j] << 16), hi = __uint_as_float(w[j] & 0xffff0000u); ss += lo * lo + hi * hi; } } }
                if (!Xout) { ss += __shfl_xor(ss, 16); ss += __shfl_xor(ss, 32); if (fq == 0) atomicAdd(SS + row, (unsigned long long)(ss * 1048576.f + 0.5f)); } }
            asm volatile("" ::: "memory");
        }
    }
};
struct EpiGlu {
    static constexpr bool PERM = true, AFTER_DRAIN = false, HAS_PRE = false;
    const bf16_t* YG; bf16_t* Y; const float* bias; int ldy; int ycol0;
    __device__ __forceinline__ void operator()(const f32x4 (&acc)[2][2][4][2], const Unit& u, int wr, int wc, int fr, int fq, int) const {
        const int row0 = u.pm * BM + wr * 64 + fr; const int col0 = u.pn * BM + wc * 64 + 8 * fq;
        f32x4 bb[2][2];
#pragma unroll
        for (int bj = 0; bj < 2; ++bj) { bb[bj][0] = *(const f32x4*)(bias + col0 + bj * 32); bb[bj][1] = *(const f32x4*)(bias + col0 + bj * 32 + 4); }
#pragma unroll
        for (int ai = 0; ai < 2; ++ai) {
            u32x4 gl[4][2];
#pragma unroll
            for (int m = 0; m < 4; ++m)
#pragma unroll
                for (int bj = 0; bj < 2; ++bj) gl[m][bj] = *(const u32x4*)(YG + (size_t)(row0 + ai * HALF + m * 16) * 512 + col0 + bj * 32);
            asm volatile("" ::: "memory");
#pragma unroll
            for (int m = 0; m < 4; ++m) { const int row = row0 + ai * HALF + m * 16;
#pragma unroll
                for (int bj = 0; bj < 2; ++bj) { const int col = col0 + bj * 32; const u32x4 g = gl[m][bj];
                    const f32x4 v0 = acc[ai][bj][m][0] + bb[bj][0], v1 = acc[ai][bj][m][1] + bb[bj][1];
                    float o[8];
#pragma unroll
                    for (int j = 0; j < 4; ++j) { const unsigned gw0 = g[j >> 1], gw1 = g[2 + (j >> 1)];
                        const float y0 = __uint_as_float((j & 1) ? (gw0 & 0xffff0000u) : (gw0 << 16)), y1 = __uint_as_float((j & 1) ? (gw1 & 0xffff0000u) : (gw1 << 16));
                        o[j] = y0 * __builtin_amdgcn_rcpf(1.f + __expf(-v0[j])); o[4 + j] = y1 * __builtin_amdgcn_rcpf(1.f + __expf(-v1[j])); }
                    u32x4 w; w.x = cvt_pk_bf16(o[0], o[1]); w.y = cvt_pk_bf16(o[2], o[3]); w.z = cvt_pk_bf16(o[4], o[5]); w.w = cvt_pk_bf16(o[6], o[7]);
                    *(u32x4*)(Y + (size_t)row * ldy + ycol0 + col) = w; } }
            asm volatile("" ::: "memory");
        }
    }
};

template <class Epi, class Sched, bool ALIGN_EPI = false, bool SP2 = false>
__device__ __forceinline__ void gemm_phase(PG8_LAS unsigned char* lds, const Gemm g, const Sched& S, const Epi& E) {
    int tid_ = threadIdx.x; asm volatile("" : "+v"(tid_));
    const int tid = tid_, wid = __builtin_amdgcn_readfirstlane(tid >> 6), lane = tid & 63, wr = wid >> 2, wc = wid & 3, fr = lane & 15, fq = lane >> 4;
    const int K = g.K, nt = K / BK;
    unsigned voffA[2], voffB[2];
#pragma unroll
    for (int i = 0; i < 2; ++i) { int R, C; stage_rc(tid * 16 + i * 8192, R, C); const int Rb = Epi::PERM ? (64 * (R >> 5) + perm32(R & 31)) : R;
        voffA[i] = (unsigned)(R * K + C) * 2u; voffB[i] = (unsigned)(Rb * K + C) * 2u; }
    const size_t kstep = (size_t)(BK * 2);
    const size_t hstep = (size_t)HALF * K * 2;
    const size_t hstepB = Epi::PERM ? (size_t)32 * K * 2 : hstep;
    const size_t tstep = 2 * hstep;
    const unsigned ldsw = (unsigned)wid * 1024u;
    const int aoff = lds_byte(wr * 64 + fr, fq * 8), boff = lds_byte(wc * 32 + fr, fq * 8);
#define PG8_SA(b, h) (((b) * 2 + (h)) * HTB)
#define PG8_SB(b, h) ((4 + (b) * 2 + (h)) * HTB)
#define PG8_STAGE(bufoff, gbase, voff) do { _Pragma("unroll") for (int _i = 0; _i < 2; ++_i) \
        __builtin_amdgcn_global_load_lds((const unsigned*)((const char*)(gbase) + (voff)[_i]), (PG8_LAS unsigned*)(lds + (bufoff) + ldsw + _i * 8192), 16, 0, 0); } while (0)
#define PG8_LDA(dst, b, h) do { _Pragma("unroll") for (int m = 0; m < 4; ++m) _Pragma("unroll") for (int k = 0; k < 2; ++k) dst[m][k] = *(const PG8_LAS bf16x8*)(lds + PG8_SA(b, h) + aoff + m * 2048 + k * 1024); } while (0)
#define PG8_LDB(dst, b, h) do { _Pragma("unroll") for (int n = 0; n < 2; ++n) _Pragma("unroll") for (int k = 0; k < 2; ++k) dst[n][k] = *(const PG8_LAS bf16x8*)(lds + PG8_SB(b, h) + boff + n * 2048 + k * 1024); } while (0)
#define PG8_MMA(ai, bj, At, Bt) do { __builtin_amdgcn_s_setprio(1); _Pragma("unroll") for (int m = 0; m < 4; ++m) _Pragma("unroll") for (int n = 0; n < 2; ++n) _Pragma("unroll") for (int k = 0; k < 2; ++k) \
        acc[ai][bj][m][n] = __builtin_amdgcn_mfma_f32_16x16x32_bf16(Bt[n][k], At[m][k], acc[ai][bj][m][n], 0, 0, 0); __builtin_amdgcn_s_setprio(0); } while (0)
#define PG8_WAIT_V(n) asm volatile("s_waitcnt vmcnt(" #n ")" ::: "memory")
#define PG8_WAIT_L(n) asm volatile("s_waitcnt lgkmcnt(" #n ")" ::: "memory")
#define PG8_BAR __builtin_amdgcn_s_barrier()
#define PG8_SCHED __builtin_amdgcn_sched_barrier(0)
    Unit cur, nxt; int ui = 0;
    if (!S.next(0, cur)) return;
    if constexpr (Epi::HAS_PRE) E.pre_all(S, tid);
    f32x4 acc[2][2][4][2];
#pragma unroll
    for (int a = 0; a < 2; ++a)
#pragma unroll
        for (int b = 0; b < 2; ++b)
#pragma unroll
            for (int m = 0; m < 4; ++m)
#pragma unroll
                for (int n = 0; n < 2; ++n) acc[a][b][m][n] = (f32x4){0.f, 0.f, 0.f, 0.f};
    bf16x8 At[4][2], B0[2][2], B1[2][2];
    const char* cA = (const char*)g.A + (size_t)cur.pm * tstep; const char* cB = (const char*)g.Bt + (size_t)cur.pn * tstep;
    S.a_ready(cur);
    if constexpr (SP2) {
        PG8_STAGE(PG8_SB(0, 0), cB, voffB); PG8_STAGE(PG8_SB(0, 1), cB + hstepB, voffB); PG8_STAGE(PG8_SA(0, 0), cA, voffA); PG8_STAGE(PG8_SA(0, 1), cA + hstep, voffA);
        if (wr == 1) PG8_BAR;
        PG8_WAIT_V(2); PG8_BAR;
        PG8_STAGE(PG8_SB(1, 0), cB + kstep, voffB); PG8_STAGE(PG8_SA(1, 0), cA + kstep, voffA); PG8_STAGE(PG8_SB(1, 1), cB + hstepB + kstep, voffB);
        PG8_WAIT_V(6); PG8_BAR;
    } else {
        PG8_STAGE(PG8_SB(0, 0), cB, voffB); PG8_STAGE(PG8_SA(0, 0), cA, voffA); PG8_STAGE(PG8_SB(0, 1), cB + hstepB, voffB); PG8_STAGE(PG8_SA(0, 1), cA + hstep, voffA);
        if (wr == 1) PG8_BAR;
        PG8_WAIT_V(4); PG8_BAR;
        PG8_STAGE(PG8_SB(1, 0), cB + kstep, voffB); PG8_STAGE(PG8_SA(1, 0), cA + kstep, voffA); PG8_STAGE(PG8_SB(1, 1), cB + hstepB + kstep, voffB);
        PG8_WAIT_V(6); PG8_BAR;
    }
    for (;;) {
        const bool has_next = S.next(ui + 1, nxt);
        const char* nA = has_next ? (const char*)g.A + (size_t)nxt.pm * tstep : cA; const char* nB = has_next ? (const char*)g.Bt + (size_t)nxt.pn * tstep : cB;
        for (int t = 0; t < nt; t += 2) {
            const bool last = (t == nt - 2);
            const char* a1 = cA + (size_t)(t + 1) * kstep;
            const char* a2 = last ? nA : cA + (size_t)(t + 2) * kstep; const char* b2 = last ? nB : cB + (size_t)(t + 2) * kstep;
            const char* a3 = a2 + kstep; const char* b3 = b2 + kstep;
            if (last && has_next) S.a_ready(nxt);
            if constexpr (SP2) {
            PG8_LDB(B0, 0, 0); PG8_LDB(B1, 0, 1); PG8_SCHED; PG8_LDA(At, 0, 0); PG8_STAGE(PG8_SA(1, 1), a1 + hstep, voffA);
            PG8_WAIT_V(8); PG8_WAIT_L(0); PG8_BAR; PG8_MMA(0, 0, At, B0); PG8_MMA(0, 1, At, B1); PG8_BAR; PG8_SCHED;
            PG8_LDA(At, 0, 1); PG8_STAGE(PG8_SB(0, 0), b2, voffB); PG8_STAGE(PG8_SB(0, 1), b2 + hstepB, voffB); PG8_STAGE(PG8_SA(0, 0), a2, voffA);
            PG8_WAIT_V(8); PG8_WAIT_L(0); PG8_BAR; PG8_MMA(1, 0, At, B0); PG8_MMA(1, 1, At, B1); PG8_BAR; PG8_SCHED;
            PG8_LDB(B0, 1, 0); PG8_LDB(B1, 1, 1); PG8_SCHED; PG8_LDA(At, 1, 0); PG8_STAGE(PG8_SA(0, 1), a2 + hstep, voffA);
            PG8_WAIT_V(8); PG8_WAIT_L(0); PG8_BAR; PG8_MMA(0, 0, At, B0); PG8_MMA(0, 1, At, B1); PG8_BAR; PG8_SCHED;
            PG8_LDA(At, 1, 1); PG8_STAGE(PG8_SB(1, 0), b3, voffB); PG8_STAGE(PG8_SB(1, 1), b3 + hstepB, voffB); PG8_STAGE(PG8_SA(1, 0), a3, voffA);
            PG8_WAIT_V(8); PG8_WAIT_L(0); PG8_BAR; PG8_MMA(1, 0, At, B0); PG8_MMA(1, 1, At, B1); PG8_BAR; PG8_SCHED;
            } else {
            PG8_LDB(B0, 0, 0); PG8_SCHED; PG8_LDA(At, 0, 0); PG8_STAGE(PG8_SA(1, 1), a1 + hstep, voffA);
            PG8_WAIT_L(8); PG8_BAR; PG8_WAIT_L(0); PG8_MMA(0, 0, At, B0); PG8_BAR; PG8_SCHED;
            PG8_LDB(B1, 0, 1); PG8_STAGE(PG8_SB(0, 0), b2, voffB);
            PG8_BAR; PG8_WAIT_L(0); PG8_MMA(0, 1, At, B1); PG8_BAR;
            PG8_LDA(At, 0, 1); PG8_STAGE(PG8_SA(0, 0), a2, voffA);
            PG8_BAR; PG8_WAIT_L(0); PG8_MMA(1, 0, At, B0); PG8_BAR; PG8_SCHED;
            PG8_STAGE(PG8_SB(0, 1), b2 + hstepB, voffB);
            PG8_WAIT_V(6); PG8_BAR; PG8_MMA(1, 1, At, B1); PG8_BAR;
            PG8_LDB(B0, 1, 0); PG8_SCHED; PG8_LDA(At, 1, 0); PG8_STAGE(PG8_SA(0, 1), a2 + hstep, voffA);
            PG8_WAIT_L(8); PG8_BAR; PG8_WAIT_L(0); PG8_MMA(0, 0, At, B0); PG8_BAR; PG8_SCHED;
            PG8_LDB(B1, 1, 1); PG8_STAGE(PG8_SB(1, 0), b3, voffB);
            PG8_BAR; PG8_WAIT_L(0); PG8_MMA(0, 1, At, B1); PG8_BAR;
            PG8_LDA(At, 1, 1); PG8_STAGE(PG8_SA(1, 0), a3, voffA);
            PG8_BAR; PG8_WAIT_L(0); PG8_MMA(1, 0, At, B0); PG8_BAR; PG8_SCHED;
            PG8_STAGE(PG8_SB(1, 1), b3 + hstepB, voffB);
            PG8_WAIT_V(6); PG8_BAR; PG8_MMA(1, 1, At, B1); PG8_BAR;
            }
        }
        if constexpr (ALIGN_EPI) { if (wr == 0) PG8_BAR; }
        if constexpr (!Epi::AFTER_DRAIN) { E(acc, cur, wr, wc, fr, fq, ui); S.done(cur); }
        if (!has_next) break;
#pragma unroll
        for (int a = 0; a < 2; ++a)
#pragma unroll
            for (int b = 0; b < 2; ++b)
#pragma unroll
                for (int m = 0; m < 4; ++m)
#pragma unroll
                    for (int n = 0; n < 2; ++n) acc[a][b][m][n] = (f32x4){0.f, 0.f, 0.f, 0.f};
        cur = nxt; cA = nA; cB = nB; ++ui;
        if constexpr (ALIGN_EPI) { if (wr == 1) PG8_BAR; }
    }
    PG8_WAIT_V(0);
    if constexpr (!ALIGN_EPI) { if (wr == 0) PG8_BAR; }
    PG8_BAR;
    if constexpr (Epi::AFTER_DRAIN) { E.fused(acc, cur, wr, wc, fr, fq, lds, wid, lane); S.done(cur); }
#undef PG8_SA
#undef PG8_SB
#undef PG8_STAGE
#undef PG8_LDA
#undef PG8_LDB
#undef PG8_MMA
#undef PG8_WAIT_V
#undef PG8_WAIT_L
#undef PG8_BAR
#undef PG8_SCHED
}
}

#ifndef MK_ONE_LAUNCH
#define MK_ONE_LAUNCH 1
#endif
#ifndef PROBE_GN2
#define PROBE_GN2 0
#endif
#ifndef PROBE_FIN2
#define PROBE_FIN2 0
#endif
#ifndef PROBE_CAR2
#define PROBE_CAR2 0
#endif
#ifndef PROBE_BAR2
#define PROBE_BAR2 0
#endif
#ifndef PROBE_WIN2
#define PROBE_WIN2 0
#endif
#ifndef PROBE_GLU2
#define PROBE_GLU2 0
#endif
#ifndef PROBE_WOUT2
#define PROBE_WOUT2 0
#endif
#ifndef PROBE_DN2
#define PROBE_DN2 0
#endif
#ifndef PROBE_UP2
#define PROBE_UP2 0
#endif
#ifndef PROBE_PRO2
#define PROBE_PRO2 0
#endif
#ifndef PROBE_NA2
#define PROBE_NA2 0
#endif
#ifndef PROBE_SCAN2
#define PROBE_SCAN2 0
#endif
constexpr int NWAVES = 8, NTHR = 512;
constexpr int DM = 2048, NTOK = 40960, ZW = 4608, DFF = 8192, DEPTH = 4;
constexpr int ZK = 1024, ZV = 2048, ZXR = 3072, ZGT = 3584, ZXS = 4096;
constexpr int MLPC = 8192, NMLPC = NTOK / MLPC;
constexpr int LCH = 32, NLCH = NTOK / LCH;
constexpr int SCH = 64, NSCH = NTOK / SCH;
constexpr float EPS = 1e-6f;
constexpr int PH_PER_LAYER = 14, NPHASE = DEPTH * PH_PER_LAYER + 1;

constexpr size_t MiB = 1u << 20;
constexpr size_t WS_CTL = 0, CTL_ZERO_BYTES = 2 * MiB;
constexpr size_t WS_SS = 65536;
constexpr size_t WS_WIN = 2 * MiB, WS_WOUT = 20 * MiB, WS_WUP = 28 * MiB, WS_WDN = 60 * MiB, WS_WGLU = 92 * MiB;
constexpr size_t WS_TLB = 93 * MiB;
constexpr size_t WS_TBB = 93 * MiB + 65536;
constexpr size_t WS_H = 96 * MiB;
constexpr size_t WS_Z = 256 * MiB;
constexpr size_t WS_Y = 616 * MiB;
constexpr size_t WS_YG = 776 * MiB;
constexpr size_t WS_HF = 816 * MiB;
constexpr size_t WS_TBBF = 94 * MiB;
constexpr size_t WS_TCF = 94 * MiB + 524288;
constexpr size_t WS_TWF = 95 * MiB;
constexpr size_t WS_LAGG = 896 * MiB;
constexpr size_t WS_LCIN = 906 * MiB;
constexpr size_t WS_SEND = 912 * MiB;
constexpr size_t WS_SCIN = 932 * MiB;
constexpr size_t WS_SSQ = 952 * MiB, SSQ_BYTES = (size_t)DEPTH * 2 * NTOK * 8;
constexpr size_t WS_END = 956 * MiB;
constexpr int CW_BAR = 4096;

constexpr int RING_OFF = 0, RING_BYTES = 131072;
constexpr int XTRA_OFF = RING_BYTES, XTRA_BYTES = 12288;
constexpr int LDSCTL_OFF = 163840 - 1024, MISC_OFF = LDSCTL_OFF + 320;
constexpr int LDS_BYTES = 163840;
static_assert(MISC_OFF + 128 <= LDS_BYTES, "LDS map");

#define GAS __attribute__((address_space(1)))
#define LAS __attribute__((address_space(3)))
typedef unsigned short bf16;
typedef unsigned v4u __attribute__((ext_vector_type(4)));
typedef unsigned v2u __attribute__((ext_vector_type(2)));
typedef float f32x4 __attribute__((ext_vector_type(4)));
typedef float f32x2 __attribute__((ext_vector_type(2)));
#define LDS_WAIT() asm volatile("s_waitcnt lgkmcnt(0)" ::: "memory")
#define VM_WAIT() asm volatile("s_waitcnt vmcnt(0)" ::: "memory")
__device__ __forceinline__ unsigned f2bf(float f) { unsigned u = __builtin_bit_cast(unsigned, f); return (u + 0x7fffu + ((u >> 16) & 1u)) >> 16; }
typedef __bf16 bf16x2_t __attribute__((ext_vector_type(2)));
__device__ __forceinline__ unsigned pk2(float lo, float hi) { const f32x2 v = {lo, hi}; return __builtin_bit_cast(unsigned, __builtin_convertvector(v, bf16x2_t)); }
__device__ __forceinline__ unsigned pk2s(float lo, float hi) { return f2bf(lo) | (f2bf(hi) << 16); }
__device__ __forceinline__ float frcp(float x) { return __builtin_amdgcn_rcpf(x); }
__device__ __forceinline__ float fsqrt_(float x) { return __builtin_amdgcn_sqrtf(x); }
__device__ __forceinline__ float bf2f(unsigned b) { return __builtin_bit_cast(float, b << 16); }
__device__ __forceinline__ float bflo(unsigned w) { return __builtin_bit_cast(float, w << 16); }
__device__ __forceinline__ float bfhi(unsigned w) { return __builtin_bit_cast(float, w & 0xffff0000u); }
__device__ __forceinline__ float wave_sum(float v) {
#pragma unroll
    for (int o = 1; o < 64; o <<= 1) v += __shfl_xor(v, o);
    return v;
}
__device__ __forceinline__ float wave_max(float v) {
#pragma unroll
    for (int o = 1; o < 64; o <<= 1) v = fmaxf(v, __shfl_xor(v, o));
    return v;
}
__device__ __forceinline__ float sigmoidf_(float x) { return frcp(1.f + __expf(-x)); }
__device__ __forceinline__ float gelu_tanh(float x) { const float y = 0.7978845608028654f * (x + 0.044715f * x * x * x); const float e = __expf(2.f * y); return x - x * frcp(e + 1.f); }
__device__ __forceinline__ void seq_of(int tok, int& s0, int& T) { if (tok < 8192) { s0 = tok & ~2047; T = 2048; } else { s0 = 8192 + ((tok - 8192) & ~16383); T = 16384; } }

#define XB_TMO      128
#define XB_XCNT(j)  (256  + 64 * (j))
#define XB_XSUB(j)  (1280 + 64 * (j))
#define XB_XGEN(j)  (2304 + 64 * (j))
#define XB_TOP      3328
#define XB_TOPGEN   3392
#define XCD_BAR_WORDS 3456
#define XB_SPIN_CAP (1u << 18)

__device__ __forceinline__ unsigned xb_ld(unsigned* p)              { return __hip_atomic_load(p, __ATOMIC_RELAXED, __HIP_MEMORY_SCOPE_AGENT); }
__device__ __forceinline__ unsigned xb_add(unsigned* p, unsigned v) { return __hip_atomic_fetch_add(p, v, __ATOMIC_RELAXED, __HIP_MEMORY_SCOPE_AGENT); }
__device__ __forceinline__ unsigned xb_xcc_id() { return (unsigned)__builtin_amdgcn_s_getreg((3 << 11) | 20) & 0xFu; }
#define XB_SPIN(cond, bar) do { unsigned _sp = 0; while (cond) { __builtin_amdgcn_s_sleep(1); \
    if ((++_sp & 255u) == 0u) { if (xb_ld(&(bar)[XB_TMO])) break; if (_sp > XB_SPIN_CAP) { atomicAdd(&(bar)[XB_TMO], 1u); break; } } } } while (0)

struct XcdBarrier {
    unsigned* bar; unsigned x;
    volatile LAS unsigned* st;
};

__device__ __forceinline__ XcdBarrier xcd_barrier_post(unsigned* bar, volatile LAS unsigned* st) {
    XcdBarrier b; b.bar = bar; b.x = xb_xcc_id(); b.st = st;
    if (threadIdx.x == 0) (void)xb_add(&bar[XB_XCNT(b.x)], 1u);
    return b;
}
__device__ __forceinline__ void xcd_barrier_complete(unsigned* bar, unsigned x, unsigned& nloc, unsigned& nx) {
    const unsigned G = gridDim.x * gridDim.y * gridDim.z;
    unsigned sum, cnt, mine, sp = 0u;
    for (;;) {
        sum = 0u; cnt = 0u; mine = 0u;
#pragma unroll
        for (unsigned j = 0; j < 16; ++j) { const unsigned c = xb_ld(&bar[XB_XCNT(j)]); sum += c; cnt += (c > 0u) ? 1u : 0u; mine = (j == x) ? c : mine; }
        if (sum == G) break;
        __builtin_amdgcn_s_sleep(1);
        if ((++sp & 255u) == 0u) { if (xb_ld(&bar[XB_TMO])) break; if (sp > XB_SPIN_CAP) { atomicAdd(&bar[XB_TMO], 1u); break; } }
    }
    nloc = mine > 0u ? mine : 1u; nx = cnt > 0u ? cnt : 1u;
}

__device__ __forceinline__ void xcd_barrier(const XcdBarrier& b) {
    asm volatile("s_waitcnt vmcnt(0)" ::: "memory");
    __syncthreads();
    if (threadIdx.x == 0) {
        unsigned* bar = b.bar;
        __builtin_amdgcn_s_waitcnt(0);
        unsigned nloc = b.st[0], nx = b.st[1];
        if (nloc == 0u) { xcd_barrier_complete(bar, b.x, nloc, nx); b.st[0] = nloc; b.st[1] = nx; }
        const unsigned old = xb_add(&bar[XB_XSUB(b.x)], 1u);
        const unsigned gen = old / nloc;
        if (old + 1u == (gen + 1u) * nloc) {
            __builtin_amdgcn_fence(__ATOMIC_RELEASE, "agent");
            asm volatile("s_waitcnt vmcnt(0)" ::: "memory");
            const unsigned og = xb_add(&bar[XB_TOP], 1u);
            const unsigned tg = og / nx;
            if (og + 1u == (tg + 1u) * nx) xb_add(&bar[XB_TOPGEN], 1u);
            else XB_SPIN(xb_ld(&bar[XB_TOPGEN]) == tg, bar);
            __builtin_amdgcn_fence(__ATOMIC_ACQUIRE, "agent");
            xb_add(&bar[XB_XGEN(b.x)], 1u);
            asm volatile("s_waitcnt vmcnt(0)" ::: "memory");
        } else {
            XB_SPIN(xb_ld(&bar[XB_XGEN(b.x)]) == gen, bar);
            __builtin_amdgcn_fence(__ATOMIC_ACQUIRE, "agent");
            asm volatile("s_waitcnt vmcnt(0)" ::: "memory");
        }
    }
    __syncthreads();
}


struct Args { const float* in[28]; float* out; unsigned char* ws; int ph_lo, ph_hi; };
struct Frame {
    LAS unsigned char* lds; unsigned char* ldsg;
    int tid, lane, wave, vcu, G;
};
enum { I_XP = 0, I_XS, I_NMG, I_WIN, I_RPB, I_CW, I_CB, I_LWA, I_LBA, I_LWX, I_LBX, I_LAM, I_ARE, I_AIM, I_LDT, I_BRE, I_BIM, I_CRE, I_CIM, I_SD, I_WGLU, I_BGLU, I_GOUT, I_WOUT, I_NLG, I_WUP, I_WDN, I_FING };

__device__ __forceinline__ void transpose_item(const float* W, int K, int N, bf16* WT, LAS float* scr, int item, int lane, const float* gk) {
    const int nblk = N / 32, kb = item / nblk, nb = item % nblk, k0 = 64 * kb, n0 = 32 * nb;
    float wv[32];
#pragma unroll
    for (int i = 0; i < 32; ++i) wv[i] = W[(size_t)(k0 + 2 * i + (lane >> 5)) * N + n0 + (lane & 31)];
    if (gk) {
#pragma unroll
        for (int i = 0; i < 32; ++i) wv[i] *= gk[k0 + 2 * i + (lane >> 5)]; }
#pragma unroll
    for (int i = 0; i < 32; ++i) scr[(2 * i + (lane >> 5)) * 33 + (lane & 31)] = wv[i];
    LDS_WAIT();
    const int c = lane & 7;
#pragma unroll
    for (int j = 0; j < 4; ++j) { const int n = (lane >> 3) + 8 * j; const LAS float* s = scr + (8 * c) * 33 + n;
        v4u o; o.x = pk2(s[0 * 33], s[1 * 33]); o.y = pk2(s[2 * 33], s[3 * 33]); o.z = pk2(s[4 * 33], s[5 * 33]); o.w = pk2(s[6 * 33], s[7 * 33]);
        *(v4u*)(WT + (size_t)(n0 + n) * K + k0 + 8 * c) = o; }
    LDS_WAIT();
}

__device__ __forceinline__ void xb_row(const float* xrow, bf16* orow, unsigned long long* ss, int lane) {
    const f32x4* xr = (const f32x4*)xrow + lane; f32x4 v[8]; float s = 0.f;
#pragma unroll
    for (int j = 0; j < 8; ++j) { v[j] = xr[64 * j]; s += (v[j].x * v[j].x + v[j].y * v[j].y) + (v[j].z * v[j].z + v[j].w * v[j].w); }
    s = wave_sum(s); if (lane == 0) *ss = (unsigned long long)(s * 1048576.f + 0.5f);
    v2u* o8 = (v2u*)orow + lane;
#pragma unroll
    for (int j = 0; j < 8; ++j) { v2u o; o.x = pk2(v[j].x, v[j].y); o.y = pk2(v[j].z, v[j].w); o8[64 * j] = o; }
}

__device__ __forceinline__ void norm_row_bf16(const float* xrow, const float* g, bf16* orow, int lane) {
    const f32x4* xr = (const f32x4*)xrow + lane; const f32x4* gr = (const f32x4*)g + lane;
    f32x4 v[8]; float s = 0.f;
#pragma unroll
    for (int j = 0; j < 8; ++j) { v[j] = xr[64 * j]; s += (v[j].x * v[j].x + v[j].y * v[j].y) + (v[j].z * v[j].z + v[j].w * v[j].w); }
    const float rstd = 1.f / sqrtf(wave_sum(s) * (1.f / DM) + EPS);
    v2u* o8 = (v2u*)orow + lane;
#pragma unroll
    for (int j = 0; j < 8; ++j) { const f32x4 gg = gr[64 * j]; v2u o; o.x = pk2(v[j].x * rstd * gg.x, v[j].y * rstd * gg.y); o.y = pk2(v[j].z * rstd * gg.z, v[j].w * rstd * gg.w); o8[64 * j] = o; }
}
__device__ __forceinline__ const float* x_row(const Args& a, int l, int row) {
    if (l == 0) return row < 8192 ? a.in[I_XP] + (size_t)row * DM : a.in[I_XS] + (size_t)(row - 8192) * DM;
    return a.out + (size_t)row * DM;
}

__device__ __forceinline__ void ph_prologue(const Args& a, const Frame& F, int l) {
    int tid = threadIdx.x; asm volatile("" : "+v"(tid)); int lane = tid & 63; (void)lane;
    LAS float* scr = (LAS float*)(F.lds + RING_OFF + F.wave * 16384);
    const int gw = F.vcu * NWAVES + F.wave, NGW = F.G * NWAVES;
    constexpr int I_IN = (DM / 64) * (ZW / 32), I_OUT = (DM / 64) * (DM / 32), I_UP = (DM / 64) * (DFF / 32), I_DN = (DFF / 64) * (DM / 32), I_GL = (512 / 64) * (512 / 32);
    constexpr int NITEMS = I_IN + I_OUT + I_UP + I_DN + I_GL;
    unsigned char* ws = a.ws;
    for (int it = gw; it < NITEMS; it += NGW) {
        int r = it;
        if (r < I_IN) { transpose_item(a.in[I_WIN] + (size_t)l * DM * ZW, DM, ZW, (bf16*)(ws + WS_WIN), scr, r, lane, a.in[I_NMG] + (size_t)l * DM); continue; } r -= I_IN;
        if (r < I_OUT) { transpose_item(a.in[I_WOUT] + (size_t)l * DM * DM, DM, DM, (bf16*)(ws + WS_WOUT), scr, r, lane, nullptr); continue; } r -= I_OUT;
        if (r < I_UP) { transpose_item(a.in[I_WUP] + (size_t)l * DM * DFF, DM, DFF, (bf16*)(ws + WS_WUP), scr, r, lane, a.in[I_NLG] + (size_t)l * DM); continue; } r -= I_UP;
        if (r < I_DN) { transpose_item(a.in[I_WDN] + (size_t)l * DFF * DM, DFF, DM, (bf16*)(ws + WS_WDN), scr, r, lane, nullptr); continue; } r -= I_DN;
        transpose_item(a.in[I_WGLU] + (size_t)l * 512 * 512, 512, 512, (bf16*)(ws + WS_WGLU), scr, r, lane, nullptr);
    }
    { const int gt = F.vcu * NTHR + tid;
      if (gt < 4096) {
        const int dir = gt >> 11, g = (gt >> 6) & 31, p = gt & 63; const size_t ix = ((size_t)(l * 2 + dir) * 32 + g) * 64 + p;
        const double are = (double)a.in[I_ARE][ix], aim = (double)a.in[I_AIM][ix]; const double ldt = (double)a.in[I_LDT][(l * 2 + dir) * 32 + g];
        double e = 1.0; { const double x8 = ldt * 0.125; for (int n = 20; n >= 1; --n) e = 1.0 + e * x8 / (double)n; e = e * e; e = e * e; e = e * e; }
        const double dt = e;
        double mag = 1.0; { const double x = are * dt; for (int n = 14; n >= 1; --n) mag = 1.0 + mag * x / (double)n; }
        const double th = aim * dt; const double kq = __builtin_rint(th * 0.15915494309189535); const double r = th - kq * 6.283185307179586476925;
        const double r2 = r * r; double c = 1.0, s = 1.0;
        for (int n = 15; n >= 1; --n) { c = 1.0 - c * r2 / (double)((2 * n - 1) * (2 * n)); s = 1.0 - s * r2 / (double)((2 * n) * (2 * n + 1)); }
        s *= r;
        const double lbr = mag * c, lbi = mag * s, den = are * are + aim * aim, nre = lbr - 1.0, nim = lbi;
        const double cor = (nre * are + nim * aim) / den, coi = (nim * are - nre * aim) / den;
        float* tlb = (float*)(ws + WS_TLB) + (size_t)gt * 2; tlb[0] = (float)lbr; tlb[1] = (float)lbi;
        float* tbb = (float*)(ws + WS_TBB) + (size_t)gt * 32; const float* bre = a.in[I_BRE] + ix * 16; const float* bim = a.in[I_BIM] + ix * 16;
        bf16* bbf = (bf16*)(ws + WS_TBBF);
        for (int h = 0; h < 16; ++h) { const double br = (double)bre[h], bi = (double)bim[h]; const float vr = (float)(cor * br - coi * bi), vi = (float)(cor * bi + coi * br); tbb[h] = vr; tbb[16 + h] = vi;
            const int n = p & 15, gk0 = h >> 3, j = h & 7;
            const unsigned hr = f2bf(vr), hi_ = f2bf(vi); const unsigned lr = f2bf(vr - bf2f(hr)), li = f2bf(vi - bf2f(hi_));
            const size_t fr = ((size_t)((dir * 32 + g) * 8 + (p >> 4)) * 64) * 8, fi = ((size_t)((dir * 32 + g) * 8 + 4 + (p >> 4)) * 64) * 8;
            bbf[fr + (size_t)(n + 16 * gk0) * 8 + j] = (bf16)hr; bbf[fr + (size_t)(n + 16 * (gk0 + 2)) * 8 + j] = (bf16)lr;
            bbf[fi + (size_t)(n + 16 * gk0) * 8 + j] = (bf16)hi_; bbf[fi + (size_t)(n + 16 * (gk0 + 2)) * 8 + j] = (bf16)li; }
      } else if (gt < 4096 + 16384) {
        const int e = gt - 4096, lane_ = e & 63, ks = (e >> 6) & 3, g = (e >> 8) & 31, dir = e >> 13; const int h = lane_ & 15, gk = lane_ >> 4;
        const float* cre = a.in[I_CRE] + (((size_t)(l * 2 + dir) * 32 + g) * 16 + h) * 64; const float* cim = a.in[I_CIM] + (((size_t)(l * 2 + dir) * 32 + g) * 16 + h) * 64;
        bf16* cf = (bf16*)(ws + WS_TCF) + (size_t)e * 8;
        for (int j = 0; j < 8; ++j) { const int P = 16 * (j >> 1) + 4 * ks + gk; cf[j] = (bf16)f2bf((j & 1) ? -cim[P] : cre[P]); }
      } else if (gt >= 20480 && gt < 20480 + 16384) {
        const int e = gt - 20480, lane_ = e & 63, ks = (e >> 6) & 1, cb = (e >> 7) & 3, mat = (e >> 9) & 1, nb = (e >> 10) & 7, dir = e >> 13; const int n = lane_ & 15, gk = lane_ >> 4;
        const float* W = a.in[mat ? I_LWX : I_LWA] + ((size_t)(l * 2 + dir) * 8 + nb) * 4096 + (size_t)(32 * ks + 8 * gk) * 64 + 16 * cb + n;
        bf16* wf = (bf16*)(ws + WS_TWF) + (size_t)e * 8;
        for (int j = 0; j < 8; ++j) wf[j] = (bf16)f2bf(W[j * 64]);
      } }
    if (l == 0) { bf16* XB = (bf16*)(ws + WS_H); unsigned long long* SS = (unsigned long long*)(ws + WS_SSQ);
        for (int m0 = gw; m0 < NTOK; m0 += 2 * NGW) {
            f32x4 v[2][8];
#pragma unroll
            for (int r = 0; r < 2; ++r) { const int m = m0 + r * NGW; const f32x4* xr = (const f32x4*)x_row(a, 0, m < NTOK ? m : m0) + lane;
#pragma unroll
                for (int j = 0; j < 8; ++j) v[r][j] = xr[64 * j]; }
#pragma unroll
            for (int r = 0; r < 2; ++r) { const int m = m0 + r * NGW; float sq = 0.f;
#pragma unroll
                for (int j = 0; j < 8; ++j) sq += (v[r][j].x * v[r][j].x + v[r][j].y * v[r][j].y) + (v[r][j].z * v[r][j].z + v[r][j].w * v[r][j].w);
                sq = wave_sum(sq);
                if (m < NTOK) { if (lane == 0) SS[m] = (unsigned long long)(sq * 1048576.f + 0.5f);
                    v2u* o8 = (v2u*)(XB + (size_t)m * DM) + lane;
#pragma unroll
                    for (int j = 0; j < 8; ++j) { v2u o; o.x = pk2(v[r][j].x, v[r][j].y); o.y = pk2(v[r][j].z, v[r][j].w); o8[64 * j] = o; } } } } }
}

__device__ __forceinline__ void ph_na_simple(const Args& a, const Frame& F, int l) {
    int tid = threadIdx.x; asm volatile("" : "+v"(tid)); int lane = tid & 63; (void)lane;
    const bf16* Z = (const bf16*)(a.ws + WS_Z); bf16* Y = (bf16*)(a.ws + WS_Y);
    const float* rpb = a.in[I_RPB] + (size_t)l * 16 * 15 * 31;
    float* qs = (float*)(F.ldsg + RING_OFF) + F.wave * 64;
    const long U = (long)NTOK * 16; const long u0 = U * F.vcu / F.G, u1 = U * (F.vcu + 1) / F.G;
    for (long u = u0 + F.wave; u < u1; u += NWAVES) {
        const int tok = (int)(u >> 4), h = (int)(u & 15);
        int s0, T; seq_of(tok, s0, T); const int pos = tok - s0, r = pos >> 6, c = pos & 63, R = T >> 6;
        const int rs = min(max(r - 4, 0), R - 8), cs = min(max(c - 8, 0), 48);
        LDS_WAIT();
        qs[lane] = bf2f(Z[(size_t)tok * ZW + h * 64 + lane]);
        LDS_WAIT();
        float sc[2];
#pragma unroll
        for (int i = 0; i < 2; ++i) {
            const int kk = lane + 64 * i, krow = rs + (kk >> 4), kcol = cs + (kk & 15); const int ktok = s0 + krow * 64 + kcol;
            const v4u* kp = (const v4u*)(Z + (size_t)ktok * ZW + ZK + h * 64);
            float d = 0.f;
#pragma unroll
            for (int j = 0; j < 8; ++j) { const v4u w = kp[j]; const f32x4 q0 = *(const f32x4*)(qs + 8 * j), q1 = *(const f32x4*)(qs + 8 * j + 4);
                d += bflo(w.x) * q0.x + bfhi(w.x) * q0.y + bflo(w.y) * q0.z + bfhi(w.y) * q0.w + bflo(w.z) * q1.x + bfhi(w.z) * q1.y + bflo(w.w) * q1.z + bfhi(w.w) * q1.w; }
            sc[i] = d * 0.125f + rpb[(h * 15 + (krow - r + 7)) * 31 + (kcol - c + 15)];
        }
        const float m = wave_max(fmaxf(sc[0], sc[1])); const float p0 = __expf(sc[0] - m), p1 = __expf(sc[1] - m); const float sum = wave_sum(p0 + p1);
        float acc = 0.f;
        for (int kk = 0; kk < 128; ++kk) {
            const float p = __shfl(kk < 64 ? p0 : p1, kk & 63);
            const int krow = rs + (kk >> 4), kcol = cs + (kk & 15); const int vtok = s0 + krow * 64 + kcol;
            acc += p * bf2f(Z[(size_t)vtok * ZW + ZV + h * 64 + lane]);
        }
        Y[(size_t)tok * DM + h * 64 + lane] = (bf16)f2bf(acc / sum);
    }
}

typedef short s16x4_t __attribute__((ext_vector_type(4)));
__device__ __forceinline__ pg8::bf16x8 v_tr_pair(const LAS unsigned char* p) {
    const s16x4_t lo = __builtin_amdgcn_ds_read_tr16_b64_v4i16((LAS s16x4_t*)p), hi = __builtin_amdgcn_ds_read_tr16_b64_v4i16((LAS s16x4_t*)(p + 512));
    return __builtin_shufflevector(lo, hi, 0, 1, 2, 3, 4, 5, 6, 7);
}
__device__ __forceinline__ void glds16_asm(const void* gsrc, unsigned lds_dst) {
    unsigned keep;
    asm volatile("s_mov_b32 %0, m0\n\ts_mov_b32 m0, %2\n\ts_nop 0\n\tglobal_load_lds_dwordx4 %1, off\n\ts_mov_b32 m0, %0" : "=&s"(keep) : "v"(gsrc), "s"(lds_dst) : "memory");
}
__device__ __forceinline__ void ph_na_mfma(const Args& a, const Frame& F, int l) {
    int tid = threadIdx.x; asm volatile("" : "+v"(tid)); int lane = tid & 63; (void)lane;
    const bf16* Z = (const bf16*)(a.ws + WS_Z); bf16* Y = (bf16*)(a.ws + WS_Y);
    constexpr int KR = 0, VR = 73728, BIAS = 147456, MRG = 149504;
    LAS unsigned char* L = F.lds;
    const int w = F.wave, qt = w & 3, half = w >> 2, q = lane & 15, g = lane >> 4;
    const int c0 = 16 * qt, kc0 = (qt == 0) ? 0 : (qt == 1 ? 8 : (qt == 2 ? 24 : 32)), c = c0 + q, cs = min(max(c - 8, 0), 48);
    const int NIT = (NTOK / 64) * 16; const int i0 = (int)((long)NIT * F.vcu / F.G), i1 = (int)((long)NIT * (F.vcu + 1) / F.G);
#define NA_ITEM(it_, s0_, R_, h_, r_) do { if ((it_) < 2048) { const int _col = (it_) >> 5; r_ = (it_) & 31; R_ = 32; s0_ = (_col >> 4) * 2048; h_ = _col & 15; } \
        else { const int _j = (it_) - 2048, _col = _j >> 8; r_ = _j & 255; R_ = 256; s0_ = 8192 + (_col >> 4) * 16384; h_ = _col & 15; } } while (0)
#define NA_SWZ(col_) (((((col_) >> 3) & 3) << 1) | (((col_) >> 1) & 1))
#define NA_ROW_DMA(zoff_, row_, slotbase_) do { \
        _Pragma("unroll") for (int _j = 0; _j < 2; ++_j) { const int _col = c0 + 8 * _j + (lane >> 3); \
            const bf16* _gp = Z + (size_t)(s0 + (row_) * 64 + _col) * ZW + (zoff_) + h * 64 + (((lane & 7) ^ NA_SWZ(_col)) * 8); \
            glds16_asm(_gp, (unsigned)(size_t)(L + (slotbase_) + (c0 + 8 * _j) * 128)); } } while (0)
#define NA_BAR() asm volatile("s_barrier" ::: "memory")
    pg8::bf16x8 qn0, qn1;
    { int s0, R, h, r; NA_ITEM(i0, s0, R, h, r); const bf16* qp = Z + (size_t)(s0 + r * 64 + c) * ZW + h * 64 + 8 * g; qn0 = *(const pg8::bf16x8*)qp; qn1 = *(const pg8::bf16x8*)(qp + 32); }
    v2u st0, st1, st2, st3; bf16* stp = Y;
    st0 = st1 = st2 = st3 = (v2u){0u, 0u};
    int it = i0;
    while (it < i1) {
        int s0, R, h, r0; NA_ITEM(it, s0, R, h, r0);
        const int m = min(R - r0, i1 - it);
        {
            const int rs = min(max(r0 - 4, 0), R - 8);
#pragma unroll
            for (int i = 0; i < 16; ++i) { const int id = w * 16 + i, t = id >> 6, ri = (id >> 3) & 7, j8 = id & 7, row = rs + ri;
                const int colw = 8 * j8 + (lane >> 3);
                const bf16* gp = Z + (size_t)(s0 + row * 64 + colw) * ZW + (t ? ZV : ZK) + h * 64 + (((lane & 7) ^ NA_SWZ(colw)) * 8);
                glds16_asm(gp, (unsigned)(size_t)(L + (t ? VR : KR) + (row % 9) * 8192 + j8 * 1024)); }
            if (tid < 465) ((LAS float*)(L + BIAS))[tid] = a.in[I_RPB][((size_t)l * 16 + h) * 465 + tid];
            VM_WAIT(); LDS_WAIT();
            __syncthreads();
        }
        if (half == 1) NA_BAR();
        for (int j = 0; j < m; ++j) {
            const int r = r0 + j, rs = min(max(r - 4, 0), R - 8);
            pg8::bf16x8 qf0 = qn0, qf1 = qn1;
            asm volatile("" : "+v"(qf0), "+v"(qf1) :: "memory");
            if (half == 1 && j > 0) { *(v2u*)(stp) = st0; *(v2u*)(stp + 16) = st1; *(v2u*)(stp + 32) = st2; *(v2u*)(stp + 48) = st3; }
            if (it + j + 1 < i1) {
                int s0n, Rn, hn, rn; NA_ITEM(it + j + 1, s0n, Rn, hn, rn);
                if (half == 0 && j + 1 < m) { const int rsn = min(max(rn - 4, 0), Rn - 8); if (rsn > rs) { NA_ROW_DMA(ZK, rsn + 7, KR + ((rsn + 7) % 9) * 8192); NA_ROW_DMA(ZV, rsn + 7, VR + ((rsn + 7) % 9) * 8192); } }
                const bf16* qp = Z + (size_t)(s0n + rn * 64 + c) * ZW + hn * 64 + 8 * g; qn0 = *(const pg8::bf16x8*)qp; qn1 = *(const pg8::bf16x8*)(qp + 32);
            }
            const int tokrow0 = s0 + r * 64;
            f32x4 sc[4][2];
            pg8::bf16x8 kf[4][2][2];
#pragma unroll
            for (int kk = 0; kk < 4; ++kk) { const int row = rs + 4 * half + kk; const LAS unsigned char* kb = L + KR + (row % 9) * 8192;
#pragma unroll
                for (int blk = 0; blk < 2; ++blk) { const int col = kc0 + 8 * (q >> 2) + 4 * blk + (q & 3); const int sw = NA_SWZ(col);
                    kf[kk][blk][0] = *(const LAS pg8::bf16x8*)(kb + col * 128 + ((g ^ sw) * 16)); kf[kk][blk][1] = *(const LAS pg8::bf16x8*)(kb + col * 128 + (((4 + g) ^ sw) * 16)); } }
            const LAS float* bh = (const LAS float*)(L + BIAS) + (rs + 4 * half - r + 7) * 31;
            float bv[4][2][4];
#pragma unroll
            for (int blk = 0; blk < 2; ++blk)
#pragma unroll
                for (int rg = 0; rg < 4; ++rg) { const int dc = min(max(kc0 + 8 * g + 4 * blk + rg - c + 15, 0), 30);
#pragma unroll
                    for (int kk = 0; kk < 4; ++kk) bv[kk][blk][rg] = bh[kk * 31 + dc]; }
            __builtin_amdgcn_sched_barrier(0);
#pragma unroll
            for (int kk = 0; kk < 4; ++kk)
#pragma unroll
                for (int blk = 0; blk < 2; ++blk) sc[kk][blk] = __builtin_amdgcn_mfma_f32_16x16x32_bf16(kf[kk][blk][0], qf0, (f32x4){0.f, 0.f, 0.f, 0.f}, 0, 0, 0);
#pragma unroll
            for (int kk = 0; kk < 4; ++kk)
#pragma unroll
                for (int blk = 0; blk < 2; ++blk) sc[kk][blk] = __builtin_amdgcn_mfma_f32_16x16x32_bf16(kf[kk][blk][1], qf1, sc[kk][blk], 0, 0, 0);
            __builtin_amdgcn_sched_barrier(0);
            float mx = -INFINITY;
#pragma unroll
            for (int kk = 0; kk < 4; ++kk)
#pragma unroll
                for (int blk = 0; blk < 2; ++blk)
#pragma unroll
                    for (int rg = 0; rg < 4; ++rg) { const int col = kc0 + 8 * g + 4 * blk + rg; const bool valid = (unsigned)(col - cs) < 16u;
                        const float s = valid ? sc[kk][blk][rg] * 0.125f + bv[kk][blk][rg] : -INFINITY; sc[kk][blk][rg] = s; mx = fmaxf(mx, s); }
            mx = fmaxf(mx, __shfl_xor(mx, 16)); mx = fmaxf(mx, __shfl_xor(mx, 32));
            LDS_WAIT();
            __syncthreads();
            pg8::bf16x8 vfr[4][4];
#pragma unroll
            for (int kk = 0; kk < 4; ++kk) { const int row = rs + 4 * half + kk;
                const int colv = kc0 + 8 * g + ((lane & 15) >> 2), sw0 = NA_SWZ(colv), sw1 = NA_SWZ(colv + 4), pq = lane & 3;
                const LAS unsigned char* vb0 = L + VR + (row % 9) * 8192 + colv * 128 + (pq & 1) * 8; const LAS unsigned char* vb1 = vb0 + 512;
#pragma unroll
                for (int db = 0; db < 4; ++db) { const int ch = 2 * db + (pq >> 1);
                    const s16x4_t lo = __builtin_amdgcn_ds_read_tr16_b64_v4i16((LAS s16x4_t*)(vb0 + ((ch ^ sw0) * 16))), hi = __builtin_amdgcn_ds_read_tr16_b64_v4i16((LAS s16x4_t*)(vb1 + ((ch ^ sw1) * 16)));
                    vfr[kk][db] = __builtin_shufflevector(lo, hi, 0, 1, 2, 3, 4, 5, 6, 7); } }
            __builtin_amdgcn_sched_barrier(0);
            float sum = 0.f; pg8::bf16x8 pf[4];
#pragma unroll
            for (int kk = 0; kk < 4; ++kk) { float p[8];
#pragma unroll
                for (int blk = 0; blk < 2; ++blk)
#pragma unroll
                    for (int rg = 0; rg < 4; ++rg) { const float e = __expf(sc[kk][blk][rg] - mx); p[4 * blk + rg] = e; sum += e; }
                v4u wv; wv.x = pk2(p[0], p[1]); wv.y = pk2(p[2], p[3]); wv.z = pk2(p[4], p[5]); wv.w = pk2(p[6], p[7]); pf[kk] = __builtin_bit_cast(pg8::bf16x8, wv); }
            sum += __shfl_xor(sum, 16); sum += __shfl_xor(sum, 32);
            f32x4 o[4];
#pragma unroll
            for (int db = 0; db < 4; ++db) o[db] = (f32x4){0.f, 0.f, 0.f, 0.f};
#pragma unroll
            for (int kk = 0; kk < 4; ++kk)
#pragma unroll
                for (int db = 0; db < 4; ++db) o[db] = __builtin_amdgcn_mfma_f32_16x16x32_bf16(vfr[kk][db], pf[kk], o[db], 0, 0, 0);
            LAS unsigned char* mg = L + MRG + (qt * 64 + lane) * 48;
            if (half == 0) {
                v4u w0, w1; w0.x = pk2(o[0][0], o[0][1]); w0.y = pk2(o[0][2], o[0][3]); w0.z = pk2(o[1][0], o[1][1]); w0.w = pk2(o[1][2], o[1][3]);
                w1.x = pk2(o[2][0], o[2][1]); w1.y = pk2(o[2][2], o[2][3]); w1.z = pk2(o[3][0], o[3][1]); w1.w = pk2(o[3][2], o[3][3]);
                *(LAS v4u*)mg = w0; *(LAS v4u*)(mg + 16) = w1; *(LAS f32x2*)(mg + 32) = (f32x2){mx, sum};
                VM_WAIT();
            } else {
                const v4u w0 = *(const LAS v4u*)mg, w1 = *(const LAS v4u*)(mg + 16); const f32x2 ml = *(const LAS f32x2*)(mg + 32);
                const float mm = fmaxf(mx, ml.x), a0 = __expf(mx - mm), a1 = __expf(ml.x - mm); const float inv = frcp(sum * a0 + ml.y * a1);
                const float sa = a0 * inv, sb = a1 * inv;
                stp = Y + (size_t)(tokrow0 + c) * DM + h * 64 + 4 * g;
                st0.x = pk2(o[0][0] * sa + bflo(w0.x) * sb, o[0][1] * sa + bfhi(w0.x) * sb); st0.y = pk2(o[0][2] * sa + bflo(w0.y) * sb, o[0][3] * sa + bfhi(w0.y) * sb);
                st1.x = pk2(o[1][0] * sa + bflo(w0.z) * sb, o[1][1] * sa + bfhi(w0.z) * sb); st1.y = pk2(o[1][2] * sa + bflo(w0.w) * sb, o[1][3] * sa + bfhi(w0.w) * sb);
                st2.x = pk2(o[2][0] * sa + bflo(w1.x) * sb, o[2][1] * sa + bfhi(w1.x) * sb); st2.y = pk2(o[2][2] * sa + bflo(w1.y) * sb, o[2][3] * sa + bfhi(w1.y) * sb);
                st3.x = pk2(o[3][0] * sa + bflo(w1.z) * sb, o[3][1] * sa + bfhi(w1.z) * sb); st3.y = pk2(o[3][2] * sa + bflo(w1.w) * sb, o[3][3] * sa + bfhi(w1.w) * sb);
            }
            LDS_WAIT();
            __syncthreads();
        }
        if (half == 1) { *(v2u*)(stp) = st0; *(v2u*)(stp + 16) = st1; *(v2u*)(stp + 32) = st2; *(v2u*)(stp + 48) = st3; }
        if (half == 0) NA_BAR();
        it += m;
    }
#undef NA_BAR
#undef NA_ROW_DMA
#undef NA_SWZ
#undef NA_ITEM
    VM_WAIT(); LDS_WAIT();
    __syncthreads();
}

template <int MODE> __device__ __forceinline__ void ph_lru_simple(const Args& a, const Frame& F, int l) {
    int tid = threadIdx.x; asm volatile("" : "+v"(tid)); int lane = tid & 63; (void)lane;
    const bf16* Z = (const bf16*)(a.ws + WS_Z); bf16* Y = (bf16*)(a.ws + WS_Y); float* HF = (float*)(a.ws + WS_HF);
    float* agg = (float*)(a.ws + WS_LAGG); const float* cin = (const float*)(a.ws + WS_LCIN);
    float* xc = (float*)(F.ldsg + RING_OFF);
    const int c = tid, n = c >> 6, k = c & 63;
    float cw[4];
#pragma unroll
    for (int j = 0; j < 4; ++j) cw[j] = a.in[I_CW][((size_t)l * 4 + j) * 512 + c];
    const float cb = a.in[I_CB][(size_t)l * 512 + c];
    for (int ch = F.vcu; ch < NLCH; ch += F.G) {
        const int tok0 = ch * LCH; int s0, T; seq_of(tok0, s0, T); const int s1 = s0 + T;
        __syncthreads();
        for (int t = 0; t < LCH; ++t) { const int tok = tok0 + t; float v = cb;
#pragma unroll
            for (int j = 0; j < 4; ++j) { const int tt = tok + j - 2; if (tt >= s0 && tt < s1) v += cw[j] * bf2f(Z[(size_t)tt * ZW + ZXR + c]); }
            xc[t * 512 + c] = v; }
        __syncthreads();
        for (int dir = 0; dir < 2; ++dir) {
            float wa[64], wx[64];
            const float* pwa = a.in[I_LWA] + ((size_t)(l * 2 + dir) * 8 + n) * 4096 + k; const float* pwx = a.in[I_LWX] + ((size_t)(l * 2 + dir) * 8 + n) * 4096 + k;
#pragma unroll
            for (int j = 0; j < 64; ++j) { wa[j] = pwa[j * 64]; wx[j] = pwx[j * 64]; }
            const float ba = a.in[I_LBA][(size_t)(l * 2 + dir) * 512 + c], bx = a.in[I_LBX][(size_t)(l * 2 + dir) * 512 + c];
            const float lam = a.in[I_LAM][(size_t)(l * 2 + dir) * 512 + c]; const float ls8 = -8.f * log1pf(__expf(-lam));
            float h = MODE ? cin[((size_t)ch * 2 + dir) * 512 + c] : 0.f, P = 1.f;
            for (int st = 0; st < LCH; ++st) {
                const int t = dir ? (LCH - 1 - st) : st; const float* xr = xc + t * 512 + n * 64;
                float pa = ba, px = bx;
#pragma unroll
                for (int j = 0; j < 64; j += 4) { const f32x4 x4 = *(const f32x4*)(xr + j);
                    pa += x4.x * wa[j] + x4.y * wa[j + 1] + x4.z * wa[j + 2] + x4.w * wa[j + 3]; px += x4.x * wx[j] + x4.y * wx[j + 1] + x4.z * wx[j + 2] + x4.w * wx[j + 3]; }
                const float rr = sigmoidf_(pa), ii = sigmoidf_(px), loga = ls8 * rr, av = __expf(loga), mult = sqrtf(fmaxf(-expm1f(2.f * loga), 0.f));
                const float uu = mult * ii * xc[t * 512 + c];
                h = av * h + uu; P *= av;
                if (MODE) { const size_t tok = (size_t)(tok0 + t);
                    if (dir == 0) HF[tok * 512 + c] = h;
                    else { const float gt = bf2f(Z[tok * ZW + ZGT + c]); Y[tok * DM + 1024 + c] = (bf16)f2bf((HF[tok * 512 + c] + h) * gelu_tanh(gt)); } }
            }
            if (!MODE) { float* ag = agg + (((size_t)ch * 2 + dir) * 512 + c) * 2; ag[0] = P; ag[1] = h; }
        }
    }
}

template <int MODE> __device__ __forceinline__ void ph_s5_simple(const Args& a, const Frame& F, int l) {
    int tid = threadIdx.x; asm volatile("" : "+v"(tid)); int lane = tid & 63; (void)lane;
    const bf16* Z = (const bf16*)(a.ws + WS_Z); bf16* YG = (bf16*)(a.ws + WS_YG);
    float* E = (float*)(a.ws + WS_SEND); const float* CIN = (const float*)(a.ws + WS_SCIN);
    const float* TLB = (const float*)(a.ws + WS_TLB); const float* TBB = (const float*)(a.ws + WS_TBB);
    float* Sst = (float*)(F.ldsg + RING_OFF + F.wave * 16384);
    float* Yf = Sst + 2048;
    float* Ub = (float*)(F.ldsg + XTRA_OFF + F.wave * 1024);
    const int gw = F.vcu * NWAVES + F.wave, NGW = F.G * NWAVES;
    for (int u = gw; u < NSCH * 32; u += NGW) {
        const int ch = u >> 5, g = u & 31, tok0 = ch * SCH;
        for (int dir = 0; dir < 2; ++dir) {
            const int dg = dir * 32 + g;
            const float lbr = TLB[((size_t)dg * 64 + lane) * 2], lbi = TLB[((size_t)dg * 64 + lane) * 2 + 1];
            float bbr[16], bbi[16];
            { const f32x4* tb = (const f32x4*)(TBB + ((size_t)dg * 64 + lane) * 32);
#pragma unroll
              for (int q = 0; q < 4; ++q) { const f32x4 x = tb[q], y = tb[4 + q]; bbr[4 * q] = x.x; bbr[4 * q + 1] = x.y; bbr[4 * q + 2] = x.z; bbr[4 * q + 3] = x.w; bbi[4 * q] = y.x; bbi[4 * q + 1] = y.y; bbi[4 * q + 2] = y.z; bbi[4 * q + 3] = y.w; } }
            float cr[64], ci[64];
            if (MODE) { const int h = lane & 15; const f32x4* pr = (const f32x4*)(a.in[I_CRE] + (((size_t)(l * 2 + dir) * 32 + g) * 16 + h) * 64); const f32x4* pi = (const f32x4*)(a.in[I_CIM] + (((size_t)(l * 2 + dir) * 32 + g) * 16 + h) * 64);
#pragma unroll
              for (int q = 0; q < 16; ++q) { const f32x4 x = pr[q], y = pi[q]; cr[4 * q] = x.x; cr[4 * q + 1] = x.y; cr[4 * q + 2] = x.z; cr[4 * q + 3] = x.w; ci[4 * q] = y.x; ci[4 * q + 1] = y.y; ci[4 * q + 2] = y.z; ci[4 * q + 3] = y.w; } }
            float sr = 0.f, si = 0.f;
            if (MODE) { const float* cp = CIN + ((((size_t)ch * 2 + dir) * 32 + g) * 64 + lane) * 2; sr = cp[0]; si = cp[1]; }
            for (int b = 0; b < SCH / 16; ++b) {
                { const int tt = lane >> 2, hq = lane & 3; const int tl = dir ? (SCH - 1 - (16 * b + tt)) : (16 * b + tt);
                  const v2u w = *(const v2u*)(Z + (size_t)(tok0 + tl) * ZW + ZXS + g * 16 + hq * 4);
                  LDS_WAIT();
                  *(f32x4*)(Ub + tt * 16 + hq * 4) = (f32x4){bflo(w.x), bfhi(w.x), bflo(w.y), bfhi(w.y)};
                  LDS_WAIT(); }
                for (int tt = 0; tt < 16; ++tt) {
                    const f32x4 u0 = *(const f32x4*)(Ub + tt * 16), u1 = *(const f32x4*)(Ub + tt * 16 + 4), u2 = *(const f32x4*)(Ub + tt * 16 + 8), u3 = *(const f32x4*)(Ub + tt * 16 + 12);
                    float ir = u0.x * bbr[0] + u0.y * bbr[1] + u0.z * bbr[2] + u0.w * bbr[3] + u1.x * bbr[4] + u1.y * bbr[5] + u1.z * bbr[6] + u1.w * bbr[7]
                             + u2.x * bbr[8] + u2.y * bbr[9] + u2.z * bbr[10] + u2.w * bbr[11] + u3.x * bbr[12] + u3.y * bbr[13] + u3.z * bbr[14] + u3.w * bbr[15];
                    float ii = u0.x * bbi[0] + u0.y * bbi[1] + u0.z * bbi[2] + u0.w * bbi[3] + u1.x * bbi[4] + u1.y * bbi[5] + u1.z * bbi[6] + u1.w * bbi[7]
                             + u2.x * bbi[8] + u2.y * bbi[9] + u2.z * bbi[10] + u2.w * bbi[11] + u3.x * bbi[12] + u3.y * bbi[13] + u3.z * bbi[14] + u3.w * bbi[15];
                    const float nr = lbr * sr - lbi * si + ir, ni = lbr * si + lbi * sr + ii; sr = nr; si = ni;
                    if (MODE) { Sst[(tt * 64 + lane) * 2] = sr; Sst[(tt * 64 + lane) * 2 + 1] = si; }
                }
                if (MODE) {
                    LDS_WAIT();
                    const int h = lane & 15, tq = lane >> 4;
#pragma unroll
                    for (int j = 0; j < 4; ++j) { const int slot = tq * 4 + j; const float* sp = Sst + slot * 128; float y = 0.f;
#pragma unroll
                        for (int p = 0; p < 64; p += 2) { const f32x4 s4 = *(const f32x4*)(sp + 2 * p); y += s4.x * cr[p] - s4.y * ci[p] + s4.z * cr[p + 1] - s4.w * ci[p + 1]; }
                        const int tl = dir ? (SCH - 1 - (16 * b + slot)) : (16 * b + slot);
                        if (dir == 0) Yf[tl * 16 + h] = y; else Yf[tl * 16 + h] += y; }
                    LDS_WAIT();
                }
            }
            if (!MODE) { float* ep = E + ((((size_t)ch * 2 + dir) * 32 + g) * 64 + lane) * 2; ep[0] = sr; ep[1] = si; }
        }
        if (MODE) {
            LDS_WAIT();
            for (int i = 0; i < 32; ++i) { const int idx = lane + 64 * i, tl = idx >> 4, h = idx & 15; const size_t tok = (size_t)(tok0 + tl);
                const float xs = bf2f(Z[tok * ZW + ZXS + g * 16 + h]); const float y = Yf[tl * 16 + h] + a.in[I_SD][(size_t)l * 512 + g * 16 + h] * xs;
                YG[tok * 512 + g * 16 + h] = (bf16)f2bf(gelu_tanh(y)); }
            LDS_WAIT();
        }
    }
}

template <int MODE, int DIR> __device__ __forceinline__ void s5_dir(const Args& a, int l, int lane, int tok0, int gr, LAS unsigned char* st, bf16* yf) {
    const bf16* Z = (const bf16*)(a.ws + WS_Z); bf16* YG = (bf16*)(a.ws + WS_YG);
    float* E = (float*)(a.ws + WS_SEND); const float* CIN = (const float*)(a.ws + WS_SCIN); const float* TLB = (const float*)(a.ws + WS_TLB);
    const int n = lane & 15, g = lane >> 4, dg = DIR * 32 + gr, ch = tok0 / SCH + g;
    pg8::bf16x8 bbf[8], cf[4];
    { const pg8::bf16x8* bp = (const pg8::bf16x8*)(a.ws + WS_TBBF) + (size_t)dg * 8 * 64 + lane;
#pragma unroll
      for (int c = 0; c < 8; ++c) bbf[c] = bp[c * 64]; }
    if (MODE) { const pg8::bf16x8* cp = (const pg8::bf16x8*)(a.ws + WS_TCF) + (size_t)dg * 4 * 64 + lane;
#pragma unroll
      for (int c = 0; c < 4; ++c) cf[c] = cp[c * 64]; }
    float lbr[4], lbi[4], sr[4], si[4];
#pragma unroll
    for (int cb = 0; cb < 4; ++cb) { const size_t ix = ((size_t)dg * 64 + 16 * cb + n) * 2; lbr[cb] = TLB[ix]; lbi[cb] = TLB[ix + 1];
        if (MODE) { const size_t cx = ((((size_t)ch * 2 + DIR) * 32 + gr) * 64 + 16 * cb + n) * 2; sr[cb] = CIN[cx]; si[cb] = CIN[cx + 1]; } else { sr[cb] = 0.f; si[cb] = 0.f; } }
    const float dsk = MODE ? a.in[I_SD][(size_t)l * 512 + 16 * gr + n] : 0.f;
    const bf16* ua = Z + (size_t)(tok0 + (n >> 2) * SCH + (n & 3)) * ZW + ZXS + 16 * gr + 8 * (g & 1);
    bf16* yo = YG + (size_t)(tok0 + g * SCH) * 512 + 16 * gr + n;
    const bf16* xo = Z + (size_t)(tok0 + g * SCH) * ZW + ZXS + 16 * gr + n;
    constexpr int NST = SCH / 4, T0 = DIR ? (SCH - 4) : 0, DT = DIR ? -4 : 4;
    pg8::bf16x8 un = *(const pg8::bf16x8*)(ua + (size_t)T0 * ZW);
    unsigned short ygn[4], xsn[4];
    if (MODE && DIR) {
        VM_WAIT();
#pragma unroll
        for (int rg = 0; rg < 4; ++rg) { ygn[rg] = yf[((T0 >> 2) * 4 + rg) * 64 + lane]; xsn[rg] = xo[(size_t)(T0 + rg) * ZW]; } }
#pragma unroll 1
    for (int step = 0; step < NST; ++step) {
        const int t4 = T0 + DT * step;
        const pg8::bf16x8 u8 = un; unsigned short ygc[4], xsc[4];
        if (MODE && DIR) {
#pragma unroll
            for (int rg = 0; rg < 4; ++rg) { ygc[rg] = ygn[rg]; xsc[rg] = xsn[rg]; } }
        if (step + 1 < NST) { un = *(const pg8::bf16x8*)(ua + (size_t)(t4 + DT) * ZW);
            if (MODE && DIR) {
#pragma unroll
                for (int rg = 0; rg < 4; ++rg) { ygn[rg] = yf[(((t4 + DT) >> 2) * 4 + rg) * 64 + lane]; xsn[rg] = xo[(size_t)(t4 + DT + rg) * ZW]; } } }
        f32x4 in[8];
#pragma unroll
        for (int c = 0; c < 8; ++c) in[c] = __builtin_amdgcn_mfma_f32_16x16x32_bf16(u8, bbf[c], (f32x4){0.f, 0.f, 0.f, 0.f}, 0, 0, 0);
        float str[4][4], sti[4][4];
#pragma unroll
        for (int rr = 0; rr < 4; ++rr) { const int rg = DIR ? 3 - rr : rr;
#pragma unroll
            for (int cb = 0; cb < 4; ++cb) { const float nr = lbr[cb] * sr[cb] - lbi[cb] * si[cb] + in[cb][rg], ni = lbr[cb] * si[cb] + lbi[cb] * sr[cb] + in[4 + cb][rg];
                sr[cb] = nr; si[cb] = ni; str[cb][rg] = nr; sti[cb][rg] = ni; } }
        if (MODE) {
#pragma unroll
            for (int rg = 0; rg < 4; ++rg) { v4u w; w.x = pk2s(str[0][rg], sti[0][rg]); w.y = pk2s(str[1][rg], sti[1][rg]); w.z = pk2s(str[2][rg], sti[2][rg]); w.w = pk2s(str[3][rg], sti[3][rg]);
                *(LAS v4u*)(st + (4 * g + rg) * 272 + n * 16) = w; asm volatile("s_nop 1" ::: "memory"); }
            LDS_WAIT();
            f32x4 y = (f32x4){0.f, 0.f, 0.f, 0.f};
#pragma unroll
            for (int ks = 0; ks < 4; ++ks) { const pg8::bf16x8 sf = *(const LAS pg8::bf16x8*)(st + n * 272 + ks * 64 + g * 16); y = __builtin_amdgcn_mfma_f32_16x16x32_bf16(sf, cf[ks], y, 0, 0, 0); }
            LDS_WAIT();
#pragma unroll
            for (int rg = 0; rg < 4; ++rg) {
                if (DIR == 0) yf[((t4 >> 2) * 4 + rg) * 64 + lane] = (bf16)f2bf(y[rg]);
                else { const float v = y[rg] + bf2f(ygc[rg]) + dsk * bf2f(xsc[rg]); yo[(size_t)(t4 + rg) * 512] = (bf16)f2bf(gelu_tanh(v)); } }
        }
    }
    if (!MODE) {
#pragma unroll
        for (int cb = 0; cb < 4; ++cb) { const size_t cx = ((((size_t)ch * 2 + DIR) * 32 + gr) * 64 + 16 * cb + n) * 2; E[cx] = sr[cb]; E[cx + 1] = si[cb]; } }
}

template <int MODE, int DIR> __device__ __forceinline__ void lru_dir(const Args& a, int l, int lane, int tok0, int nb, int half, const LAS unsigned char* xt, bf16* hf) {
    const bf16* Z = (const bf16*)(a.ws + WS_Z); bf16* Y = (bf16*)(a.ws + WS_Y);
    float* agg = (float*)(a.ws + WS_LAGG); const float* cin = (const float*)(a.ws + WS_LCIN);
    const int n = lane & 15, g = lane >> 4, ch = tok0 / LCH + g;
    pg8::bf16x8 wa[2][2], wx[2][2];
    { const pg8::bf16x8* wp = (const pg8::bf16x8*)(a.ws + WS_TWF) + (size_t)((DIR * 8 + nb) * 2) * 4 * 2 * 64 + lane;
#pragma unroll
      for (int c2 = 0; c2 < 2; ++c2)
#pragma unroll
          for (int ks = 0; ks < 2; ++ks) { wa[c2][ks] = wp[((2 * half + c2) * 2 + ks) * 64]; wx[c2][ks] = wp[(8 + (2 * half + c2) * 2 + ks) * 64]; } }
    pg8::bf16x8 idn[2];
#pragma unroll
    for (int hf = 0; hf < 2; ++hf) { v4u w;
#pragma unroll
        for (int jj = 0; jj < 4; ++jj) { const int k0 = 8 * g + 2 * jj; w[jj] = ((k0 == 16 * hf + n) ? 0x3f80u : 0u) | ((k0 + 1 == 16 * hf + n) ? 0x3f800000u : 0u); }
        idn[hf] = __builtin_bit_cast(pg8::bf16x8, w); }
    float ba[2], bx[2], ls8[2], h[2], P[2];
    const int cch = 64 * nb + 32 * half + n;
#pragma unroll
    for (int c2 = 0; c2 < 2; ++c2) { const int c = cch + 16 * c2; const size_t ix = (size_t)(l * 2 + DIR) * 512 + c;
        ba[c2] = a.in[I_LBA][ix]; bx[c2] = a.in[I_LBX][ix]; ls8[c2] = -8.f * log1pf(__expf(-a.in[I_LAM][ix]));
        h[c2] = MODE ? cin[((size_t)ch * 2 + DIR) * 512 + c] : 0.f; P[c2] = 1.f; }
    const LAS unsigned char* xa = xt + ((n >> 2) * LCH + (n & 3)) * 128 + g * 16;
    bf16* yo = Y + (size_t)(tok0 + g * LCH) * DM + 1024 + cch;
    const bf16* go = Z + (size_t)(tok0 + g * LCH) * ZW + ZGT + cch;
    constexpr int NST = LCH / 4, T0 = DIR ? (LCH - 4) : 0, DT = DIR ? -4 : 4;
    unsigned short yn[2][4], gn[2][4];
    if (MODE && DIR) {
        VM_WAIT();
#pragma unroll
        for (int rg = 0; rg < 4; ++rg)
#pragma unroll
            for (int c2 = 0; c2 < 2; ++c2) { yn[c2][rg] = hf[(((T0 >> 2) * 4 + rg) * 2 + c2) * 64 + lane]; gn[c2][rg] = go[(size_t)(T0 + rg) * ZW + 16 * c2]; } }
#pragma unroll 1
    for (int step = 0; step < NST; ++step) {
        const int t4 = T0 + DT * step;
        unsigned short yc[2][4], gc[2][4];
        if (MODE && DIR) {
#pragma unroll
            for (int rg = 0; rg < 4; ++rg)
#pragma unroll
                for (int c2 = 0; c2 < 2; ++c2) { yc[c2][rg] = yn[c2][rg]; gc[c2][rg] = gn[c2][rg]; }
            if (step + 1 < NST) {
#pragma unroll
                for (int rg = 0; rg < 4; ++rg)
#pragma unroll
                    for (int c2 = 0; c2 < 2; ++c2) { yn[c2][rg] = hf[((((t4 + DT) >> 2) * 4 + rg) * 2 + c2) * 64 + lane]; gn[c2][rg] = go[(size_t)(t4 + DT + rg) * ZW + 16 * c2]; } } }
        const pg8::bf16x8 a0 = *(const LAS pg8::bf16x8*)(xa + t4 * 128), a1 = *(const LAS pg8::bf16x8*)(xa + t4 * 128 + 64);
        const pg8::bf16x8 ah = half ? a1 : a0;
        f32x4 pa[2], px[2], xd[2];
#pragma unroll
        for (int c2 = 0; c2 < 2; ++c2) { const f32x4 z4 = (f32x4){0.f, 0.f, 0.f, 0.f};
            pa[c2] = __builtin_amdgcn_mfma_f32_16x16x32_bf16(a0, wa[c2][0], z4, 0, 0, 0); pa[c2] = __builtin_amdgcn_mfma_f32_16x16x32_bf16(a1, wa[c2][1], pa[c2], 0, 0, 0);
            px[c2] = __builtin_amdgcn_mfma_f32_16x16x32_bf16(a0, wx[c2][0], z4, 0, 0, 0); px[c2] = __builtin_amdgcn_mfma_f32_16x16x32_bf16(a1, wx[c2][1], px[c2], 0, 0, 0);
            xd[c2] = __builtin_amdgcn_mfma_f32_16x16x32_bf16(ah, idn[c2], z4, 0, 0, 0); }
#pragma unroll
        for (int rr = 0; rr < 4; ++rr) { const int rg = DIR ? 3 - rr : rr;
#pragma unroll
            for (int c2 = 0; c2 < 2; ++c2) {
                const float r_ = sigmoidf_(pa[c2][rg] + ba[c2]), i_ = sigmoidf_(px[c2][rg] + bx[c2]); const float loga = ls8[c2] * r_, av = __expf(loga), mult = fsqrt_(fmaxf(1.f - av * av, 0.f));
                h[c2] = av * h[c2] + mult * i_ * xd[c2][rg]; P[c2] *= av;
                if (MODE) {
                    if (DIR == 0) hf[(((t4 >> 2) * 4 + rg) * 2 + c2) * 64 + lane] = (bf16)f2bf(h[c2]);
                    else yo[(size_t)(t4 + rg) * DM + 16 * c2] = (bf16)f2bf((bf2f(yc[c2][rg]) + h[c2]) * gelu_tanh(bf2f(gc[c2][rg]))); } }
        }
    }
    if (!MODE) {
#pragma unroll
        for (int c2 = 0; c2 < 2; ++c2) { float* ag = agg + (((size_t)ch * 2 + DIR) * 512 + cch + 16 * c2) * 2; ag[0] = P[c2]; ag[1] = h[c2]; } }
}
__device__ __forceinline__ void lru_prepass(const Args& a, int l, int lane, int tok0, int nb, LAS unsigned char* xt) {
    const bf16* Z = (const bf16*)(a.ws + WS_Z);
    int s0, T; seq_of(tok0, s0, T); const int s1 = s0 + T;
    const int oc = lane & 7, tg = lane >> 3, cbase = 64 * nb + 8 * oc; float cw[4][8], cbv[8];
    v4u x[19];
    const int tb = tok0 + 16 * tg - 2;
#pragma unroll
    for (int i = 0; i < 19; ++i) { const int tt = tb + i; x[i] = (v4u){0u, 0u, 0u, 0u}; if (tt >= s0 && tt < s1) x[i] = *(const v4u*)(Z + (size_t)tt * ZW + ZXR + cbase); }
#pragma unroll
    for (int tp = 0; tp < 4; ++tp) { const f32x4* wp = (const f32x4*)(a.in[I_CW] + ((size_t)l * 4 + tp) * 512 + cbase); const f32x4 w0 = wp[0], w1 = wp[1];
        cw[tp][0] = w0.x; cw[tp][1] = w0.y; cw[tp][2] = w0.z; cw[tp][3] = w0.w; cw[tp][4] = w1.x; cw[tp][5] = w1.y; cw[tp][6] = w1.z; cw[tp][7] = w1.w; }
    { const f32x4* bp = (const f32x4*)(a.in[I_CB] + (size_t)l * 512 + cbase); const f32x4 b0 = bp[0], b1 = bp[1]; cbv[0] = b0.x; cbv[1] = b0.y; cbv[2] = b0.z; cbv[3] = b0.w; cbv[4] = b1.x; cbv[5] = b1.y; cbv[6] = b1.z; cbv[7] = b1.w; }
    LDS_WAIT();
#pragma unroll
    for (int i = 0; i < 16; ++i) { float acc[8];
#pragma unroll
        for (int e = 0; e < 8; ++e) acc[e] = cbv[e];
#pragma unroll
        for (int tp = 0; tp < 4; ++tp) { const v4u xx = x[i + tp];
            acc[0] += cw[tp][0] * bflo(xx.x); acc[1] += cw[tp][1] * bfhi(xx.x); acc[2] += cw[tp][2] * bflo(xx.y); acc[3] += cw[tp][3] * bfhi(xx.y);
            acc[4] += cw[tp][4] * bflo(xx.z); acc[5] += cw[tp][5] * bfhi(xx.z); acc[6] += cw[tp][6] * bflo(xx.w); acc[7] += cw[tp][7] * bfhi(xx.w); }
        v4u o; o.x = pk2(acc[0], acc[1]); o.y = pk2(acc[2], acc[3]); o.z = pk2(acc[4], acc[5]); o.w = pk2(acc[6], acc[7]);
        *(LAS v4u*)(xt + (16 * tg + i) * 128 + oc * 16) = o; asm volatile("s_nop 1" ::: "memory"); }
    LDS_WAIT();
}
template <int MODE> __device__ __forceinline__ void ph_scan(const Args& a, const Frame& F, int l) {
    int tid = threadIdx.x; asm volatile("" : "+v"(tid)); int lane = tid & 63; (void)lane;
    LAS unsigned char* slab = F.lds + RING_OFF + F.wave * 16384;
    LAS int* ctr = (LAS int*)(F.lds + MISC_OFF + 64);
    __syncthreads(); if (tid == 0) *ctr = 0; __syncthreads();
    constexpr int NLU = (NLCH / 4) * 16, NSU = (NSCH / 4) * 32;
    const int l0 = (int)((long)NLU * F.vcu / F.G), l1 = (int)((long)NLU * (F.vcu + 1) / F.G), s0u = (int)((long)NSU * F.vcu / F.G), s1u = (int)((long)NSU * (F.vcu + 1) / F.G);
    const int nl = l1 - l0, ntot = nl + (s1u - s0u);
    for (;;) {
        int it = 0; if (lane == 0) it = __hip_atomic_fetch_add(ctr, 1, __ATOMIC_RELAXED, __HIP_MEMORY_SCOPE_WORKGROUP);
        it = __builtin_amdgcn_readfirstlane(it);
        if (it >= ntot) break;
        if (it < nl) { const int u = l0 + it, half = u & 1, nb = (u >> 1) & 7, cq = u >> 4, tok0 = cq * 4 * LCH;
            bf16* hf = (bf16*)(a.ws + WS_HF) + (size_t)u * 4096;
            lru_prepass(a, l, lane, tok0, nb, slab);
            lru_dir<MODE, 0>(a, l, lane, tok0, nb, half, slab, hf); lru_dir<MODE, 1>(a, l, lane, tok0, nb, half, slab, hf);
        } else { const int u = s0u + it - nl, gr = u & 31, cq = u >> 5, tok0 = cq * 4 * SCH;
            bf16* yf = (bf16*)(a.ws + WS_HF + 40 * MiB) + (size_t)u * 4096;
            s5_dir<MODE, 0>(a, l, lane, tok0, gr, slab, yf); s5_dir<MODE, 1>(a, l, lane, tok0, gr, slab, yf); }
    }
    LDS_WAIT();
}

__device__ __forceinline__ void ph_carries(const Args& a, const Frame& F, int l) {
    int tid = threadIdx.x; asm volatile("" : "+v"(tid)); int lane = tid & 63; (void)lane;
    constexpr int NL_LONG = 2 * 2 * 512 * (16384 / LCH / 16), NL_SHORT = 4 * 2 * 512 * (2048 / LCH / 16);
    constexpr int NS_LONG = 2 * 2 * 2048 * (16384 / SCH / 16), NS_SHORT = 4 * 2 * 2048 * (2048 / SCH / 16);
    constexpr int NITEM = NL_LONG + NL_SHORT + NS_LONG + NS_SHORT;
    static_assert(NL_LONG % 512 == 0 && NL_SHORT % 512 == 0 && NS_LONG % 512 == 0 && NS_SHORT % 512 == 0, "item classes are whole workgroups");
    for (int base = F.vcu * NTHR; base < NITEM; base += F.G * NTHR) {
        int it = base + tid;
        if (it < NL_LONG + NL_SHORT) {
            const bool lg = it < NL_LONG; if (!lg) it -= NL_LONG;
            const int W = lg ? (16384 / LCH / 16) : (2048 / LCH / 16); const int seg = it & (W - 1), chain = it / W;
            const int c = chain & 511, dir = (chain >> 9) & 1, sq = chain >> 10; const int s0 = lg ? 8192 + sq * 16384 : sq * 2048, T = lg ? 16384 : 2048; const int c0 = s0 / LCH, nc = T / LCH;
            const f32x2* agg = (const f32x2*)(a.ws + WS_LAGG); float* cin = (float*)(a.ws + WS_LCIN);
            f32x2 v[16]; float A = 1.f, B = 0.f;
#pragma unroll
            for (int j = 0; j < 16; ++j) { const int pos = seg * 16 + j, ch = c0 + (dir ? nc - 1 - pos : pos); v[j] = agg[((size_t)ch * 2 + dir) * 512 + c]; }
#pragma unroll
            for (int j = 0; j < 16; ++j) { B = v[j].x * B + v[j].y; A *= v[j].x; }
            for (int off = 1; off < W; off <<= 1) { const float Ap = __shfl_up(A, off, 64), Bp = __shfl_up(B, off, 64); if (seg >= off) { B = A * Bp + B; A = A * Ap; } }
            float carry = __shfl_up(B, 1, 64); if (seg == 0) carry = 0.f;
#pragma unroll
            for (int j = 0; j < 16; ++j) { const int pos = seg * 16 + j, ch = c0 + (dir ? nc - 1 - pos : pos); cin[((size_t)ch * 2 + dir) * 512 + c] = carry; carry = v[j].x * carry + v[j].y; }
        } else {
            it -= NL_LONG + NL_SHORT;
            const bool lg = it < NS_LONG; if (!lg) it -= NS_LONG;
            const int W = lg ? (16384 / SCH / 16) : (2048 / SCH / 16); const int seg = it & (W - 1), chain = it / W;
            const int p = chain & 63, g = (chain >> 6) & 31, dir = (chain >> 11) & 1, sq = chain >> 12; const int s0 = lg ? 8192 + sq * 16384 : sq * 2048, T = lg ? 16384 : 2048; const int c0 = s0 / SCH, nc = T / SCH;
            const float* TLB = (const float*)(a.ws + WS_TLB); const f32x2* E = (const f32x2*)(a.ws + WS_SEND); f32x2* CIN = (f32x2*)(a.ws + WS_SCIN);
            float pr = TLB[((size_t)(dir * 32 + g) * 64 + p) * 2], pi = TLB[((size_t)(dir * 32 + g) * 64 + p) * 2 + 1];
            static_assert(SCH == 64, "lb^SCH by 6 squarings");
#pragma unroll
            for (int i = 0; i < 6; ++i) { const float nr = pr * pr - pi * pi, ni = 2.f * pr * pi; pr = nr; pi = ni; }
            f32x2 v[16]; float Br = 0.f, Bi = 0.f;
#pragma unroll
            for (int j = 0; j < 16; ++j) { const int pos = seg * 16 + j, ch = c0 + (dir ? nc - 1 - pos : pos); v[j] = E[(((size_t)ch * 2 + dir) * 32 + g) * 64 + p]; }
#pragma unroll
            for (int j = 0; j < 16; ++j) { const float nr = pr * Br - pi * Bi + v[j].x, ni = pr * Bi + pi * Br + v[j].y; Br = nr; Bi = ni; }
            float Ar = pr, Ai = pi;
#pragma unroll
            for (int i = 0; i < 4; ++i) { const float nr = Ar * Ar - Ai * Ai, ni = 2.f * Ar * Ai; Ar = nr; Ai = ni; }
            for (int off = 1; off < W; off <<= 1) { const float Apr = __shfl_up(Ar, off, 64), Api = __shfl_up(Ai, off, 64), Bpr = __shfl_up(Br, off, 64), Bpi = __shfl_up(Bi, off, 64);
                if (seg >= off) { const float nbr = Ar * Bpr - Ai * Bpi + Br, nbi = Ar * Bpi + Ai * Bpr + Bi, nar = Ar * Apr - Ai * Api, nai = Ar * Api + Ai * Apr; Br = nbr; Bi = nbi; Ar = nar; Ai = nai; } }
            float cr = __shfl_up(Br, 1, 64), ci = __shfl_up(Bi, 1, 64); if (seg == 0) { cr = 0.f; ci = 0.f; }
#pragma unroll
            for (int j = 0; j < 16; ++j) { const int pos = seg * 16 + j, ch = c0 + (dir ? nc - 1 - pos : pos); CIN[(((size_t)ch * 2 + dir) * 32 + g) * 64 + p] = (f32x2){cr, ci};
                const float nr = pr * cr - pi * ci + v[j].x, ni = pr * ci + pi * cr + v[j].y; cr = nr; ci = ni; }
        }
    }
}

__device__ __forceinline__ void ph_groupnorm(const Args& a, const Frame& F, int l, bf16* dst = nullptr) {
    int tid = threadIdx.x; asm volatile("" : "+v"(tid)); int lane = tid & 63; (void)lane;
    bf16* Y = (bf16*)(a.ws + WS_Y); const float* g = a.in[I_GOUT] + (size_t)l * DM;
    const int gw = F.vcu * NWAVES + F.wave, NGW = F.G * NWAVES;
    static_assert(NTOK % (256 * NWAVES * 4) == 0 || true, "");
    for (int m0 = gw; m0 < NTOK; m0 += 4 * NGW) {
        v4u w[4][4];
#pragma unroll
        for (int r = 0; r < 4; ++r) { const int m = m0 + r * NGW; const v4u* yr = (const v4u*)(Y + (size_t)(m < NTOK ? m : m0) * DM) + lane;
#pragma unroll
            for (int j = 0; j < 4; ++j) w[r][j] = yr[64 * j]; }
        f32x4 g0[4], g1[4];
#pragma unroll
        for (int j = 0; j < 4; ++j) { const f32x4* gp = (const f32x4*)(g + 8 * (lane + 64 * j)); g0[j] = gp[0]; g1[j] = gp[1]; }
#pragma unroll
        for (int r = 0; r < 4; ++r) { const int m = m0 + r * NGW; float ss[4];
#pragma unroll
            for (int j = 0; j < 4; ++j) { float sq = 0.f;
#pragma unroll
                for (int q = 0; q < 4; ++q) { const float lo = bflo(w[r][j][q]), hi = bfhi(w[r][j][q]); sq += lo * lo + hi * hi; }
                ss[j] = sq; }
            const float sa = wave_sum(ss[0] + ss[1]), sb = wave_sum(ss[2]), sc = wave_sum(ss[3]);
            const float ra = 1.f / sqrtf(sa * (1.f / 1024.f) + EPS), rb = 1.f / sqrtf(sb * (1.f / 512.f) + EPS), rc = 1.f / sqrtf(sc * (1.f / 512.f) + EPS);
            if (m < NTOK) {
                v4u* yo = (dst ? (v4u*)(dst + (size_t)m * DM) : (v4u*)(Y + (size_t)m * DM)) + lane;
#pragma unroll
                for (int j = 0; j < 4; ++j) { const float rr = j < 2 ? ra : (j == 2 ? rb : rc);
                    v4u o; o.x = pk2(bflo(w[r][j].x) * rr * g0[j].x, bfhi(w[r][j].x) * rr * g0[j].y); o.y = pk2(bflo(w[r][j].y) * rr * g0[j].z, bfhi(w[r][j].y) * rr * g0[j].w);
                    o.z = pk2(bflo(w[r][j].z) * rr * g1[j].x, bfhi(w[r][j].z) * rr * g1[j].y); o.w = pk2(bflo(w[r][j].w) * rr * g1[j].z, bfhi(w[r][j].w) * rr * g1[j].w);
                    yo[64 * j] = o; } } }
    }
}

__device__ __forceinline__ void ph_norm2(const Args& a, const Frame& F, int l) {
    int tid = threadIdx.x; asm volatile("" : "+v"(tid)); int lane = tid & 63; (void)lane;
    const int gw = F.vcu * NWAVES + F.wave, NGW = F.G * NWAVES; const float* g = a.in[I_NLG] + (size_t)l * DM; bf16* H = (bf16*)(a.ws + WS_H);
    for (int m = gw; m < NTOK; m += NGW) norm_row_bf16(a.out + (size_t)m * DM, g, H + (size_t)m * DM, lane);
}
__device__ __forceinline__ void ph_final(const Args& a, const Frame& F, float* dst = nullptr) {
    int tid = threadIdx.x; asm volatile("" : "+v"(tid)); int lane = tid & 63; (void)lane;
    const int gw = F.vcu * NWAVES + F.wave, NGW = F.G * NWAVES; const f32x4* gr = (const f32x4*)a.in[I_FING] + lane;
    for (int m0 = gw; m0 < NTOK; m0 += 2 * NGW) {
        f32x4 v[2][8];
#pragma unroll
        for (int r = 0; r < 2; ++r) { const int m = m0 + r * NGW; const f32x4* xr = (const f32x4*)(a.out + (size_t)(m < NTOK ? m : m0) * DM) + lane;
#pragma unroll
            for (int j = 0; j < 8; ++j) v[r][j] = xr[64 * j]; }
#pragma unroll
        for (int r = 0; r < 2; ++r) { const int m = m0 + r * NGW; float sq = 0.f;
#pragma unroll
            for (int j = 0; j < 8; ++j) sq += (v[r][j].x * v[r][j].x + v[r][j].y * v[r][j].y) + (v[r][j].z * v[r][j].z + v[r][j].w * v[r][j].w);
            const float rstd = 1.f / sqrtf(wave_sum(sq) * (1.f / DM) + EPS);
            if (m < NTOK) { f32x4* xo = (dst ? (f32x4*)(dst + (size_t)m * DM) : (f32x4*)(a.out + (size_t)m * DM)) + lane;
#pragma unroll
                for (int j = 0; j < 8; ++j) xo[64 * j] = v[r][j] * rstd * gr[64 * j]; } }
    }
}

__global__ void __launch_bounds__(NTHR, 2) mk_fwd(Args args) {
    extern __shared__ __attribute__((aligned(16))) unsigned char lds[];
    Frame F; F.lds = (LAS unsigned char*)lds; F.ldsg = lds;
    F.tid = threadIdx.x; F.lane = F.tid & 63; F.wave = __builtin_amdgcn_readfirstlane(F.tid >> 6);
    F.G = gridDim.x; { const int bx = blockIdx.x; F.vcu = (F.G % 8 == 0) ? (bx % 8) * (F.G / 8) + bx / 8 : bx; }
    volatile LAS unsigned* MISC = (volatile LAS unsigned*)(F.lds + MISC_OFF);
    for (int u = F.tid; u < (LDS_BYTES - LDSCTL_OFF) / 4; u += NTHR) ((LAS unsigned*)(F.lds + LDSCTL_OFF))[u] = 0u;
    __syncthreads();
    unsigned char* ws = args.ws;
    XcdBarrier bar; bar.bar = (unsigned*)(ws + WS_CTL) + CW_BAR; bar.x = 0; bar.st = nullptr;
#if MK_ONE_LAUNCH
    bar = xcd_barrier_post((unsigned*)(ws + WS_CTL) + CW_BAR, MISC + 8);
#endif
    const int lo = args.ph_lo, hi = args.ph_hi;
#define IN(k) (lo <= (k) && (k) < hi)
#if MK_ONE_LAUNCH
#if PROBE_BAR2
#define SEAM(k) do { if (IN(k) && IN((k) + 1)) { xcd_barrier(bar); xcd_barrier(bar); } } while (0)
#else
#define SEAM(k) do { if (IN(k) && IN((k) + 1)) xcd_barrier(bar); } while (0)
#endif
#else
#define SEAM(k) do { } while (0)
#endif
    for (int l = 0; l < DEPTH; ++l) {
        const int pb = l * PH_PER_LAYER;
        if (IN(pb + 0)) { ph_prologue(args, F, l);
#if PROBE_PRO2
            __syncthreads(); ph_prologue(args, F, l);
#endif
        } SEAM(pb + 0);
        if (IN(pb + 1)) {
            pg8::Gemm g{(const bf16*)(ws + WS_H), (const bf16*)(ws + WS_WIN), NTOK, ZW, DM}; pg8::StaticOrder S; S.init(NTOK, ZW, F.G, (int)blockIdx.x);
            pg8::EpiBf16<0> E{(bf16*)(ws + WS_Z), ZW, (const unsigned long long*)(ws + WS_SSQ) + (size_t)(l * 2) * NTOK, (LAS float*)(F.lds + XTRA_OFF)};
            pg8::gemm_phase<pg8::EpiBf16<0>, pg8::StaticOrder, true, true>(F.lds + RING_OFF, g, S, E);
#if PROBE_WIN2
            pg8::gemm_phase<pg8::EpiBf16<0>, pg8::StaticOrder, true, true>(F.lds + RING_OFF, g, S, E);
#endif
        } SEAM(pb + 1);
        if (IN(pb + 2)) { ph_na_mfma(args, F, l); ph_scan<0>(args, F, l);
#if PROBE_NA2
            __syncthreads(); ph_na_mfma(args, F, l);
#endif
#if PROBE_SCAN2
            ph_scan<0>(args, F, l);
#endif
        } SEAM(pb + 2);
        if (IN(pb + 3)) { ph_carries(args, F, l);
#if PROBE_SCAN2 || PROBE_CAR2
            ph_carries(args, F, l);
#endif
        } SEAM(pb + 3);
        if (IN(pb + 4)) { ph_scan<1>(args, F, l);
#if PROBE_SCAN2
            ph_scan<1>(args, F, l);
#endif
        } SEAM(pb + 4);
        if (IN(pb + 5)) {
            __syncthreads();
            pg8::Gemm g{(const bf16*)(ws + WS_YG), (const bf16*)(ws + WS_WGLU), NTOK, 512, 512}; pg8::StaticOrder S; S.init(NTOK, 512, F.G, (int)blockIdx.x);
            pg8::EpiGlu E{(const bf16*)(ws + WS_YG), (bf16*)(ws + WS_Y), args.in[I_BGLU] + (size_t)l * 512, DM, 1536};
            pg8::gemm_phase<pg8::EpiGlu, pg8::StaticOrder, true, true>(F.lds + RING_OFF, g, S, E);
#if PROBE_GLU2
            pg8::gemm_phase<pg8::EpiGlu, pg8::StaticOrder, true, true>(F.lds + RING_OFF, g, S, E);
#endif
        } SEAM(pb + 5);
        if (IN(pb + 6)) {
#if PROBE_GN2
            ph_groupnorm(args, F, l, (bf16*)(ws + WS_Z));
#endif
            ph_groupnorm(args, F, l); } SEAM(pb + 6);
        if (IN(pb + 7)) {
            pg8::Gemm g{(const bf16*)(ws + WS_Y), (const bf16*)(ws + WS_WOUT), NTOK, DM, DM}; pg8::StaticOrder S; S.init(NTOK, DM, F.G, (int)blockIdx.x);
#if PROBE_WOUT2
            { pg8::EpiResid E2{l == 0 ? args.in[I_XP] : nullptr, l == 0 ? args.in[I_XS] : nullptr, 8192, (float*)(ws + WS_Z), DM, (bf16*)(ws + WS_H), nullptr};
              pg8::gemm_phase<pg8::EpiResid, pg8::StaticOrder, true, true>(F.lds + RING_OFF, g, S, E2); }
#endif
            pg8::EpiResid E{l == 0 ? args.in[I_XP] : nullptr, l == 0 ? args.in[I_XS] : nullptr, 8192, nullptr, DM, (bf16*)(ws + WS_H), (unsigned long long*)(ws + WS_SSQ) + (size_t)(l * 2 + 1) * NTOK};
            pg8::gemm_phase<pg8::EpiResid, pg8::StaticOrder, true, true>(F.lds + RING_OFF, g, S, E);
        } SEAM(pb + 7);
        for (int s = 0; s <= NMLPC; ++s) {
            if (IN(pb + 8 + s)) {
                if (s > 0) {
                    const int c = s - 1;
                    pg8::Gemm g{(const bf16*)(ws + WS_Z + (size_t)(c & 1) * 128 * MiB), (const bf16*)(ws + WS_WDN), MLPC, DM, DFF}; pg8::StaticOrder S; S.init(MLPC, DM, F.G, (int)blockIdx.x);
                    pg8::EpiResid E{nullptr, nullptr, 1 << 30, l + 1 < DEPTH ? nullptr : args.out + (size_t)c * MLPC * DM, DM,
                                    (bf16*)(ws + WS_H) + (size_t)c * MLPC * DM, (unsigned long long*)(ws + WS_SSQ) + (size_t)((l + 1 < DEPTH ? l + 1 : 0) * 2) * NTOK + (size_t)c * MLPC};
#if PROBE_DN2
                    { pg8::EpiResid E2{nullptr, nullptr, 1 << 30, (float*)(ws + WS_Z + 256 * MiB), DM, (bf16*)(ws + WS_H) + (size_t)c * MLPC * DM, nullptr};
                      pg8::gemm_phase<pg8::EpiResid, pg8::StaticOrder, true, true>(F.lds + RING_OFF, g, S, E2); }
#endif
                    pg8::gemm_phase<pg8::EpiResid, pg8::StaticOrder, true, true>(F.lds + RING_OFF, g, S, E);
                }
                if (s < NMLPC) {
                    const int c = s;
                    pg8::Gemm g{(const bf16*)(ws + WS_H) + (size_t)c * MLPC * DM, (const bf16*)(ws + WS_WUP), MLPC, DFF, DM}; pg8::StaticOrder S; S.init(MLPC, DFF, F.G, (int)blockIdx.x);
                    pg8::EpiBf16<1> E{(bf16*)(ws + WS_Z + (size_t)(c & 1) * 128 * MiB), DFF, (const unsigned long long*)(ws + WS_SSQ) + (size_t)(l * 2 + 1) * NTOK + (size_t)c * MLPC, (LAS float*)(F.lds + XTRA_OFF)};
                    pg8::gemm_phase<pg8::EpiBf16<1>, pg8::StaticOrder, true, true>(F.lds + RING_OFF, g, S, E);
#if PROBE_UP2
                    pg8::gemm_phase<pg8::EpiBf16<1>, pg8::StaticOrder, true, true>(F.lds + RING_OFF, g, S, E);
#endif
                }
            } SEAM(pb + 8 + s);
        }
    }
    if (IN(NPHASE - 1)) {
#if PROBE_FIN2
        ph_final(args, F, (float*)(ws + WS_Z));
#endif
        ph_final(args, F); }
#undef IN
#undef SEAM
}

extern "C" void kernel_launch(void* const* d_in, const int* in_sizes, int n_in, void* d_out, int out_size, void* d_ws, size_t ws_size, hipStream_t stream) {
    static int grid = 0;
    if (grid == 0) {
        if (n_in != 28 || out_size != NTOK * DM || ws_size < WS_END) { fprintf(stderr, "kernel_launch: unexpected shapes (n_in %d out %d ws %zu)\n", n_in, out_size, ws_size); grid = -1; return; }
        int dev = 0, cus = 0, per_cu = 0;
        if (hipGetDevice(&dev) != hipSuccess || hipDeviceGetAttribute(&cus, hipDeviceAttributeMultiprocessorCount, dev) != hipSuccess) { grid = -1; return; }
        if (hipFuncSetAttribute((const void*)mk_fwd, hipFuncAttributeMaxDynamicSharedMemorySize, LDS_BYTES) != hipSuccess) { fprintf(stderr, "kernel_launch: hipFuncSetAttribute failed\n"); grid = -1; return; }
        if (hipOccupancyMaxActiveBlocksPerMultiprocessor(&per_cu, (const void*)mk_fwd, NTHR, LDS_BYTES) != hipSuccess || per_cu < 1) fprintf(stderr, "kernel_launch: occupancy query says %d\n", per_cu);
        (void)hipGetLastError();
        grid = cus;
    }
    if (grid < 0) return;
    if (hipMemsetAsync((char*)d_ws + WS_CTL, 0, CTL_ZERO_BYTES, stream) != hipSuccess) return;
    if (hipMemsetAsync((char*)d_ws + WS_SSQ, 0, SSQ_BYTES, stream) != hipSuccess) return;
    Args a{};
    for (int i = 0; i < 28; ++i) a.in[i] = (const float*)d_in[i];
    a.out = (float*)d_out; a.ws = (unsigned char*)d_ws;
#if MK_ONE_LAUNCH
    a.ph_lo = 0; a.ph_hi = NPHASE;
    hipLaunchKernelGGL(mk_fwd, dim3(grid), dim3(NTHR), LDS_BYTES, stream, a);
#else
    for (int ph = 0; ph < NPHASE; ++ph) { a.ph_lo = ph; a.ph_hi = ph + 1; hipLaunchKernelGGL(mk_fwd, dim3(grid), dim3(NTHR), LDS_BYTES, stream, a); }
#endif
}
```

```cpp
#include <hip/hip_runtime.h>
#include <cstdio>
#include <cstdint>
namespace pg8 {
#define PG8_LAS __attribute__((address_space(3)))
typedef unsigned short bf16_t;
typedef short bf16x8 __attribute__((ext_vector_type(8)));
typedef float f32x4 __attribute__((ext_vector_type(4)));
typedef unsigned u32x4 __attribute__((ext_vector_type(4)));
constexpr int BM = 256, BK = 64, HALF = 128, HTB = HALF * BK * 2  , STAGE_BYTES = 8 * HTB, NXCD = 8, WGM = 8;

__host__ __device__ __forceinline__ int lds_byte(int r, int c) { const int st = (r >> 4) * 2 + (c >> 5), rr = r & 15, cc = c & 31, ob = rr * 64 + cc * 2; return st * 1024 + (ob ^ (((ob >> 9) & 1) << 5)); }
__host__ __device__ __forceinline__ void stage_rc(int b, int& R, int& C) { const int st = b / 1024, sb = b % 1024, swz = sb ^ (((sb >> 9) & 1) << 5); R = (st >> 1) * 16 + swz / 64; C = (st & 1) * 32 + (swz % 64) / 2; }
__host__ __device__ __forceinline__ int perm32(int rho) { const int n = rho >> 4, i = rho & 15; return 8 * (i >> 2) + 4 * n + (i & 3); }

struct Unit { int pm, pn; };
struct Gemm { const bf16_t* A; const bf16_t* Bt; int M, N, K; };

struct StaticOrder {
    int nM, nN, nwg, G, c;
    __host__ __device__ void init(int M, int N, int G_, int c_) { nM = M / BM; nN = N / BM; nwg = nM * nN; G = G_; c = c_; }
    __host__ __device__ bool next(int i, Unit& u) const {
        const long L = (long)i * G + c; if (L >= nwg) return false;
        int wgid = (int)L; { const int q = nwg / NXCD, r = nwg % NXCD, xcd = wgid % NXCD, off = wgid / NXCD; wgid = (xcd < r ? xcd * (q + 1) : r * (q + 1) + (xcd - r) * q) + off; }
        const int nig = WGM * nN, gid = wgid / nig, fm = gid * WGM, gsz = (nM - fm) < WGM ? (nM - fm) : WGM;
        u.pm = fm + ((wgid % nig) % gsz); u.pn = (wgid % nig) / gsz; return true;
    }
    __device__ __forceinline__ void a_ready(const Unit&) const {}
    __device__ __forceinline__ void done(const Unit&) const {}
};
__device__ __forceinline__ unsigned cvt_pk_bf16(float lo, float hi) { unsigned r; asm volatile("v_cvt_pk_bf16_f32 %0, %1, %2" : "=v"(r) : "v"(lo), "v"(hi)); return r; }
template <int ACT> struct EpiBf16 {
    static constexpr bool PERM = true, AFTER_DRAIN = false, HAS_PRE = true;
    bf16_t* O; int ldc; const unsigned long long* SS; PG8_LAS float* tbl;
    template <class Sched> __device__ __forceinline__ void pre_all(const Sched& S, int tid) const {
        unsigned long long v[12]; Unit u;
#pragma unroll
        for (int i = 0; i < 12; ++i) { v[i] = 0ull; if (S.next(i, u)) v[i] = SS[u.pm * BM + (tid & 255)]; }
#pragma unroll
        for (int i = 0; i < 12; ++i) if (tid < 256 && S.next(i, u)) tbl[i * 256 + tid] = 1.f / sqrtf((float)v[i] * (1.f / 1048576.f / 2048.f) + 1e-6f);
    }
    __device__ __forceinline__ void operator()(const f32x4 (&acc)[2][2][4][2], const Unit& u, int wr, int wc, int fr, int fq, int slot) const {
        const int row0 = u.pm * BM + wr * 64 + fr; const int col0 = u.pn * BM + wc * 64 + 8 * fq;
        const unsigned ta = (unsigned)(size_t)(tbl + slot * 256 + wr * 64 + fr);
        float rs[2][4];
#pragma unroll
        for (int ai = 0; ai < 2; ++ai)
#pragma unroll
            for (int m = 0; m < 4; ++m) asm volatile("ds_read_b32 %0, %1 offset:%2" : "=v"(rs[ai][m]) : "v"(ta), "i"((ai * HALF + m * 16) * 4));
        asm volatile("s_waitcnt lgkmcnt(0)" : "+v"(rs[0][0]), "+v"(rs[0][1]), "+v"(rs[0][2]), "+v"(rs[0][3]), "+v"(rs[1][0]), "+v"(rs[1][1]), "+v"(rs[1][2]), "+v"(rs[1][3]));
#pragma unroll
        for (int ai = 0; ai < 2; ++ai)
#pragma unroll
            for (int m = 0; m < 4; ++m) { bf16_t* rowp = O + (size_t)(row0 + ai * HALF + m * 16) * ldc + col0; const float r = rs[ai][m];
#pragma unroll
                for (int bj = 0; bj < 2; ++bj) { f32x4 v0 = acc[ai][bj][m][0] * r, v1 = acc[ai][bj][m][1] * r;
                    if (ACT == 1) {
#pragma unroll
                        for (int j = 0; j < 4; ++j) { const float a = fmaxf(v0[j], 0.f), b = fmaxf(v1[j], 0.f); v0[j] = a * a; v1[j] = b * b; } }
                    u32x4 w; w.x = cvt_pk_bf16(v0[0], v0[1]); w.y = cvt_pk_bf16(v0[2], v0[3]); w.z = cvt_pk_bf16(v1[0], v1[1]); w.w = cvt_pk_bf16(v1[2], v1[3]);
                    *(u32x4*)(rowp + bj * 32) = w; } }
    }
};
struct EpiResid {
    static constexpr bool PERM = true, AFTER_DRAIN = false, HAS_PRE = false;
    const float* Xin0; const float* Xin1; int split; float* Xout; int ldc; bf16_t* XB; unsigned long long* SS;
    __device__ __forceinline__ void operator()(const f32x4 (&acc)[2][2][4][2], const Unit& u, int wr, int wc, int fr, int fq, int) const {
        const int row0 = u.pm * BM + wr * 64 + fr, col0 = u.pn * BM + wc * 64 + 8 * fq;
        const float* Xin = (u.pm * BM < split) ? Xin0 : Xin1 - (size_t)split * ldc;
#pragma unroll
        for (int am = 0; am < 4; ++am) { const int ai = am >> 1, m0 = (am & 1) * 2;
            f32x4 xf[2][2][2]; u32x4 xr[2][2];
            if (Xin0) {
#pragma unroll
                for (int mm = 0; mm < 2; ++mm) { const size_t ro = (size_t)(row0 + ai * HALF + (m0 + mm) * 16) * ldc + col0;
#pragma unroll
                    for (int bj = 0; bj < 2; ++bj) { xf[mm][bj][0] = *(const f32x4*)(Xin + ro + bj * 32); xf[mm][bj][1] = *(const f32x4*)(Xin + ro + bj * 32 + 4); } }
            } else {
#pragma unroll
                for (int mm = 0; mm < 2; ++mm)
#pragma unroll
                    for (int bj = 0; bj < 2; ++bj) xr[mm][bj] = *(const u32x4*)(XB + (size_t)(row0 + ai * HALF + (m0 + mm) * 16) * ldc + col0 + bj * 32);
            }
            asm volatile("" ::: "memory");
#pragma unroll
            for (int mm = 0; mm < 2; ++mm) { const int m = m0 + mm; const int row = row0 + ai * HALF + m * 16; const size_t ro = (size_t)row * ldc + col0; float ss = 0.f;
#pragma unroll
                for (int bj = 0; bj < 2; ++bj) { f32x4 x0, x1;
                    if (Xin0) { x0 = xf[mm][bj][0]; x1 = xf[mm][bj][1]; }
                    else { const u32x4 w = xr[mm][bj];
                        x0 = (f32x4){__uint_as_float(w.x << 16), __uint_as_float(w.x & 0xffff0000u), __uint_as_float(w.y << 16), __uint_as_float(w.y & 0xffff0000u)};
                        x1 = (f32x4){__uint_as_float(w.z << 16), __uint_as_float(w.z & 0xffff0000u), __uint_as_float(w.w << 16), __uint_as_float(w.w & 0xffff0000u)}; }
                    x0 = x0 + acc[ai][bj][m][0]; x1 = x1 + acc[ai][bj][m][1];
                    if (Xout) { *(f32x4*)(Xout + ro + bj * 32) = x0; *(f32x4*)(Xout + ro + bj * 32 + 4) = x1; }
                    else { u32x4 w; w.x = cvt_pk_bf16(x0[0], x0[1]); w.y = cvt_pk_bf16(x0[2], x0[3]); w.z = cvt_pk_bf16(x1[0], x1[1]); w.w = cvt_pk_bf16(x1[2], x1[3]); *(u32x4*)(XB + ro + bj * 32) = w;
#pragma unroll
                        for (int j = 0; j < 4; ++j) { const float lo = __uint_as_float(w[j] << 16), hi = __uint_as_float(w[j] & 0xffff0000u); ss += lo * lo + hi * hi; } } }
                if (!Xout) { ss += __shfl_xor(ss, 16); ss += __shfl_xor(ss, 32); if (fq == 0) atomicAdd(SS + row, (unsigned long long)(ss * 1048576.f + 0.5f)); } }
            asm volatile("" ::: "memory");
        }
    }
};
struct EpiGlu {
    static constexpr bool PERM = true, AFTER_DRAIN = false, HAS_PRE = false;
    const bf16_t* YG; bf16_t* Y; const float* bias; int ldy; int ycol0;
    __device__ __forceinline__ void operator()(const f32x4 (&acc)[2][2][4][2], const Unit& u, int wr, int wc, int fr, int fq, int) const {
        const int row0 = u.pm * BM + wr * 64 + fr; const int col0 = u.pn * BM + wc * 64 + 8 * fq;
        f32x4 bb[2][2];
#pragma unroll
        for (int bj = 0; bj < 2; ++bj) { bb[bj][0] = *(const f32x4*)(bias + col0 + bj * 32); bb[bj][1] = *(const f32x4*)(bias + col0 + bj * 32 + 4); }
#pragma unroll
        for (int ai = 0; ai < 2; ++ai) {
            u32x4 gl[4][2];
#pragma unroll
            for (int m = 0; m < 4; ++m)
#pragma unroll
                for (int bj = 0; bj < 2; ++bj) gl[m][bj] = *(const u32x4*)(YG + (size_t)(row0 + ai * HALF + m * 16) * 512 + col0 + bj * 32);
            asm volatile("" ::: "memory");
#pragma unroll
            for (int m = 0; m < 4; ++m) { const int row = row0 + ai * HALF + m * 16;
#pragma unroll
                for (int bj = 0; bj < 2; ++bj) { const int col = col0 + bj * 32; const u32x4 g = gl[m][bj];
                    const f32x4 v0 = acc[ai][bj][m][0] + bb[bj][0], v1 = acc[ai][bj][m][1] + bb[bj][1];
                    float o[8];
#pragma unroll
                    for (int j = 0; j < 4; ++j) { const unsigned gw0 = g[j >> 1], gw1 = g[2 + (j >> 1)];
                        const float y0 = __uint_as_float((j & 1) ? (gw0 & 0xffff0000u) : (gw0 << 16)), y1 = __uint_as_float((j & 1) ? (gw1 & 0xffff0000u) : (gw1 << 16));
                        o[j] = y0 * __builtin_amdgcn_rcpf(1.f + __expf(-v0[j])); o[4 + j] = y1 * __builtin_amdgcn_rcpf(1.f + __expf(-v1[j])); }
                    u32x4 w; w.x = cvt_pk_bf16(o[0], o[1]); w.y = cvt_pk_bf16(o[2], o[3]); w.z = cvt_pk_bf16(o[4], o[5]); w.w = cvt_pk_bf16(o[6], o[7]);
                    *(u32x4*)(Y + (size_t)row * ldy + ycol0 + col) = w; } }
            asm volatile("" ::: "memory");
        }
    }
};

template <class Epi, class Sched, bool ALIGN_EPI = false, bool SP2 = false>
__device__ __forceinline__ void gemm_phase(PG8_LAS unsigned char* lds, const Gemm g, const Sched& S, const Epi& E) {
    int tid_ = threadIdx.x; asm volatile("" : "+v"(tid_));
    const int tid = tid_, wid = __builtin_amdgcn_readfirstlane(tid >> 6), lane = tid & 63, wr = wid >> 2, wc = wid & 3, fr = lane & 15, fq = lane >> 4;
    const int K = g.K, nt = K / BK;
    unsigned voffA[2], voffB[2];
#pragma unroll
    for (int i = 0; i < 2; ++i) { int R, C; stage_rc(tid * 16 + i * 8192, R, C); const int Rb = Epi::PERM ? (64 * (R >> 5) + perm32(R & 31)) : R;
        voffA[i] = (unsigned)(R * K + C) * 2u; voffB[i] = (unsigned)(Rb * K + C) * 2u; }
    const size_t kstep = (size_t)(BK * 2);
    const size_t hstep = (size_t)HALF * K * 2;
    const size_t hstepB = Epi::PERM ? (size_t)32 * K * 2 : hstep;
    const size_t tstep = 2 * hstep;
    const unsigned ldsw = (unsigned)wid * 1024u;
    const int aoff = lds_byte(wr * 64 + fr, fq * 8), boff = lds_byte(wc * 32 + fr, fq * 8);
#define PG8_SA(b, h) (((b) * 2 + (h)) * HTB)
#define PG8_SB(b, h) ((4 + (b) * 2 + (h)) * HTB)
#define PG8_STAGE(bufoff, gbase, voff) do { _Pragma("unroll") for (int _i = 0; _i < 2; ++_i) \
        __builtin_amdgcn_global_load_lds((const unsigned*)((const char*)(gbase) + (voff)[_i]), (PG8_LAS unsigned*)(lds + (bufoff) + ldsw + _i * 8192), 16, 0, 0); } while (0)
#define PG8_LDA(dst, b, h) do { _Pragma("unroll") for (int m = 0; m < 4; ++m) _Pragma("unroll") for (int k = 0; k < 2; ++k) dst[m][k] = *(const PG8_LAS bf16x8*)(lds + PG8_SA(b, h) + aoff + m * 2048 + k * 1024); } while (0)
#define PG8_LDB(dst, b, h) do { _Pragma("unroll") for (int n = 0; n < 2; ++n) _Pragma("unroll") for (int k = 0; k < 2; ++k) dst[n][k] = *(const PG8_LAS bf16x8*)(lds + PG8_SB(b, h) + boff + n * 2048 + k * 1024); } while (0)
#define PG8_MMA(ai, bj, At, Bt) do { __builtin_amdgcn_s_setprio(1); _Pragma("unroll") for (int m = 0; m < 4; ++m) _Pragma("unroll") for (int n = 0; n < 2; ++n) _Pragma("unroll") for (int k = 0; k < 2; ++k) \
        acc[ai][bj][m][n] = __builtin_amdgcn_mfma_f32_16x16x32_bf16(Bt[n][k], At[m][k], acc[ai][bj][m][n], 0, 0, 0); __builtin_amdgcn_s_setprio(0); } while (0)
#define PG8_WAIT_V(n) asm volatile("s_waitcnt vmcnt(" #n ")" ::: "memory")
#define PG8_WAIT_L(n) asm volatile("s_waitcnt lgkmcnt(" #n ")" ::: "memory")
#define PG8_BAR __builtin_amdgcn_s_barrier()
#define PG8_SCHED __builtin_amdgcn_sched_barrier(0)
    Unit cur, nxt; int ui = 0;
    if (!S.next(0, cur)) return;
    if constexpr (Epi::HAS_PRE) E.pre_all(S, tid);
    f32x4 acc[2][2][4][2];
#pragma unroll
    for (int a = 0; a < 2; ++a)
#pragma unroll
        for (int b = 0; b < 2; ++b)
#pragma unroll
            for (int m = 0; m < 4; ++m)
#pragma unroll
                for (int n = 0; n < 2; ++n) acc[a][b][m][n] = (f32x4){0.f, 0.f, 0.f, 0.f};
    bf16x8 At[4][2], B0[2][2], B1[2][2];
    const char* cA = (const char*)g.A + (size_t)cur.pm * tstep; const char* cB = (const char*)g.Bt + (size_t)cur.pn * tstep;
    S.a_ready(cur);
    if constexpr (SP2) {
        PG8_STAGE(PG8_SB(0, 0), cB, voffB); PG8_STAGE(PG8_SB(0, 1), cB + hstepB, voffB); PG8_STAGE(PG8_SA(0, 0), cA, voffA); PG8_STAGE(PG8_SA(0, 1), cA + hstep, voffA);
        if (wr == 1) PG8_BAR;
        PG8_WAIT_V(2); PG8_BAR;
        PG8_STAGE(PG8_SB(1, 0), cB + kstep, voffB); PG8_STAGE(PG8_SA(1, 0), cA + kstep, voffA); PG8_STAGE(PG8_SB(1, 1), cB + hstepB + kstep, voffB);
        PG8_WAIT_V(6); PG8_BAR;
    } else {
        PG8_STAGE(PG8_SB(0, 0), cB, voffB); PG8_STAGE(PG8_SA(0, 0), cA, voffA); PG8_STAGE(PG8_SB(0, 1), cB + hstepB, voffB); PG8_STAGE(PG8_SA(0, 1), cA + hstep, voffA);
        if (wr == 1) PG8_BAR;
        PG8_WAIT_V(4); PG8_BAR;
        PG8_STAGE(PG8_SB(1, 0), cB + kstep, voffB); PG8_STAGE(PG8_SA(1, 0), cA + kstep, voffA); PG8_STAGE(PG8_SB(1, 1), cB + hstepB + kstep, voffB);
        PG8_WAIT_V(6); PG8_BAR;
    }
    for (;;) {
        const bool has_next = S.next(ui + 1, nxt);
        const char* nA = has_next ? (const char*)g.A + (size_t)nxt.pm * tstep : cA; const char* nB = has_next ? (const char*)g.Bt + (size_t)nxt.pn * tstep : cB;
        for (int t = 0; t < nt; t += 2) {
            const bool last = (t == nt - 2);
            const char* a1 = cA + (size_t)(t + 1) * kstep;
            const char* a2 = last ? nA : cA + (size_t)(t + 2) * kstep; const char* b2 = last ? nB : cB + (size_t)(t + 2) * kstep;
            const char* a3 = a2 + kstep; const char* b3 = b2 + kstep;
            if (last && has_next) S.a_ready(nxt);
            if constexpr (SP2) {
            PG8_LDB(B0, 0, 0); PG8_LDB(B1, 0, 1); PG8_SCHED; PG8_LDA(At, 0, 0); PG8_STAGE(PG8_SA(1, 1), a1 + hstep, voffA);
            PG8_WAIT_V(8); PG8_WAIT_L(0); PG8_BAR; PG8_MMA(0, 0, At, B0); PG8_MMA(0, 1, At, B1); PG8_BAR; PG8_SCHED;
            PG8_LDA(At, 0, 1); PG8_STAGE(PG8_SB(0, 0), b2, voffB); PG8_STAGE(PG8_SB(0, 1), b2 + hstepB, voffB); PG8_STAGE(PG8_SA(0, 0), a2, voffA);
            PG8_WAIT_V(8); PG8_WAIT_L(0); PG8_BAR; PG8_MMA(1, 0, At, B0); PG8_MMA(1, 1, At, B1); PG8_BAR; PG8_SCHED;
            PG8_LDB(B0, 1, 0); PG8_LDB(B1, 1, 1); PG8_SCHED; PG8_LDA(At, 1, 0); PG8_STAGE(PG8_SA(0, 1), a2 + hstep, voffA);
            PG8_WAIT_V(8); PG8_WAIT_L(0); PG8_BAR; PG8_MMA(0, 0, At, B0); PG8_MMA(0, 1, At, B1); PG8_BAR; PG8_SCHED;
            PG8_LDA(At, 1, 1); PG8_STAGE(PG8_SB(1, 0), b3, voffB); PG8_STAGE(PG8_SB(1, 1), b3 + hstepB, voffB); PG8_STAGE(PG8_SA(1, 0), a3, voffA);
            PG8_WAIT_V(8); PG8_WAIT_L(0); PG8_BAR; PG8_MMA(1, 0, At, B0); PG8_MMA(1, 1, At, B1); PG8_BAR; PG8_SCHED;
            } else {
            PG8_LDB(B0, 0, 0); PG8_SCHED; PG8_LDA(At, 0, 0); PG8_STAGE(PG8_SA(1, 1), a1 + hstep, voffA);
            PG8_WAIT_L(8); PG8_BAR; PG8_WAIT_L(0); PG8_MMA(0, 0, At, B0); PG8_BAR; PG8_SCHED;
            PG8_LDB(B1, 0, 1); PG8_STAGE(PG8_SB(0, 0), b2, voffB);
            PG8_BAR; PG8_WAIT_L(0); PG8_MMA(0, 1, At, B1); PG8_BAR;
            PG8_LDA(At, 0, 1); PG8_STAGE(PG8_SA(0, 0), a2, voffA);
            PG8_BAR; PG8_WAIT_L(0); PG8_MMA(1, 0, At, B0); PG8_BAR; PG8_SCHED;
            PG8_STAGE(PG8_SB(0, 1), b2 + hstepB, voffB);
            PG8_WAIT_V(6); PG8_BAR; PG8_MMA(1, 1, At, B1); PG8_BAR;
            PG8_LDB(B0, 1, 0); PG8_SCHED; PG8_LDA(At, 1, 0); PG8_STAGE(PG8_SA(0, 1), a2 + hstep, voffA);
            PG8_WAIT_L(8); PG8_BAR; PG8_WAIT_L(0); PG8_MMA(0, 0, At, B0); PG8_BAR; PG8_SCHED;
            PG8_LDB(B1, 1, 1); PG8_STAGE(PG8_SB(1, 0), b3, voffB);
            PG8_BAR; PG8_WAIT_L(0); PG8_MMA(0, 1, At, B1); PG8_BAR;
            PG8_LDA(At, 1, 1); PG8_STAGE(PG8_SA(1, 0), a3, voffA);
            PG8_BAR; PG8_WAIT_L(0); PG8_MMA(1, 0, At, B0); PG8_BAR; PG8_SCHED;
            PG8_STAGE(PG8_SB(1, 1), b3 + hstepB, voffB);
            PG8_WAIT_V(6); PG8_BAR; PG8_MMA(1, 1, At, B1); PG8_BAR;
            }
        }
        if constexpr (ALIGN_EPI) { if (wr == 0) PG8_BAR; }
        if constexpr (!Epi::AFTER_DRAIN) { E(acc, cur, wr, wc, fr, fq, ui); S.done(cur); }
        if (!has_next) break;
#pragma unroll
        for (int a = 0; a < 2; ++a)
#pragma unroll
            for (int b = 0; b < 2; ++b)
#pragma unroll
                for (int m = 0; m < 4; ++m)
#pragma unroll
                    for (int n = 0; n < 2; ++n) acc[a][b][m][n] = (f32x4){0.f, 0.f, 0.f, 0.f};
        cur = nxt; cA = nA; cB = nB; ++ui;
        if constexpr (ALIGN_EPI) { if (wr == 1) PG8_BAR; }
    }
    PG8_WAIT_V(0);
    if constexpr (!ALIGN_EPI) { if (wr == 0) PG8_BAR; }
    PG8_BAR;
    if constexpr (Epi::AFTER_DRAIN) { E.fused(acc, cur, wr, wc, fr, fq, lds, wid, lane); S.done(cur); }
#undef PG8_SA
#undef PG8_SB
#undef PG8_STAGE
#undef PG8_LDA
#undef PG8_LDB
#undef PG8_MMA
#undef PG8_WAIT_V
#undef PG8_WAIT_L
#undef PG8_BAR
#undef PG8_SCHED
}
}

#ifndef MK_ONE_LAUNCH
#define MK_ONE_LAUNCH 1
#endif
#ifndef PROBE_GN2
#define PROBE_GN2 0
#endif
#ifndef PROBE_FIN2
#define PROBE_FIN2 0
#endif
#ifndef PROBE_CAR2
#define PROBE_CAR2 0
#endif
#ifndef PROBE_BAR2
#define PROBE_BAR2 0
#endif
#ifndef PROBE_WIN2
#define PROBE_WIN2 0
#endif
#ifndef PROBE_GLU2
#define PROBE_GLU2 0
#endif
#ifndef PROBE_WOUT2
#define PROBE_WOUT2 0
#endif
#ifndef PROBE_DN2
#define PROBE_DN2 0
#endif
#ifndef PROBE_UP2
#define PROBE_UP2 0
#endif
#ifndef PROBE_PRO2
#define PROBE_PRO2 0
#endif
#ifndef PROBE_NA2
#define PROBE_NA2 0
#endif
#ifndef PROBE_SCAN2
#define PROBE_SCAN2 0
#endif
constexpr int NWAVES = 8, NTHR = 512;
constexpr int DM = 2048, NTOK = 40960, ZW = 4608, DFF = 8192, DEPTH = 4;
constexpr int ZK = 1024, ZV = 2048, ZXR = 3072, ZGT = 3584, ZXS = 4096;
constexpr int MLPC = 8192, NMLPC = NTOK / MLPC;
constexpr int LCH = 32, NLCH = NTOK / LCH;
constexpr int SCH = 64, NSCH = NTOK / SCH;
constexpr float EPS = 1e-6f;
constexpr int PH_PER_LAYER = 14, NPHASE = DEPTH * PH_PER_LAYER + 1;

constexpr size_t MiB = 1u << 20;
constexpr size_t WS_CTL = 0, CTL_ZERO_BYTES = 2 * MiB;
constexpr size_t WS_SS = 65536;
constexpr size_t WS_WIN = 2 * MiB, WS_WOUT = 20 * MiB, WS_WUP = 28 * MiB, WS_WDN = 60 * MiB, WS_WGLU = 92 * MiB;
constexpr size_t WS_TLB = 93 * MiB;
constexpr size_t WS_TBB = 93 * MiB + 65536;
constexpr size_t WS_H = 96 * MiB;
constexpr size_t WS_Z = 256 * MiB;
constexpr size_t WS_Y = 616 * MiB;
constexpr size_t WS_YG = 776 * MiB;
constexpr size_t WS_HF = 816 * MiB;
constexpr size_t WS_TBBF = 94 * MiB;
constexpr size_t WS_TCF = 94 * MiB + 524288;
constexpr size_t WS_TWF = 95 * MiB;
constexpr size_t WS_LAGG = 896 * MiB;
constexpr size_t WS_LCIN = 906 * MiB;
constexpr size_t WS_SEND = 912 * MiB;
constexpr size_t WS_SCIN = 932 * MiB;
constexpr size_t WS_SSQ = 952 * MiB, SSQ_BYTES = (size_t)DEPTH * 2 * NTOK * 8;
constexpr size_t WS_END = 956 * MiB;
constexpr int CW_BAR = 4096;

constexpr int RING_OFF = 0, RING_BYTES = 131072;
constexpr int XTRA_OFF = RING_BYTES, XTRA_BYTES = 12288;
constexpr int LDSCTL_OFF = 163840 - 1024, MISC_OFF = LDSCTL_OFF + 320;
constexpr int LDS_BYTES = 163840;
static_assert(MISC_OFF + 128 <= LDS_BYTES, "LDS map");

#define GAS __attribute__((address_space(1)))
#define LAS __attribute__((address_space(3)))
typedef unsigned short bf16;
typedef unsigned v4u __attribute__((ext_vector_type(4)));
typedef unsigned v2u __attribute__((ext_vector_type(2)));
typedef float f32x4 __attribute__((ext_vector_type(4)));
typedef float f32x2 __attribute__((ext_vector_type(2)));
#define LDS_WAIT() asm volatile("s_waitcnt lgkmcnt(0)" ::: "memory")
#define VM_WAIT() asm volatile("s_waitcnt vmcnt(0)" ::: "memory")
__device__ __forceinline__ unsigned f2bf(float f) { unsigned u = __builtin_bit_cast(unsigned, f); return (u + 0x7fffu + ((u >> 16) & 1u)) >> 16; }
typedef __bf16 bf16x2_t __attribute__((ext_vector_type(2)));
__device__ __forceinline__ unsigned pk2(float lo, float hi) { const f32x2 v = {lo, hi}; return __builtin_bit_cast(unsigned, __builtin_convertvector(v, bf16x2_t)); }
__device__ __forceinline__ unsigned pk2s(float lo, float hi) { return f2bf(lo) | (f2bf(hi) << 16); }
__device__ __forceinline__ float frcp(float x) { return __builtin_amdgcn_rcpf(x); }
__device__ __forceinline__ float fsqrt_(float x) { return __builtin_amdgcn_sqrtf(x); }
__device__ __forceinline__ float bf2f(unsigned b) { return __builtin_bit_cast(float, b << 16); }
__device__ __forceinline__ float bflo(unsigned w) { return __builtin_bit_cast(float, w << 16); }
__device__ __forceinline__ float bfhi(unsigned w) { return __builtin_bit_cast(float, w & 0xffff0000u); }
__device__ __forceinline__ float wave_sum(float v) {
#pragma unroll
    for (int o = 1; o < 64; o <<= 1) v += __shfl_xor(v, o);
    return v;
}
__device__ __forceinline__ float wave_max(float v) {
#pragma unroll
    for (int o = 1; o < 64; o <<= 1) v = fmaxf(v, __shfl_xor(v, o));
    return v;
}
__device__ __forceinline__ float sigmoidf_(float x) { return frcp(1.f + __expf(-x)); }
__device__ __forceinline__ float gelu_tanh(float x) { const float y = 0.7978845608028654f * (x + 0.044715f * x * x * x); const float e = __expf(2.f * y); return x - x * frcp(e + 1.f); }
__device__ __forceinline__ void seq_of(int tok, int& s0, int& T) { if (tok < 8192) { s0 = tok & ~2047; T = 2048; } else { s0 = 8192 + ((tok - 8192) & ~16383); T = 16384; } }

#define XB_TMO      128
#define XB_XCNT(j)  (256  + 64 * (j))
#define XB_XSUB(j)  (1280 + 64 * (j))
#define XB_XGEN(j)  (2304 + 64 * (j))
#define XB_TOP      3328
#define XB_TOPGEN   3392
#define XCD_BAR_WORDS 3456
#define XB_SPIN_CAP (1u << 18)

__device__ __forceinline__ unsigned xb_ld(unsigned* p)              { return __hip_atomic_load(p, __ATOMIC_RELAXED, __HIP_MEMORY_SCOPE_AGENT); }
__device__ __forceinline__ unsigned xb_add(unsigned* p, unsigned v) { return __hip_atomic_fetch_add(p, v, __ATOMIC_RELAXED, __HIP_MEMORY_SCOPE_AGENT); }
__device__ __forceinline__ unsigned xb_xcc_id() { return (unsigned)__builtin_amdgcn_s_getreg((3 << 11) | 20) & 0xFu; }
#define XB_SPIN(cond, bar) do { unsigned _sp = 0; while (cond) { __builtin_amdgcn_s_sleep(1); \
    if ((++_sp & 255u) == 0u) { if (xb_ld(&(bar)[XB_TMO])) break; if (_sp > XB_SPIN_CAP) { atomicAdd(&(bar)[XB_TMO], 1u); break; } } } } while (0)

struct XcdBarrier {
    unsigned* bar; unsigned x;
    volatile LAS unsigned* st;
};

__device__ __forceinline__ XcdBarrier xcd_barrier_post(unsigned* bar, volatile LAS unsigned* st) {
    XcdBarrier b; b.bar = bar; b.x = xb_xcc_id(); b.st = st;
    if (threadIdx.x == 0) (void)xb_add(&bar[XB_XCNT(b.x)], 1u);
    return b;
}
__device__ __forceinline__ void xcd_barrier_complete(unsigned* bar, unsigned x, unsigned& nloc, unsigned& nx) {
    const unsigned G = gridDim.x * gridDim.y * gridDim.z;
    unsigned sum, cnt, mine, sp = 0u;
    for (;;) {
        sum = 0u; cnt = 0u; mine = 0u;
#pragma unroll
        for (unsigned j = 0; j < 16; ++j) { const unsigned c = xb_ld(&bar[XB_XCNT(j)]); sum += c; cnt += (c > 0u) ? 1u : 0u; mine = (j == x) ? c : mine; }
        if (sum == G) break;
        __builtin_amdgcn_s_sleep(1);
        if ((++sp & 255u) == 0u) { if (xb_ld(&bar[XB_TMO])) break; if (sp > XB_SPIN_CAP) { atomicAdd(&bar[XB_TMO], 1u); break; } }
    }
    nloc = mine > 0u ? mine : 1u; nx = cnt > 0u ? cnt : 1u;
}

__device__ __forceinline__ void xcd_barrier(const XcdBarrier& b) {
    asm volatile("s_waitcnt vmcnt(0)" ::: "memory");
    __syncthreads();
    if (threadIdx.x == 0) {
        unsigned* bar = b.bar;
        __builtin_amdgcn_s_waitcnt(0);
        unsigned nloc = b.st[0], nx = b.st[1];
        if (nloc == 0u) { xcd_barrier_complete(bar, b.x, nloc, nx); b.st[0] = nloc; b.st[1] = nx; }
        const unsigned old = xb_add(&bar[XB_XSUB(b.x)], 1u);
        const unsigned gen = old / nloc;
        if (old + 1u == (gen + 1u) * nloc) {
            __builtin_amdgcn_fence(__ATOMIC_RELEASE, "agent");
            asm volatile("s_waitcnt vmcnt(0)" ::: "memory");
            const unsigned og = xb_add(&bar[XB_TOP], 1u);
            const unsigned tg = og / nx;
            if (og + 1u == (tg + 1u) * nx) xb_add(&bar[XB_TOPGEN], 1u);
            else XB_SPIN(xb_ld(&bar[XB_TOPGEN]) == tg, bar);
            __builtin_amdgcn_fence(__ATOMIC_ACQUIRE, "agent");
            xb_add(&bar[XB_XGEN(b.x)], 1u);
            asm volatile("s_waitcnt vmcnt(0)" ::: "memory");
        } else {
            XB_SPIN(xb_ld(&bar[XB_XGEN(b.x)]) == gen, bar);
            __builtin_amdgcn_fence(__ATOMIC_ACQUIRE, "agent");
            asm volatile("s_waitcnt vmcnt(0)" ::: "memory");
        }
    }
    __syncthreads();
}


struct Args { const float* in[28]; float* out; unsigned char* ws; int ph_lo, ph_hi; };
struct Frame {
    LAS unsigned char* lds; unsigned char* ldsg;
    int tid, lane, wave, vcu, G;
};
enum { I_XP = 0, I_XS, I_NMG, I_WIN, I_RPB, I_CW, I_CB, I_LWA, I_LBA, I_LWX, I_LBX, I_LAM, I_ARE, I_AIM, I_LDT, I_BRE, I_BIM, I_CRE, I_CIM, I_SD, I_WGLU, I_BGLU, I_GOUT, I_WOUT, I_NLG, I_WUP, I_WDN, I_FING };

__device__ __forceinline__ void transpose_item(const float* W, int K, int N, bf16* WT, LAS float* scr, int item, int lane, const float* gk) {
    const int nblk = N / 32, kb = item / nblk, nb = item % nblk, k0 = 64 * kb, n0 = 32 * nb;
    float wv[32];
#pragma unroll
    for (int i = 0; i < 32; ++i) wv[i] = W[(size_t)(k0 + 2 * i + (lane >> 5)) * N + n0 + (lane & 31)];
    if (gk) {
#pragma unroll
        for (int i = 0; i < 32; ++i) wv[i] *= gk[k0 + 2 * i + (lane >> 5)]; }
#pragma unroll
    for (int i = 0; i < 32; ++i) scr[(2 * i + (lane >> 5)) * 33 + (lane & 31)] = wv[i];
    LDS_WAIT();
    const int c = lane & 7;
#pragma unroll
    for (int j = 0; j < 4; ++j) { const int n = (lane >> 3) + 8 * j; const LAS float* s = scr + (8 * c) * 33 + n;
        v4u o; o.x = pk2(s[0 * 33], s[1 * 33]); o.y = pk2(s[2 * 33], s[3 * 33]); o.z = pk2(s[4 * 33], s[5 * 33]); o.w = pk2(s[6 * 33], s[7 * 33]);
        *(v4u*)(WT + (size_t)(n0 + n) * K + k0 + 8 * c) = o; }
    LDS_WAIT();
}

__device__ __forceinline__ void xb_row(const float* xrow, bf16* orow, unsigned long long* ss, int lane) {
    const f32x4* xr = (const f32x4*)xrow + lane; f32x4 v[8]; float s = 0.f;
#pragma unroll
    for (int j = 0; j < 8; ++j) { v[j] = xr[64 * j]; s += (v[j].x * v[j].x + v[j].y * v[j].y) + (v[j].z * v[j].z + v[j].w * v[j].w); }
    s = wave_sum(s); if (lane == 0) *ss = (unsigned long long)(s * 1048576.f + 0.5f);
    v2u* o8 = (v2u*)orow + lane;
#pragma unroll
    for (int j = 0; j < 8; ++j) { v2u o; o.x = pk2(v[j].x, v[j].y); o.y = pk2(v[j].z, v[j].w); o8[64 * j] = o; }
}

__device__ __forceinline__ void norm_row_bf16(const float* xrow, const float* g, bf16* orow, int lane) {
    const f32x4* xr = (const f32x4*)xrow + lane; const f32x4* gr = (const f32x4*)g + lane;
    f32x4 v[8]; float s = 0.f;
#pragma unroll
    for (int j = 0; j < 8; ++j) { v[j] = xr[64 * j]; s += (v[j].x * v[j].x + v[j].y * v[j].y) + (v[j].z * v[j].z + v[j].w * v[j].w); }
    const float rstd = 1.f / sqrtf(wave_sum(s) * (1.f / DM) + EPS);
    v2u* o8 = (v2u*)orow + lane;
#pragma unroll
    for (int j = 0; j < 8; ++j) { const f32x4 gg = gr[64 * j]; v2u o; o.x = pk2(v[j].x * rstd * gg.x, v[j].y * rstd * gg.y); o.y = pk2(v[j].z * rstd * gg.z, v[j].w * rstd * gg.w); o8[64 * j] = o; }
}
__device__ __forceinline__ const float* x_row(const Args& a, int l, int row) {
    if (l == 0) return row < 8192 ? a.in[I_XP] + (size_t)row * DM : a.in[I_XS] + (size_t)(row - 8192) * DM;
    return a.out + (size_t)row * DM;
}

__device__ __forceinline__ void ph_prologue(const Args& a, const Frame& F, int l) {
    int tid = threadIdx.x; asm volatile("" : "+v"(tid)); int lane = tid & 63; (void)lane;
    LAS float* scr = (LAS float*)(F.lds + RING_OFF + F.wave * 16384);
    const int gw = F.vcu * NWAVES + F.wave, NGW = F.G * NWAVES;
    constexpr int I_IN = (DM / 64) * (ZW / 32), I_OUT = (DM / 64) * (DM / 32), I_UP = (DM / 64) * (DFF / 32), I_DN = (DFF / 64) * (DM / 32), I_GL = (512 / 64) * (512 / 32);
    constexpr int NITEMS = I_IN + I_OUT + I_UP + I_DN + I_GL;
    unsigned char* ws = a.ws;
    for (int it = gw; it < NITEMS; it += NGW) {
        int r = it;
        if (r < I_IN) { transpose_item(a.in[I_WIN] + (size_t)l * DM * ZW, DM, ZW, (bf16*)(ws + WS_WIN), scr, r, lane, a.in[I_NMG] + (size_t)l * DM); continue; } r -= I_IN;
        if (r < I_OUT) { transpose_item(a.in[I_WOUT] + (size_t)l * DM * DM, DM, DM, (bf16*)(ws + WS_WOUT), scr, r, lane, nullptr); continue; } r -= I_OUT;
        if (r < I_UP) { transpose_item(a.in[I_WUP] + (size_t)l * DM * DFF, DM, DFF, (bf16*)(ws + WS_WUP), scr, r, lane, a.in[I_NLG] + (size_t)l * DM); continue; } r -= I_UP;
        if (r < I_DN) { transpose_item(a.in[I_WDN] + (size_t)l * DFF * DM, DFF, DM, (bf16*)(ws + WS_WDN), scr, r, lane, nullptr); continue; } r -= I_DN;
        transpose_item(a.in[I_WGLU] + (size_t)l * 512 * 512, 512, 512, (bf16*)(ws + WS_WGLU), scr, r, lane, nullptr);
    }
    { const int gt = F.vcu * NTHR + tid;
      if (gt < 4096) {
        const int dir = gt >> 11, g = (gt >> 6) & 31, p = gt & 63; const size_t ix = ((size_t)(l * 2 + dir) * 32 + g) * 64 + p;
        const double are = (double)a.in[I_ARE][ix], aim = (double)a.in[I_AIM][ix]; const double ldt = (double)a.in[I_LDT][(l * 2 + dir) * 32 + g];
        double e = 1.0; { const double x8 = ldt * 0.125; for (int n = 20; n >= 1; --n) e = 1.0 + e * x8 / (double)n; e = e * e; e = e * e; e = e * e; }
        const double dt = e;
        double mag = 1.0; { const double x = are * dt; for (int n = 14; n >= 1; --n) mag = 1.0 + mag * x / (double)n; }
        const double th = aim * dt; const double kq = __builtin_rint(th * 0.15915494309189535); const double r = th - kq * 6.283185307179586476925;
        const double r2 = r * r; double c = 1.0, s = 1.0;
        for (int n = 15; n >= 1; --n) { c = 1.0 - c * r2 / (double)((2 * n - 1) * (2 * n)); s = 1.0 - s * r2 / (double)((2 * n) * (2 * n + 1)); }
        s *= r;
        const double lbr = mag * c, lbi = mag * s, den = are * are + aim * aim, nre = lbr - 1.0, nim = lbi;
        const double cor = (nre * are + nim * aim) / den, coi = (nim * are - nre * aim) / den;
        float* tlb = (float*)(ws + WS_TLB) + (size_t)gt * 2; tlb[0] = (float)lbr; tlb[1] = (float)lbi;
        float* tbb = (float*)(ws + WS_TBB) + (size_t)gt * 32; const float* bre = a.in[I_BRE] + ix * 16; const float* bim = a.in[I_BIM] + ix * 16;
        bf16* bbf = (bf16*)(ws + WS_TBBF);
        for (int h = 0; h < 16; ++h) { const double br = (double)bre[h], bi = (double)bim[h]; const float vr = (float)(cor * br - coi * bi), vi = (float)(cor * bi + coi * br); tbb[h] = vr; tbb[16 + h] = vi;
            const int n = p & 15, gk0 = h >> 3, j = h & 7;
            const unsigned hr = f2bf(vr), hi_ = f2bf(vi); const unsigned lr = f2bf(vr - bf2f(hr)), li = f2bf(vi - bf2f(hi_));
            const size_t fr = ((size_t)((dir * 32 + g) * 8 + (p >> 4)) * 64) * 8, fi = ((size_t)((dir * 32 + g) * 8 + 4 + (p >> 4)) * 64) * 8;
            bbf[fr + (size_t)(n + 16 * gk0) * 8 + j] = (bf16)hr; bbf[fr + (size_t)(n + 16 * (gk0 + 2)) * 8 + j] = (bf16)lr;
            bbf[fi + (size_t)(n + 16 * gk0) * 8 + j] = (bf16)hi_; bbf[fi + (size_t)(n + 16 * (gk0 + 2)) * 8 + j] = (bf16)li; }
      } else if (gt < 4096 + 16384) {
        const int e = gt - 4096, lane_ = e & 63, ks = (e >> 6) & 3, g = (e >> 8) & 31, dir = e >> 13; const int h = lane_ & 15, gk = lane_ >> 4;
        const float* cre = a.in[I_CRE] + (((size_t)(l * 2 + dir) * 32 + g) * 16 + h) * 64; const float* cim = a.in[I_CIM] + (((size_t)(l * 2 + dir) * 32 + g) * 16 + h) * 64;
        bf16* cf = (bf16*)(ws + WS_TCF) + (size_t)e * 8;
        for (int j = 0; j < 8; ++j) { const int P = 16 * (j >> 1) + 4 * ks + gk; cf[j] = (bf16)f2bf((j & 1) ? -cim[P] : cre[P]); }
      } else if (gt >= 20480 && gt < 20480 + 16384) {
        const int e = gt - 20480, lane_ = e & 63, ks = (e >> 6) & 1, cb = (e >> 7) & 3, mat = (e >> 9) & 1, nb = (e >> 10) & 7, dir = e >> 13; const int n = lane_ & 15, gk = lane_ >> 4;
        const float* W = a.in[mat ? I_LWX : I_LWA] + ((size_t)(l * 2 + dir) * 8 + nb) * 4096 + (size_t)(32 * ks + 8 * gk) * 64 + 16 * cb + n;
        bf16* wf = (bf16*)(ws + WS_TWF) + (size_t)e * 8;
        for (int j = 0; j < 8; ++j) wf[j] = (bf16)f2bf(W[j * 64]);
      } }
    if (l == 0) { bf16* XB = (bf16*)(ws + WS_H); unsigned long long* SS = (unsigned long long*)(ws + WS_SSQ);
        for (int m = gw; m < NTOK; m += NGW) xb_row(x_row(a, 0, m), XB + (size_t)m * DM, SS + m, lane); }
}

__device__ __forceinline__ void ph_na_simple(const Args& a, const Frame& F, int l) {
    int tid = threadIdx.x; asm volatile("" : "+v"(tid)); int lane = tid & 63; (void)lane;
    const bf16* Z = (const bf16*)(a.ws + WS_Z); bf16* Y = (bf16*)(a.ws + WS_Y);
    const float* rpb = a.in[I_RPB] + (size_t)l * 16 * 15 * 31;
    float* qs = (float*)(F.ldsg + RING_OFF) + F.wave * 64;
    const long U = (long)NTOK * 16; const long u0 = U * F.vcu / F.G, u1 = U * (F.vcu + 1) / F.G;
    for (long u = u0 + F.wave; u < u1; u += NWAVES) {
        const int tok = (int)(u >> 4), h = (int)(u & 15);
        int s0, T; seq_of(tok, s0, T); const int pos = tok - s0, r = pos >> 6, c = pos & 63, R = T >> 6;
        const int rs = min(max(r - 4, 0), R - 8), cs = min(max(c - 8, 0), 48);
        LDS_WAIT();
        qs[lane] = bf2f(Z[(size_t)tok * ZW + h * 64 + lane]);
        LDS_WAIT();
        float sc[2];
#pragma unroll
        for (int i = 0; i < 2; ++i) {
            const int kk = lane + 64 * i, krow = rs + (kk >> 4), kcol = cs + (kk & 15); const int ktok = s0 + krow * 64 + kcol;
            const v4u* kp = (const v4u*)(Z + (size_t)ktok * ZW + ZK + h * 64);
            float d = 0.f;
#pragma unroll
            for (int j = 0; j < 8; ++j) { const v4u w = kp[j]; const f32x4 q0 = *(const f32x4*)(qs + 8 * j), q1 = *(const f32x4*)(qs + 8 * j + 4);
                d += bflo(w.x) * q0.x + bfhi(w.x) * q0.y + bflo(w.y) * q0.z + bfhi(w.y) * q0.w + bflo(w.z) * q1.x + bfhi(w.z) * q1.y + bflo(w.w) * q1.z + bfhi(w.w) * q1.w; }
            sc[i] = d * 0.125f + rpb[(h * 15 + (krow - r + 7)) * 31 + (kcol - c + 15)];
        }
        const float m = wave_max(fmaxf(sc[0], sc[1])); const float p0 = __expf(sc[0] - m), p1 = __expf(sc[1] - m); const float sum = wave_sum(p0 + p1);
        float acc = 0.f;
        for (int kk = 0; kk < 128; ++kk) {
            const float p = __shfl(kk < 64 ? p0 : p1, kk & 63);
            const int krow = rs + (kk >> 4), kcol = cs + (kk & 15); const int vtok = s0 + krow * 64 + kcol;
            acc += p * bf2f(Z[(size_t)vtok * ZW + ZV + h * 64 + lane]);
        }
        Y[(size_t)tok * DM + h * 64 + lane] = (bf16)f2bf(acc / sum);
    }
}

typedef short s16x4_t __attribute__((ext_vector_type(4)));
__device__ __forceinline__ pg8::bf16x8 v_tr_pair(const LAS unsigned char* p) {
    const s16x4_t lo = __builtin_amdgcn_ds_read_tr16_b64_v4i16((LAS s16x4_t*)p), hi = __builtin_amdgcn_ds_read_tr16_b64_v4i16((LAS s16x4_t*)(p + 512));
    return __builtin_shufflevector(lo, hi, 0, 1, 2, 3, 4, 5, 6, 7);
}
__device__ __forceinline__ void glds16_asm(const void* gsrc, unsigned lds_dst) {
    unsigned keep;
    asm volatile("s_mov_b32 %0, m0\n\ts_mov_b32 m0, %2\n\ts_nop 0\n\tglobal_load_lds_dwordx4 %1, off\n\ts_mov_b32 m0, %0" : "=&s"(keep) : "v"(gsrc), "s"(lds_dst) : "memory");
}
__device__ __forceinline__ void ph_na_mfma(const Args& a, const Frame& F, int l) {
    int tid = threadIdx.x; asm volatile("" : "+v"(tid)); int lane = tid & 63; (void)lane;
    const bf16* Z = (const bf16*)(a.ws + WS_Z); bf16* Y = (bf16*)(a.ws + WS_Y);
    constexpr int KR = 0, VR = 73728, BIAS = 147456, MRG = 149504;
    LAS unsigned char* L = F.lds;
    const int w = F.wave, qt = w & 3, half = w >> 2, q = lane & 15, g = lane >> 4;
    const int c0 = 16 * qt, kc0 = (qt == 0) ? 0 : (qt == 1 ? 8 : (qt == 2 ? 24 : 32)), c = c0 + q, cs = min(max(c - 8, 0), 48);
    const int NIT = (NTOK / 64) * 16; const int i0 = (int)((long)NIT * F.vcu / F.G), i1 = (int)((long)NIT * (F.vcu + 1) / F.G);
#define NA_ITEM(it_, s0_, R_, h_, r_) do { if ((it_) < 2048) { const int _col = (it_) >> 5; r_ = (it_) & 31; R_ = 32; s0_ = (_col >> 4) * 2048; h_ = _col & 15; } \
        else { const int _j = (it_) - 2048, _col = _j >> 8; r_ = _j & 255; R_ = 256; s0_ = 8192 + (_col >> 4) * 16384; h_ = _col & 15; } } while (0)
#define NA_SWZ(col_) (((((col_) >> 3) & 3) << 1) | (((col_) >> 1) & 1))
#define NA_ROW_DMA(zoff_, row_, slotbase_) do { \
        _Pragma("unroll") for (int _j = 0; _j < 2; ++_j) { const int _col = c0 + 8 * _j + (lane >> 3); \
            const bf16* _gp = Z + (size_t)(s0 + (row_) * 64 + _col) * ZW + (zoff_) + h * 64 + (((lane & 7) ^ NA_SWZ(_col)) * 8); \
            glds16_asm(_gp, (unsigned)(size_t)(L + (slotbase_) + (c0 + 8 * _j) * 128)); } } while (0)
#define NA_BAR() asm volatile("s_barrier" ::: "memory")
    pg8::bf16x8 qn0, qn1;
    { int s0, R, h, r; NA_ITEM(i0, s0, R, h, r); const bf16* qp = Z + (size_t)(s0 + r * 64 + c) * ZW + h * 64 + 8 * g; qn0 = *(const pg8::bf16x8*)qp; qn1 = *(const pg8::bf16x8*)(qp + 32); }
    v2u st0, st1, st2, st3; bf16* stp = Y;
    st0 = st1 = st2 = st3 = (v2u){0u, 0u};
    int it = i0;
    while (it < i1) {
        int s0, R, h, r0; NA_ITEM(it, s0, R, h, r0);
        const int m = min(R - r0, i1 - it);
        {
            const int rs = min(max(r0 - 4, 0), R - 8);
#pragma unroll
            for (int i = 0; i < 16; ++i) { const int id = w * 16 + i, t = id >> 6, ri = (id >> 3) & 7, j8 = id & 7, row = rs + ri;
                const int colw = 8 * j8 + (lane >> 3);
                const bf16* gp = Z + (size_t)(s0 + row * 64 + colw) * ZW + (t ? ZV : ZK) + h * 64 + (((lane & 7) ^ NA_SWZ(colw)) * 8);
                glds16_asm(gp, (unsigned)(size_t)(L + (t ? VR : KR) + (row % 9) * 8192 + j8 * 1024)); }
            if (tid < 465) ((LAS float*)(L + BIAS))[tid] = a.in[I_RPB][((size_t)l * 16 + h) * 465 + tid];
            VM_WAIT(); LDS_WAIT();
            __syncthreads();
        }
        float ti[4][2][4];
        { const LAS float* bt = (const LAS float*)(L + BIAS);
#pragma unroll
          for (int kk = 0; kk < 4; ++kk)
#pragma unroll
              for (int blk = 0; blk < 2; ++blk)
#pragma unroll
                  for (int rg = 0; rg < 4; ++rg) { const int col = kc0 + 8 * g + 4 * blk + rg; const int dc = min(max(col - c + 15, 0), 30); const bool valid = (unsigned)(col - cs) < 16u;
                      ti[kk][blk][rg] = valid ? 8.f * bt[(kk + 4 * half + 3) * 31 + dc] : -INFINITY; } }
        if (half == 1) NA_BAR();
        for (int j = 0; j < m; ++j) {
            const int r = r0 + j, rs = min(max(r - 4, 0), R - 8);
            pg8::bf16x8 qf0 = qn0, qf1 = qn1;
            asm volatile("" : "+v"(qf0), "+v"(qf1) :: "memory");
            if (half == 1 && j > 0) { *(v2u*)(stp) = st0; *(v2u*)(stp + 16) = st1; *(v2u*)(stp + 32) = st2; *(v2u*)(stp + 48) = st3; }
            if (it + j + 1 < i1) {
                int s0n, Rn, hn, rn; NA_ITEM(it + j + 1, s0n, Rn, hn, rn);
                if (half == 0 && j + 1 < m) { const int rsn = min(max(rn - 4, 0), Rn - 8); if (rsn > rs) { NA_ROW_DMA(ZK, rsn + 7, KR + ((rsn + 7) % 9) * 8192); NA_ROW_DMA(ZV, rsn + 7, VR + ((rsn + 7) % 9) * 8192); } }
                const bf16* qp = Z + (size_t)(s0n + rn * 64 + c) * ZW + hn * 64 + 8 * g; qn0 = *(const pg8::bf16x8*)qp; qn1 = *(const pg8::bf16x8*)(qp + 32);
            }
            const int tokrow0 = s0 + r * 64;
            f32x4 sc[4][2];
            pg8::bf16x8 kf[4][2][2];
#pragma unroll
            for (int kk = 0; kk < 4; ++kk) { const int row = rs + 4 * half + kk; const LAS unsigned char* kb = L + KR + (row % 9) * 8192;
#pragma unroll
                for (int blk = 0; blk < 2; ++blk) { const int col = kc0 + 8 * (q >> 2) + 4 * blk + (q & 3); const int sw = NA_SWZ(col);
                    kf[kk][blk][0] = *(const LAS pg8::bf16x8*)(kb + col * 128 + ((g ^ sw) * 16)); kf[kk][blk][1] = *(const LAS pg8::bf16x8*)(kb + col * 128 + (((4 + g) ^ sw) * 16)); } }
            const bool interior = (rs == r - 4);
            __builtin_amdgcn_sched_barrier(0);
#pragma unroll
            for (int kk = 0; kk < 4; ++kk)
#pragma unroll
                for (int blk = 0; blk < 2; ++blk) { f32x4 ini = (f32x4){0.f, 0.f, 0.f, 0.f};
                    if (interior) ini = (f32x4){ti[kk][blk][0], ti[kk][blk][1], ti[kk][blk][2], ti[kk][blk][3]};
                    sc[kk][blk] = __builtin_amdgcn_mfma_f32_16x16x32_bf16(kf[kk][blk][0], qf0, ini, 0, 0, 0); }
#pragma unroll
            for (int kk = 0; kk < 4; ++kk)
#pragma unroll
                for (int blk = 0; blk < 2; ++blk) sc[kk][blk] = __builtin_amdgcn_mfma_f32_16x16x32_bf16(kf[kk][blk][1], qf1, sc[kk][blk], 0, 0, 0);
            __builtin_amdgcn_sched_barrier(0);
            if (!interior) {
                const LAS float* bh = (const LAS float*)(L + BIAS) + (rs + 4 * half - r + 7) * 31;
#pragma unroll
                for (int blk = 0; blk < 2; ++blk)
#pragma unroll
                    for (int rg = 0; rg < 4; ++rg) { const int col = kc0 + 8 * g + 4 * blk + rg; const int dc = min(max(col - c + 15, 0), 30); const bool valid = (unsigned)(col - cs) < 16u;
#pragma unroll
                        for (int kk = 0; kk < 4; ++kk) sc[kk][blk][rg] = valid ? sc[kk][blk][rg] + 8.f * bh[kk * 31 + dc] : -INFINITY; }
            }
            float mx = -INFINITY;
#pragma unroll
            for (int kk = 0; kk < 4; ++kk)
#pragma unroll
                for (int blk = 0; blk < 2; ++blk)
#pragma unroll
                    for (int rg = 0; rg < 4; ++rg) mx = fmaxf(mx, sc[kk][blk][rg]);
            mx = fmaxf(mx, __shfl_xor(mx, 16)); mx = fmaxf(mx, __shfl_xor(mx, 32));
            LDS_WAIT();
            __syncthreads();
            pg8::bf16x8 vfr[4][4];
#pragma unroll
            for (int kk = 0; kk < 4; ++kk) { const int row = rs + 4 * half + kk;
                const int colv = kc0 + 8 * g + ((lane & 15) >> 2), sw0 = NA_SWZ(colv), sw1 = NA_SWZ(colv + 4), pq = lane & 3;
                const LAS unsigned char* vb0 = L + VR + (row % 9) * 8192 + colv * 128 + (pq & 1) * 8; const LAS unsigned char* vb1 = vb0 + 512;
#pragma unroll
                for (int db = 0; db < 4; ++db) { const int ch = 2 * db + (pq >> 1);
                    const s16x4_t lo = __builtin_amdgcn_ds_read_tr16_b64_v4i16((LAS s16x4_t*)(vb0 + ((ch ^ sw0) * 16))), hi = __builtin_amdgcn_ds_read_tr16_b64_v4i16((LAS s16x4_t*)(vb1 + ((ch ^ sw1) * 16)));
                    vfr[kk][db] = __builtin_shufflevector(lo, hi, 0, 1, 2, 3, 4, 5, 6, 7); } }
            __builtin_amdgcn_sched_barrier(0);
            pg8::bf16x8 pf[4];
            constexpr float CS = 0.125f * 1.4426950408889634f;
            const float nm = -mx * CS;
#pragma unroll
            for (int kk = 0; kk < 4; ++kk) { float p[8];
#pragma unroll
                for (int blk = 0; blk < 2; ++blk)
#pragma unroll
                    for (int rg = 0; rg < 4; ++rg) p[4 * blk + rg] = __builtin_amdgcn_exp2f(__builtin_fmaf(sc[kk][blk][rg], CS, nm));
                v4u wv; wv.x = pk2(p[0], p[1]); wv.y = pk2(p[2], p[3]); wv.z = pk2(p[4], p[5]); wv.w = pk2(p[6], p[7]); pf[kk] = __builtin_bit_cast(pg8::bf16x8, wv); }
            f32x4 osum = (f32x4){0.f, 0.f, 0.f, 0.f};
            { const v4u onesw = (v4u){0x3f803f80u, 0x3f803f80u, 0x3f803f80u, 0x3f803f80u}; const pg8::bf16x8 ones = __builtin_bit_cast(pg8::bf16x8, onesw);
#pragma unroll
              for (int kk = 0; kk < 4; ++kk) osum = __builtin_amdgcn_mfma_f32_16x16x32_bf16(ones, pf[kk], osum, 0, 0, 0); }
            const float sum = osum[0];
            f32x4 o[4];
#pragma unroll
            for (int db = 0; db < 4; ++db) o[db] = (f32x4){0.f, 0.f, 0.f, 0.f};
#pragma unroll
            for (int kk = 0; kk < 4; ++kk)
#pragma unroll
                for (int db = 0; db < 4; ++db) o[db] = __builtin_amdgcn_mfma_f32_16x16x32_bf16(vfr[kk][db], pf[kk], o[db], 0, 0, 0);
            LAS unsigned char* mg = L + MRG + (qt * 64 + lane) * 48;
            if (half == 0) {
                v4u w0, w1; w0.x = pk2(o[0][0], o[0][1]); w0.y = pk2(o[0][2], o[0][3]); w0.z = pk2(o[1][0], o[1][1]); w0.w = pk2(o[1][2], o[1][3]);
                w1.x = pk2(o[2][0], o[2][1]); w1.y = pk2(o[2][2], o[2][3]); w1.z = pk2(o[3][0], o[3][1]); w1.w = pk2(o[3][2], o[3][3]);
                *(LAS v4u*)mg = w0; *(LAS v4u*)(mg + 16) = w1; *(LAS f32x2*)(mg + 32) = (f32x2){mx, sum};
                VM_WAIT();
            } else {
                const v4u w0 = *(const LAS v4u*)mg, w1 = *(const LAS v4u*)(mg + 16); const f32x2 ml = *(const LAS f32x2*)(mg + 32);
                const float mm = fmaxf(mx, ml.x), a0 = __builtin_amdgcn_exp2f((mx - mm) * CS), a1 = __builtin_amdgcn_exp2f((ml.x - mm) * CS); const float inv = frcp(sum * a0 + ml.y * a1);
                const float sa = a0 * inv, sb = a1 * inv;
                stp = Y + (size_t)(tokrow0 + c) * DM + h * 64 + 4 * g;
                st0.x = pk2(o[0][0] * sa + bflo(w0.x) * sb, o[0][1] * sa + bfhi(w0.x) * sb); st0.y = pk2(o[0][2] * sa + bflo(w0.y) * sb, o[0][3] * sa + bfhi(w0.y) * sb);
                st1.x = pk2(o[1][0] * sa + bflo(w0.z) * sb, o[1][1] * sa + bfhi(w0.z) * sb); st1.y = pk2(o[1][2] * sa + bflo(w0.w) * sb, o[1][3] * sa + bfhi(w0.w) * sb);
                st2.x = pk2(o[2][0] * sa + bflo(w1.x) * sb, o[2][1] * sa + bfhi(w1.x) * sb); st2.y = pk2(o[2][2] * sa + bflo(w1.y) * sb, o[2][3] * sa + bfhi(w1.y) * sb);
                st3.x = pk2(o[3][0] * sa + bflo(w1.z) * sb, o[3][1] * sa + bfhi(w1.z) * sb); st3.y = pk2(o[3][2] * sa + bflo(w1.w) * sb, o[3][3] * sa + bfhi(w1.w) * sb);
            }
            LDS_WAIT();
            __syncthreads();
        }
        if (half == 1) { *(v2u*)(stp) = st0; *(v2u*)(stp + 16) = st1; *(v2u*)(stp + 32) = st2; *(v2u*)(stp + 48) = st3; }
        if (half == 0) NA_BAR();
        it += m;
    }
#undef NA_BAR
#undef NA_ROW_DMA
#undef NA_SWZ
#undef NA_ITEM
    VM_WAIT(); LDS_WAIT();
    __syncthreads();
}

template <int MODE> __device__ __forceinline__ void ph_lru_simple(const Args& a, const Frame& F, int l) {
    int tid = threadIdx.x; asm volatile("" : "+v"(tid)); int lane = tid & 63; (void)lane;
    const bf16* Z = (const bf16*)(a.ws + WS_Z); bf16* Y = (bf16*)(a.ws + WS_Y); float* HF = (float*)(a.ws + WS_HF);
    float* agg = (float*)(a.ws + WS_LAGG); const float* cin = (const float*)(a.ws + WS_LCIN);
    float* xc = (float*)(F.ldsg + RING_OFF);
    const int c = tid, n = c >> 6, k = c & 63;
    float cw[4];
#pragma unroll
    for (int j = 0; j < 4; ++j) cw[j] = a.in[I_CW][((size_t)l * 4 + j) * 512 + c];
    const float cb = a.in[I_CB][(size_t)l * 512 + c];
    for (int ch = F.vcu; ch < NLCH; ch += F.G) {
        const int tok0 = ch * LCH; int s0, T; seq_of(tok0, s0, T); const int s1 = s0 + T;
        __syncthreads();
        for (int t = 0; t < LCH; ++t) { const int tok = tok0 + t; float v = cb;
#pragma unroll
            for (int j = 0; j < 4; ++j) { const int tt = tok + j - 2; if (tt >= s0 && tt < s1) v += cw[j] * bf2f(Z[(size_t)tt * ZW + ZXR + c]); }
            xc[t * 512 + c] = v; }
        __syncthreads();
        for (int dir = 0; dir < 2; ++dir) {
            float wa[64], wx[64];
            const float* pwa = a.in[I_LWA] + ((size_t)(l * 2 + dir) * 8 + n) * 4096 + k; const float* pwx = a.in[I_LWX] + ((size_t)(l * 2 + dir) * 8 + n) * 4096 + k;
#pragma unroll
            for (int j = 0; j < 64; ++j) { wa[j] = pwa[j * 64]; wx[j] = pwx[j * 64]; }
            const float ba = a.in[I_LBA][(size_t)(l * 2 + dir) * 512 + c], bx = a.in[I_LBX][(size_t)(l * 2 + dir) * 512 + c];
            const float lam = a.in[I_LAM][(size_t)(l * 2 + dir) * 512 + c]; const float ls8 = -8.f * log1pf(__expf(-lam));
            float h = MODE ? cin[((size_t)ch * 2 + dir) * 512 + c] : 0.f, P = 1.f;
            for (int st = 0; st < LCH; ++st) {
                const int t = dir ? (LCH - 1 - st) : st; const float* xr = xc + t * 512 + n * 64;
                float pa = ba, px = bx;
#pragma unroll
                for (int j = 0; j < 64; j += 4) { const f32x4 x4 = *(const f32x4*)(xr + j);
                    pa += x4.x * wa[j] + x4.y * wa[j + 1] + x4.z * wa[j + 2] + x4.w * wa[j + 3]; px += x4.x * wx[j] + x4.y * wx[j + 1] + x4.z * wx[j + 2] + x4.w * wx[j + 3]; }
                const float rr = sigmoidf_(pa), ii = sigmoidf_(px), loga = ls8 * rr, av = __expf(loga), mult = sqrtf(fmaxf(-expm1f(2.f * loga), 0.f));
                const float uu = mult * ii * xc[t * 512 + c];
                h = av * h + uu; P *= av;
                if (MODE) { const size_t tok = (size_t)(tok0 + t);
                    if (dir == 0) HF[tok * 512 + c] = h;
                    else { const float gt = bf2f(Z[tok * ZW + ZGT + c]); Y[tok * DM + 1024 + c] = (bf16)f2bf((HF[tok * 512 + c] + h) * gelu_tanh(gt)); } }
            }
            if (!MODE) { float* ag = agg + (((size_t)ch * 2 + dir) * 512 + c) * 2; ag[0] = P; ag[1] = h; }
        }
    }
}

template <int MODE> __device__ __forceinline__ void ph_s5_simple(const Args& a, const Frame& F, int l) {
    int tid = threadIdx.x; asm volatile("" : "+v"(tid)); int lane = tid & 63; (void)lane;
    const bf16* Z = (const bf16*)(a.ws + WS_Z); bf16* YG = (bf16*)(a.ws + WS_YG);
    float* E = (float*)(a.ws + WS_SEND); const float* CIN = (const float*)(a.ws + WS_SCIN);
    const float* TLB = (const float*)(a.ws + WS_TLB); const float* TBB = (const float*)(a.ws + WS_TBB);
    float* Sst = (float*)(F.ldsg + RING_OFF + F.wave * 16384);
    float* Yf = Sst + 2048;
    float* Ub = (float*)(F.ldsg + XTRA_OFF + F.wave * 1024);
    const int gw = F.vcu * NWAVES + F.wave, NGW = F.G * NWAVES;
    for (int u = gw; u < NSCH * 32; u += NGW) {
        const int ch = u >> 5, g = u & 31, tok0 = ch * SCH;
        for (int dir = 0; dir < 2; ++dir) {
            const int dg = dir * 32 + g;
            const float lbr = TLB[((size_t)dg * 64 + lane) * 2], lbi = TLB[((size_t)dg * 64 + lane) * 2 + 1];
            float bbr[16], bbi[16];
            { const f32x4* tb = (const f32x4*)(TBB + ((size_t)dg * 64 + lane) * 32);
#pragma unroll
              for (int q = 0; q < 4; ++q) { const f32x4 x = tb[q], y = tb[4 + q]; bbr[4 * q] = x.x; bbr[4 * q + 1] = x.y; bbr[4 * q + 2] = x.z; bbr[4 * q + 3] = x.w; bbi[4 * q] = y.x; bbi[4 * q + 1] = y.y; bbi[4 * q + 2] = y.z; bbi[4 * q + 3] = y.w; } }
            float cr[64], ci[64];
            if (MODE) { const int h = lane & 15; const f32x4* pr = (const f32x4*)(a.in[I_CRE] + (((size_t)(l * 2 + dir) * 32 + g) * 16 + h) * 64); const f32x4* pi = (const f32x4*)(a.in[I_CIM] + (((size_t)(l * 2 + dir) * 32 + g) * 16 + h) * 64);
#pragma unroll
              for (int q = 0; q < 16; ++q) { const f32x4 x = pr[q], y = pi[q]; cr[4 * q] = x.x; cr[4 * q + 1] = x.y; cr[4 * q + 2] = x.z; cr[4 * q + 3] = x.w; ci[4 * q] = y.x; ci[4 * q + 1] = y.y; ci[4 * q + 2] = y.z; ci[4 * q + 3] = y.w; } }
            float sr = 0.f, si = 0.f;
            if (MODE) { const float* cp = CIN + ((((size_t)ch * 2 + dir) * 32 + g) * 64 + lane) * 2; sr = cp[0]; si = cp[1]; }
            for (int b = 0; b < SCH / 16; ++b) {
                { const int tt = lane >> 2, hq = lane & 3; const int tl = dir ? (SCH - 1 - (16 * b + tt)) : (16 * b + tt);
                  const v2u w = *(const v2u*)(Z + (size_t)(tok0 + tl) * ZW + ZXS + g * 16 + hq * 4);
                  LDS_WAIT();
                  *(f32x4*)(Ub + tt * 16 + hq * 4) = (f32x4){bflo(w.x), bfhi(w.x), bflo(w.y), bfhi(w.y)};
                  LDS_WAIT(); }
                for (int tt = 0; tt < 16; ++tt) {
                    const f32x4 u0 = *(const f32x4*)(Ub + tt * 16), u1 = *(const f32x4*)(Ub + tt * 16 + 4), u2 = *(const f32x4*)(Ub + tt * 16 + 8), u3 = *(const f32x4*)(Ub + tt * 16 + 12);
                    float ir = u0.x * bbr[0] + u0.y * bbr[1] + u0.z * bbr[2] + u0.w * bbr[3] + u1.x * bbr[4] + u1.y * bbr[5] + u1.z * bbr[6] + u1.w * bbr[7]
                             + u2.x * bbr[8] + u2.y * bbr[9] + u2.z * bbr[10] + u2.w * bbr[11] + u3.x * bbr[12] + u3.y * bbr[13] + u3.z * bbr[14] + u3.w * bbr[15];
                    float ii = u0.x * bbi[0] + u0.y * bbi[1] + u0.z * bbi[2] + u0.w * bbi[3] + u1.x * bbi[4] + u1.y * bbi[5] + u1.z * bbi[6] + u1.w * bbi[7]
                             + u2.x * bbi[8] + u2.y * bbi[9] + u2.z * bbi[10] + u2.w * bbi[11] + u3.x * bbi[12] + u3.y * bbi[13] + u3.z * bbi[14] + u3.w * bbi[15];
                    const float nr = lbr * sr - lbi * si + ir, ni = lbr * si + lbi * sr + ii; sr = nr; si = ni;
                    if (MODE) { Sst[(tt * 64 + lane) * 2] = sr; Sst[(tt * 64 + lane) * 2 + 1] = si; }
                }
                if (MODE) {
                    LDS_WAIT();
                    const int h = lane & 15, tq = lane >> 4;
#pragma unroll
                    for (int j = 0; j < 4; ++j) { const int slot = tq * 4 + j; const float* sp = Sst + slot * 128; float y = 0.f;
#pragma unroll
                        for (int p = 0; p < 64; p += 2) { const f32x4 s4 = *(const f32x4*)(sp + 2 * p); y += s4.x * cr[p] - s4.y * ci[p] + s4.z * cr[p + 1] - s4.w * ci[p + 1]; }
                        const int tl = dir ? (SCH - 1 - (16 * b + slot)) : (16 * b + slot);
                        if (dir == 0) Yf[tl * 16 + h] = y; else Yf[tl * 16 + h] += y; }
                    LDS_WAIT();
                }
            }
            if (!MODE) { float* ep = E + ((((size_t)ch * 2 + dir) * 32 + g) * 64 + lane) * 2; ep[0] = sr; ep[1] = si; }
        }
        if (MODE) {
            LDS_WAIT();
            for (int i = 0; i < 32; ++i) { const int idx = lane + 64 * i, tl = idx >> 4, h = idx & 15; const size_t tok = (size_t)(tok0 + tl);
                const float xs = bf2f(Z[tok * ZW + ZXS + g * 16 + h]); const float y = Yf[tl * 16 + h] + a.in[I_SD][(size_t)l * 512 + g * 16 + h] * xs;
                YG[tok * 512 + g * 16 + h] = (bf16)f2bf(gelu_tanh(y)); }
            LDS_WAIT();
        }
    }
}

template <int MODE, int DIR> __device__ __forceinline__ void s5_dir(const Args& a, int l, int lane, int tok0, int gr, LAS unsigned char* st, bf16* yf) {
    const bf16* Z = (const bf16*)(a.ws + WS_Z); bf16* YG = (bf16*)(a.ws + WS_YG);
    float* E = (float*)(a.ws + WS_SEND); const float* CIN = (const float*)(a.ws + WS_SCIN); const float* TLB = (const float*)(a.ws + WS_TLB);
    const int n = lane & 15, g = lane >> 4, dg = DIR * 32 + gr, ch = tok0 / SCH + g;
    pg8::bf16x8 bbf[8], cf[4];
    { const pg8::bf16x8* bp = (const pg8::bf16x8*)(a.ws + WS_TBBF) + (size_t)dg * 8 * 64 + lane;
#pragma unroll
      for (int c = 0; c < 8; ++c) bbf[c] = bp[c * 64]; }
    if (MODE) { const pg8::bf16x8* cp = (const pg8::bf16x8*)(a.ws + WS_TCF) + (size_t)dg * 4 * 64 + lane;
#pragma unroll
      for (int c = 0; c < 4; ++c) cf[c] = cp[c * 64]; }
    float lbr[4], lbi[4], sr[4], si[4];
#pragma unroll
    for (int cb = 0; cb < 4; ++cb) { const size_t ix = ((size_t)dg * 64 + 16 * cb + n) * 2; lbr[cb] = TLB[ix]; lbi[cb] = TLB[ix + 1];
        if (MODE) { const size_t cx = ((((size_t)ch * 2 + DIR) * 32 + gr) * 64 + 16 * cb + n) * 2; sr[cb] = CIN[cx]; si[cb] = CIN[cx + 1]; } else { sr[cb] = 0.f; si[cb] = 0.f; } }
    const float dsk = MODE ? a.in[I_SD][(size_t)l * 512 + 16 * gr + n] : 0.f;
    const bf16* ua = Z + (size_t)(tok0 + (n >> 2) * SCH + (n & 3)) * ZW + ZXS + 16 * gr + 8 * (g & 1);
    bf16* yo = YG + (size_t)(tok0 + g * SCH) * 512 + 16 * gr + n;
    const bf16* xo = Z + (size_t)(tok0 + g * SCH) * ZW + ZXS + 16 * gr + n;
    constexpr int NST = SCH / 4, T0 = DIR ? (SCH - 4) : 0, DT = DIR ? -4 : 4;
    pg8::bf16x8 un = *(const pg8::bf16x8*)(ua + (size_t)T0 * ZW);
    unsigned short ygn[4], xsn[4];
    if (MODE && DIR) {
        VM_WAIT();
#pragma unroll
        for (int rg = 0; rg < 4; ++rg) { ygn[rg] = yf[((T0 >> 2) * 4 + rg) * 64 + lane]; xsn[rg] = xo[(size_t)(T0 + rg) * ZW]; } }
#pragma unroll 1
    for (int step = 0; step < NST; ++step) {
        const int t4 = T0 + DT * step;
        const pg8::bf16x8 u8 = un; unsigned short ygc[4], xsc[4];
        if (MODE && DIR) {
#pragma unroll
            for (int rg = 0; rg < 4; ++rg) { ygc[rg] = ygn[rg]; xsc[rg] = xsn[rg]; } }
        if (step + 1 < NST) { un = *(const pg8::bf16x8*)(ua + (size_t)(t4 + DT) * ZW);
            if (MODE && DIR) {
#pragma unroll
                for (int rg = 0; rg < 4; ++rg) { ygn[rg] = yf[(((t4 + DT) >> 2) * 4 + rg) * 64 + lane]; xsn[rg] = xo[(size_t)(t4 + DT + rg) * ZW]; } } }
        f32x4 in[8];
#pragma unroll
        for (int c = 0; c < 8; ++c) in[c] = __builtin_amdgcn_mfma_f32_16x16x32_bf16(u8, bbf[c], (f32x4){0.f, 0.f, 0.f, 0.f}, 0, 0, 0);
        float str[4][4], sti[4][4];
#pragma unroll
        for (int rr = 0; rr < 4; ++rr) { const int rg = DIR ? 3 - rr : rr;
#pragma unroll
            for (int cb = 0; cb < 4; ++cb) { const float nr = lbr[cb] * sr[cb] - lbi[cb] * si[cb] + in[cb][rg], ni = lbr[cb] * si[cb] + lbi[cb] * sr[cb] + in[4 + cb][rg];
                sr[cb] = nr; si[cb] = ni; str[cb][rg] = nr; sti[cb][rg] = ni; } }
        if (MODE) {
#pragma unroll
            for (int rg = 0; rg < 4; ++rg) { v4u w; w.x = pk2s(str[0][rg], sti[0][rg]); w.y = pk2s(str[1][rg], sti[1][rg]); w.z = pk2s(str[2][rg], sti[2][rg]); w.w = pk2s(str[3][rg], sti[3][rg]);
                *(LAS v4u*)(st + (4 * g + rg) * 272 + n * 16) = w; asm volatile("s_nop 1" ::: "memory"); }
            LDS_WAIT();
            f32x4 y = (f32x4){0.f, 0.f, 0.f, 0.f};
#pragma unroll
            for (int ks = 0; ks < 4; ++ks) { const pg8::bf16x8 sf = *(const LAS pg8::bf16x8*)(st + n * 272 + ks * 64 + g * 16); y = __builtin_amdgcn_mfma_f32_16x16x32_bf16(sf, cf[ks], y, 0, 0, 0); }
            LDS_WAIT();
#pragma unroll
            for (int rg = 0; rg < 4; ++rg) {
                if (DIR == 0) yf[((t4 >> 2) * 4 + rg) * 64 + lane] = (bf16)f2bf(y[rg]);
                else { const float v = y[rg] + bf2f(ygc[rg]) + dsk * bf2f(xsc[rg]); yo[(size_t)(t4 + rg) * 512] = (bf16)f2bf(gelu_tanh(v)); } }
        }
    }
    if (!MODE) {
#pragma unroll
        for (int cb = 0; cb < 4; ++cb) { const size_t cx = ((((size_t)ch * 2 + DIR) * 32 + gr) * 64 + 16 * cb + n) * 2; E[cx] = sr[cb]; E[cx + 1] = si[cb]; } }
}

template <int MODE, int DIR> __device__ __forceinline__ void lru_dir(const Args& a, int l, int lane, int tok0, int nb, int half, const LAS unsigned char* xt, bf16* hf) {
    const bf16* Z = (const bf16*)(a.ws + WS_Z); bf16* Y = (bf16*)(a.ws + WS_Y);
    float* agg = (float*)(a.ws + WS_LAGG); const float* cin = (const float*)(a.ws + WS_LCIN);
    const int n = lane & 15, g = lane >> 4, ch = tok0 / LCH + g;
    pg8::bf16x8 wa[2][2], wx[2][2];
    { const pg8::bf16x8* wp = (const pg8::bf16x8*)(a.ws + WS_TWF) + (size_t)((DIR * 8 + nb) * 2) * 4 * 2 * 64 + lane;
#pragma unroll
      for (int c2 = 0; c2 < 2; ++c2)
#pragma unroll
          for (int ks = 0; ks < 2; ++ks) { wa[c2][ks] = wp[((2 * half + c2) * 2 + ks) * 64]; wx[c2][ks] = wp[(8 + (2 * half + c2) * 2 + ks) * 64]; } }
    pg8::bf16x8 idn[2];
#pragma unroll
    for (int hf = 0; hf < 2; ++hf) { v4u w;
#pragma unroll
        for (int jj = 0; jj < 4; ++jj) { const int k0 = 8 * g + 2 * jj; w[jj] = ((k0 == 16 * hf + n) ? 0x3f80u : 0u) | ((k0 + 1 == 16 * hf + n) ? 0x3f800000u : 0u); }
        idn[hf] = __builtin_bit_cast(pg8::bf16x8, w); }
    float ba[2], bx[2], ls8[2], h[2], P[2];
    const int cch = 64 * nb + 32 * half + n;
#pragma unroll
    for (int c2 = 0; c2 < 2; ++c2) { const int c = cch + 16 * c2; const size_t ix = (size_t)(l * 2 + DIR) * 512 + c;
        ba[c2] = a.in[I_LBA][ix]; bx[c2] = a.in[I_LBX][ix]; ls8[c2] = -8.f * log1pf(__expf(-a.in[I_LAM][ix]));
        h[c2] = MODE ? cin[((size_t)ch * 2 + DIR) * 512 + c] : 0.f; P[c2] = 1.f; }
    const LAS unsigned char* xa = xt + ((n >> 2) * LCH + (n & 3)) * 128 + g * 16;
    bf16* yo = Y + (size_t)(tok0 + g * LCH) * DM + 1024 + cch;
    const bf16* go = Z + (size_t)(tok0 + g * LCH) * ZW + ZGT + cch;
    constexpr int NST = LCH / 4, T0 = DIR ? (LCH - 4) : 0, DT = DIR ? -4 : 4;
    unsigned short yn[2][4], gn[2][4];
    if (MODE && DIR) {
        VM_WAIT();
#pragma unroll
        for (int rg = 0; rg < 4; ++rg)
#pragma unroll
            for (int c2 = 0; c2 < 2; ++c2) { yn[c2][rg] = hf[(((T0 >> 2) * 4 + rg) * 2 + c2) * 64 + lane]; gn[c2][rg] = go[(size_t)(T0 + rg) * ZW + 16 * c2]; } }
#pragma unroll 1
    for (int step = 0; step < NST; ++step) {
        const int t4 = T0 + DT * step;
        unsigned short yc[2][4], gc[2][4];
        if (MODE && DIR) {
#pragma unroll
            for (int rg = 0; rg < 4; ++rg)
#pragma unroll
                for (int c2 = 0; c2 < 2; ++c2) { yc[c2][rg] = yn[c2][rg]; gc[c2][rg] = gn[c2][rg]; }
            if (step + 1 < NST) {
#pragma unroll
                for (int rg = 0; rg < 4; ++rg)
#pragma unroll
                    for (int c2 = 0; c2 < 2; ++c2) { yn[c2][rg] = hf[((((t4 + DT) >> 2) * 4 + rg) * 2 + c2) * 64 + lane]; gn[c2][rg] = go[(size_t)(t4 + DT + rg) * ZW + 16 * c2]; } } }
        const pg8::bf16x8 a0 = *(const LAS pg8::bf16x8*)(xa + t4 * 128), a1 = *(const LAS pg8::bf16x8*)(xa + t4 * 128 + 64);
        const pg8::bf16x8 ah = half ? a1 : a0;
        f32x4 pa[2], px[2], xd[2];
#pragma unroll
        for (int c2 = 0; c2 < 2; ++c2) { const f32x4 z4 = (f32x4){0.f, 0.f, 0.f, 0.f};
            pa[c2] = __builtin_amdgcn_mfma_f32_16x16x32_bf16(a0, wa[c2][0], z4, 0, 0, 0); pa[c2] = __builtin_amdgcn_mfma_f32_16x16x32_bf16(a1, wa[c2][1], pa[c2], 0, 0, 0);
            px[c2] = __builtin_amdgcn_mfma_f32_16x16x32_bf16(a0, wx[c2][0], z4, 0, 0, 0); px[c2] = __builtin_amdgcn_mfma_f32_16x16x32_bf16(a1, wx[c2][1], px[c2], 0, 0, 0);
            xd[c2] = __builtin_amdgcn_mfma_f32_16x16x32_bf16(ah, idn[c2], z4, 0, 0, 0); }
#pragma unroll
        for (int rr = 0; rr < 4; ++rr) { const int rg = DIR ? 3 - rr : rr;
#pragma unroll
            for (int c2 = 0; c2 < 2; ++c2) {
                const float r_ = sigmoidf_(pa[c2][rg] + ba[c2]), i_ = sigmoidf_(px[c2][rg] + bx[c2]); const float loga = ls8[c2] * r_, av = __expf(loga), mult = fsqrt_(fmaxf(1.f - av * av, 0.f));
                h[c2] = av * h[c2] + mult * i_ * xd[c2][rg]; P[c2] *= av;
                if (MODE) {
                    if (DIR == 0) hf[(((t4 >> 2) * 4 + rg) * 2 + c2) * 64 + lane] = (bf16)f2bf(h[c2]);
                    else yo[(size_t)(t4 + rg) * DM + 16 * c2] = (bf16)f2bf((bf2f(yc[c2][rg]) + h[c2]) * gelu_tanh(bf2f(gc[c2][rg]))); } }
        }
    }
    if (!MODE) {
#pragma unroll
        for (int c2 = 0; c2 < 2; ++c2) { float* ag = agg + (((size_t)ch * 2 + DIR) * 512 + cch + 16 * c2) * 2; ag[0] = P[c2]; ag[1] = h[c2]; } }
}
__device__ __forceinline__ void lru_prepass(const Args& a, int l, int lane, int tok0, int nb, LAS unsigned char* xt) {
    const bf16* Z = (const bf16*)(a.ws + WS_Z);
    int s0, T; seq_of(tok0, s0, T); const int s1 = s0 + T;
    const int oc = lane & 7, tg = lane >> 3, cbase = 64 * nb + 8 * oc; float cw[4][8], cbv[8];
    v4u x[19];
    const int tb = tok0 + 16 * tg - 2;
#pragma unroll
    for (int i = 0; i < 19; ++i) { const int tt = tb + i; x[i] = (v4u){0u, 0u, 0u, 0u}; if (tt >= s0 && tt < s1) x[i] = *(const v4u*)(Z + (size_t)tt * ZW + ZXR + cbase); }
#pragma unroll
    for (int tp = 0; tp < 4; ++tp) { const f32x4* wp = (const f32x4*)(a.in[I_CW] + ((size_t)l * 4 + tp) * 512 + cbase); const f32x4 w0 = wp[0], w1 = wp[1];
        cw[tp][0] = w0.x; cw[tp][1] = w0.y; cw[tp][2] = w0.z; cw[tp][3] = w0.w; cw[tp][4] = w1.x; cw[tp][5] = w1.y; cw[tp][6] = w1.z; cw[tp][7] = w1.w; }
    { const f32x4* bp = (const f32x4*)(a.in[I_CB] + (size_t)l * 512 + cbase); const f32x4 b0 = bp[0], b1 = bp[1]; cbv[0] = b0.x; cbv[1] = b0.y; cbv[2] = b0.z; cbv[3] = b0.w; cbv[4] = b1.x; cbv[5] = b1.y; cbv[6] = b1.z; cbv[7] = b1.w; }
    LDS_WAIT();
#pragma unroll
    for (int i = 0; i < 16; ++i) { float acc[8];
#pragma unroll
        for (int e = 0; e < 8; ++e) acc[e] = cbv[e];
#pragma unroll
        for (int tp = 0; tp < 4; ++tp) { const v4u xx = x[i + tp];
            acc[0] += cw[tp][0] * bflo(xx.x); acc[1] += cw[tp][1] * bfhi(xx.x); acc[2] += cw[tp][2] * bflo(xx.y); acc[3] += cw[tp][3] * bfhi(xx.y);
            acc[4] += cw[tp][4] * bflo(xx.z); acc[5] += cw[tp][5] * bfhi(xx.z); acc[6] += cw[tp][6] * bflo(xx.w); acc[7] += cw[tp][7] * bfhi(xx.w); }
        v4u o; o.x = pk2(acc[0], acc[1]); o.y = pk2(acc[2], acc[3]); o.z = pk2(acc[4], acc[5]); o.w = pk2(acc[6], acc[7]);
        *(LAS v4u*)(xt + (16 * tg + i) * 128 + oc * 16) = o; asm volatile("s_nop 1" ::: "memory"); }
    LDS_WAIT();
}
template <int MODE> __device__ __forceinline__ void ph_scan(const Args& a, const Frame& F, int l) {
    int tid = threadIdx.x; asm volatile("" : "+v"(tid)); int lane = tid & 63; (void)lane;
    LAS unsigned char* slab = F.lds + RING_OFF + F.wave * 16384;
    LAS int* ctr = (LAS int*)(F.lds + MISC_OFF + 64);
    __syncthreads(); if (tid == 0) *ctr = 0; __syncthreads();
    constexpr int NLU = (NLCH / 4) * 16, NSU = (NSCH / 4) * 32;
    const int l0 = (int)((long)NLU * F.vcu / F.G), l1 = (int)((long)NLU * (F.vcu + 1) / F.G), s0u = (int)((long)NSU * F.vcu / F.G), s1u = (int)((long)NSU * (F.vcu + 1) / F.G);
    const int nl = l1 - l0, ntot = nl + (s1u - s0u);
    for (;;) {
        int it = 0; if (lane == 0) it = __hip_atomic_fetch_add(ctr, 1, __ATOMIC_RELAXED, __HIP_MEMORY_SCOPE_WORKGROUP);
        it = __builtin_amdgcn_readfirstlane(it);
        if (it >= ntot) break;
        if (it < nl) { const int u = l0 + it, half = u & 1, nb = (u >> 1) & 7, cq = u >> 4, tok0 = cq * 4 * LCH;
            bf16* hf = (bf16*)(a.ws + WS_HF) + (size_t)u * 4096;
            lru_prepass(a, l, lane, tok0, nb, slab);
            lru_dir<MODE, 0>(a, l, lane, tok0, nb, half, slab, hf); lru_dir<MODE, 1>(a, l, lane, tok0, nb, half, slab, hf);
        } else { const int u = s0u + it - nl, gr = u & 31, cq = u >> 5, tok0 = cq * 4 * SCH;
            bf16* yf = (bf16*)(a.ws + WS_HF + 40 * MiB) + (size_t)u * 4096;
            s5_dir<MODE, 0>(a, l, lane, tok0, gr, slab, yf); s5_dir<MODE, 1>(a, l, lane, tok0, gr, slab, yf); }
    }
    LDS_WAIT();
}

__device__ __forceinline__ void ph_carries(const Args& a, const Frame& F, int l) {
    int tid = threadIdx.x; asm volatile("" : "+v"(tid)); int lane = tid & 63; (void)lane;
    constexpr int NL_LONG = 2 * 2 * 512 * (16384 / LCH / 16), NL_SHORT = 4 * 2 * 512 * (2048 / LCH / 16);
    constexpr int NS_LONG = 2 * 2 * 2048 * (16384 / SCH / 16), NS_SHORT = 4 * 2 * 2048 * (2048 / SCH / 16);
    constexpr int NITEM = NL_LONG + NL_SHORT + NS_LONG + NS_SHORT;
    static_assert(NL_LONG % 512 == 0 && NL_SHORT % 512 == 0 && NS_LONG % 512 == 0 && NS_SHORT % 512 == 0, "item classes are whole workgroups");
    for (int base = F.vcu * NTHR; base < NITEM; base += F.G * NTHR) {
        int it = base + tid;
        if (it < NL_LONG + NL_SHORT) {
            const bool lg = it < NL_LONG; if (!lg) it -= NL_LONG;
            const int W = lg ? (16384 / LCH / 16) : (2048 / LCH / 16); const int seg = it & (W - 1), chain = it / W;
            const int c = chain & 511, dir = (chain >> 9) & 1, sq = chain >> 10; const int s0 = lg ? 8192 + sq * 16384 : sq * 2048, T = lg ? 16384 : 2048; const int c0 = s0 / LCH, nc = T / LCH;
            const f32x2* agg = (const f32x2*)(a.ws + WS_LAGG); float* cin = (float*)(a.ws + WS_LCIN);
            f32x2 v[16]; float A = 1.f, B = 0.f;
#pragma unroll
            for (int j = 0; j < 16; ++j) { const int pos = seg * 16 + j, ch = c0 + (dir ? nc - 1 - pos : pos); v[j] = agg[((size_t)ch * 2 + dir) * 512 + c]; }
#pragma unroll
            for (int j = 0; j < 16; ++j) { B = v[j].x * B + v[j].y; A *= v[j].x; }
            for (int off = 1; off < W; off <<= 1) { const float Ap = __shfl_up(A, off, 64), Bp = __shfl_up(B, off, 64); if (seg >= off) { B = A * Bp + B; A = A * Ap; } }
            float carry = __shfl_up(B, 1, 64); if (seg == 0) carry = 0.f;
#pragma unroll
            for (int j = 0; j < 16; ++j) { const int pos = seg * 16 + j, ch = c0 + (dir ? nc - 1 - pos : pos); cin[((size_t)ch * 2 + dir) * 512 + c] = carry; carry = v[j].x * carry + v[j].y; }
        } else {
            it -= NL_LONG + NL_SHORT;
            const bool lg = it < NS_LONG; if (!lg) it -= NS_LONG;
            const int W = lg ? (16384 / SCH / 16) : (2048 / SCH / 16); const int seg = it & (W - 1), chain = it / W;
            const int p = chain & 63, g = (chain >> 6) & 31, dir = (chain >> 11) & 1, sq = chain >> 12; const int s0 = lg ? 8192 + sq * 16384 : sq * 2048, T = lg ? 16384 : 2048; const int c0 = s0 / SCH, nc = T / SCH;
            const float* TLB = (const float*)(a.ws + WS_TLB); const f32x2* E = (const f32x2*)(a.ws + WS_SEND); f32x2* CIN = (f32x2*)(a.ws + WS_SCIN);
            float pr = TLB[((size_t)(dir * 32 + g) * 64 + p) * 2], pi = TLB[((size_t)(dir * 32 + g) * 64 + p) * 2 + 1];
            static_assert(SCH == 64, "lb^SCH by 6 squarings");
#pragma unroll
            for (int i = 0; i < 6; ++i) { const float nr = pr * pr - pi * pi, ni = 2.f * pr * pi; pr = nr; pi = ni; }
            f32x2 v[16]; float Br = 0.f, Bi = 0.f;
#pragma unroll
            for (int j = 0; j < 16; ++j) { const int pos = seg * 16 + j, ch = c0 + (dir ? nc - 1 - pos : pos); v[j] = E[(((size_t)ch * 2 + dir) * 32 + g) * 64 + p]; }
#pragma unroll
            for (int j = 0; j < 16; ++j) { const float nr = pr * Br - pi * Bi + v[j].x, ni = pr * Bi + pi * Br + v[j].y; Br = nr; Bi = ni; }
            float Ar = pr, Ai = pi;
#pragma unroll
            for (int i = 0; i < 4; ++i) { const float nr = Ar * Ar - Ai * Ai, ni = 2.f * Ar * Ai; Ar = nr; Ai = ni; }
            for (int off = 1; off < W; off <<= 1) { const float Apr = __shfl_up(Ar, off, 64), Api = __shfl_up(Ai, off, 64), Bpr = __shfl_up(Br, off, 64), Bpi = __shfl_up(Bi, off, 64);
                if (seg >= off) { const float nbr = Ar * Bpr - Ai * Bpi + Br, nbi = Ar * Bpi + Ai * Bpr + Bi, nar = Ar * Apr - Ai * Api, nai = Ar * Api + Ai * Apr; Br = nbr; Bi = nbi; Ar = nar; Ai = nai; } }
            float cr = __shfl_up(Br, 1, 64), ci = __shfl_up(Bi, 1, 64); if (seg == 0) { cr = 0.f; ci = 0.f; }
#pragma unroll
            for (int j = 0; j < 16; ++j) { const int pos = seg * 16 + j, ch = c0 + (dir ? nc - 1 - pos : pos); CIN[(((size_t)ch * 2 + dir) * 32 + g) * 64 + p] = (f32x2){cr, ci};
                const float nr = pr * cr - pi * ci + v[j].x, ni = pr * ci + pi * cr + v[j].y; cr = nr; ci = ni; }
        }
    }
}

__device__ __forceinline__ void ph_groupnorm(const Args& a, const Frame& F, int l, bf16* dst = nullptr) {
    int tid = threadIdx.x; asm volatile("" : "+v"(tid)); int lane = tid & 63; (void)lane;
    bf16* Y = (bf16*)(a.ws + WS_Y); const float* g = a.in[I_GOUT] + (size_t)l * DM;
    const int gw = F.vcu * NWAVES + F.wave, NGW = F.G * NWAVES;
    for (int m = gw; m < NTOK; m += NGW) {
        v4u* yr = (v4u*)(Y + (size_t)m * DM) + lane;
        v4u w[4]; float ss[4];
#pragma unroll
        for (int j = 0; j < 4; ++j) { w[j] = yr[64 * j]; float s = 0.f;
#pragma unroll
            for (int q = 0; q < 4; ++q) { const float lo = bflo(w[j][q]), hi = bfhi(w[j][q]); s += lo * lo + hi * hi; }
            ss[j] = s; }
        const float sa = wave_sum(ss[0] + ss[1]), sb = wave_sum(ss[2]), sc = wave_sum(ss[3]);
        const float ra = 1.f / sqrtf(sa * (1.f / 1024.f) + EPS), rb = 1.f / sqrtf(sb * (1.f / 512.f) + EPS), rc = 1.f / sqrtf(sc * (1.f / 512.f) + EPS);
#pragma unroll
        for (int j = 0; j < 4; ++j) { const float r = j < 2 ? ra : (j == 2 ? rb : rc); const f32x4* gp = (const f32x4*)(g + 8 * (lane + 64 * j)); const f32x4 g0 = gp[0], g1 = gp[1];
            v4u o; o.x = pk2(bflo(w[j].x) * r * g0.x, bfhi(w[j].x) * r * g0.y); o.y = pk2(bflo(w[j].y) * r * g0.z, bfhi(w[j].y) * r * g0.w);
            o.z = pk2(bflo(w[j].z) * r * g1.x, bfhi(w[j].z) * r * g1.y); o.w = pk2(bflo(w[j].w) * r * g1.z, bfhi(w[j].w) * r * g1.w);
            if (dst) ((v4u*)(dst + (size_t)m * DM) + lane)[64 * j] = o; else yr[64 * j] = o; }
    }
}

__device__ __forceinline__ void ph_norm2(const Args& a, const Frame& F, int l) {
    int tid = threadIdx.x; asm volatile("" : "+v"(tid)); int lane = tid & 63; (void)lane;
    const int gw = F.vcu * NWAVES + F.wave, NGW = F.G * NWAVES; const float* g = a.in[I_NLG] + (size_t)l * DM; bf16* H = (bf16*)(a.ws + WS_H);
    for (int m = gw; m < NTOK; m += NGW) norm_row_bf16(a.out + (size_t)m * DM, g, H + (size_t)m * DM, lane);
}
__device__ __forceinline__ void ph_final(const Args& a, const Frame& F, float* dst = nullptr) {
    int tid = threadIdx.x; asm volatile("" : "+v"(tid)); int lane = tid & 63; (void)lane;
    const int gw = F.vcu * NWAVES + F.wave, NGW = F.G * NWAVES; const f32x4* gr = (const f32x4*)a.in[I_FING] + lane;
    for (int m = gw; m < NTOK; m += NGW) {
        f32x4* xr = (f32x4*)(a.out + (size_t)m * DM) + lane; f32x4 v[8]; float s = 0.f;
#pragma unroll
        for (int j = 0; j < 8; ++j) { v[j] = xr[64 * j]; s += (v[j].x * v[j].x + v[j].y * v[j].y) + (v[j].z * v[j].z + v[j].w * v[j].w); }
        const float rstd = 1.f / sqrtf(wave_sum(s) * (1.f / DM) + EPS);
#pragma unroll
        for (int j = 0; j < 8; ++j) { if (dst) ((f32x4*)(dst + (size_t)m * DM) + lane)[64 * j] = v[j] * rstd * gr[64 * j]; else xr[64 * j] = v[j] * rstd * gr[64 * j]; }
    }
}

__global__ void __launch_bounds__(NTHR, 2) mk_fwd(Args args) {
    extern __shared__ __attribute__((aligned(16))) unsigned char lds[];
    Frame F; F.lds = (LAS unsigned char*)lds; F.ldsg = lds;
    F.tid = threadIdx.x; F.lane = F.tid & 63; F.wave = __builtin_amdgcn_readfirstlane(F.tid >> 6);
    F.G = gridDim.x; { const int bx = blockIdx.x; F.vcu = (F.G % 8 == 0) ? (bx % 8) * (F.G / 8) + bx / 8 : bx; }
    volatile LAS unsigned* MISC = (volatile LAS unsigned*)(F.lds + MISC_OFF);
    for (int u = F.tid; u < (LDS_BYTES - LDSCTL_OFF) / 4; u += NTHR) ((LAS unsigned*)(F.lds + LDSCTL_OFF))[u] = 0u;
    __syncthreads();
    unsigned char* ws = args.ws;
    XcdBarrier bar; bar.bar = (unsigned*)(ws + WS_CTL) + CW_BAR; bar.x = 0; bar.st = nullptr;
#if MK_ONE_LAUNCH
    bar = xcd_barrier_post((unsigned*)(ws + WS_CTL) + CW_BAR, MISC + 8);
#endif
    const int lo = args.ph_lo, hi = args.ph_hi;
#define IN(k) (lo <= (k) && (k) < hi)
#if MK_ONE_LAUNCH
#if PROBE_BAR2
#define SEAM(k) do { if (IN(k) && IN((k) + 1)) { xcd_barrier(bar); xcd_barrier(bar); } } while (0)
#else
#define SEAM(k) do { if (IN(k) && IN((k) + 1)) xcd_barrier(bar); } while (0)
#endif
#else
#define SEAM(k) do { } while (0)
#endif
    for (int l = 0; l < DEPTH; ++l) {
        const int pb = l * PH_PER_LAYER;
        if (IN(pb + 0)) { ph_prologue(args, F, l);
#if PROBE_PRO2
            __syncthreads(); ph_prologue(args, F, l);
#endif
        } SEAM(pb + 0);
        if (IN(pb + 1)) {
            pg8::Gemm g{(const bf16*)(ws + WS_H), (const bf16*)(ws + WS_WIN), NTOK, ZW, DM}; pg8::StaticOrder S; S.init(NTOK, ZW, F.G, (int)blockIdx.x);
            pg8::EpiBf16<0> E{(bf16*)(ws + WS_Z), ZW, (const unsigned long long*)(ws + WS_SSQ) + (size_t)(l * 2) * NTOK, (LAS float*)(F.lds + XTRA_OFF)};
            pg8::gemm_phase<pg8::EpiBf16<0>, pg8::StaticOrder, true, true>(F.lds + RING_OFF, g, S, E);
#if PROBE_WIN2
            pg8::gemm_phase<pg8::EpiBf16<0>, pg8::StaticOrder, true, true>(F.lds + RING_OFF, g, S, E);
#endif
        } SEAM(pb + 1);
        if (IN(pb + 2)) { ph_na_mfma(args, F, l); ph_scan<0>(args, F, l);
#if PROBE_NA2
            __syncthreads(); ph_na_mfma(args, F, l);
#endif
#if PROBE_SCAN2
            ph_scan<0>(args, F, l);
#endif
        } SEAM(pb + 2);
        if (IN(pb + 3)) { ph_carries(args, F, l);
#if PROBE_SCAN2 || PROBE_CAR2
            ph_carries(args, F, l);
#endif
        } SEAM(pb + 3);
        if (IN(pb + 4)) { ph_scan<1>(args, F, l);
#if PROBE_SCAN2
            ph_scan<1>(args, F, l);
#endif
        } SEAM(pb + 4);
        if (IN(pb + 5)) {
            __syncthreads();
            pg8::Gemm g{(const bf16*)(ws + WS_YG), (const bf16*)(ws + WS_WGLU), NTOK, 512, 512}; pg8::StaticOrder S; S.init(NTOK, 512, F.G, (int)blockIdx.x);
            pg8::EpiGlu E{(const bf16*)(ws + WS_YG), (bf16*)(ws + WS_Y), args.in[I_BGLU] + (size_t)l * 512, DM, 1536};
            pg8::gemm_phase<pg8::EpiGlu, pg8::StaticOrder, true, true>(F.lds + RING_OFF, g, S, E);
#if PROBE_GLU2
            pg8::gemm_phase<pg8::EpiGlu, pg8::StaticOrder, true, true>(F.lds + RING_OFF, g, S, E);
#endif
        } SEAM(pb + 5);
        if (IN(pb + 6)) {
#if PROBE_GN2
            ph_groupnorm(args, F, l, (bf16*)(ws + WS_Z));
#endif
            ph_groupnorm(args, F, l); } SEAM(pb + 6);
        if (IN(pb + 7)) {
            pg8::Gemm g{(const bf16*)(ws + WS_Y), (const bf16*)(ws + WS_WOUT), NTOK, DM, DM}; pg8::StaticOrder S; S.init(NTOK, DM, F.G, (int)blockIdx.x);
#if PROBE_WOUT2
            { pg8::EpiResid E2{l == 0 ? args.in[I_XP] : nullptr, l == 0 ? args.in[I_XS] : nullptr, 8192, (float*)(ws + WS_Z), DM, (bf16*)(ws + WS_H), nullptr};
              pg8::gemm_phase<pg8::EpiResid, pg8::StaticOrder, true, true>(F.lds + RING_OFF, g, S, E2); }
#endif
            pg8::EpiResid E{l == 0 ? args.in[I_XP] : nullptr, l == 0 ? args.in[I_XS] : nullptr, 8192, nullptr, DM, (bf16*)(ws + WS_H), (unsigned long long*)(ws + WS_SSQ) + (size_t)(l * 2 + 1) * NTOK};
            pg8::gemm_phase<pg8::EpiResid, pg8::StaticOrder, true, true>(F.lds + RING_OFF, g, S, E);
        } SEAM(pb + 7);
        for (int s = 0; s <= NMLPC; ++s) {
            if (IN(pb + 8 + s)) {
                if (s > 0) {
                    const int c = s - 1;
                    pg8::Gemm g{(const bf16*)(ws + WS_Z + (size_t)(c & 1) * 128 * MiB), (const bf16*)(ws + WS_WDN), MLPC, DM, DFF}; pg8::StaticOrder S; S.init(MLPC, DM, F.G, (int)blockIdx.x);
                    pg8::EpiResid E{nullptr, nullptr, 1 << 30, l + 1 < DEPTH ? nullptr : args.out + (size_t)c * MLPC * DM, DM,
                                    (bf16*)(ws + WS_H) + (size_t)c * MLPC * DM, (unsigned long long*)(ws + WS_SSQ) + (size_t)((l + 1 < DEPTH ? l + 1 : 0) * 2) * NTOK + (size_t)c * MLPC};
#if PROBE_DN2
                    { pg8::EpiResid E2{nullptr, nullptr, 1 << 30, (float*)(ws + WS_Z + 256 * MiB), DM, (bf16*)(ws + WS_H) + (size_t)c * MLPC * DM, nullptr};
                      pg8::gemm_phase<pg8::EpiResid, pg8::StaticOrder, true, true>(F.lds + RING_OFF, g, S, E2); }
#endif
                    pg8::gemm_phase<pg8::EpiResid, pg8::StaticOrder, true, true>(F.lds + RING_OFF, g, S, E);
                }
                if (s < NMLPC) {
                    const int c = s;
                    pg8::Gemm g{(const bf16*)(ws + WS_H) + (size_t)c * MLPC * DM, (const bf16*)(ws + WS_WUP), MLPC, DFF, DM}; pg8::StaticOrder S; S.init(MLPC, DFF, F.G, (int)blockIdx.x);
                    pg8::EpiBf16<1> E{(bf16*)(ws + WS_Z + (size_t)(c & 1) * 128 * MiB), DFF, (const unsigned long long*)(ws + WS_SSQ) + (size_t)(l * 2 + 1) * NTOK + (size_t)c * MLPC, (LAS float*)(F.lds + XTRA_OFF)};
                    pg8::gemm_phase<pg8::EpiBf16<1>, pg8::StaticOrder, true, true>(F.lds + RING_OFF, g, S, E);
#if PROBE_UP2
                    pg8::gemm_phase<pg8::EpiBf16<1>, pg8::StaticOrder, true, true>(F.lds + RING_OFF, g, S, E);
#endif
                }
            } SEAM(pb + 8 + s);
        }
    }
    if (IN(NPHASE - 1)) {
#if PROBE_FIN2
        ph_final(args, F, (float*)(ws + WS_Z));
#endif
        ph_final(args, F); }
#undef IN
#undef SEAM
}

extern "C" void kernel_launch(void* const* d_in, const int* in_sizes, int n_in, void* d_out, int out_size, void* d_ws, size_t ws_size, hipStream_t stream) {
    static int grid = 0;
    if (grid == 0) {
        if (n_in != 28 || out_size != NTOK * DM || ws_size < WS_END) { fprintf(stderr, "kernel_launch: unexpected shapes (n_in %d out %d ws %zu)\n", n_in, out_size, ws_size); grid = -1; return; }
        int dev = 0, cus = 0, per_cu = 0;
        if (hipGetDevice(&dev) != hipSuccess || hipDeviceGetAttribute(&cus, hipDeviceAttributeMultiprocessorCount, dev) != hipSuccess) { grid = -1; return; }
        if (hipFuncSetAttribute((const void*)mk_fwd, hipFuncAttributeMaxDynamicSharedMemorySize, LDS_BYTES) != hipSuccess) { fprintf(stderr, "kernel_launch: hipFuncSetAttribute failed\n"); grid = -1; return; }
        if (hipOccupancyMaxActiveBlocksPerMultiprocessor(&per_cu, (const void*)mk_fwd, NTHR, LDS_BYTES) != hipSuccess || per_cu < 1) fprintf(stderr, "kernel_launch: occupancy query says %d\n", per_cu);
        (void)hipGetLastError();
        grid = cus;
    }
    if (grid < 0) return;
    if (hipMemsetAsync((char*)d_ws + WS_CTL, 0, CTL_ZERO_BYTES, stream) != hipSuccess) return;
    if (hipMemsetAsync((char*)d_ws + WS_SSQ, 0, SSQ_BYTES, stream) != hipSuccess) return;
    Args a{};
    for (int i = 0; i < 28; ++i) a.in[i] = (const float*)d_in[i];
    a.out = (float*)d_out; a.ws = (unsigned char*)d_ws;
#if MK_ONE_LAUNCH
    a.ph_lo = 0; a.ph_hi = NPHASE;
    hipLaunchKernelGGL(mk_fwd, dim3(grid), dim3(NTHR), LDS_BYTES, stream, a);
#else
    for (int ph = 0; ph < NPHASE; ++ph) { a.ph_lo = ph; a.ph_hi = ph + 1; hipLaunchKernelGGL(mk_fwd, dim3(grid), dim3(NTHR), LDS_BYTES, stream, a); }
#endif
}
```

```cpp
#include <hip/hip_runtime.h>
#include <cstdio>
#include <cstdint>
namespace pg8 {
#define PG8_LAS __attribute__((address_space(3)))
typedef unsigned short bf16_t;
typedef short bf16x8 __attribute__((ext_vector_type(8)));
typedef float f32x4 __attribute__((ext_vector_type(4)));
typedef unsigned u32x4 __attribute__((ext_vector_type(4)));
constexpr int BM = 256, BK = 64, HALF = 128, HTB = HALF * BK * 2  , STAGE_BYTES = 8 * HTB, NXCD = 8, WGM = 8;

__host__ __device__ __forceinline__ int lds_byte(int r, int c) { const int st = (r >> 4) * 2 + (c >> 5), rr = r & 15, cc = c & 31, ob = rr * 64 + cc * 2; return st * 1024 + (ob ^ (((ob >> 9) & 1) << 5)); }
__host__ __device__ __forceinline__ void stage_rc(int b, int& R, int& C) { const int st = b / 1024, sb = b % 1024, swz = sb ^ (((sb >> 9) & 1) << 5); R = (st >> 1) * 16 + swz / 64; C = (st & 1) * 32 + (swz % 64) / 2; }
__host__ __device__ __forceinline__ int perm32(int rho) { const int n = rho >> 4, i = rho & 15; return 8 * (i >> 2) + 4 * n + (i & 3); }

struct Unit { int pm, pn; };
struct Gemm { const bf16_t* A; const bf16_t* Bt; int M, N, K; };

struct StaticOrder {
    int nM, nN, nwg, G, c;
    __host__ __device__ void init(int M, int N, int G_, int c_) { nM = M / BM; nN = N / BM; nwg = nM * nN; G = G_; c = c_; }
    __host__ __device__ bool next(int i, Unit& u) const {
        const long L = (long)i * G + c; if (L >= nwg) return false;
        int wgid = (int)L; { const int q = nwg / NXCD, r = nwg % NXCD, xcd = wgid % NXCD, off = wgid / NXCD; wgid = (xcd < r ? xcd * (q + 1) : r * (q + 1) + (xcd - r) * q) + off; }
        const int nig = WGM * nN, gid = wgid / nig, fm = gid * WGM, gsz = (nM - fm) < WGM ? (nM - fm) : WGM;
        u.pm = fm + ((wgid % nig) % gsz); u.pn = (wgid % nig) / gsz; return true;
    }
    __device__ __forceinline__ void a_ready(const Unit&) const {}
    __device__ __forceinline__ void done(const Unit&) const {}
};
__device__ __forceinline__ unsigned cvt_pk_bf16(float lo, float hi) { unsigned r; asm volatile("v_cvt_pk_bf16_f32 %0, %1, %2" : "=v"(r) : "v"(lo), "v"(hi)); return r; }
template <int ACT> struct EpiBf16 {
    static constexpr bool PERM = true, AFTER_DRAIN = false, HAS_PRE = true;
    bf16_t* O; int ldc; const unsigned long long* SS; PG8_LAS float* tbl;
    template <class Sched> __device__ __forceinline__ void pre_all(const Sched& S, int tid) const {
        unsigned long long v[12]; Unit u;
#pragma unroll
        for (int i = 0; i < 12; ++i) { v[i] = 0ull; if (S.next(i, u)) v[i] = SS[u.pm * BM + (tid & 255)]; }
#pragma unroll
        for (int i = 0; i < 12; ++i) if (tid < 256 && S.next(i, u)) tbl[i * 256 + tid] = 1.f / sqrtf((float)v[i] * (1.f / 1048576.f / 2048.f) + 1e-6f);
    }
    __device__ __forceinline__ void operator()(const f32x4 (&acc)[2][2][4][2], const Unit& u, int wr, int wc, int fr, int fq, int slot) const {
        const int row0 = u.pm * BM + wr * 64 + fr; const int col0 = u.pn * BM + wc * 64 + 8 * fq;
        const unsigned ta = (unsigned)(size_t)(tbl + slot * 256 + wr * 64 + fr);
        float rs[2][4];
#pragma unroll
        for (int ai = 0; ai < 2; ++ai)
#pragma unroll
            for (int m = 0; m < 4; ++m) asm volatile("ds_read_b32 %0, %1 offset:%2" : "=v"(rs[ai][m]) : "v"(ta), "i"((ai * HALF + m * 16) * 4));
        asm volatile("s_waitcnt lgkmcnt(0)" : "+v"(rs[0][0]), "+v"(rs[0][1]), "+v"(rs[0][2]), "+v"(rs[0][3]), "+v"(rs[1][0]), "+v"(rs[1][1]), "+v"(rs[1][2]), "+v"(rs[1][3]));
#pragma unroll
        for (int ai = 0; ai < 2; ++ai)
#pragma unroll
            for (int m = 0; m < 4; ++m) { bf16_t* rowp = O + (size_t)(row0 + ai * HALF + m * 16) * ldc + col0; const float r = rs[ai][m];
                if (ACT == 2) {
                    const size_t row = (size_t)(row0 + ai * HALF + m * 16);
                    rowp = (u.pn < 12) ? O + ((size_t)((u.pn >> 2) * 16 + (u.pn & 3) * 4 + wc) * ldc + row) * 64 + 8 * fq
                                       : O + (size_t)48 * ldc * 64 + row * 1536 + (u.pn - 12) * 256 + wc * 64 + 8 * fq; }
#pragma unroll
                for (int bj = 0; bj < 2; ++bj) { f32x4 v0 = acc[ai][bj][m][0] * r, v1 = acc[ai][bj][m][1] * r;
                    if (ACT == 1) {
#pragma unroll
                        for (int j = 0; j < 4; ++j) { const float a = fmaxf(v0[j], 0.f), b = fmaxf(v1[j], 0.f); v0[j] = a * a; v1[j] = b * b; } }
                    u32x4 w; w.x = cvt_pk_bf16(v0[0], v0[1]); w.y = cvt_pk_bf16(v0[2], v0[3]); w.z = cvt_pk_bf16(v1[0], v1[1]); w.w = cvt_pk_bf16(v1[2], v1[3]);
                    *(u32x4*)(rowp + bj * 32) = w; } }
    }
};
struct EpiResid {
    static constexpr bool PERM = true, AFTER_DRAIN = false, HAS_PRE = false;
    const float* Xin0; const float* Xin1; int split; float* Xout; int ldc; bf16_t* XB; unsigned long long* SS;
    __device__ __forceinline__ void operator()(const f32x4 (&acc)[2][2][4][2], const Unit& u, int wr, int wc, int fr, int fq, int) const {
        const int row0 = u.pm * BM + wr * 64 + fr, col0 = u.pn * BM + wc * 64 + 8 * fq;
        const float* Xin = (u.pm * BM < split) ? Xin0 : Xin1 - (size_t)split * ldc;
#pragma unroll
        for (int am = 0; am < 4; ++am) { const int ai = am >> 1, m0 = (am & 1) * 2;
            f32x4 xf[2][2][2]; u32x4 xr[2][2];
            if (Xin0) {
#pragma unroll
                for (int mm = 0; mm < 2; ++mm) { const size_t ro = (size_t)(row0 + ai * HALF + (m0 + mm) * 16) * ldc + col0;
#pragma unroll
                    for (int bj = 0; bj < 2; ++bj) { xf[mm][bj][0] = *(const f32x4*)(Xin + ro + bj * 32); xf[mm][bj][1] = *(const f32x4*)(Xin + ro + bj * 32 + 4); } }
            } else {
#pragma unroll
                for (int mm = 0; mm < 2; ++mm)
#pragma unroll
                    for (int bj = 0; bj < 2; ++bj) xr[mm][bj] = *(const u32x4*)(XB + (size_t)(row0 + ai * HALF + (m0 + mm) * 16) * ldc + col0 + bj * 32);
            }
            asm volatile("" ::: "memory");
#pragma unroll
            for (int mm = 0; mm < 2; ++mm) { const int m = m0 + mm; const int row = row0 + ai * HALF + m * 16; const size_t ro = (size_t)row * ldc + col0; float ss = 0.f;
#pragma unroll
                for (int bj = 0; bj < 2; ++bj) { f32x4 x0, x1;
                    if (Xin0) { x0 = xf[mm][bj][0]; x1 = xf[mm][bj][1]; }
                    else { const u32x4 w = xr[mm][bj];
                        x0 = (f32x4){__uint_as_float(w.x << 16), __uint_as_float(w.x & 0xffff0000u), __uint_as_float(w.y << 16), __uint_as_float(w.y & 0xffff0000u)};
                        x1 = (f32x4){__uint_as_float(w.z << 16), __uint_as_float(w.z & 0xffff0000u), __uint_as_float(w.w << 16), __uint_as_float(w.w & 0xffff0000u)}; }
                    x0 = x0 + acc[ai][bj][m][0]; x1 = x1 + acc[ai][bj][m][1];
                    if (Xout) { *(f32x4*)(Xout + ro + bj * 32) = x0; *(f32x4*)(Xout + ro + bj * 32 + 4) = x1; }
                    else { u32x4 w; w.x = cvt_pk_bf16(x0[0], x0[1]); w.y = cvt_pk_bf16(x0[2], x0[3]); w.z = cvt_pk_bf16(x1[0], x1[1]); w.w = cvt_pk_bf16(x1[2], x1[3]); *(u32x4*)(XB + ro + bj * 32) = w;
#pragma unroll
                        for (int j = 0; j < 4; ++j) { const float lo = __uint_as_float(w[j] << 16), hi = __uint_as_float(w[j] & 0xffff0000u); ss += lo * lo + hi * hi; } } }
                if (!Xout) { ss += __shfl_xor(ss, 16); ss += __shfl_xor(ss, 32); if (fq == 0) atomicAdd(SS + row, (unsigned long long)(ss * 1048576.f + 0.5f)); } }
            asm volatile("" ::: "memory");
        }
    }
};
struct EpiGlu {
    static constexpr bool PERM = true, AFTER_DRAIN = false, HAS_PRE = false;
    const bf16_t* YG; bf16_t* Y; const float* bias; int ldy; int ycol0;
    __device__ __forceinline__ void operator()(const f32x4 (&acc)[2][2][4][2], const Unit& u, int wr, int wc, int fr, int fq, int) const {
        const int row0 = u.pm * BM + wr * 64 + fr; const int col0 = u.pn * BM + wc * 64 + 8 * fq;
        f32x4 bb[2][2];
#pragma unroll
        for (int bj = 0; bj < 2; ++bj) { bb[bj][0] = *(const f32x4*)(bias + col0 + bj * 32); bb[bj][1] = *(const f32x4*)(bias + col0 + bj * 32 + 4); }
#pragma unroll
        for (int ai = 0; ai < 2; ++ai) {
            u32x4 gl[4][2];
#pragma unroll
            for (int m = 0; m < 4; ++m)
#pragma unroll
                for (int bj = 0; bj < 2; ++bj) gl[m][bj] = *(const u32x4*)(YG + (size_t)(row0 + ai * HALF + m * 16) * 512 + col0 + bj * 32);
            asm volatile("" ::: "memory");
#pragma unroll
            for (int m = 0; m < 4; ++m) { const int row = row0 + ai * HALF + m * 16;
#pragma unroll
                for (int bj = 0; bj < 2; ++bj) { const int col = col0 + bj * 32; const u32x4 g = gl[m][bj];
                    const f32x4 v0 = acc[ai][bj][m][0] + bb[bj][0], v1 = acc[ai][bj][m][1] + bb[bj][1];
                    float o[8];
#pragma unroll
                    for (int j = 0; j < 4; ++j) { const unsigned gw0 = g[j >> 1], gw1 = g[2 + (j >> 1)];
                        const float y0 = __uint_as_float((j & 1) ? (gw0 & 0xffff0000u) : (gw0 << 16)), y1 = __uint_as_float((j & 1) ? (gw1 & 0xffff0000u) : (gw1 << 16));
                        o[j] = y0 * __builtin_amdgcn_rcpf(1.f + __expf(-v0[j])); o[4 + j] = y1 * __builtin_amdgcn_rcpf(1.f + __expf(-v1[j])); }
                    u32x4 w; w.x = cvt_pk_bf16(o[0], o[1]); w.y = cvt_pk_bf16(o[2], o[3]); w.z = cvt_pk_bf16(o[4], o[5]); w.w = cvt_pk_bf16(o[6], o[7]);
                    *(u32x4*)(Y + (size_t)row * ldy + ycol0 + col) = w; } }
            asm volatile("" ::: "memory");
        }
    }
};

template <class Epi, class Sched, bool ALIGN_EPI = false, bool SP2 = false>
__device__ __forceinline__ void gemm_phase(PG8_LAS unsigned char* lds, const Gemm g, const Sched& S, const Epi& E) {
    int tid_ = threadIdx.x; asm volatile("" : "+v"(tid_));
    const int tid = tid_, wid = __builtin_amdgcn_readfirstlane(tid >> 6), lane = tid & 63, wr = wid >> 2, wc = wid & 3, fr = lane & 15, fq = lane >> 4;
    const int K = g.K, nt = K / BK;
    unsigned voffA[2], voffB[2];
#pragma unroll
    for (int i = 0; i < 2; ++i) { int R, C; stage_rc(tid * 16 + i * 8192, R, C); const int Rb = Epi::PERM ? (64 * (R >> 5) + perm32(R & 31)) : R;
        voffA[i] = (unsigned)(R * K + C) * 2u; voffB[i] = (unsigned)(Rb * K + C) * 2u; }
    const size_t kstep = (size_t)(BK * 2);
    const size_t hstep = (size_t)HALF * K * 2;
    const size_t hstepB = Epi::PERM ? (size_t)32 * K * 2 : hstep;
    const size_t tstep = 2 * hstep;
    const unsigned ldsw = (unsigned)wid * 1024u;
    const int aoff = lds_byte(wr * 64 + fr, fq * 8), boff = lds_byte(wc * 32 + fr, fq * 8);
#define PG8_SA(b, h) (((b) * 2 + (h)) * HTB)
#define PG8_SB(b, h) ((4 + (b) * 2 + (h)) * HTB)
#define PG8_STAGE(bufoff, gbase, voff) do { _Pragma("unroll") for (int _i = 0; _i < 2; ++_i) \
        __builtin_amdgcn_global_load_lds((const unsigned*)((const char*)(gbase) + (voff)[_i]), (PG8_LAS unsigned*)(lds + (bufoff) + ldsw + _i * 8192), 16, 0, 0); } while (0)
#define PG8_LDA(dst, b, h) do { _Pragma("unroll") for (int m = 0; m < 4; ++m) _Pragma("unroll") for (int k = 0; k < 2; ++k) dst[m][k] = *(const PG8_LAS bf16x8*)(lds + PG8_SA(b, h) + aoff + m * 2048 + k * 1024); } while (0)
#define PG8_LDB(dst, b, h) do { _Pragma("unroll") for (int n = 0; n < 2; ++n) _Pragma("unroll") for (int k = 0; k < 2; ++k) dst[n][k] = *(const PG8_LAS bf16x8*)(lds + PG8_SB(b, h) + boff + n * 2048 + k * 1024); } while (0)
#define PG8_MMA(ai, bj, At, Bt) do { __builtin_amdgcn_s_setprio(1); _Pragma("unroll") for (int m = 0; m < 4; ++m) _Pragma("unroll") for (int n = 0; n < 2; ++n) _Pragma("unroll") for (int k = 0; k < 2; ++k) \
        acc[ai][bj][m][n] = __builtin_amdgcn_mfma_f32_16x16x32_bf16(Bt[n][k], At[m][k], acc[ai][bj][m][n], 0, 0, 0); __builtin_amdgcn_s_setprio(0); } while (0)
#define PG8_WAIT_V(n) asm volatile("s_waitcnt vmcnt(" #n ")" ::: "memory")
#define PG8_WAIT_L(n) asm volatile("s_waitcnt lgkmcnt(" #n ")" ::: "memory")
#define PG8_BAR __builtin_amdgcn_s_barrier()
#define PG8_SCHED __builtin_amdgcn_sched_barrier(0)
    Unit cur, nxt; int ui = 0;
    if (!S.next(0, cur)) return;
    if constexpr (Epi::HAS_PRE) E.pre_all(S, tid);
    f32x4 acc[2][2][4][2];
#pragma unroll
    for (int a = 0; a < 2; ++a)
#pragma unroll
        for (int b = 0; b < 2; ++b)
#pragma unroll
            for (int m = 0; m < 4; ++m)
#pragma unroll
                for (int n = 0; n < 2; ++n) acc[a][b][m][n] = (f32x4){0.f, 0.f, 0.f, 0.f};
    bf16x8 At[4][2], B0[2][2], B1[2][2];
    const char* cA = (const char*)g.A + (size_t)cur.pm * tstep; const char* cB = (const char*)g.Bt + (size_t)cur.pn * tstep;
    S.a_ready(cur);
    if constexpr (SP2) {
        PG8_STAGE(PG8_SB(0, 0), cB, voffB); PG8_STAGE(PG8_SB(0, 1), cB + hstepB, voffB); PG8_STAGE(PG8_SA(0, 0), cA, voffA); PG8_STAGE(PG8_SA(0, 1), cA + hstep, voffA);
        if (wr == 1) PG8_BAR;
        PG8_WAIT_V(2); PG8_BAR;
        PG8_STAGE(PG8_SB(1, 0), cB + kstep, voffB); PG8_STAGE(PG8_SA(1, 0), cA + kstep, voffA); PG8_STAGE(PG8_SB(1, 1), cB + hstepB + kstep, voffB);
        PG8_WAIT_V(6); PG8_BAR;
    } else {
        PG8_STAGE(PG8_SB(0, 0), cB, voffB); PG8_STAGE(PG8_SA(0, 0), cA, voffA); PG8_STAGE(PG8_SB(0, 1), cB + hstepB, voffB); PG8_STAGE(PG8_SA(0, 1), cA + hstep, voffA);
        if (wr == 1) PG8_BAR;
        PG8_WAIT_V(4); PG8_BAR;
        PG8_STAGE(PG8_SB(1, 0), cB + kstep, voffB); PG8_STAGE(PG8_SA(1, 0), cA + kstep, voffA); PG8_STAGE(PG8_SB(1, 1), cB + hstepB + kstep, voffB);
        PG8_WAIT_V(6); PG8_BAR;
    }
    for (;;) {
        const bool has_next = S.next(ui + 1, nxt);
        const char* nA = has_next ? (const char*)g.A + (size_t)nxt.pm * tstep : cA; const char* nB = has_next ? (const char*)g.Bt + (size_t)nxt.pn * tstep : cB;
        for (int t = 0; t < nt; t += 2) {
            const bool last = (t == nt - 2);
            const char* a1 = cA + (size_t)(t + 1) * kstep;
            const char* a2 = last ? nA : cA + (size_t)(t + 2) * kstep; const char* b2 = last ? nB : cB + (size_t)(t + 2) * kstep;
            const char* a3 = a2 + kstep; const char* b3 = b2 + kstep;
            if (last && has_next) S.a_ready(nxt);
            if constexpr (SP2) {
            PG8_LDB(B0, 0, 0); PG8_LDB(B1, 0, 1); PG8_SCHED; PG8_LDA(At, 0, 0); PG8_STAGE(PG8_SA(1, 1), a1 + hstep, voffA);
            PG8_WAIT_V(8); PG8_WAIT_L(0); PG8_BAR; PG8_MMA(0, 0, At, B0); PG8_MMA(0, 1, At, B1); PG8_BAR; PG8_SCHED;
            PG8_LDA(At, 0, 1); PG8_STAGE(PG8_SB(0, 0), b2, voffB); PG8_STAGE(PG8_SB(0, 1), b2 + hstepB, voffB); PG8_STAGE(PG8_SA(0, 0), a2, voffA);
            PG8_WAIT_V(8); PG8_WAIT_L(0); PG8_BAR; PG8_MMA(1, 0, At, B0); PG8_MMA(1, 1, At, B1); PG8_BAR; PG8_SCHED;
            PG8_LDB(B0, 1, 0); PG8_LDB(B1, 1, 1); PG8_SCHED; PG8_LDA(At, 1, 0); PG8_STAGE(PG8_SA(0, 1), a2 + hstep, voffA);
            PG8_WAIT_V(8); PG8_WAIT_L(0); PG8_BAR; PG8_MMA(0, 0, At, B0); PG8_MMA(0, 1, At, B1); PG8_BAR; PG8_SCHED;
            PG8_LDA(At, 1, 1); PG8_STAGE(PG8_SB(1, 0), b3, voffB); PG8_STAGE(PG8_SB(1, 1), b3 + hstepB, voffB); PG8_STAGE(PG8_SA(1, 0), a3, voffA);
            PG8_WAIT_V(8); PG8_WAIT_L(0); PG8_BAR; PG8_MMA(1, 0, At, B0); PG8_MMA(1, 1, At, B1); PG8_BAR; PG8_SCHED;
            } else {
            PG8_LDB(B0, 0, 0); PG8_SCHED; PG8_LDA(At, 0, 0); PG8_STAGE(PG8_SA(1, 1), a1 + hstep, voffA);
            PG8_WAIT_L(8); PG8_BAR; PG8_WAIT_L(0); PG8_MMA(0, 0, At, B0); PG8_BAR; PG8_SCHED;
            PG8_LDB(B1, 0, 1); PG8_STAGE(PG8_SB(0, 0), b2, voffB);
            PG8_BAR; PG8_WAIT_L(0); PG8_MMA(0, 1, At, B1); PG8_BAR;
            PG8_LDA(At, 0, 1); PG8_STAGE(PG8_SA(0, 0), a2, voffA);
            PG8_BAR; PG8_WAIT_L(0); PG8_MMA(1, 0, At, B0); PG8_BAR; PG8_SCHED;
            PG8_STAGE(PG8_SB(0, 1), b2 + hstepB, voffB);
            PG8_WAIT_V(6); PG8_BAR; PG8_MMA(1, 1, At, B1); PG8_BAR;
            PG8_LDB(B0, 1, 0); PG8_SCHED; PG8_LDA(At, 1, 0); PG8_STAGE(PG8_SA(0, 1), a2 + hstep, voffA);
            PG8_WAIT_L(8); PG8_BAR; PG8_WAIT_L(0); PG8_MMA(0, 0, At, B0); PG8_BAR; PG8_SCHED;
            PG8_LDB(B1, 1, 1); PG8_STAGE(PG8_SB(1, 0), b3, voffB);
            PG8_BAR; PG8_WAIT_L(0); PG8_MMA(0, 1, At, B1); PG8_BAR;
            PG8_LDA(At, 1, 1); PG8_STAGE(PG8_SA(1, 0), a3, voffA);
            PG8_BAR; PG8_WAIT_L(0); PG8_MMA(1, 0, At, B0); PG8_BAR; PG8_SCHED;
            PG8_STAGE(PG8_SB(1, 1), b3 + hstepB, voffB);
            PG8_WAIT_V(6); PG8_BAR; PG8_MMA(1, 1, At, B1); PG8_BAR;
            }
        }
        if constexpr (ALIGN_EPI) { if (wr == 0) PG8_BAR; }
        if constexpr (!Epi::AFTER_DRAIN) { E(acc, cur, wr, wc, fr, fq, ui); S.done(cur); }
        if (!has_next) break;
#pragma unroll
        for (int a = 0; a < 2; ++a)
#pragma unroll
            for (int b = 0; b < 2; ++b)
#pragma unroll
                for (int m = 0; m < 4; ++m)
#pragma unroll
                    for (int n = 0; n < 2; ++n) acc[a][b][m][n] = (f32x4){0.f, 0.f, 0.f, 0.f};
        cur = nxt; cA = nA; cB = nB; ++ui;
        if constexpr (ALIGN_EPI) { if (wr == 1) PG8_BAR; }
    }
    PG8_WAIT_V(0);
    if constexpr (!ALIGN_EPI) { if (wr == 0) PG8_BAR; }
    PG8_BAR;
    if constexpr (Epi::AFTER_DRAIN) { E.fused(acc, cur, wr, wc, fr, fq, lds, wid, lane); S.done(cur); }
#undef PG8_SA
#undef PG8_SB
#undef PG8_STAGE
#undef PG8_LDA
#undef PG8_LDB
#undef PG8_MMA
#undef PG8_WAIT_V
#undef PG8_WAIT_L
#undef PG8_BAR
#undef PG8_SCHED
}
}

#ifndef MK_ONE_LAUNCH
#define MK_ONE_LAUNCH 1
#endif
#ifndef PROBE_GN2
#define PROBE_GN2 0
#endif
#ifndef PROBE_FIN2
#define PROBE_FIN2 0
#endif
#ifndef PROBE_CAR2
#define PROBE_CAR2 0
#endif
#ifndef PROBE_BAR2
#define PROBE_BAR2 0
#endif
#ifndef PROBE_WIN2
#define PROBE_WIN2 0
#endif
#ifndef PROBE_GLU2
#define PROBE_GLU2 0
#endif
#ifndef PROBE_WOUT2
#define PROBE_WOUT2 0
#endif
#ifndef PROBE_DN2
#define PROBE_DN2 0
#endif
#ifndef PROBE_UP2
#define PROBE_UP2 0
#endif
#ifndef PROBE_PRO2
#define PROBE_PRO2 0
#endif
#ifndef PROBE_NA2
#define PROBE_NA2 0
#endif
#ifndef PROBE_SCAN2
#define PROBE_SCAN2 0
#endif
constexpr int NWAVES = 8, NTHR = 512;
constexpr int DM = 2048, NTOK = 40960, ZW = 4608, DFF = 8192, DEPTH = 4;
constexpr int ZK = 1024, ZV = 2048, ZXR = 3072, ZGT = 3584, ZXS = 4096;
constexpr int MLPC = 8192, NMLPC = NTOK / MLPC;
constexpr int LCH = 32, NLCH = NTOK / LCH;
constexpr int SCH = 64, NSCH = NTOK / SCH;
constexpr float EPS = 1e-6f;
constexpr int PH_PER_LAYER = 14, NPHASE = DEPTH * PH_PER_LAYER + 1;

constexpr size_t MiB = 1u << 20;
constexpr size_t WS_CTL = 0, CTL_ZERO_BYTES = 2 * MiB;
constexpr size_t WS_SS = 65536;
constexpr size_t WS_WIN = 2 * MiB, WS_WOUT = 20 * MiB, WS_WUP = 28 * MiB, WS_WDN = 60 * MiB, WS_WGLU = 92 * MiB;
constexpr size_t WS_TLB = 93 * MiB;
constexpr size_t WS_TBB = 93 * MiB + 65536;
constexpr size_t WS_H = 96 * MiB;
constexpr size_t WS_ZR = 256 * MiB + (size_t)48 * NTOK * 64 * 2;
constexpr int ZRW = 1536, RXR = 0, RGT = 512, RXS = 1024;
constexpr size_t WS_Z = 256 * MiB;
constexpr size_t WS_Y = 616 * MiB;
constexpr size_t WS_YG = 776 * MiB;
constexpr size_t WS_HF = 816 * MiB;
constexpr size_t WS_TBBF = 94 * MiB;
constexpr size_t WS_TCF = 94 * MiB + 524288;
constexpr size_t WS_TWF = 95 * MiB;
constexpr size_t WS_LAGG = 896 * MiB;
constexpr size_t WS_LCIN = 906 * MiB;
constexpr size_t WS_SEND = 912 * MiB;
constexpr size_t WS_SCIN = 932 * MiB;
constexpr size_t WS_SSQ = 952 * MiB, SSQ_BYTES = (size_t)DEPTH * 2 * NTOK * 8;
constexpr size_t WS_END = 956 * MiB;
constexpr int CW_BAR = 4096;

constexpr int RING_OFF = 0, RING_BYTES = 131072;
constexpr int XTRA_OFF = RING_BYTES, XTRA_BYTES = 12288;
constexpr int LDSCTL_OFF = 163840 - 1024, MISC_OFF = LDSCTL_OFF + 320;
constexpr int LDS_BYTES = 163840;
static_assert(MISC_OFF + 128 <= LDS_BYTES, "LDS map");

#define GAS __attribute__((address_space(1)))
#define LAS __attribute__((address_space(3)))
typedef unsigned short bf16;
typedef unsigned v4u __attribute__((ext_vector_type(4)));
typedef unsigned v2u __attribute__((ext_vector_type(2)));
typedef float f32x4 __attribute__((ext_vector_type(4)));
typedef float f32x2 __attribute__((ext_vector_type(2)));
#define LDS_WAIT() asm volatile("s_waitcnt lgkmcnt(0)" ::: "memory")
#define VM_WAIT() asm volatile("s_waitcnt vmcnt(0)" ::: "memory")
__device__ __forceinline__ unsigned f2bf(float f) { unsigned u = __builtin_bit_cast(unsigned, f); return (u + 0x7fffu + ((u >> 16) & 1u)) >> 16; }
typedef __bf16 bf16x2_t __attribute__((ext_vector_type(2)));
__device__ __forceinline__ unsigned pk2(float lo, float hi) { const f32x2 v = {lo, hi}; return __builtin_bit_cast(unsigned, __builtin_convertvector(v, bf16x2_t)); }
__device__ __forceinline__ unsigned pk2s(float lo, float hi) { return f2bf(lo) | (f2bf(hi) << 16); }
__device__ __forceinline__ float frcp(float x) { return __builtin_amdgcn_rcpf(x); }
__device__ __forceinline__ float fsqrt_(float x) { return __builtin_amdgcn_sqrtf(x); }
__device__ __forceinline__ float bf2f(unsigned b) { return __builtin_bit_cast(float, b << 16); }
__device__ __forceinline__ float bflo(unsigned w) { return __builtin_bit_cast(float, w << 16); }
__device__ __forceinline__ float bfhi(unsigned w) { return __builtin_bit_cast(float, w & 0xffff0000u); }
__device__ __forceinline__ float wave_sum(float v) {
#pragma unroll
    for (int o = 1; o < 64; o <<= 1) v += __shfl_xor(v, o);
    return v;
}
__device__ __forceinline__ float wave_max(float v) {
#pragma unroll
    for (int o = 1; o < 64; o <<= 1) v = fmaxf(v, __shfl_xor(v, o));
    return v;
}
__device__ __forceinline__ float sigmoidf_(float x) { return frcp(1.f + __expf(-x)); }
__device__ __forceinline__ float gelu_tanh(float x) { const float y = 0.7978845608028654f * (x + 0.044715f * x * x * x); const float e = __expf(2.f * y); return x - x * frcp(e + 1.f); }
__device__ __forceinline__ void seq_of(int tok, int& s0, int& T) { if (tok < 8192) { s0 = tok & ~2047; T = 2048; } else { s0 = 8192 + ((tok - 8192) & ~16383); T = 16384; } }

#define XB_TMO      128
#define XB_XCNT(j)  (256  + 64 * (j))
#define XB_XSUB(j)  (1280 + 64 * (j))
#define XB_XGEN(j)  (2304 + 64 * (j))
#define XB_TOP      3328
#define XB_TOPGEN   3392
#define XCD_BAR_WORDS 3456
#define XB_SPIN_CAP (1u << 18)

__device__ __forceinline__ unsigned xb_ld(unsigned* p)              { return __hip_atomic_load(p, __ATOMIC_RELAXED, __HIP_MEMORY_SCOPE_AGENT); }
__device__ __forceinline__ unsigned xb_add(unsigned* p, unsigned v) { return __hip_atomic_fetch_add(p, v, __ATOMIC_RELAXED, __HIP_MEMORY_SCOPE_AGENT); }
__device__ __forceinline__ unsigned xb_xcc_id() { return (unsigned)__builtin_amdgcn_s_getreg((3 << 11) | 20) & 0xFu; }
#define XB_SPIN(cond, bar) do { unsigned _sp = 0; while (cond) { __builtin_amdgcn_s_sleep(1); \
    if ((++_sp & 255u) == 0u) { if (xb_ld(&(bar)[XB_TMO])) break; if (_sp > XB_SPIN_CAP) { atomicAdd(&(bar)[XB_TMO], 1u); break; } } } } while (0)

struct XcdBarrier {
    unsigned* bar; unsigned x;
    volatile LAS unsigned* st;
};

__device__ __forceinline__ XcdBarrier xcd_barrier_post(unsigned* bar, volatile LAS unsigned* st) {
    XcdBarrier b; b.bar = bar; b.x = xb_xcc_id(); b.st = st;
    if (threadIdx.x == 0) (void)xb_add(&bar[XB_XCNT(b.x)], 1u);
    return b;
}
__device__ __forceinline__ void xcd_barrier_complete(unsigned* bar, unsigned x, unsigned& nloc, unsigned& nx) {
    const unsigned G = gridDim.x * gridDim.y * gridDim.z;
    unsigned sum, cnt, mine, sp = 0u;
    for (;;) {
        sum = 0u; cnt = 0u; mine = 0u;
#pragma unroll
        for (unsigned j = 0; j < 16; ++j) { const unsigned c = xb_ld(&bar[XB_XCNT(j)]); sum += c; cnt += (c > 0u) ? 1u : 0u; mine = (j == x) ? c : mine; }
        if (sum == G) break;
        __builtin_amdgcn_s_sleep(1);
        if ((++sp & 255u) == 0u) { if (xb_ld(&bar[XB_TMO])) break; if (sp > XB_SPIN_CAP) { atomicAdd(&bar[XB_TMO], 1u); break; } }
    }
    nloc = mine > 0u ? mine : 1u; nx = cnt > 0u ? cnt : 1u;
}

__device__ __forceinline__ void xcd_barrier(const XcdBarrier& b) {
    asm volatile("s_waitcnt vmcnt(0)" ::: "memory");
    __syncthreads();
    if (threadIdx.x == 0) {
        unsigned* bar = b.bar;
        __builtin_amdgcn_s_waitcnt(0);
        unsigned nloc = b.st[0], nx = b.st[1];
        if (nloc == 0u) { xcd_barrier_complete(bar, b.x, nloc, nx); b.st[0] = nloc; b.st[1] = nx; }
        const unsigned old = xb_add(&bar[XB_XSUB(b.x)], 1u);
        const unsigned gen = old / nloc;
        if (old + 1u == (gen + 1u) * nloc) {
            __builtin_amdgcn_fence(__ATOMIC_RELEASE, "agent");
            asm volatile("s_waitcnt vmcnt(0)" ::: "memory");
            const unsigned og = xb_add(&bar[XB_TOP], 1u);
            const unsigned tg = og / nx;
            if (og + 1u == (tg + 1u) * nx) xb_add(&bar[XB_TOPGEN], 1u);
            else XB_SPIN(xb_ld(&bar[XB_TOPGEN]) == tg, bar);
            __builtin_amdgcn_fence(__ATOMIC_ACQUIRE, "agent");
            xb_add(&bar[XB_XGEN(b.x)], 1u);
            asm volatile("s_waitcnt vmcnt(0)" ::: "memory");
        } else {
            XB_SPIN(xb_ld(&bar[XB_XGEN(b.x)]) == gen, bar);
            __builtin_amdgcn_fence(__ATOMIC_ACQUIRE, "agent");
            asm volatile("s_waitcnt vmcnt(0)" ::: "memory");
        }
    }
    __syncthreads();
}


struct Args { const float* in[28]; float* out; unsigned char* ws; int ph_lo, ph_hi; };
struct Frame {
    LAS unsigned char* lds; unsigned char* ldsg;
    int tid, lane, wave, vcu, G;
};
enum { I_XP = 0, I_XS, I_NMG, I_WIN, I_RPB, I_CW, I_CB, I_LWA, I_LBA, I_LWX, I_LBX, I_LAM, I_ARE, I_AIM, I_LDT, I_BRE, I_BIM, I_CRE, I_CIM, I_SD, I_WGLU, I_BGLU, I_GOUT, I_WOUT, I_NLG, I_WUP, I_WDN, I_FING };

__device__ __forceinline__ void transpose_item(const float* W, int K, int N, bf16* WT, LAS float* scr, int item, int lane, const float* gk) {
    const int nblk = N / 32, kb = item / nblk, nb = item % nblk, k0 = 64 * kb, n0 = 32 * nb;
    float wv[32];
#pragma unroll
    for (int i = 0; i < 32; ++i) wv[i] = W[(size_t)(k0 + 2 * i + (lane >> 5)) * N + n0 + (lane & 31)];
    if (gk) {
#pragma unroll
        for (int i = 0; i < 32; ++i) wv[i] *= gk[k0 + 2 * i + (lane >> 5)]; }
#pragma unroll
    for (int i = 0; i < 32; ++i) scr[(2 * i + (lane >> 5)) * 33 + (lane & 31)] = wv[i];
    LDS_WAIT();
    const int c = lane & 7;
#pragma unroll
    for (int j = 0; j < 4; ++j) { const int n = (lane >> 3) + 8 * j; const LAS float* s = scr + (8 * c) * 33 + n;
        v4u o; o.x = pk2(s[0 * 33], s[1 * 33]); o.y = pk2(s[2 * 33], s[3 * 33]); o.z = pk2(s[4 * 33], s[5 * 33]); o.w = pk2(s[6 * 33], s[7 * 33]);
        *(v4u*)(WT + (size_t)(n0 + n) * K + k0 + 8 * c) = o; }
    LDS_WAIT();
}

__device__ __forceinline__ void xb_row(const float* xrow, bf16* orow, unsigned long long* ss, int lane) {
    const f32x4* xr = (const f32x4*)xrow + lane; f32x4 v[8]; float s = 0.f;
#pragma unroll
    for (int j = 0; j < 8; ++j) { v[j] = xr[64 * j]; s += (v[j].x * v[j].x + v[j].y * v[j].y) + (v[j].z * v[j].z + v[j].w * v[j].w); }
    s = wave_sum(s); if (lane == 0) *ss = (unsigned long long)(s * 1048576.f + 0.5f);
    v2u* o8 = (v2u*)orow + lane;
#pragma unroll
    for (int j = 0; j < 8; ++j) { v2u o; o.x = pk2(v[j].x, v[j].y); o.y = pk2(v[j].z, v[j].w); o8[64 * j] = o; }
}

__device__ __forceinline__ void norm_row_bf16(const float* xrow, const float* g, bf16* orow, int lane) {
    const f32x4* xr = (const f32x4*)xrow + lane; const f32x4* gr = (const f32x4*)g + lane;
    f32x4 v[8]; float s = 0.f;
#pragma unroll
    for (int j = 0; j < 8; ++j) { v[j] = xr[64 * j]; s += (v[j].x * v[j].x + v[j].y * v[j].y) + (v[j].z * v[j].z + v[j].w * v[j].w); }
    const float rstd = 1.f / sqrtf(wave_sum(s) * (1.f / DM) + EPS);
    v2u* o8 = (v2u*)orow + lane;
#pragma unroll
    for (int j = 0; j < 8; ++j) { const f32x4 gg = gr[64 * j]; v2u o; o.x = pk2(v[j].x * rstd * gg.x, v[j].y * rstd * gg.y); o.y = pk2(v[j].z * rstd * gg.z, v[j].w * rstd * gg.w); o8[64 * j] = o; }
}
__device__ __forceinline__ const float* x_row(const Args& a, int l, int row) {
    if (l == 0) return row < 8192 ? a.in[I_XP] + (size_t)row * DM : a.in[I_XS] + (size_t)(row - 8192) * DM;
    return a.out + (size_t)row * DM;
}

__device__ __forceinline__ void ph_prologue(const Args& a, const Frame& F, int l) {
    int tid = threadIdx.x; asm volatile("" : "+v"(tid)); int lane = tid & 63; (void)lane;
    LAS float* scr = (LAS float*)(F.lds + RING_OFF + F.wave * 16384);
    const int gw = F.vcu * NWAVES + F.wave, NGW = F.G * NWAVES;
    constexpr int I_IN = (DM / 64) * (ZW / 32), I_OUT = (DM / 64) * (DM / 32), I_UP = (DM / 64) * (DFF / 32), I_DN = (DFF / 64) * (DM / 32), I_GL = (512 / 64) * (512 / 32);
    constexpr int NITEMS = I_IN + I_OUT + I_UP + I_DN + I_GL;
    unsigned char* ws = a.ws;
    for (int it = gw; it < NITEMS; it += NGW) {
        int r = it;
        if (r < I_IN) { transpose_item(a.in[I_WIN] + (size_t)l * DM * ZW, DM, ZW, (bf16*)(ws + WS_WIN), scr, r, lane, a.in[I_NMG] + (size_t)l * DM); continue; } r -= I_IN;
        if (r < I_OUT) { transpose_item(a.in[I_WOUT] + (size_t)l * DM * DM, DM, DM, (bf16*)(ws + WS_WOUT), scr, r, lane, nullptr); continue; } r -= I_OUT;
        if (r < I_UP) { transpose_item(a.in[I_WUP] + (size_t)l * DM * DFF, DM, DFF, (bf16*)(ws + WS_WUP), scr, r, lane, a.in[I_NLG] + (size_t)l * DM); continue; } r -= I_UP;
        if (r < I_DN) { transpose_item(a.in[I_WDN] + (size_t)l * DFF * DM, DFF, DM, (bf16*)(ws + WS_WDN), scr, r, lane, nullptr); continue; } r -= I_DN;
        transpose_item(a.in[I_WGLU] + (size_t)l * 512 * 512, 512, 512, (bf16*)(ws + WS_WGLU), scr, r, lane, nullptr);
    }
    { const int gt = F.vcu * NTHR + tid;
      if (gt < 4096) {
        const int dir = gt >> 11, g = (gt >> 6) & 31, p = gt & 63; const size_t ix = ((size_t)(l * 2 + dir) * 32 + g) * 64 + p;
        const double are = (double)a.in[I_ARE][ix], aim = (double)a.in[I_AIM][ix]; const double ldt = (double)a.in[I_LDT][(l * 2 + dir) * 32 + g];
        double e = 1.0; { const double x8 = ldt * 0.125; for (int n = 20; n >= 1; --n) e = 1.0 + e * x8 / (double)n; e = e * e; e = e * e; e = e * e; }
        const double dt = e;
        double mag = 1.0; { const double x = are * dt; for (int n = 14; n >= 1; --n) mag = 1.0 + mag * x / (double)n; }
        const double th = aim * dt; const double kq = __builtin_rint(th * 0.15915494309189535); const double r = th - kq * 6.283185307179586476925;
        const double r2 = r * r; double c = 1.0, s = 1.0;
        for (int n = 15; n >= 1; --n) { c = 1.0 - c * r2 / (double)((2 * n - 1) * (2 * n)); s = 1.0 - s * r2 / (double)((2 * n) * (2 * n + 1)); }
        s *= r;
        const double lbr = mag * c, lbi = mag * s, den = are * are + aim * aim, nre = lbr - 1.0, nim = lbi;
        const double cor = (nre * are + nim * aim) / den, coi = (nim * are - nre * aim) / den;
        float* tlb = (float*)(ws + WS_TLB) + (size_t)gt * 2; tlb[0] = (float)lbr; tlb[1] = (float)lbi;
        float* tbb = (float*)(ws + WS_TBB) + (size_t)gt * 32; const float* bre = a.in[I_BRE] + ix * 16; const float* bim = a.in[I_BIM] + ix * 16;
        bf16* bbf = (bf16*)(ws + WS_TBBF);
        for (int h = 0; h < 16; ++h) { const double br = (double)bre[h], bi = (double)bim[h]; const float vr = (float)(cor * br - coi * bi), vi = (float)(cor * bi + coi * br); tbb[h] = vr; tbb[16 + h] = vi;
            const int n = p & 15, gk0 = h >> 3, j = h & 7;
            const unsigned hr = f2bf(vr), hi_ = f2bf(vi); const unsigned lr = f2bf(vr - bf2f(hr)), li = f2bf(vi - bf2f(hi_));
            const size_t fr = ((size_t)((dir * 32 + g) * 8 + (p >> 4)) * 64) * 8, fi = ((size_t)((dir * 32 + g) * 8 + 4 + (p >> 4)) * 64) * 8;
            bbf[fr + (size_t)(n + 16 * gk0) * 8 + j] = (bf16)hr; bbf[fr + (size_t)(n + 16 * (gk0 + 2)) * 8 + j] = (bf16)lr;
            bbf[fi + (size_t)(n + 16 * gk0) * 8 + j] = (bf16)hi_; bbf[fi + (size_t)(n + 16 * (gk0 + 2)) * 8 + j] = (bf16)li; }
      } else if (gt < 4096 + 16384) {
        const int e = gt - 4096, lane_ = e & 63, ks = (e >> 6) & 3, g = (e >> 8) & 31, dir = e >> 13; const int h = lane_ & 15, gk = lane_ >> 4;
        const float* cre = a.in[I_CRE] + (((size_t)(l * 2 + dir) * 32 + g) * 16 + h) * 64; const float* cim = a.in[I_CIM] + (((size_t)(l * 2 + dir) * 32 + g) * 16 + h) * 64;
        bf16* cf = (bf16*)(ws + WS_TCF) + (size_t)e * 8;
        for (int j = 0; j < 8; ++j) { const int P = 16 * (j >> 1) + 4 * ks + gk; cf[j] = (bf16)f2bf((j & 1) ? -cim[P] : cre[P]); }
      } else if (gt >= 20480 && gt < 20480 + 16384) {
        const int e = gt - 20480, lane_ = e & 63, ks = (e >> 6) & 1, cb = (e >> 7) & 3, mat = (e >> 9) & 1, nb = (e >> 10) & 7, dir = e >> 13; const int n = lane_ & 15, gk = lane_ >> 4;
        const float* W = a.in[mat ? I_LWX : I_LWA] + ((size_t)(l * 2 + dir) * 8 + nb) * 4096 + (size_t)(32 * ks + 8 * gk) * 64 + 16 * cb + n;
        bf16* wf = (bf16*)(ws + WS_TWF) + (size_t)e * 8;
        for (int j = 0; j < 8; ++j) wf[j] = (bf16)f2bf(W[j * 64]);
      } }
    if (l == 0) { bf16* XB = (bf16*)(ws + WS_H); unsigned long long* SS = (unsigned long long*)(ws + WS_SSQ);
        for (int m = gw; m < NTOK; m += NGW) xb_row(x_row(a, 0, m), XB + (size_t)m * DM, SS + m, lane); }
}

__device__ __forceinline__ void ph_na_simple(const Args& a, const Frame& F, int l) {
    int tid = threadIdx.x; asm volatile("" : "+v"(tid)); int lane = tid & 63; (void)lane;
    const bf16* Z = (const bf16*)(a.ws + WS_Z); bf16* Y = (bf16*)(a.ws + WS_Y);
    const float* rpb = a.in[I_RPB] + (size_t)l * 16 * 15 * 31;
    float* qs = (float*)(F.ldsg + RING_OFF) + F.wave * 64;
    const long U = (long)NTOK * 16; const long u0 = U * F.vcu / F.G, u1 = U * (F.vcu + 1) / F.G;
    for (long u = u0 + F.wave; u < u1; u += NWAVES) {
        const int tok = (int)(u >> 4), h = (int)(u & 15);
        int s0, T; seq_of(tok, s0, T); const int pos = tok - s0, r = pos >> 6, c = pos & 63, R = T >> 6;
        const int rs = min(max(r - 4, 0), R - 8), cs = min(max(c - 8, 0), 48);
        LDS_WAIT();
        qs[lane] = bf2f(Z[(size_t)tok * ZW + h * 64 + lane]);
        LDS_WAIT();
        float sc[2];
#pragma unroll
        for (int i = 0; i < 2; ++i) {
            const int kk = lane + 64 * i, krow = rs + (kk >> 4), kcol = cs + (kk & 15); const int ktok = s0 + krow * 64 + kcol;
            const v4u* kp = (const v4u*)(Z + (size_t)ktok * ZW + ZK + h * 64);
            float d = 0.f;
#pragma unroll
            for (int j = 0; j < 8; ++j) { const v4u w = kp[j]; const f32x4 q0 = *(const f32x4*)(qs + 8 * j), q1 = *(const f32x4*)(qs + 8 * j + 4);
                d += bflo(w.x) * q0.x + bfhi(w.x) * q0.y + bflo(w.y) * q0.z + bfhi(w.y) * q0.w + bflo(w.z) * q1.x + bfhi(w.z) * q1.y + bflo(w.w) * q1.z + bfhi(w.w) * q1.w; }
            sc[i] = d * 0.125f + rpb[(h * 15 + (krow - r + 7)) * 31 + (kcol - c + 15)];
        }
        const float m = wave_max(fmaxf(sc[0], sc[1])); const float p0 = __expf(sc[0] - m), p1 = __expf(sc[1] - m); const float sum = wave_sum(p0 + p1);
        float acc = 0.f;
        for (int kk = 0; kk < 128; ++kk) {
            const float p = __shfl(kk < 64 ? p0 : p1, kk & 63);
            const int krow = rs + (kk >> 4), kcol = cs + (kk & 15); const int vtok = s0 + krow * 64 + kcol;
            acc += p * bf2f(Z[(size_t)vtok * ZW + ZV + h * 64 + lane]);
        }
        Y[(size_t)tok * DM + h * 64 + lane] = (bf16)f2bf(acc / sum);
    }
}

typedef short s16x4_t __attribute__((ext_vector_type(4)));
__device__ __forceinline__ pg8::bf16x8 v_tr_pair(const LAS unsigned char* p) {
    const s16x4_t lo = __builtin_amdgcn_ds_read_tr16_b64_v4i16((LAS s16x4_t*)p), hi = __builtin_amdgcn_ds_read_tr16_b64_v4i16((LAS s16x4_t*)(p + 512));
    return __builtin_shufflevector(lo, hi, 0, 1, 2, 3, 4, 5, 6, 7);
}
__device__ __forceinline__ void glds16_asm(const void* gsrc, unsigned lds_dst) {
    unsigned keep;
    asm volatile("s_mov_b32 %0, m0\n\ts_mov_b32 m0, %2\n\ts_nop 0\n\tglobal_load_lds_dwordx4 %1, off\n\ts_mov_b32 m0, %0" : "=&s"(keep) : "v"(gsrc), "s"(lds_dst) : "memory");
}
__device__ __forceinline__ void ph_na_mfma(const Args& a, const Frame& F, int l) {
    int tid = threadIdx.x; asm volatile("" : "+v"(tid)); int lane = tid & 63; (void)lane;
    const bf16* Z = (const bf16*)(a.ws + WS_Z); bf16* Y = (bf16*)(a.ws + WS_Y);
    constexpr int KR = 0, VR = 73728, BIAS = 147456, MRG = 149504;
    LAS unsigned char* L = F.lds;
    const int w = F.wave, qt = w & 3, half = w >> 2, q = lane & 15, g = lane >> 4;
    const int c0 = 16 * qt, kc0 = (qt == 0) ? 0 : (qt == 1 ? 8 : (qt == 2 ? 24 : 32)), c = c0 + q, cs = min(max(c - 8, 0), 48);
    const int NIT = (NTOK / 64) * 16; const int i0 = (int)((long)NIT * F.vcu / F.G), i1 = (int)((long)NIT * (F.vcu + 1) / F.G);
#define NA_ITEM(it_, s0_, R_, h_, r_) do { if ((it_) < 2048) { const int _col = (it_) >> 5; r_ = (it_) & 31; R_ = 32; s0_ = (_col >> 4) * 2048; h_ = _col & 15; } \
        else { const int _j = (it_) - 2048, _col = _j >> 8; r_ = _j & 255; R_ = 256; s0_ = 8192 + (_col >> 4) * 16384; h_ = _col & 15; } } while (0)
#define NA_SWZ(col_) (((((col_) >> 3) & 3) << 1) | (((col_) >> 1) & 1))
#define NA_ROW_DMA(zoff_, row_, slotbase_) do { \
        _Pragma("unroll") for (int _j = 0; _j < 2; ++_j) { const int _col = c0 + 8 * _j + (lane >> 3); \
            const bf16* _gp = Z + ((size_t)((zoff_) / 64 + h) * NTOK + (s0 + (row_) * 64 + _col)) * 64 + (((lane & 7) ^ NA_SWZ(_col)) * 8); \
            glds16_asm(_gp, (unsigned)(size_t)(L + (slotbase_) + (c0 + 8 * _j) * 128)); } } while (0)
#define NA_BAR() asm volatile("s_barrier" ::: "memory")
    pg8::bf16x8 qn0, qn1;
    { int s0, R, h, r; NA_ITEM(i0, s0, R, h, r); const bf16* qp = Z + ((size_t)h * NTOK + (s0 + r * 64 + c)) * 64 + 8 * g; qn0 = *(const pg8::bf16x8*)qp; qn1 = *(const pg8::bf16x8*)(qp + 32); }
    v2u st0, st1, st2, st3; bf16* stp = Y;
    st0 = st1 = st2 = st3 = (v2u){0u, 0u};
    int it = i0;
    while (it < i1) {
        int s0, R, h, r0; NA_ITEM(it, s0, R, h, r0);
        const int m = min(R - r0, i1 - it);
        {
            const int rs = min(max(r0 - 4, 0), R - 8);
#pragma unroll
            for (int i = 0; i < 16; ++i) { const int id = w * 16 + i, t = id >> 6, ri = (id >> 3) & 7, j8 = id & 7, row = rs + ri;
                const int colw = 8 * j8 + (lane >> 3);
                const bf16* gp = Z + ((size_t)((t ? 32 : 16) + h) * NTOK + (s0 + row * 64 + colw)) * 64 + (((lane & 7) ^ NA_SWZ(colw)) * 8);
                glds16_asm(gp, (unsigned)(size_t)(L + (t ? VR : KR) + (row % 9) * 8192 + j8 * 1024)); }
            if (tid < 465) ((LAS float*)(L + BIAS))[tid] = a.in[I_RPB][((size_t)l * 16 + h) * 465 + tid];
            VM_WAIT(); LDS_WAIT();
            __syncthreads();
        }
        if (half == 1) NA_BAR();
        for (int j = 0; j < m; ++j) {
            const int r = r0 + j, rs = min(max(r - 4, 0), R - 8);
            pg8::bf16x8 qf0 = qn0, qf1 = qn1;
            asm volatile("" : "+v"(qf0), "+v"(qf1) :: "memory");
            if (half == 1 && j > 0) { *(v2u*)(stp) = st0; *(v2u*)(stp + 16) = st1; *(v2u*)(stp + 32) = st2; *(v2u*)(stp + 48) = st3; }
            if (it + j + 1 < i1) {
                int s0n, Rn, hn, rn; NA_ITEM(it + j + 1, s0n, Rn, hn, rn);
                if (half == 0 && j + 1 < m) { const int rsn = min(max(rn - 4, 0), Rn - 8); if (rsn > rs) { NA_ROW_DMA(ZK, rsn + 7, KR + ((rsn + 7) % 9) * 8192); NA_ROW_DMA(ZV, rsn + 7, VR + ((rsn + 7) % 9) * 8192); } }
                const bf16* qp = Z + ((size_t)hn * NTOK + (s0n + rn * 64 + c)) * 64 + 8 * g; qn0 = *(const pg8::bf16x8*)qp; qn1 = *(const pg8::bf16x8*)(qp + 32);
            }
            const int tokrow0 = s0 + r * 64;
            f32x4 sc[4][2];
            pg8::bf16x8 kf[4][2][2];
#pragma unroll
            for (int kk = 0; kk < 4; ++kk) { const int row = rs + 4 * half + kk; const LAS unsigned char* kb = L + KR + (row % 9) * 8192;
#pragma unroll
                for (int blk = 0; blk < 2; ++blk) { const int col = kc0 + 8 * (q >> 2) + 4 * blk + (q & 3); const int sw = NA_SWZ(col);
                    kf[kk][blk][0] = *(const LAS pg8::bf16x8*)(kb + col * 128 + ((g ^ sw) * 16)); kf[kk][blk][1] = *(const LAS pg8::bf16x8*)(kb + col * 128 + (((4 + g) ^ sw) * 16)); } }
            const LAS float* bh = (const LAS float*)(L + BIAS) + (rs + 4 * half - r + 7) * 31;
            float bv[4][2][4];
#pragma unroll
            for (int blk = 0; blk < 2; ++blk)
#pragma unroll
                for (int rg = 0; rg < 4; ++rg) { const int dc = min(max(kc0 + 8 * g + 4 * blk + rg - c + 15, 0), 30);
#pragma unroll
                    for (int kk = 0; kk < 4; ++kk) bv[kk][blk][rg] = bh[kk * 31 + dc]; }
            __builtin_amdgcn_sched_barrier(0);
#pragma unroll
            for (int kk = 0; kk < 4; ++kk)
#pragma unroll
                for (int blk = 0; blk < 2; ++blk) sc[kk][blk] = __builtin_amdgcn_mfma_f32_16x16x32_bf16(kf[kk][blk][0], qf0, (f32x4){0.f, 0.f, 0.f, 0.f}, 0, 0, 0);
#pragma unroll
            for (int kk = 0; kk < 4; ++kk)
#pragma unroll
                for (int blk = 0; blk < 2; ++blk) sc[kk][blk] = __builtin_amdgcn_mfma_f32_16x16x32_bf16(kf[kk][blk][1], qf1, sc[kk][blk], 0, 0, 0);
            __builtin_amdgcn_sched_barrier(0);
            float mx = -INFINITY;
#pragma unroll
            for (int kk = 0; kk < 4; ++kk)
#pragma unroll
                for (int blk = 0; blk < 2; ++blk)
#pragma unroll
                    for (int rg = 0; rg < 4; ++rg) { const int col = kc0 + 8 * g + 4 * blk + rg; const bool valid = (unsigned)(col - cs) < 16u;
                        const float s = valid ? sc[kk][blk][rg] * 0.125f + bv[kk][blk][rg] : -INFINITY; sc[kk][blk][rg] = s; mx = fmaxf(mx, s); }
            mx = fmaxf(mx, __shfl_xor(mx, 16)); mx = fmaxf(mx, __shfl_xor(mx, 32));
            LDS_WAIT();
            __syncthreads();
            pg8::bf16x8 vfr[4][4];
#pragma unroll
            for (int kk = 0; kk < 4; ++kk) { const int row = rs + 4 * half + kk;
                const int colv = kc0 + 8 * g + ((lane & 15) >> 2), sw0 = NA_SWZ(colv), sw1 = NA_SWZ(colv + 4), pq = lane & 3;
                const LAS unsigned char* vb0 = L + VR + (row % 9) * 8192 + colv * 128 + (pq & 1) * 8; const LAS unsigned char* vb1 = vb0 + 512;
#pragma unroll
                for (int db = 0; db < 4; ++db) { const int ch = 2 * db + (pq >> 1);
                    const s16x4_t lo = __builtin_amdgcn_ds_read_tr16_b64_v4i16((LAS s16x4_t*)(vb0 + ((ch ^ sw0) * 16))), hi = __builtin_amdgcn_ds_read_tr16_b64_v4i16((LAS s16x4_t*)(vb1 + ((ch ^ sw1) * 16)));
                    vfr[kk][db] = __builtin_shufflevector(lo, hi, 0, 1, 2, 3, 4, 5, 6, 7); } }
            __builtin_amdgcn_sched_barrier(0);
            float sum = 0.f; pg8::bf16x8 pf[4];
#pragma unroll
            for (int kk = 0; kk < 4; ++kk) { float p[8];
#pragma unroll
                for (int blk = 0; blk < 2; ++blk)
#pragma unroll
                    for (int rg = 0; rg < 4; ++rg) { const float e = __expf(sc[kk][blk][rg] - mx); p[4 * blk + rg] = e; sum += e; }
                v4u wv; wv.x = pk2(p[0], p[1]); wv.y = pk2(p[2], p[3]); wv.z = pk2(p[4], p[5]); wv.w = pk2(p[6], p[7]); pf[kk] = __builtin_bit_cast(pg8::bf16x8, wv); }
            sum += __shfl_xor(sum, 16); sum += __shfl_xor(sum, 32);
            f32x4 o[4];
#pragma unroll
            for (int db = 0; db < 4; ++db) o[db] = (f32x4){0.f, 0.f, 0.f, 0.f};
#pragma unroll
            for (int kk = 0; kk < 4; ++kk)
#pragma unroll
                for (int db = 0; db < 4; ++db) o[db] = __builtin_amdgcn_mfma_f32_16x16x32_bf16(vfr[kk][db], pf[kk], o[db], 0, 0, 0);
            LAS unsigned char* mg = L + MRG + (qt * 64 + lane) * 48;
            if (half == 0) {
                v4u w0, w1; w0.x = pk2(o[0][0], o[0][1]); w0.y = pk2(o[0][2], o[0][3]); w0.z = pk2(o[1][0], o[1][1]); w0.w = pk2(o[1][2], o[1][3]);
                w1.x = pk2(o[2][0], o[2][1]); w1.y = pk2(o[2][2], o[2][3]); w1.z = pk2(o[3][0], o[3][1]); w1.w = pk2(o[3][2], o[3][3]);
                *(LAS v4u*)mg = w0; *(LAS v4u*)(mg + 16) = w1; *(LAS f32x2*)(mg + 32) = (f32x2){mx, sum};
                VM_WAIT();
            } else {
                const v4u w0 = *(const LAS v4u*)mg, w1 = *(const LAS v4u*)(mg + 16); const f32x2 ml = *(const LAS f32x2*)(mg + 32);
                const float mm = fmaxf(mx, ml.x), a0 = __expf(mx - mm), a1 = __expf(ml.x - mm); const float inv = frcp(sum * a0 + ml.y * a1);
                const float sa = a0 * inv, sb = a1 * inv;
                stp = Y + (size_t)(tokrow0 + c) * DM + h * 64 + 4 * g;
                st0.x = pk2(o[0][0] * sa + bflo(w0.x) * sb, o[0][1] * sa + bfhi(w0.x) * sb); st0.y = pk2(o[0][2] * sa + bflo(w0.y) * sb, o[0][3] * sa + bfhi(w0.y) * sb);
                st1.x = pk2(o[1][0] * sa + bflo(w0.z) * sb, o[1][1] * sa + bfhi(w0.z) * sb); st1.y = pk2(o[1][2] * sa + bflo(w0.w) * sb, o[1][3] * sa + bfhi(w0.w) * sb);
                st2.x = pk2(o[2][0] * sa + bflo(w1.x) * sb, o[2][1] * sa + bfhi(w1.x) * sb); st2.y = pk2(o[2][2] * sa + bflo(w1.y) * sb, o[2][3] * sa + bfhi(w1.y) * sb);
                st3.x = pk2(o[3][0] * sa + bflo(w1.z) * sb, o[3][1] * sa + bfhi(w1.z) * sb); st3.y = pk2(o[3][2] * sa + bflo(w1.w) * sb, o[3][3] * sa + bfhi(w1.w) * sb);
            }
            LDS_WAIT();
            __syncthreads();
        }
        if (half == 1) { *(v2u*)(stp) = st0; *(v2u*)(stp + 16) = st1; *(v2u*)(stp + 32) = st2; *(v2u*)(stp + 48) = st3; }
        if (half == 0) NA_BAR();
        it += m;
    }
#undef NA_BAR
#undef NA_ROW_DMA
#undef NA_SWZ
#undef NA_ITEM
    VM_WAIT(); LDS_WAIT();
    __syncthreads();
}

template <int MODE> __device__ __forceinline__ void ph_lru_simple(const Args& a, const Frame& F, int l) {
    int tid = threadIdx.x; asm volatile("" : "+v"(tid)); int lane = tid & 63; (void)lane;
    const bf16* Z = (const bf16*)(a.ws + WS_Z); bf16* Y = (bf16*)(a.ws + WS_Y); float* HF = (float*)(a.ws + WS_HF);
    float* agg = (float*)(a.ws + WS_LAGG); const float* cin = (const float*)(a.ws + WS_LCIN);
    float* xc = (float*)(F.ldsg + RING_OFF);
    const int c = tid, n = c >> 6, k = c & 63;
    float cw[4];
#pragma unroll
    for (int j = 0; j < 4; ++j) cw[j] = a.in[I_CW][((size_t)l * 4 + j) * 512 + c];
    const float cb = a.in[I_CB][(size_t)l * 512 + c];
    for (int ch = F.vcu; ch < NLCH; ch += F.G) {
        const int tok0 = ch * LCH; int s0, T; seq_of(tok0, s0, T); const int s1 = s0 + T;
        __syncthreads();
        for (int t = 0; t < LCH; ++t) { const int tok = tok0 + t; float v = cb;
#pragma unroll
            for (int j = 0; j < 4; ++j) { const int tt = tok + j - 2; if (tt >= s0 && tt < s1) v += cw[j] * bf2f(Z[(size_t)tt * ZW + ZXR + c]); }
            xc[t * 512 + c] = v; }
        __syncthreads();
        for (int dir = 0; dir < 2; ++dir) {
            float wa[64], wx[64];
            const float* pwa = a.in[I_LWA] + ((size_t)(l * 2 + dir) * 8 + n) * 4096 + k; const float* pwx = a.in[I_LWX] + ((size_t)(l * 2 + dir) * 8 + n) * 4096 + k;
#pragma unroll
            for (int j = 0; j < 64; ++j) { wa[j] = pwa[j * 64]; wx[j] = pwx[j * 64]; }
            const float ba = a.in[I_LBA][(size_t)(l * 2 + dir) * 512 + c], bx = a.in[I_LBX][(size_t)(l * 2 + dir) * 512 + c];
            const float lam = a.in[I_LAM][(size_t)(l * 2 + dir) * 512 + c]; const float ls8 = -8.f * log1pf(__expf(-lam));
            float h = MODE ? cin[((size_t)ch * 2 + dir) * 512 + c] : 0.f, P = 1.f;
            for (int st = 0; st < LCH; ++st) {
                const int t = dir ? (LCH - 1 - st) : st; const float* xr = xc + t * 512 + n * 64;
                float pa = ba, px = bx;
#pragma unroll
                for (int j = 0; j < 64; j += 4) { const f32x4 x4 = *(const f32x4*)(xr + j);
                    pa += x4.x * wa[j] + x4.y * wa[j + 1] + x4.z * wa[j + 2] + x4.w * wa[j + 3]; px += x4.x * wx[j] + x4.y * wx[j + 1] + x4.z * wx[j + 2] + x4.w * wx[j + 3]; }
                const float rr = sigmoidf_(pa), ii = sigmoidf_(px), loga = ls8 * rr, av = __expf(loga), mult = sqrtf(fmaxf(-expm1f(2.f * loga), 0.f));
                const float uu = mult * ii * xc[t * 512 + c];
                h = av * h + uu; P *= av;
                if (MODE) { const size_t tok = (size_t)(tok0 + t);
                    if (dir == 0) HF[tok * 512 + c] = h;
                    else { const float gt = bf2f(Z[tok * ZW + ZGT + c]); Y[tok * DM + 1024 + c] = (bf16)f2bf((HF[tok * 512 + c] + h) * gelu_tanh(gt)); } }
            }
            if (!MODE) { float* ag = agg + (((size_t)ch * 2 + dir) * 512 + c) * 2; ag[0] = P; ag[1] = h; }
        }
    }
}

template <int MODE> __device__ __forceinline__ void ph_s5_simple(const Args& a, const Frame& F, int l) {
    int tid = threadIdx.x; asm volatile("" : "+v"(tid)); int lane = tid & 63; (void)lane;
    const bf16* Z = (const bf16*)(a.ws + WS_Z); bf16* YG = (bf16*)(a.ws + WS_YG);
    float* E = (float*)(a.ws + WS_SEND); const float* CIN = (const float*)(a.ws + WS_SCIN);
    const float* TLB = (const float*)(a.ws + WS_TLB); const float* TBB = (const float*)(a.ws + WS_TBB);
    float* Sst = (float*)(F.ldsg + RING_OFF + F.wave * 16384);
    float* Yf = Sst + 2048;
    float* Ub = (float*)(F.ldsg + XTRA_OFF + F.wave * 1024);
    const int gw = F.vcu * NWAVES + F.wave, NGW = F.G * NWAVES;
    for (int u = gw; u < NSCH * 32; u += NGW) {
        const int ch = u >> 5, g = u & 31, tok0 = ch * SCH;
        for (int dir = 0; dir < 2; ++dir) {
            const int dg = dir * 32 + g;
            const float lbr = TLB[((size_t)dg * 64 + lane) * 2], lbi = TLB[((size_t)dg * 64 + lane) * 2 + 1];
            float bbr[16], bbi[16];
            { const f32x4* tb = (const f32x4*)(TBB + ((size_t)dg * 64 + lane) * 32);
#pragma unroll
              for (int q = 0; q < 4; ++q) { const f32x4 x = tb[q], y = tb[4 + q]; bbr[4 * q] = x.x; bbr[4 * q + 1] = x.y; bbr[4 * q + 2] = x.z; bbr[4 * q + 3] = x.w; bbi[4 * q] = y.x; bbi[4 * q + 1] = y.y; bbi[4 * q + 2] = y.z; bbi[4 * q + 3] = y.w; } }
            float cr[64], ci[64];
            if (MODE) { const int h = lane & 15; const f32x4* pr = (const f32x4*)(a.in[I_CRE] + (((size_t)(l * 2 + dir) * 32 + g) * 16 + h) * 64); const f32x4* pi = (const f32x4*)(a.in[I_CIM] + (((size_t)(l * 2 + dir) * 32 + g) * 16 + h) * 64);
#pragma unroll
              for (int q = 0; q < 16; ++q) { const f32x4 x = pr[q], y = pi[q]; cr[4 * q] = x.x; cr[4 * q + 1] = x.y; cr[4 * q + 2] = x.z; cr[4 * q + 3] = x.w; ci[4 * q] = y.x; ci[4 * q + 1] = y.y; ci[4 * q + 2] = y.z; ci[4 * q + 3] = y.w; } }
            float sr = 0.f, si = 0.f;
            if (MODE) { const float* cp = CIN + ((((size_t)ch * 2 + dir) * 32 + g) * 64 + lane) * 2; sr = cp[0]; si = cp[1]; }
            for (int b = 0; b < SCH / 16; ++b) {
                { const int tt = lane >> 2, hq = lane & 3; const int tl = dir ? (SCH - 1 - (16 * b + tt)) : (16 * b + tt);
                  const v2u w = *(const v2u*)(Z + (size_t)(tok0 + tl) * ZW + ZXS + g * 16 + hq * 4);
                  LDS_WAIT();
                  *(f32x4*)(Ub + tt * 16 + hq * 4) = (f32x4){bflo(w.x), bfhi(w.x), bflo(w.y), bfhi(w.y)};
                  LDS_WAIT(); }
                for (int tt = 0; tt < 16; ++tt) {
                    const f32x4 u0 = *(const f32x4*)(Ub + tt * 16), u1 = *(const f32x4*)(Ub + tt * 16 + 4), u2 = *(const f32x4*)(Ub + tt * 16 + 8), u3 = *(const f32x4*)(Ub + tt * 16 + 12);
                    float ir = u0.x * bbr[0] + u0.y * bbr[1] + u0.z * bbr[2] + u0.w * bbr[3] + u1.x * bbr[4] + u1.y * bbr[5] + u1.z * bbr[6] + u1.w * bbr[7]
                             + u2.x * bbr[8] + u2.y * bbr[9] + u2.z * bbr[10] + u2.w * bbr[11] + u3.x * bbr[12] + u3.y * bbr[13] + u3.z * bbr[14] + u3.w * bbr[15];
                    float ii = u0.x * bbi[0] + u0.y * bbi[1] + u0.z * bbi[2] + u0.w * bbi[3] + u1.x * bbi[4] + u1.y * bbi[5] + u1.z * bbi[6] + u1.w * bbi[7]
                             + u2.x * bbi[8] + u2.y * bbi[9] + u2.z * bbi[10] + u2.w * bbi[11] + u3.x * bbi[12] + u3.y * bbi[13] + u3.z * bbi[14] + u3.w * bbi[15];
                    const float nr = lbr * sr - lbi * si + ir, ni = lbr * si + lbi * sr + ii; sr = nr; si = ni;
                    if (MODE) { Sst[(tt * 64 + lane) * 2] = sr; Sst[(tt * 64 + lane) * 2 + 1] = si; }
                }
                if (MODE) {
                    LDS_WAIT();
                    const int h = lane & 15, tq = lane >> 4;
#pragma unroll
                    for (int j = 0; j < 4; ++j) { const int slot = tq * 4 + j; const float* sp = Sst + slot * 128; float y = 0.f;
#pragma unroll
                        for (int p = 0; p < 64; p += 2) { const f32x4 s4 = *(const f32x4*)(sp + 2 * p); y += s4.x * cr[p] - s4.y * ci[p] + s4.z * cr[p + 1] - s4.w * ci[p + 1]; }
                        const int tl = dir ? (SCH - 1 - (16 * b + slot)) : (16 * b + slot);
                        if (dir == 0) Yf[tl * 16 + h] = y; else Yf[tl * 16 + h] += y; }
                    LDS_WAIT();
                }
            }
            if (!MODE) { float* ep = E + ((((size_t)ch * 2 + dir) * 32 + g) * 64 + lane) * 2; ep[0] = sr; ep[1] = si; }
        }
        if (MODE) {
            LDS_WAIT();
            for (int i = 0; i < 32; ++i) { const int idx = lane + 64 * i, tl = idx >> 4, h = idx & 15; const size_t tok = (size_t)(tok0 + tl);
                const float xs = bf2f(Z[tok * ZW + ZXS + g * 16 + h]); const float y = Yf[tl * 16 + h] + a.in[I_SD][(size_t)l * 512 + g * 16 + h] * xs;
                YG[tok * 512 + g * 16 + h] = (bf16)f2bf(gelu_tanh(y)); }
            LDS_WAIT();
        }
    }
}

template <int MODE, int DIR> __device__ __forceinline__ void s5_dir(const Args& a, int l, int lane, int tok0, int gr, LAS unsigned char* st, bf16* yf) {
    const bf16* Z = (const bf16*)(a.ws + WS_ZR); bf16* YG = (bf16*)(a.ws + WS_YG);
    float* E = (float*)(a.ws + WS_SEND); const float* CIN = (const float*)(a.ws + WS_SCIN); const float* TLB = (const float*)(a.ws + WS_TLB);
    const int n = lane & 15, g = lane >> 4, dg = DIR * 32 + gr, ch = tok0 / SCH + g;
    pg8::bf16x8 bbf[8], cf[4];
    { const pg8::bf16x8* bp = (const pg8::bf16x8*)(a.ws + WS_TBBF) + (size_t)dg * 8 * 64 + lane;
#pragma unroll
      for (int c = 0; c < 8; ++c) bbf[c] = bp[c * 64]; }
    if (MODE) { const pg8::bf16x8* cp = (const pg8::bf16x8*)(a.ws + WS_TCF) + (size_t)dg * 4 * 64 + lane;
#pragma unroll
      for (int c = 0; c < 4; ++c) cf[c] = cp[c * 64]; }
    float lbr[4], lbi[4], sr[4], si[4];
#pragma unroll
    for (int cb = 0; cb < 4; ++cb) { const size_t ix = ((size_t)dg * 64 + 16 * cb + n) * 2; lbr[cb] = TLB[ix]; lbi[cb] = TLB[ix + 1];
        if (MODE) { const size_t cx = ((((size_t)ch * 2 + DIR) * 32 + gr) * 64 + 16 * cb + n) * 2; sr[cb] = CIN[cx]; si[cb] = CIN[cx + 1]; } else { sr[cb] = 0.f; si[cb] = 0.f; } }
    const float dsk = MODE ? a.in[I_SD][(size_t)l * 512 + 16 * gr + n] : 0.f;
    const bf16* ua = Z + (size_t)(tok0 + (n >> 2) * SCH + (n & 3)) * ZRW + RXS + 16 * gr + 8 * (g & 1);
    bf16* yo = YG + (size_t)(tok0 + g * SCH) * 512 + 16 * gr + n;
    const bf16* xo = Z + (size_t)(tok0 + g * SCH) * ZRW + RXS + 16 * gr + n;
    constexpr int NST = SCH / 4, T0 = DIR ? (SCH - 4) : 0, DT = DIR ? -4 : 4;
    pg8::bf16x8 un = *(const pg8::bf16x8*)(ua + (size_t)T0 * ZRW);
    unsigned short ygn[4], xsn[4];
    if (MODE && DIR) {
        VM_WAIT();
#pragma unroll
        for (int rg = 0; rg < 4; ++rg) { ygn[rg] = yf[((T0 >> 2) * 4 + rg) * 64 + lane]; xsn[rg] = xo[(size_t)(T0 + rg) * ZRW]; } }
#pragma unroll 1
    for (int step = 0; step < NST; ++step) {
        const int t4 = T0 + DT * step;
        const pg8::bf16x8 u8 = un; unsigned short ygc[4], xsc[4];
        if (MODE && DIR) {
#pragma unroll
            for (int rg = 0; rg < 4; ++rg) { ygc[rg] = ygn[rg]; xsc[rg] = xsn[rg]; } }
        if (step + 1 < NST) { un = *(const pg8::bf16x8*)(ua + (size_t)(t4 + DT) * ZRW);
            if (MODE && DIR) {
#pragma unroll
                for (int rg = 0; rg < 4; ++rg) { ygn[rg] = yf[(((t4 + DT) >> 2) * 4 + rg) * 64 + lane]; xsn[rg] = xo[(size_t)(t4 + DT + rg) * ZRW]; } } }
        f32x4 in[8];
#pragma unroll
        for (int c = 0; c < 8; ++c) in[c] = __builtin_amdgcn_mfma_f32_16x16x32_bf16(u8, bbf[c], (f32x4){0.f, 0.f, 0.f, 0.f}, 0, 0, 0);
        float str[4][4], sti[4][4];
#pragma unroll
        for (int rr = 0; rr < 4; ++rr) { const int rg = DIR ? 3 - rr : rr;
#pragma unroll
            for (int cb = 0; cb < 4; ++cb) { const float nr = lbr[cb] * sr[cb] - lbi[cb] * si[cb] + in[cb][rg], ni = lbr[cb] * si[cb] + lbi[cb] * sr[cb] + in[4 + cb][rg];
                sr[cb] = nr; si[cb] = ni; str[cb][rg] = nr; sti[cb][rg] = ni; } }
        if (MODE) {
#pragma unroll
            for (int rg = 0; rg < 4; ++rg) { v4u w; w.x = pk2s(str[0][rg], sti[0][rg]); w.y = pk2s(str[1][rg], sti[1][rg]); w.z = pk2s(str[2][rg], sti[2][rg]); w.w = pk2s(str[3][rg], sti[3][rg]);
                *(LAS v4u*)(st + (4 * g + rg) * 272 + n * 16) = w; asm volatile("s_nop 1" ::: "memory"); }
            LDS_WAIT();
            f32x4 y = (f32x4){0.f, 0.f, 0.f, 0.f};
#pragma unroll
            for (int ks = 0; ks < 4; ++ks) { const pg8::bf16x8 sf = *(const LAS pg8::bf16x8*)(st + n * 272 + ks * 64 + g * 16); y = __builtin_amdgcn_mfma_f32_16x16x32_bf16(sf, cf[ks], y, 0, 0, 0); }
            LDS_WAIT();
#pragma unroll
            for (int rg = 0; rg < 4; ++rg) {
                if (DIR == 0) yf[((t4 >> 2) * 4 + rg) * 64 + lane] = (bf16)f2bf(y[rg]);
                else { const float v = y[rg] + bf2f(ygc[rg]) + dsk * bf2f(xsc[rg]); yo[(size_t)(t4 + rg) * 512] = (bf16)f2bf(gelu_tanh(v)); } }
        }
    }
    if (!MODE) {
#pragma unroll
        for (int cb = 0; cb < 4; ++cb) { const size_t cx = ((((size_t)ch * 2 + DIR) * 32 + gr) * 64 + 16 * cb + n) * 2; E[cx] = sr[cb]; E[cx + 1] = si[cb]; } }
}

template <int MODE, int DIR> __device__ __forceinline__ void lru_dir(const Args& a, int l, int lane, int tok0, int nb, int half, const LAS unsigned char* xt, bf16* hf) {
    const bf16* Z = (const bf16*)(a.ws + WS_ZR); bf16* Y = (bf16*)(a.ws + WS_Y);
    float* agg = (float*)(a.ws + WS_LAGG); const float* cin = (const float*)(a.ws + WS_LCIN);
    const int n = lane & 15, g = lane >> 4, ch = tok0 / LCH + g;
    pg8::bf16x8 wa[2][2], wx[2][2];
    { const pg8::bf16x8* wp = (const pg8::bf16x8*)(a.ws + WS_TWF) + (size_t)((DIR * 8 + nb) * 2) * 4 * 2 * 64 + lane;
#pragma unroll
      for (int c2 = 0; c2 < 2; ++c2)
#pragma unroll
          for (int ks = 0; ks < 2; ++ks) { wa[c2][ks] = wp[((2 * half + c2) * 2 + ks) * 64]; wx[c2][ks] = wp[(8 + (2 * half + c2) * 2 + ks) * 64]; } }
    pg8::bf16x8 idn[2];
#pragma unroll
    for (int hf = 0; hf < 2; ++hf) { v4u w;
#pragma unroll
        for (int jj = 0; jj < 4; ++jj) { const int k0 = 8 * g + 2 * jj; w[jj] = ((k0 == 16 * hf + n) ? 0x3f80u : 0u) | ((k0 + 1 == 16 * hf + n) ? 0x3f800000u : 0u); }
        idn[hf] = __builtin_bit_cast(pg8::bf16x8, w); }
    float ba[2], bx[2], ls8[2], h[2], P[2];
    const int cch = 64 * nb + 32 * half + n;
#pragma unroll
    for (int c2 = 0; c2 < 2; ++c2) { const int c = cch + 16 * c2; const size_t ix = (size_t)(l * 2 + DIR) * 512 + c;
        ba[c2] = a.in[I_LBA][ix]; bx[c2] = a.in[I_LBX][ix]; ls8[c2] = -8.f * log1pf(__expf(-a.in[I_LAM][ix]));
        h[c2] = MODE ? cin[((size_t)ch * 2 + DIR) * 512 + c] : 0.f; P[c2] = 1.f; }
    const LAS unsigned char* xa = xt + ((n >> 2) * LCH + (n & 3)) * 128 + g * 16;
    bf16* yo = Y + (size_t)(tok0 + g * LCH) * DM + 1024 + cch;
    const bf16* go = Z + (size_t)(tok0 + g * LCH) * ZRW + RGT + cch;
    constexpr int NST = LCH / 4, T0 = DIR ? (LCH - 4) : 0, DT = DIR ? -4 : 4;
    unsigned short yn[2][4], gn[2][4];
    if (MODE && DIR) {
        VM_WAIT();
#pragma unroll
        for (int rg = 0; rg < 4; ++rg)
#pragma unroll
            for (int c2 = 0; c2 < 2; ++c2) { yn[c2][rg] = hf[(((T0 >> 2) * 4 + rg) * 2 + c2) * 64 + lane]; gn[c2][rg] = go[(size_t)(T0 + rg) * ZRW + 16 * c2]; } }
#pragma unroll 1
    for (int step = 0; step < NST; ++step) {
        const int t4 = T0 + DT * step;
        unsigned short yc[2][4], gc[2][4];
        if (MODE && DIR) {
#pragma unroll
            for (int rg = 0; rg < 4; ++rg)
#pragma unroll
                for (int c2 = 0; c2 < 2; ++c2) { yc[c2][rg] = yn[c2][rg]; gc[c2][rg] = gn[c2][rg]; }
            if (step + 1 < NST) {
#pragma unroll
                for (int rg = 0; rg < 4; ++rg)
#pragma unroll
                    for (int c2 = 0; c2 < 2; ++c2) { yn[c2][rg] = hf[((((t4 + DT) >> 2) * 4 + rg) * 2 + c2) * 64 + lane]; gn[c2][rg] = go[(size_t)(t4 + DT + rg) * ZRW + 16 * c2]; } } }
        const pg8::bf16x8 a0 = *(const LAS pg8::bf16x8*)(xa + t4 * 128), a1 = *(const LAS pg8::bf16x8*)(xa + t4 * 128 + 64);
        const pg8::bf16x8 ah = half ? a1 : a0;
        f32x4 pa[2], px[2], xd[2];
#pragma unroll
        for (int c2 = 0; c2 < 2; ++c2) { const f32x4 z4 = (f32x4){0.f, 0.f, 0.f, 0.f};
            pa[c2] = __builtin_amdgcn_mfma_f32_16x16x32_bf16(a0, wa[c2][0], z4, 0, 0, 0); pa[c2] = __builtin_amdgcn_mfma_f32_16x16x32_bf16(a1, wa[c2][1], pa[c2], 0, 0, 0);
            px[c2] = __builtin_amdgcn_mfma_f32_16x16x32_bf16(a0, wx[c2][0], z4, 0, 0, 0); px[c2] = __builtin_amdgcn_mfma_f32_16x16x32_bf16(a1, wx[c2][1], px[c2], 0, 0, 0);
            xd[c2] = __builtin_amdgcn_mfma_f32_16x16x32_bf16(ah, idn[c2], z4, 0, 0, 0); }
#pragma unroll
        for (int rr = 0; rr < 4; ++rr) { const int rg = DIR ? 3 - rr : rr;
#pragma unroll
            for (int c2 = 0; c2 < 2; ++c2) {
                const float r_ = sigmoidf_(pa[c2][rg] + ba[c2]), i_ = sigmoidf_(px[c2][rg] + bx[c2]); const float loga = ls8[c2] * r_, av = __expf(loga), mult = fsqrt_(fmaxf(1.f - av * av, 0.f));
                h[c2] = av * h[c2] + mult * i_ * xd[c2][rg]; P[c2] *= av;
                if (MODE) {
                    if (DIR == 0) hf[(((t4 >> 2) * 4 + rg) * 2 + c2) * 64 + lane] = (bf16)f2bf(h[c2]);
                    else yo[(size_t)(t4 + rg) * DM + 16 * c2] = (bf16)f2bf((bf2f(yc[c2][rg]) + h[c2]) * gelu_tanh(bf2f(gc[c2][rg]))); } }
        }
    }
    if (!MODE) {
#pragma unroll
        for (int c2 = 0; c2 < 2; ++c2) { float* ag = agg + (((size_t)ch * 2 + DIR) * 512 + cch + 16 * c2) * 2; ag[0] = P[c2]; ag[1] = h[c2]; } }
}
__device__ __forceinline__ void lru_prepass(const Args& a, int l, int lane, int tok0, int nb, LAS unsigned char* xt) {
    const bf16* Z = (const bf16*)(a.ws + WS_ZR);
    int s0, T; seq_of(tok0, s0, T); const int s1 = s0 + T;
    const int oc = lane & 7, tg = lane >> 3, cbase = 64 * nb + 8 * oc; float cw[4][8], cbv[8];
    v4u x[19];
    const int tb = tok0 + 16 * tg - 2;
#pragma unroll
    for (int i = 0; i < 19; ++i) { const int tt = tb + i; x[i] = (v4u){0u, 0u, 0u, 0u}; if (tt >= s0 && tt < s1) x[i] = *(const v4u*)(Z + (size_t)tt * ZRW + RXR + cbase); }
#pragma unroll
    for (int tp = 0; tp < 4; ++tp) { const f32x4* wp = (const f32x4*)(a.in[I_CW] + ((size_t)l * 4 + tp) * 512 + cbase); const f32x4 w0 = wp[0], w1 = wp[1];
        cw[tp][0] = w0.x; cw[tp][1] = w0.y; cw[tp][2] = w0.z; cw[tp][3] = w0.w; cw[tp][4] = w1.x; cw[tp][5] = w1.y; cw[tp][6] = w1.z; cw[tp][7] = w1.w; }
    { const f32x4* bp = (const f32x4*)(a.in[I_CB] + (size_t)l * 512 + cbase); const f32x4 b0 = bp[0], b1 = bp[1]; cbv[0] = b0.x; cbv[1] = b0.y; cbv[2] = b0.z; cbv[3] = b0.w; cbv[4] = b1.x; cbv[5] = b1.y; cbv[6] = b1.z; cbv[7] = b1.w; }
    LDS_WAIT();
#pragma unroll
    for (int i = 0; i < 16; ++i) { float acc[8];
#pragma unroll
        for (int e = 0; e < 8; ++e) acc[e] = cbv[e];
#pragma unroll
        for (int tp = 0; tp < 4; ++tp) { const v4u xx = x[i + tp];
            acc[0] += cw[tp][0] * bflo(xx.x); acc[1] += cw[tp][1] * bfhi(xx.x); acc[2] += cw[tp][2] * bflo(xx.y); acc[3] += cw[tp][3] * bfhi(xx.y);
            acc[4] += cw[tp][4] * bflo(xx.z); acc[5] += cw[tp][5] * bfhi(xx.z); acc[6] += cw[tp][6] * bflo(xx.w); acc[7] += cw[tp][7] * bfhi(xx.w); }
        v4u o; o.x = pk2(acc[0], acc[1]); o.y = pk2(acc[2], acc[3]); o.z = pk2(acc[4], acc[5]); o.w = pk2(acc[6], acc[7]);
        *(LAS v4u*)(xt + (16 * tg + i) * 128 + oc * 16) = o; asm volatile("s_nop 1" ::: "memory"); }
    LDS_WAIT();
}
template <int MODE> __device__ __forceinline__ void ph_scan(const Args& a, const Frame& F, int l) {
    int tid = threadIdx.x; asm volatile("" : "+v"(tid)); int lane = tid & 63; (void)lane;
    LAS unsigned char* slab = F.lds + RING_OFF + F.wave * 16384;
    LAS int* ctr = (LAS int*)(F.lds + MISC_OFF + 64);
    __syncthreads(); if (tid == 0) *ctr = 0; __syncthreads();
    constexpr int NLU = (NLCH / 4) * 16, NSU = (NSCH / 4) * 32;
    const int l0 = (int)((long)NLU * F.vcu / F.G), l1 = (int)((long)NLU * (F.vcu + 1) / F.G), s0u = (int)((long)NSU * F.vcu / F.G), s1u = (int)((long)NSU * (F.vcu + 1) / F.G);
    const int nl = l1 - l0, ntot = nl + (s1u - s0u);
    for (;;) {
        int it = 0; if (lane == 0) it = __hip_atomic_fetch_add(ctr, 1, __ATOMIC_RELAXED, __HIP_MEMORY_SCOPE_WORKGROUP);
        it = __builtin_amdgcn_readfirstlane(it);
        if (it >= ntot) break;
        if (it < nl) { const int u = l0 + it, half = u & 1, nb = (u >> 1) & 7, cq = u >> 4, tok0 = cq * 4 * LCH;
            bf16* hf = (bf16*)(a.ws + WS_HF) + (size_t)u * 4096;
            lru_prepass(a, l, lane, tok0, nb, slab);
            lru_dir<MODE, 0>(a, l, lane, tok0, nb, half, slab, hf); lru_dir<MODE, 1>(a, l, lane, tok0, nb, half, slab, hf);
        } else { const int u = s0u + it - nl, gr = u & 31, cq = u >> 5, tok0 = cq * 4 * SCH;
            bf16* yf = (bf16*)(a.ws + WS_HF + 40 * MiB) + (size_t)u * 4096;
            s5_dir<MODE, 0>(a, l, lane, tok0, gr, slab, yf); s5_dir<MODE, 1>(a, l, lane, tok0, gr, slab, yf); }
    }
    LDS_WAIT();
}

__device__ __forceinline__ void ph_carries(const Args& a, const Frame& F, int l) {
    int tid = threadIdx.x; asm volatile("" : "+v"(tid)); int lane = tid & 63; (void)lane;
    constexpr int NL_LONG = 2 * 2 * 512 * (16384 / LCH / 16), NL_SHORT = 4 * 2 * 512 * (2048 / LCH / 16);
    constexpr int NS_LONG = 2 * 2 * 2048 * (16384 / SCH / 16), NS_SHORT = 4 * 2 * 2048 * (2048 / SCH / 16);
    constexpr int NITEM = NL_LONG + NL_SHORT + NS_LONG + NS_SHORT;
    static_assert(NL_LONG % 512 == 0 && NL_SHORT % 512 == 0 && NS_LONG % 512 == 0 && NS_SHORT % 512 == 0, "item classes are whole workgroups");
    for (int base = F.vcu * NTHR; base < NITEM; base += F.G * NTHR) {
        int it = base + tid;
        if (it < NL_LONG + NL_SHORT) {
            const bool lg = it < NL_LONG; if (!lg) it -= NL_LONG;
            const int W = lg ? (16384 / LCH / 16) : (2048 / LCH / 16); const int seg = it & (W - 1), chain = it / W;
            const int c = chain & 511, dir = (chain >> 9) & 1, sq = chain >> 10; const int s0 = lg ? 8192 + sq * 16384 : sq * 2048, T = lg ? 16384 : 2048; const int c0 = s0 / LCH, nc = T / LCH;
            const f32x2* agg = (const f32x2*)(a.ws + WS_LAGG); float* cin = (float*)(a.ws + WS_LCIN);
            f32x2 v[16]; float A = 1.f, B = 0.f;
#pragma unroll
            for (int j = 0; j < 16; ++j) { const int pos = seg * 16 + j, ch = c0 + (dir ? nc - 1 - pos : pos); v[j] = agg[((size_t)ch * 2 + dir) * 512 + c]; }
#pragma unroll
            for (int j = 0; j < 16; ++j) { B = v[j].x * B + v[j].y; A *= v[j].x; }
            for (int off = 1; off < W; off <<= 1) { const float Ap = __shfl_up(A, off, 64), Bp = __shfl_up(B, off, 64); if (seg >= off) { B = A * Bp + B; A = A * Ap; } }
            float carry = __shfl_up(B, 1, 64); if (seg == 0) carry = 0.f;
#pragma unroll
            for (int j = 0; j < 16; ++j) { const int pos = seg * 16 + j, ch = c0 + (dir ? nc - 1 - pos : pos); cin[((size_t)ch * 2 + dir) * 512 + c] = carry; carry = v[j].x * carry + v[j].y; }
        } else {
            it -= NL_LONG + NL_SHORT;
            const bool lg = it < NS_LONG; if (!lg) it -= NS_LONG;
            const int W = lg ? (16384 / SCH / 16) : (2048 / SCH / 16); const int seg = it & (W - 1), chain = it / W;
            const int p = chain & 63, g = (chain >> 6) & 31, dir = (chain >> 11) & 1, sq = chain >> 12; const int s0 = lg ? 8192 + sq * 16384 : sq * 2048, T = lg ? 16384 : 2048; const int c0 = s0 / SCH, nc = T / SCH;
            const float* TLB = (const float*)(a.ws + WS_TLB); const f32x2* E = (const f32x2*)(a.ws + WS_SEND); f32x2* CIN = (f32x2*)(a.ws + WS_SCIN);
            float pr = TLB[((size_t)(dir * 32 + g) * 64 + p) * 2], pi = TLB[((size_t)(dir * 32 + g) * 64 + p) * 2 + 1];
            static_assert(SCH == 64, "lb^SCH by 6 squarings");
#pragma unroll
            for (int i = 0; i < 6; ++i) { const float nr = pr * pr - pi * pi, ni = 2.f * pr * pi; pr = nr; pi = ni; }
            f32x2 v[16]; float Br = 0.f, Bi = 0.f;
#pragma unroll
            for (int j = 0; j < 16; ++j) { const int pos = seg * 16 + j, ch = c0 + (dir ? nc - 1 - pos : pos); v[j] = E[(((size_t)ch * 2 + dir) * 32 + g) * 64 + p]; }
#pragma unroll
            for (int j = 0; j < 16; ++j) { const float nr = pr * Br - pi * Bi + v[j].x, ni = pr * Bi + pi * Br + v[j].y; Br = nr; Bi = ni; }
            float Ar = pr, Ai = pi;
#pragma unroll
            for (int i = 0; i < 4; ++i) { const float nr = Ar * Ar - Ai * Ai, ni = 2.f * Ar * Ai; Ar = nr; Ai = ni; }
            for (int off = 1; off < W; off <<= 1) { const float Apr = __shfl_up(Ar, off, 64), Api = __shfl_up(Ai, off, 64), Bpr = __shfl_up(Br, off, 64), Bpi = __shfl_up(Bi, off, 64);
                if (seg >= off) { const float nbr = Ar * Bpr - Ai * Bpi + Br, nbi = Ar * Bpi + Ai * Bpr + Bi, nar = Ar * Apr - Ai * Api, nai = Ar * Api + Ai * Apr; Br = nbr; Bi = nbi; Ar = nar; Ai = nai; } }
            float cr = __shfl_up(Br, 1, 64), ci = __shfl_up(Bi, 1, 64); if (seg == 0) { cr = 0.f; ci = 0.f; }
#pragma unroll
            for (int j = 0; j < 16; ++j) { const int pos = seg * 16 + j, ch = c0 + (dir ? nc - 1 - pos : pos); CIN[(((size_t)ch * 2 + dir) * 32 + g) * 64 + p] = (f32x2){cr, ci};
                const float nr = pr * cr - pi * ci + v[j].x, ni = pr * ci + pi * cr + v[j].y; cr = nr; ci = ni; }
        }
    }
}

__device__ __forceinline__ void ph_groupnorm(const Args& a, const Frame& F, int l, bf16* dst = nullptr) {
    int tid = threadIdx.x; asm volatile("" : "+v"(tid)); int lane = tid & 63; (void)lane;
    bf16* Y = (bf16*)(a.ws + WS_Y); const float* g = a.in[I_GOUT] + (size_t)l * DM;
    const int gw = F.vcu * NWAVES + F.wave, NGW = F.G * NWAVES;
    for (int m = gw; m < NTOK; m += NGW) {
        v4u* yr = (v4u*)(Y + (size_t)m * DM) + lane;
        v4u w[4]; float ss[4];
#pragma unroll
        for (int j = 0; j < 4; ++j) { w[j] = yr[64 * j]; float s = 0.f;
#pragma unroll
            for (int q = 0; q < 4; ++q) { const float lo = bflo(w[j][q]), hi = bfhi(w[j][q]); s += lo * lo + hi * hi; }
            ss[j] = s; }
        const float sa = wave_sum(ss[0] + ss[1]), sb = wave_sum(ss[2]), sc = wave_sum(ss[3]);
        const float ra = 1.f / sqrtf(sa * (1.f / 1024.f) + EPS), rb = 1.f / sqrtf(sb * (1.f / 512.f) + EPS), rc = 1.f / sqrtf(sc * (1.f / 512.f) + EPS);
#pragma unroll
        for (int j = 0; j < 4; ++j) { const float r = j < 2 ? ra : (j == 2 ? rb : rc); const f32x4* gp = (const f32x4*)(g + 8 * (lane + 64 * j)); const f32x4 g0 = gp[0], g1 = gp[1];
            v4u o; o.x = pk2(bflo(w[j].x) * r * g0.x, bfhi(w[j].x) * r * g0.y); o.y = pk2(bflo(w[j].y) * r * g0.z, bfhi(w[j].y) * r * g0.w);
            o.z = pk2(bflo(w[j].z) * r * g1.x, bfhi(w[j].z) * r * g1.y); o.w = pk2(bflo(w[j].w) * r * g1.z, bfhi(w[j].w) * r * g1.w);
            if (dst) ((v4u*)(dst + (size_t)m * DM) + lane)[64 * j] = o; else yr[64 * j] = o; }
    }
}

__device__ __forceinline__ void ph_norm2(const Args& a, const Frame& F, int l) {
    int tid = threadIdx.x; asm volatile("" : "+v"(tid)); int lane = tid & 63; (void)lane;
    const int gw = F.vcu * NWAVES + F.wave, NGW = F.G * NWAVES; const float* g = a.in[I_NLG] + (size_t)l * DM; bf16* H = (bf16*)(a.ws + WS_H);
    for (int m = gw; m < NTOK; m += NGW) norm_row_bf16(a.out + (size_t)m * DM, g, H + (size_t)m * DM, lane);
}
__device__ __forceinline__ void ph_final(const Args& a, const Frame& F, float* dst = nullptr) {
    int tid = threadIdx.x; asm volatile("" : "+v"(tid)); int lane = tid & 63; (void)lane;
    const int gw = F.vcu * NWAVES + F.wave, NGW = F.G * NWAVES; const f32x4* gr = (const f32x4*)a.in[I_FING] + lane;
    for (int m = gw; m < NTOK; m += NGW) {
        f32x4* xr = (f32x4*)(a.out + (size_t)m * DM) + lane; f32x4 v[8]; float s = 0.f;
#pragma unroll
        for (int j = 0; j < 8; ++j) { v[j] = xr[64 * j]; s += (v[j].x * v[j].x + v[j].y * v[j].y) + (v[j].z * v[j].z + v[j].w * v[j].w); }
        const float rstd = 1.f / sqrtf(wave_sum(s) * (1.f / DM) + EPS);
#pragma unroll
        for (int j = 0; j < 8; ++j) { if (dst) ((f32x4*)(dst + (size_t)m * DM) + lane)[64 * j] = v[j] * rstd * gr[64 * j]; else xr[64 * j] = v[j] * rstd * gr[64 * j]; }
    }
}

__global__ void __launch_bounds__(NTHR, 2) mk_fwd(Args args) {
    extern __shared__ __attribute__((aligned(16))) unsigned char lds[];
    Frame F; F.lds = (LAS unsigned char*)lds; F.ldsg = lds;
    F.tid = threadIdx.x; F.lane = F.tid & 63; F.wave = __builtin_amdgcn_readfirstlane(F.tid >> 6);
    F.G = gridDim.x; { const int bx = blockIdx.x; F.vcu = (F.G % 8 == 0) ? (bx % 8) * (F.G / 8) + bx / 8 : bx; }
    volatile LAS unsigned* MISC = (volatile LAS unsigned*)(F.lds + MISC_OFF);
    for (int u = F.tid; u < (LDS_BYTES - LDSCTL_OFF) / 4; u += NTHR) ((LAS unsigned*)(F.lds + LDSCTL_OFF))[u] = 0u;
    __syncthreads();
    unsigned char* ws = args.ws;
    XcdBarrier bar; bar.bar = (unsigned*)(ws + WS_CTL) + CW_BAR; bar.x = 0; bar.st = nullptr;
#if MK_ONE_LAUNCH
    bar = xcd_barrier_post((unsigned*)(ws + WS_CTL) + CW_BAR, MISC + 8);
#endif
    const int lo = args.ph_lo, hi = args.ph_hi;
#define IN(k) (lo <= (k) && (k) < hi)
#if MK_ONE_LAUNCH
#if PROBE_BAR2
#define SEAM(k) do { if (IN(k) && IN((k) + 1)) { xcd_barrier(bar); xcd_barrier(bar); } } while (0)
#else
#define SEAM(k) do { if (IN(k) && IN((k) + 1)) xcd_barrier(bar); } while (0)
#endif
#else
#define SEAM(k) do { } while (0)
#endif
    for (int l = 0; l < DEPTH; ++l) {
        const int pb = l * PH_PER_LAYER;
        if (IN(pb + 0)) { ph_prologue(args, F, l);
#if PROBE_PRO2
            __syncthreads(); ph_prologue(args, F, l);
#endif
        } SEAM(pb + 0);
        if (IN(pb + 1)) {
            pg8::Gemm g{(const bf16*)(ws + WS_H), (const bf16*)(ws + WS_WIN), NTOK, ZW, DM}; pg8::StaticOrder S; S.init(NTOK, ZW, F.G, (int)blockIdx.x);
            pg8::EpiBf16<2> E{(bf16*)(ws + WS_Z), NTOK, (const unsigned long long*)(ws + WS_SSQ) + (size_t)(l * 2) * NTOK, (LAS float*)(F.lds + XTRA_OFF)};
            pg8::gemm_phase<pg8::EpiBf16<2>, pg8::StaticOrder, true, true>(F.lds + RING_OFF, g, S, E);
#if PROBE_WIN2
            pg8::gemm_phase<pg8::EpiBf16<2>, pg8::StaticOrder, true, true>(F.lds + RING_OFF, g, S, E);
#endif
        } SEAM(pb + 1);
        if (IN(pb + 2)) { ph_na_mfma(args, F, l); ph_scan<0>(args, F, l);
#if PROBE_NA2
            __syncthreads(); ph_na_mfma(args, F, l);
#endif
#if PROBE_SCAN2
            ph_scan<0>(args, F, l);
#endif
        } SEAM(pb + 2);
        if (IN(pb + 3)) { ph_carries(args, F, l);
#if PROBE_SCAN2 || PROBE_CAR2
            ph_carries(args, F, l);
#endif
        } SEAM(pb + 3);
        if (IN(pb + 4)) { ph_scan<1>(args, F, l);
#if PROBE_SCAN2
            ph_scan<1>(args, F, l);
#endif
        } SEAM(pb + 4);
        if (IN(pb + 5)) {
            __syncthreads();
            pg8::Gemm g{(const bf16*)(ws + WS_YG), (const bf16*)(ws + WS_WGLU), NTOK, 512, 512}; pg8::StaticOrder S; S.init(NTOK, 512, F.G, (int)blockIdx.x);
            pg8::EpiGlu E{(const bf16*)(ws + WS_YG), (bf16*)(ws + WS_Y), args.in[I_BGLU] + (size_t)l * 512, DM, 1536};
            pg8::gemm_phase<pg8::EpiGlu, pg8::StaticOrder, true, true>(F.lds + RING_OFF, g, S, E);
#if PROBE_GLU2
            pg8::gemm_phase<pg8::EpiGlu, pg8::StaticOrder, true, true>(F.lds + RING_OFF, g, S, E);
#endif
        } SEAM(pb + 5);
        if (IN(pb + 6)) {
#if PROBE_GN2
            ph_groupnorm(args, F, l, (bf16*)(ws + WS_Z));
#endif
            ph_groupnorm(args, F, l); } SEAM(pb + 6);
        if (IN(pb + 7)) {
            pg8::Gemm g{(const bf16*)(ws + WS_Y), (const bf16*)(ws + WS_WOUT), NTOK, DM, DM}; pg8::StaticOrder S; S.init(NTOK, DM, F.G, (int)blockIdx.x);
#if PROBE_WOUT2
            { pg8::EpiResid E2{l == 0 ? args.in[I_XP] : nullptr, l == 0 ? args.in[I_XS] : nullptr, 8192, (float*)(ws + WS_Z), DM, (bf16*)(ws + WS_H), nullptr};
              pg8::gemm_phase<pg8::EpiResid, pg8::StaticOrder, true, true>(F.lds + RING_OFF, g, S, E2); }
#endif
            pg8::EpiResid E{l == 0 ? args.in[I_XP] : nullptr, l == 0 ? args.in[I_XS] : nullptr, 8192, nullptr, DM, (bf16*)(ws + WS_H), (unsigned long long*)(ws + WS_SSQ) + (size_t)(l * 2 + 1) * NTOK};
            pg8::gemm_phase<pg8::EpiResid, pg8::StaticOrder, true, true>(F.lds + RING_OFF, g, S, E);
        } SEAM(pb + 7);
        for (int s = 0; s <= NMLPC; ++s) {
            if (IN(pb + 8 + s)) {
                if (s > 0) {
                    const int c = s - 1;
                    pg8::Gemm g{(const bf16*)(ws + WS_Z + (size_t)(c & 1) * 128 * MiB), (const bf16*)(ws + WS_WDN), MLPC, DM, DFF}; pg8::StaticOrder S; S.init(MLPC, DM, F.G, (int)blockIdx.x);
                    pg8::EpiResid E{nullptr, nullptr, 1 << 30, l + 1 < DEPTH ? nullptr : args.out + (size_t)c * MLPC * DM, DM,
                                    (bf16*)(ws + WS_H) + (size_t)c * MLPC * DM, (unsigned long long*)(ws + WS_SSQ) + (size_t)((l + 1 < DEPTH ? l + 1 : 0) * 2) * NTOK + (size_t)c * MLPC};
#if PROBE_DN2
                    { pg8::EpiResid E2{nullptr, nullptr, 1 << 30, (float*)(ws + WS_Z + 256 * MiB), DM, (bf16*)(ws + WS_H) + (size_t)c * MLPC * DM, nullptr};
                      pg8::gemm_phase<pg8::EpiResid, pg8::StaticOrder, true, true>(F.lds + RING_OFF, g, S, E2); }
#endif
                    pg8::gemm_phase<pg8::EpiResid, pg8::StaticOrder, true, true>(F.lds + RING_OFF, g, S, E);
                }
                if (s < NMLPC) {
                    const int c = s;
                    pg8::Gemm g{(const bf16*)(ws + WS_H) + (size_t)c * MLPC * DM, (const bf16*)(ws + WS_WUP), MLPC, DFF, DM}; pg8::StaticOrder S; S.init(MLPC, DFF, F.G, (int)blockIdx.x);
                    pg8::EpiBf16<1> E{(bf16*)(ws + WS_Z + (size_t)(c & 1) * 128 * MiB), DFF, (const unsigned long long*)(ws + WS_SSQ) + (size_t)(l * 2 + 1) * NTOK + (size_t)c * MLPC, (LAS float*)(F.lds + XTRA_OFF)};
                    pg8::gemm_phase<pg8::EpiBf16<1>, pg8::StaticOrder, true, true>(F.lds + RING_OFF, g, S, E);
#if PROBE_UP2
                    pg8::gemm_phase<pg8::EpiBf16<1>, pg8::StaticOrder, true, true>(F.lds + RING_OFF, g, S, E);
#endif
                }
            } SEAM(pb + 8 + s);
        }
    }
    if (IN(NPHASE - 1)) {
#if PROBE_FIN2
        ph_final(args, F, (float*)(ws + WS_Z));
#endif
        ph_final(args, F); }
#undef IN
#undef SEAM
}

extern "C" void kernel_launch(void* const* d_in, const int* in_sizes, int n_in, void* d_out, int out_size, void* d_ws, size_t ws_size, hipStream_t stream) {
    static int grid = 0;
    if (grid == 0) {
        if (n_in != 28 || out_size != NTOK * DM || ws_size < WS_END) { fprintf(stderr, "kernel_launch: unexpected shapes (n_in %d out %d ws %zu)\n", n_in, out_size, ws_size); grid = -1; return; }
        int dev = 0, cus = 0, per_cu = 0;
        if (hipGetDevice(&dev) != hipSuccess || hipDeviceGetAttribute(&cus, hipDeviceAttributeMultiprocessorCount, dev) != hipSuccess) { grid = -1; return; }
        if (hipFuncSetAttribute((const void*)mk_fwd, hipFuncAttributeMaxDynamicSharedMemorySize, LDS_BYTES) != hipSuccess) { fprintf(stderr, "kernel_launch: hipFuncSetAttribute failed\n"); grid = -1; return; }
        if (hipOccupancyMaxActiveBlocksPerMultiprocessor(&per_cu, (const void*)mk_fwd, NTHR, LDS_BYTES) != hipSuccess || per_cu < 1) fprintf(stderr, "kernel_launch: occupancy query says %d\n", per_cu);
        (void)hipGetLastError();
        grid = cus;
    }
    if (grid < 0) return;
    if (hipMemsetAsync((char*)d_ws + WS_CTL, 0, CTL_ZERO_BYTES, stream) != hipSuccess) return;
    if (hipMemsetAsync((char*)d_ws + WS_SSQ, 0, SSQ_BYTES, stream) != hipSuccess) return;
    Args a{};
    for (int i = 0; i < 28; ++i) a.in[i] = (const float*)d_in[i];
    a.out = (float*)d_out; a.ws = (unsigned char*)d_ws;
#if MK_ONE_LAUNCH
    a.ph_lo = 0; a.ph_hi = NPHASE;
    hipLaunchKernelGGL(mk_fwd, dim3(grid), dim3(NTHR), LDS_BYTES, stream, a);
#else
    for (int ph = 0; ph < NPHASE; ++ph) { a.ph_lo = ph; a.ph_hi = ph + 1; hipLaunchKernelGGL(mk_fwd, dim3(grid), dim3(NTHR), LDS_BYTES, stream, a); }
#endif
}
```

```cpp
#include <hip/hip_runtime.h>
#include <cstdio>
#include <cstdint>
namespace pg8 {
#define PG8_LAS __attribute__((address_space(3)))
typedef unsigned short bf16_t;
typedef short bf16x8 __attribute__((ext_vector_type(8)));
typedef float f32x4 __attribute__((ext_vector_type(4)));
typedef unsigned u32x4 __attribute__((ext_vector_type(4)));
constexpr int BM = 256, BK = 64, HALF = 128, HTB = HALF * BK * 2  , STAGE_BYTES = 8 * HTB, NXCD = 8, WGM = 8;

__host__ __device__ __forceinline__ int lds_byte(int r, int c) { const int st = (r >> 4) * 2 + (c >> 5), rr = r & 15, cc = c & 31, ob = rr * 64 + cc * 2; return st * 1024 + (ob ^ (((ob >> 9) & 1) << 5)); }
__host__ __device__ __forceinline__ void stage_rc(int b, int& R, int& C) { const int st = b / 1024, sb = b % 1024, swz = sb ^ (((sb >> 9) & 1) << 5); R = (st >> 1) * 16 + swz / 64; C = (st & 1) * 32 + (swz % 64) / 2; }
__host__ __device__ __forceinline__ int perm32(int rho) { const int n = rho >> 4, i = rho & 15; return 8 * (i >> 2) + 4 * n + (i & 3); }

struct Unit { int pm, pn; };
struct Gemm { const bf16_t* A; const bf16_t* Bt; int M, N, K; };

struct StaticOrder {
    int nM, nN, nwg, G, c;
    __host__ __device__ void init(int M, int N, int G_, int c_) { nM = M / BM; nN = N / BM; nwg = nM * nN; G = G_; c = c_; }
    __host__ __device__ bool next(int i, Unit& u) const {
        const long L = (long)i * G + c; if (L >= nwg) return false;
        int wgid = (int)L; { const int q = nwg / NXCD, r = nwg % NXCD, xcd = wgid % NXCD, off = wgid / NXCD; wgid = (xcd < r ? xcd * (q + 1) : r * (q + 1) + (xcd - r) * q) + off; }
        const int nig = WGM * nN, gid = wgid / nig, fm = gid * WGM, gsz = (nM - fm) < WGM ? (nM - fm) : WGM;
        u.pm = fm + ((wgid % nig) % gsz); u.pn = (wgid % nig) / gsz; return true;
    }
    __device__ __forceinline__ void a_ready(const Unit&) const {}
    __device__ __forceinline__ void done(const Unit&) const {}
};
__device__ __forceinline__ unsigned cvt_pk_bf16(float lo, float hi) { unsigned r; asm volatile("v_cvt_pk_bf16_f32 %0, %1, %2" : "=v"(r) : "v"(lo), "v"(hi)); return r; }
template <int ACT> struct EpiBf16 {
    static constexpr bool PERM = true, AFTER_DRAIN = false, HAS_PRE = true;
    bf16_t* O; int ldc; const unsigned long long* SS; PG8_LAS float* tbl;
    template <class Sched> __device__ __forceinline__ void pre_all(const Sched& S, int tid) const {
        unsigned long long v[12]; Unit u;
#pragma unroll
        for (int i = 0; i < 12; ++i) { v[i] = 0ull; if (S.next(i, u)) v[i] = SS[u.pm * BM + (tid & 255)]; }
#pragma unroll
        for (int i = 0; i < 12; ++i) if (tid < 256 && S.next(i, u)) tbl[i * 256 + tid] = 1.f / sqrtf((float)v[i] * (1.f / 1048576.f / 2048.f) + 1e-6f);
    }
    __device__ __forceinline__ void operator()(const f32x4 (&acc)[2][2][4][2], const Unit& u, int wr, int wc, int fr, int fq, int slot) const {
        const int row0 = u.pm * BM + wr * 64 + fr; const int col0 = u.pn * BM + wc * 64 + 8 * fq;
        const unsigned ta = (unsigned)(size_t)(tbl + slot * 256 + wr * 64 + fr);
        float rs[2][4];
#pragma unroll
        for (int ai = 0; ai < 2; ++ai)
#pragma unroll
            for (int m = 0; m < 4; ++m) asm volatile("ds_read_b32 %0, %1 offset:%2" : "=v"(rs[ai][m]) : "v"(ta), "i"((ai * HALF + m * 16) * 4));
        asm volatile("s_waitcnt lgkmcnt(0)" : "+v"(rs[0][0]), "+v"(rs[0][1]), "+v"(rs[0][2]), "+v"(rs[0][3]), "+v"(rs[1][0]), "+v"(rs[1][1]), "+v"(rs[1][2]), "+v"(rs[1][3]));
#pragma unroll
        for (int ai = 0; ai < 2; ++ai)
#pragma unroll
            for (int m = 0; m < 4; ++m) { bf16_t* rowp = O + (size_t)(row0 + ai * HALF + m * 16) * ldc + col0; const float r = rs[ai][m];
                if (ACT == 2) {
                    const size_t row = (size_t)(row0 + ai * HALF + m * 16);
                    rowp = (u.pn < 12) ? O + ((size_t)((u.pn >> 2) * 16 + (u.pn & 3) * 4 + wc) * ldc + row) * 64 + 8 * fq
                                       : O + (size_t)48 * ldc * 64 + row * 1536 + (u.pn - 12) * 256 + wc * 64 + 8 * fq; }
#pragma unroll
                for (int bj = 0; bj < 2; ++bj) { f32x4 v0 = acc[ai][bj][m][0] * r, v1 = acc[ai][bj][m][1] * r;
                    if (ACT == 1) {
#pragma unroll
                        for (int j = 0; j < 4; ++j) { const float a = fmaxf(v0[j], 0.f), b = fmaxf(v1[j], 0.f); v0[j] = a * a; v1[j] = b * b; } }
                    u32x4 w; w.x = cvt_pk_bf16(v0[0], v0[1]); w.y = cvt_pk_bf16(v0[2], v0[3]); w.z = cvt_pk_bf16(v1[0], v1[1]); w.w = cvt_pk_bf16(v1[2], v1[3]);
                    *(u32x4*)(rowp + bj * 32) = w; } }
    }
};
struct EpiResid {
    static constexpr bool PERM = true, AFTER_DRAIN = false, HAS_PRE = false;
    const float* Xin0; const float* Xin1; int split; float* Xout; int ldc; bf16_t* XB; unsigned long long* SS;
    __device__ __forceinline__ void operator()(const f32x4 (&acc)[2][2][4][2], const Unit& u, int wr, int wc, int fr, int fq, int) const {
        const int row0 = u.pm * BM + wr * 64 + fr, col0 = u.pn * BM + wc * 64 + 8 * fq;
        const float* Xin = (u.pm * BM < split) ? Xin0 : Xin1 - (size_t)split * ldc;
#pragma unroll
        for (int am = 0; am < 4; ++am) { const int ai = am >> 1, m0 = (am & 1) * 2;
            f32x4 xf[2][2][2]; u32x4 xr[2][2];
            if (Xin0) {
#pragma unroll
                for (int mm = 0; mm < 2; ++mm) { const size_t ro = (size_t)(row0 + ai * HALF + (m0 + mm) * 16) * ldc + col0;
#pragma unroll
                    for (int bj = 0; bj < 2; ++bj) { xf[mm][bj][0] = *(const f32x4*)(Xin + ro + bj * 32); xf[mm][bj][1] = *(const f32x4*)(Xin + ro + bj * 32 + 4); } }
            } else {
#pragma unroll
                for (int mm = 0; mm < 2; ++mm)
#pragma unroll
                    for (int bj = 0; bj < 2; ++bj) xr[mm][bj] = *(const u32x4*)(XB + (size_t)(row0 + ai * HALF + (m0 + mm) * 16) * ldc + col0 + bj * 32);
            }
            asm volatile("" ::: "memory");
#pragma unroll
            for (int mm = 0; mm < 2; ++mm) { const int m = m0 + mm; const int row = row0 + ai * HALF + m * 16; const size_t ro = (size_t)row * ldc + col0; float ss = 0.f;
#pragma unroll
                for (int bj = 0; bj < 2; ++bj) { f32x4 x0, x1;
                    if (Xin0) { x0 = xf[mm][bj][0]; x1 = xf[mm][bj][1]; }
                    else { const u32x4 w = xr[mm][bj];
                        x0 = (f32x4){__uint_as_float(w.x << 16), __uint_as_float(w.x & 0xffff0000u), __uint_as_float(w.y << 16), __uint_as_float(w.y & 0xffff0000u)};
                        x1 = (f32x4){__uint_as_float(w.z << 16), __uint_as_float(w.z & 0xffff0000u), __uint_as_float(w.w << 16), __uint_as_float(w.w & 0xffff0000u)}; }
                    x0 = x0 + acc[ai][bj][m][0]; x1 = x1 + acc[ai][bj][m][1];
                    if (Xout) { *(f32x4*)(Xout + ro + bj * 32) = x0; *(f32x4*)(Xout + ro + bj * 32 + 4) = x1; }
                    else { u32x4 w; w.x = cvt_pk_bf16(x0[0], x0[1]); w.y = cvt_pk_bf16(x0[2], x0[3]); w.z = cvt_pk_bf16(x1[0], x1[1]); w.w = cvt_pk_bf16(x1[2], x1[3]); *(u32x4*)(XB + ro + bj * 32) = w;
#pragma unroll
                        for (int j = 0; j < 4; ++j) { const float lo = __uint_as_float(w[j] << 16), hi = __uint_as_float(w[j] & 0xffff0000u); ss += lo * lo + hi * hi; } } }
                if (!Xout) { ss += __shfl_xor(ss, 16); ss += __shfl_xor(ss, 32); if (fq == 0) atomicAdd(SS + row, (unsigned long long)(ss * 1048576.f + 0.5f)); } }
            asm volatile("" ::: "memory");
        }
    }
};
struct EpiGlu {
    static constexpr bool PERM = true, AFTER_DRAIN = false, HAS_PRE = false;
    const bf16_t* YG; bf16_t* Y; const float* bias; int ldy; int ycol0;
    __device__ __forceinline__ void operator()(const f32x4 (&acc)[2][2][4][2], const Unit& u, int wr, int wc, int fr, int fq, int) const {
        const int row0 = u.pm * BM + wr * 64 + fr; const int col0 = u.pn * BM + wc * 64 + 8 * fq;
        f32x4 bb[2][2];
#pragma unroll
        for (int bj = 0; bj < 2; ++bj) { bb[bj][0] = *(const f32x4*)(bias + col0 + bj * 32); bb[bj][1] = *(const f32x4*)(bias + col0 + bj * 32 + 4); }
#pragma unroll
        for (int ai = 0; ai < 2; ++ai) {
            u32x4 gl[4][2];
#pragma unroll
            for (int m = 0; m < 4; ++m)
#pragma unroll
                for (int bj = 0; bj < 2; ++bj) gl[m][bj] = *(const u32x4*)(YG + (size_t)(row0 + ai * HALF + m * 16) * 512 + col0 + bj * 32);
            asm volatile("" ::: "memory");
#pragma unroll
            for (int m = 0; m < 4; ++m) { const int row = row0 + ai * HALF + m * 16;
#pragma unroll
                for (int bj = 0; bj < 2; ++bj) { const int col = col0 + bj * 32; const u32x4 g = gl[m][bj];
                    const f32x4 v0 = acc[ai][bj][m][0] + bb[bj][0], v1 = acc[ai][bj][m][1] + bb[bj][1];
                    float o[8];
#pragma unroll
                    for (int j = 0; j < 4; ++j) { const unsigned gw0 = g[j >> 1], gw1 = g[2 + (j >> 1)];
                        const float y0 = __uint_as_float((j & 1) ? (gw0 & 0xffff0000u) : (gw0 << 16)), y1 = __uint_as_float((j & 1) ? (gw1 & 0xffff0000u) : (gw1 << 16));
                        o[j] = y0 * __builtin_amdgcn_rcpf(1.f + __expf(-v0[j])); o[4 + j] = y1 * __builtin_amdgcn_rcpf(1.f + __expf(-v1[j])); }
                    u32x4 w; w.x = cvt_pk_bf16(o[0], o[1]); w.y = cvt_pk_bf16(o[2], o[3]); w.z = cvt_pk_bf16(o[4], o[5]); w.w = cvt_pk_bf16(o[6], o[7]);
                    *(u32x4*)(Y + (size_t)row * ldy + ycol0 + col) = w; } }
            asm volatile("" ::: "memory");
        }
    }
};

template <class Epi, class Sched, bool ALIGN_EPI = false, bool SP2 = false>
__device__ __forceinline__ void gemm_phase(PG8_LAS unsigned char* lds, const Gemm g, const Sched& S, const Epi& E) {
    int tid_ = threadIdx.x; asm volatile("" : "+v"(tid_));
    const int tid = tid_, wid = __builtin_amdgcn_readfirstlane(tid >> 6), lane = tid & 63, wr = wid >> 2, wc = wid & 3, fr = lane & 15, fq = lane >> 4;
    const int K = g.K, nt = K / BK;
    unsigned voffA[2], voffB[2];
#pragma unroll
    for (int i = 0; i < 2; ++i) { int R, C; stage_rc(tid * 16 + i * 8192, R, C); const int Rb = Epi::PERM ? (64 * (R >> 5) + perm32(R & 31)) : R;
        voffA[i] = (unsigned)(R * K + C) * 2u; voffB[i] = (unsigned)(Rb * K + C) * 2u; }
    const size_t kstep = (size_t)(BK * 2);
    const size_t hstep = (size_t)HALF * K * 2;
    const size_t hstepB = Epi::PERM ? (size_t)32 * K * 2 : hstep;
    const size_t tstep = 2 * hstep;
    const unsigned ldsw = (unsigned)wid * 1024u;
    const int aoff = lds_byte(wr * 64 + fr, fq * 8), boff = lds_byte(wc * 32 + fr, fq * 8);
#define PG8_SA(b, h) (((b) * 2 + (h)) * HTB)
#define PG8_SB(b, h) ((4 + (b) * 2 + (h)) * HTB)
#define PG8_STAGE(bufoff, gbase, voff) do { _Pragma("unroll") for (int _i = 0; _i < 2; ++_i) \
        __builtin_amdgcn_global_load_lds((const unsigned*)((const char*)(gbase) + (voff)[_i]), (PG8_LAS unsigned*)(lds + (bufoff) + ldsw + _i * 8192), 16, 0, 0); } while (0)
#define PG8_LDA(dst, b, h) do { _Pragma("unroll") for (int m = 0; m < 4; ++m) _Pragma("unroll") for (int k = 0; k < 2; ++k) dst[m][k] = *(const PG8_LAS bf16x8*)(lds + PG8_SA(b, h) + aoff + m * 2048 + k * 1024); } while (0)
#define PG8_LDB(dst, b, h) do { _Pragma("unroll") for (int n = 0; n < 2; ++n) _Pragma("unroll") for (int k = 0; k < 2; ++k) dst[n][k] = *(const PG8_LAS bf16x8*)(lds + PG8_SB(b, h) + boff + n * 2048 + k * 1024); } while (0)
#define PG8_MMA(ai, bj, At, Bt) do { __builtin_amdgcn_s_setprio(1); _Pragma("unroll") for (int m = 0; m < 4; ++m) _Pragma("unroll") for (int n = 0; n < 2; ++n) _Pragma("unroll") for (int k = 0; k < 2; ++k) \
        acc[ai][bj][m][n] = __builtin_amdgcn_mfma_f32_16x16x32_bf16(Bt[n][k], At[m][k], acc[ai][bj][m][n], 0, 0, 0); __builtin_amdgcn_s_setprio(0); } while (0)
#define PG8_WAIT_V(n) asm volatile("s_waitcnt vmcnt(" #n ")" ::: "memory")
#define PG8_WAIT_L(n) asm volatile("s_waitcnt lgkmcnt(" #n ")" ::: "memory")
#define PG8_BAR __builtin_amdgcn_s_barrier()
#define PG8_SCHED __builtin_amdgcn_sched_barrier(0)
    Unit cur, nxt; int ui = 0;
    if (!S.next(0, cur)) return;
    if constexpr (Epi::HAS_PRE) E.pre_all(S, tid);
    f32x4 acc[2][2][4][2];
#pragma unroll
    for (int a = 0; a < 2; ++a)
#pragma unroll
        for (int b = 0; b < 2; ++b)
#pragma unroll
            for (int m = 0; m < 4; ++m)
#pragma unroll
                for (int n = 0; n < 2; ++n) acc[a][b][m][n] = (f32x4){0.f, 0.f, 0.f, 0.f};
    bf16x8 At[4][2], B0[2][2], B1[2][2];
    const char* cA = (const char*)g.A + (size_t)cur.pm * tstep; const char* cB = (const char*)g.Bt + (size_t)cur.pn * tstep;
    S.a_ready(cur);
    if constexpr (SP2) {
        PG8_STAGE(PG8_SB(0, 0), cB, voffB); PG8_STAGE(PG8_SB(0, 1), cB + hstepB, voffB); PG8_STAGE(PG8_SA(0, 0), cA, voffA); PG8_STAGE(PG8_SA(0, 1), cA + hstep, voffA);
        if (wr == 1) PG8_BAR;
        PG8_WAIT_V(2); PG8_BAR;
        PG8_STAGE(PG8_SB(1, 0), cB + kstep, voffB); PG8_STAGE(PG8_SA(1, 0), cA + kstep, voffA); PG8_STAGE(PG8_SB(1, 1), cB + hstepB + kstep, voffB);
        PG8_WAIT_V(6); PG8_BAR;
    } else {
        PG8_STAGE(PG8_SB(0, 0), cB, voffB); PG8_STAGE(PG8_SA(0, 0), cA, voffA); PG8_STAGE(PG8_SB(0, 1), cB + hstepB, voffB); PG8_STAGE(PG8_SA(0, 1), cA + hstep, voffA);
        if (wr == 1) PG8_BAR;
        PG8_WAIT_V(4); PG8_BAR;
        PG8_STAGE(PG8_SB(1, 0), cB + kstep, voffB); PG8_STAGE(PG8_SA(1, 0), cA + kstep, voffA); PG8_STAGE(PG8_SB(1, 1), cB + hstepB + kstep, voffB);
        PG8_WAIT_V(6); PG8_BAR;
    }
    for (;;) {
        const bool has_next = S.next(ui + 1, nxt);
        const char* nA = has_next ? (const char*)g.A + (size_t)nxt.pm * tstep : cA; const char* nB = has_next ? (const char*)g.Bt + (size_t)nxt.pn * tstep : cB;
        for (int t = 0; t < nt; t += 2) {
            const bool last = (t == nt - 2);
            const char* a1 = cA + (size_t)(t + 1) * kstep;
            const char* a2 = last ? nA : cA + (size_t)(t + 2) * kstep; const char* b2 = last ? nB : cB + (size_t)(t + 2) * kstep;
            const char* a3 = a2 + kstep; const char* b3 = b2 + kstep;
            if (last && has_next) S.a_ready(nxt);
            if constexpr (SP2) {
            PG8_LDB(B0, 0, 0); PG8_LDB(B1, 0, 1); PG8_SCHED; PG8_LDA(At, 0, 0); PG8_STAGE(PG8_SA(1, 1), a1 + hstep, voffA);
            PG8_WAIT_V(8); PG8_WAIT_L(0); PG8_BAR; PG8_MMA(0, 0, At, B0); PG8_MMA(0, 1, At, B1); PG8_BAR; PG8_SCHED;
            PG8_LDA(At, 0, 1); PG8_STAGE(PG8_SB(0, 0), b2, voffB); PG8_STAGE(PG8_SB(0, 1), b2 + hstepB, voffB); PG8_STAGE(PG8_SA(0, 0), a2, voffA);
            PG8_WAIT_V(8); PG8_WAIT_L(0); PG8_BAR; PG8_MMA(1, 0, At, B0); PG8_MMA(1, 1, At, B1); PG8_BAR; PG8_SCHED;
            PG8_LDB(B0, 1, 0); PG8_LDB(B1, 1, 1); PG8_SCHED; PG8_LDA(At, 1, 0); PG8_STAGE(PG8_SA(0, 1), a2 + hstep, voffA);
            PG8_WAIT_V(8); PG8_WAIT_L(0); PG8_BAR; PG8_MMA(0, 0, At, B0); PG8_MMA(0, 1, At, B1); PG8_BAR; PG8_SCHED;
            PG8_LDA(At, 1, 1); PG8_STAGE(PG8_SB(1, 0), b3, voffB); PG8_STAGE(PG8_SB(1, 1), b3 + hstepB, voffB); PG8_STAGE(PG8_SA(1, 0), a3, voffA);
            PG8_WAIT_V(8); PG8_WAIT_L(0); PG8_BAR; PG8_MMA(1, 0, At, B0); PG8_MMA(1, 1, At, B1); PG8_BAR; PG8_SCHED;
            } else {
            PG8_LDB(B0, 0, 0); PG8_SCHED; PG8_LDA(At, 0, 0); PG8_STAGE(PG8_SA(1, 1), a1 + hstep, voffA);
            PG8_WAIT_L(8); PG8_BAR; PG8_WAIT_L(0); PG8_MMA(0, 0, At, B0); PG8_BAR; PG8_SCHED;
            PG8_LDB(B1, 0, 1); PG8_STAGE(PG8_SB(0, 0), b2, voffB);
            PG8_BAR; PG8_WAIT_L(0); PG8_MMA(0, 1, At, B1); PG8_BAR;
            PG8_LDA(At, 0, 1); PG8_STAGE(PG8_SA(0, 0), a2, voffA);
            PG8_BAR; PG8_WAIT_L(0); PG8_MMA(1, 0, At, B0); PG8_BAR; PG8_SCHED;
            PG8_STAGE(PG8_SB(0, 1), b2 + hstepB, voffB);
            PG8_WAIT_V(6); PG8_BAR; PG8_MMA(1, 1, At, B1); PG8_BAR;
            PG8_LDB(B0, 1, 0); PG8_SCHED; PG8_LDA(At, 1, 0); PG8_STAGE(PG8_SA(0, 1), a2 + hstep, voffA);
            PG8_WAIT_L(8); PG8_BAR; PG8_WAIT_L(0); PG8_MMA(0, 0, At, B0); PG8_BAR; PG8_SCHED;
            PG8_LDB(B1, 1, 1); PG8_STAGE(PG8_SB(1, 0), b3, voffB);
            PG8_BAR; PG8_WAIT_L(0); PG8_MMA(0, 1, At, B1); PG8_BAR;
            PG8_LDA(At, 1, 1); PG8_STAGE(PG8_SA(1, 0), a3, voffA);
            PG8_BAR; PG8_WAIT_L(0); PG8_MMA(1, 0, At, B0); PG8_BAR; PG8_SCHED;
            PG8_STAGE(PG8_SB(1, 1), b3 + hstepB, voffB);
            PG8_WAIT_V(6); PG8_BAR; PG8_MMA(1, 1, At, B1); PG8_BAR;
            }
        }
        if constexpr (ALIGN_EPI) { if (wr == 0) PG8_BAR; }
        if constexpr (!Epi::AFTER_DRAIN) { E(acc, cur, wr, wc, fr, fq, ui); S.done(cur); }
        if (!has_next) break;
#pragma unroll
        for (int a = 0; a < 2; ++a)
#pragma unroll
            for (int b = 0; b < 2; ++b)
#pragma unroll
                for (int m = 0; m < 4; ++m)
#pragma unroll
                    for (int n = 0; n < 2; ++n) acc[a][b][m][n] = (f32x4){0.f, 0.f, 0.f, 0.f};
        cur = nxt; cA = nA; cB = nB; ++ui;
        if constexpr (ALIGN_EPI) { if (wr == 1) PG8_BAR; }
    }
    PG8_WAIT_V(0);
    if constexpr (!ALIGN_EPI) { if (wr == 0) PG8_BAR; }
    PG8_BAR;
    if constexpr (Epi::AFTER_DRAIN) { E.fused(acc, cur, wr, wc, fr, fq, lds, wid, lane); S.done(cur); }
#undef PG8_SA
#undef PG8_SB
#undef PG8_STAGE
#undef PG8_LDA
#undef PG8_LDB
#undef PG8_MMA
#undef PG8_WAIT_V
#undef PG8_WAIT_L
#undef PG8_BAR
#undef PG8_SCHED
}
}

#ifndef MK_ONE_LAUNCH
#define MK_ONE_LAUNCH 1
#endif
#ifndef PROBE_GN2
#define PROBE_GN2 0
#endif
#ifndef PROBE_FIN2
#define PROBE_FIN2 0
#endif
#ifndef PROBE_CAR2
#define PROBE_CAR2 0
#endif
#ifndef PROBE_BAR2
#define PROBE_BAR2 0
#endif
#ifndef PROBE_WIN2
#define PROBE_WIN2 0
#endif
#ifndef PROBE_GLU2
#define PROBE_GLU2 0
#endif
#ifndef PROBE_WOUT2
#define PROBE_WOUT2 0
#endif
#ifndef PROBE_DN2
#define PROBE_DN2 0
#endif
#ifndef PROBE_UP2
#define PROBE_UP2 0
#endif
#ifndef PROBE_PRO2
#define PROBE_PRO2 0
#endif
#ifndef PROBE_NA2
#define PROBE_NA2 0
#endif
#ifndef PROBE_SCAN2
#define PROBE_SCAN2 0
#endif
constexpr int NWAVES = 8, NTHR = 512;
constexpr int DM = 2048, NTOK = 40960, ZW = 4608, DFF = 8192, DEPTH = 4;
constexpr int ZK = 1024, ZV = 2048, ZXR = 3072, ZGT = 3584, ZXS = 4096;
constexpr int MLPC = 8192, NMLPC = NTOK / MLPC;
constexpr int LCH = 32, NLCH = NTOK / LCH;
constexpr int SCH = 64, NSCH = NTOK / SCH;
constexpr float EPS = 1e-6f;
constexpr int PH_PER_LAYER = 14, NPHASE = DEPTH * PH_PER_LAYER + 1;

constexpr size_t MiB = 1u << 20;
constexpr size_t WS_CTL = 0, CTL_ZERO_BYTES = 2 * MiB;
constexpr size_t WS_SS = 65536;
constexpr size_t WS_WIN = 2 * MiB, WS_WOUT = 20 * MiB, WS_WUP = 28 * MiB, WS_WDN = 60 * MiB, WS_WGLU = 92 * MiB;
constexpr size_t WS_TLB = 93 * MiB;
constexpr size_t WS_TBB = 93 * MiB + 65536;
constexpr size_t WS_H = 96 * MiB;
constexpr size_t WS_ZR = 256 * MiB + (size_t)48 * NTOK * 64 * 2;
constexpr int ZRW = 1536, RXR = 0, RGT = 512, RXS = 1024;
constexpr size_t WS_Z = 256 * MiB;
constexpr size_t WS_Y = 616 * MiB;
constexpr size_t WS_YG = 776 * MiB;
constexpr size_t WS_HF = 816 * MiB;
constexpr size_t WS_TBBF = 94 * MiB;
constexpr size_t WS_TCF = 94 * MiB + 524288;
constexpr size_t WS_TWF = 95 * MiB;
constexpr size_t WS_LAGG = 896 * MiB;
constexpr size_t WS_LCIN = 906 * MiB;
constexpr size_t WS_SEND = 912 * MiB;
constexpr size_t WS_SCIN = 932 * MiB;
constexpr size_t WS_SSQ = 952 * MiB, SSQ_BYTES = (size_t)DEPTH * 2 * NTOK * 8;
constexpr size_t WS_END = 956 * MiB;
constexpr int CW_BAR = 4096;

constexpr int RING_OFF = 0, RING_BYTES = 131072;
constexpr int XTRA_OFF = RING_BYTES, XTRA_BYTES = 12288;
constexpr int LDSCTL_OFF = 163840 - 1024, MISC_OFF = LDSCTL_OFF + 320;
constexpr int LDS_BYTES = 163840;
static_assert(MISC_OFF + 128 <= LDS_BYTES, "LDS map");

#define GAS __attribute__((address_space(1)))
#define LAS __attribute__((address_space(3)))
typedef unsigned short bf16;
typedef unsigned v4u __attribute__((ext_vector_type(4)));
typedef unsigned v2u __attribute__((ext_vector_type(2)));
typedef float f32x4 __attribute__((ext_vector_type(4)));
typedef float f32x2 __attribute__((ext_vector_type(2)));
#define LDS_WAIT() asm volatile("s_waitcnt lgkmcnt(0)" ::: "memory")
#define VM_WAIT() asm volatile("s_waitcnt vmcnt(0)" ::: "memory")
__device__ __forceinline__ unsigned f2bf(float f) { unsigned u = __builtin_bit_cast(unsigned, f); return (u + 0x7fffu + ((u >> 16) & 1u)) >> 16; }
typedef __bf16 bf16x2_t __attribute__((ext_vector_type(2)));
__device__ __forceinline__ unsigned pk2(float lo, float hi) { const f32x2 v = {lo, hi}; return __builtin_bit_cast(unsigned, __builtin_convertvector(v, bf16x2_t)); }
__device__ __forceinline__ unsigned pk2s(float lo, float hi) { return f2bf(lo) | (f2bf(hi) << 16); }
__device__ __forceinline__ float frcp(float x) { return __builtin_amdgcn_rcpf(x); }
__device__ __forceinline__ float fsqrt_(float x) { return __builtin_amdgcn_sqrtf(x); }
__device__ __forceinline__ float bf2f(unsigned b) { return __builtin_bit_cast(float, b << 16); }
__device__ __forceinline__ float bflo(unsigned w) { return __builtin_bit_cast(float, w << 16); }
__device__ __forceinline__ float bfhi(unsigned w) { return __builtin_bit_cast(float, w & 0xffff0000u); }
__device__ __forceinline__ float wave_sum(float v) {
#pragma unroll
    for (int o = 1; o < 64; o <<= 1) v += __shfl_xor(v, o);
    return v;
}
__device__ __forceinline__ float wave_max(float v) {
#pragma unroll
    for (int o = 1; o < 64; o <<= 1) v = fmaxf(v, __shfl_xor(v, o));
    return v;
}
__device__ __forceinline__ float sigmoidf_(float x) { return frcp(1.f + __expf(-x)); }
__device__ __forceinline__ float gelu_tanh(float x) { const float y = 0.7978845608028654f * (x + 0.044715f * x * x * x); const float e = __expf(2.f * y); return x - x * frcp(e + 1.f); }
__device__ __forceinline__ void seq_of(int tok, int& s0, int& T) { if (tok < 8192) { s0 = tok & ~2047; T = 2048; } else { s0 = 8192 + ((tok - 8192) & ~16383); T = 16384; } }

#define XB_TMO      128
#define XB_XCNT(j)  (256  + 64 * (j))
#define XB_XSUB(j)  (1280 + 64 * (j))
#define XB_XGEN(j)  (2304 + 64 * (j))
#define XB_TOP      3328
#define XB_TOPGEN   3392
#define XCD_BAR_WORDS 3456
#define XB_SPIN_CAP (1u << 18)

__device__ __forceinline__ unsigned xb_ld(unsigned* p)              { return __hip_atomic_load(p, __ATOMIC_RELAXED, __HIP_MEMORY_SCOPE_AGENT); }
__device__ __forceinline__ unsigned xb_add(unsigned* p, unsigned v) { return __hip_atomic_fetch_add(p, v, __ATOMIC_RELAXED, __HIP_MEMORY_SCOPE_AGENT); }
__device__ __forceinline__ unsigned xb_xcc_id() { return (unsigned)__builtin_amdgcn_s_getreg((3 << 11) | 20) & 0xFu; }
#define XB_SPIN(cond, bar) do { unsigned _sp = 0; while (cond) { __builtin_amdgcn_s_sleep(1); \
    if ((++_sp & 255u) == 0u) { if (xb_ld(&(bar)[XB_TMO])) break; if (_sp > XB_SPIN_CAP) { atomicAdd(&(bar)[XB_TMO], 1u); break; } } } } while (0)

struct XcdBarrier {
    unsigned* bar; unsigned x;
    volatile LAS unsigned* st;
};

__device__ __forceinline__ XcdBarrier xcd_barrier_post(unsigned* bar, volatile LAS unsigned* st) {
    XcdBarrier b; b.bar = bar; b.x = xb_xcc_id(); b.st = st;
    if (threadIdx.x == 0) (void)xb_add(&bar[XB_XCNT(b.x)], 1u);
    return b;
}
__device__ __forceinline__ void xcd_barrier_complete(unsigned* bar, unsigned x, unsigned& nloc, unsigned& nx) {
    const unsigned G = gridDim.x * gridDim.y * gridDim.z;
    unsigned sum, cnt, mine, sp = 0u;
    for (;;) {
        sum = 0u; cnt = 0u; mine = 0u;
#pragma unroll
        for (unsigned j = 0; j < 16; ++j) { const unsigned c = xb_ld(&bar[XB_XCNT(j)]); sum += c; cnt += (c > 0u) ? 1u : 0u; mine = (j == x) ? c : mine; }
        if (sum == G) break;
        __builtin_amdgcn_s_sleep(1);
        if ((++sp & 255u) == 0u) { if (xb_ld(&bar[XB_TMO])) break; if (sp > XB_SPIN_CAP) { atomicAdd(&bar[XB_TMO], 1u); break; } }
    }
    nloc = mine > 0u ? mine : 1u; nx = cnt > 0u ? cnt : 1u;
}

__device__ __forceinline__ void xcd_barrier(const XcdBarrier& b) {
    asm volatile("s_waitcnt vmcnt(0)" ::: "memory");
    __syncthreads();
    if (threadIdx.x == 0) {
        unsigned* bar = b.bar;
        __builtin_amdgcn_s_waitcnt(0);
        unsigned nloc = b.st[0], nx = b.st[1];
        if (nloc == 0u) { xcd_barrier_complete(bar, b.x, nloc, nx); b.st[0] = nloc; b.st[1] = nx; }
        const unsigned old = xb_add(&bar[XB_XSUB(b.x)], 1u);
        const unsigned gen = old / nloc;
        if (old + 1u == (gen + 1u) * nloc) {
            __builtin_amdgcn_fence(__ATOMIC_RELEASE, "agent");
            asm volatile("s_waitcnt vmcnt(0)" ::: "memory");
            const unsigned og = xb_add(&bar[XB_TOP], 1u);
            const unsigned tg = og / nx;
            if (og + 1u == (tg + 1u) * nx) xb_add(&bar[XB_TOPGEN], 1u);
            else XB_SPIN(xb_ld(&bar[XB_TOPGEN]) == tg, bar);
            __builtin_amdgcn_fence(__ATOMIC_ACQUIRE, "agent");
            xb_add(&bar[XB_XGEN(b.x)], 1u);
            asm volatile("s_waitcnt vmcnt(0)" ::: "memory");
        } else {
            XB_SPIN(xb_ld(&bar[XB_XGEN(b.x)]) == gen, bar);
            __builtin_amdgcn_fence(__ATOMIC_ACQUIRE, "agent");
            asm volatile("s_waitcnt vmcnt(0)" ::: "memory");
        }
    }
    __syncthreads();
}


struct Args { const float* in[28]; float* out; unsigned char* ws; int ph_lo, ph_hi; };
struct Frame {
    LAS unsigned char* lds; unsigned char* ldsg;
    int tid, lane, wave, vcu, G;
};
enum { I_XP = 0, I_XS, I_NMG, I_WIN, I_RPB, I_CW, I_CB, I_LWA, I_LBA, I_LWX, I_LBX, I_LAM, I_ARE, I_AIM, I_LDT, I_BRE, I_BIM, I_CRE, I_CIM, I_SD, I_WGLU, I_BGLU, I_GOUT, I_WOUT, I_NLG, I_WUP, I_WDN, I_FING };

__device__ __forceinline__ void transpose_item(const float* W, int K, int N, bf16* WT, LAS float* scr, int item, int lane, const float* gk) {
    const int nblk = N / 32, kb = item / nblk, nb = item % nblk, k0 = 64 * kb, n0 = 32 * nb;
    float wv[32];
#pragma unroll
    for (int i = 0; i < 32; ++i) wv[i] = W[(size_t)(k0 + 2 * i + (lane >> 5)) * N + n0 + (lane & 31)];
    if (gk) {
#pragma unroll
        for (int i = 0; i < 32; ++i) wv[i] *= gk[k0 + 2 * i + (lane >> 5)]; }
#pragma unroll
    for (int i = 0; i < 32; ++i) scr[(2 * i + (lane >> 5)) * 33 + (lane & 31)] = wv[i];
    LDS_WAIT();
    const int c = lane & 7;
#pragma unroll
    for (int j = 0; j < 4; ++j) { const int n = (lane >> 3) + 8 * j; const LAS float* s = scr + (8 * c) * 33 + n;
        v4u o; o.x = pk2(s[0 * 33], s[1 * 33]); o.y = pk2(s[2 * 33], s[3 * 33]); o.z = pk2(s[4 * 33], s[5 * 33]); o.w = pk2(s[6 * 33], s[7 * 33]);
        *(v4u*)(WT + (size_t)(n0 + n) * K + k0 + 8 * c) = o; }
    LDS_WAIT();
}

__device__ __forceinline__ void xb_row(const float* xrow, bf16* orow, unsigned long long* ss, int lane) {
    const f32x4* xr = (const f32x4*)xrow + lane; f32x4 v[8]; float s = 0.f;
#pragma unroll
    for (int j = 0; j < 8; ++j) { v[j] = xr[64 * j]; s += (v[j].x * v[j].x + v[j].y * v[j].y) + (v[j].z * v[j].z + v[j].w * v[j].w); }
    s = wave_sum(s); if (lane == 0) *ss = (unsigned long long)(s * 1048576.f + 0.5f);
    v2u* o8 = (v2u*)orow + lane;
#pragma unroll
    for (int j = 0; j < 8; ++j) { v2u o; o.x = pk2(v[j].x, v[j].y); o.y = pk2(v[j].z, v[j].w); o8[64 * j] = o; }
}

__device__ __forceinline__ void norm_row_bf16(const float* xrow, const float* g, bf16* orow, int lane) {
    const f32x4* xr = (const f32x4*)xrow + lane; const f32x4* gr = (const f32x4*)g + lane;
    f32x4 v[8]; float s = 0.f;
#pragma unroll
    for (int j = 0; j < 8; ++j) { v[j] = xr[64 * j]; s += (v[j].x * v[j].x + v[j].y * v[j].y) + (v[j].z * v[j].z + v[j].w * v[j].w); }
    const float rstd = 1.f / sqrtf(wave_sum(s) * (1.f / DM) + EPS);
    v2u* o8 = (v2u*)orow + lane;
#pragma unroll
    for (int j = 0; j < 8; ++j) { const f32x4 gg = gr[64 * j]; v2u o; o.x = pk2(v[j].x * rstd * gg.x, v[j].y * rstd * gg.y); o.y = pk2(v[j].z * rstd * gg.z, v[j].w * rstd * gg.w); o8[64 * j] = o; }
}
__device__ __forceinline__ const float* x_row(const Args& a, int l, int row) {
    if (l == 0) return row < 8192 ? a.in[I_XP] + (size_t)row * DM : a.in[I_XS] + (size_t)(row - 8192) * DM;
    return a.out + (size_t)row * DM;
}

__device__ __forceinline__ void ph_prologue(const Args& a, const Frame& F, int l) {
    int tid = threadIdx.x; asm volatile("" : "+v"(tid)); int lane = tid & 63; (void)lane;
    LAS float* scr = (LAS float*)(F.lds + RING_OFF + F.wave * 16384);
    const int gw = F.vcu * NWAVES + F.wave, NGW = F.G * NWAVES;
    constexpr int I_IN = (DM / 64) * (ZW / 32), I_OUT = (DM / 64) * (DM / 32), I_UP = (DM / 64) * (DFF / 32), I_DN = (DFF / 64) * (DM / 32), I_GL = (512 / 64) * (512 / 32);
    constexpr int NITEMS = I_IN + I_OUT + I_UP + I_DN + I_GL;
    unsigned char* ws = a.ws;
    for (int it = gw; it < NITEMS; it += NGW) {
        int r = it;
        if (r < I_IN) { transpose_item(a.in[I_WIN] + (size_t)l * DM * ZW, DM, ZW, (bf16*)(ws + WS_WIN), scr, r, lane, a.in[I_NMG] + (size_t)l * DM); continue; } r -= I_IN;
        if (r < I_OUT) { transpose_item(a.in[I_WOUT] + (size_t)l * DM * DM, DM, DM, (bf16*)(ws + WS_WOUT), scr, r, lane, nullptr); continue; } r -= I_OUT;
        if (r < I_UP) { transpose_item(a.in[I_WUP] + (size_t)l * DM * DFF, DM, DFF, (bf16*)(ws + WS_WUP), scr, r, lane, a.in[I_NLG] + (size_t)l * DM); continue; } r -= I_UP;
        if (r < I_DN) { transpose_item(a.in[I_WDN] + (size_t)l * DFF * DM, DFF, DM, (bf16*)(ws + WS_WDN), scr, r, lane, nullptr); continue; } r -= I_DN;
        transpose_item(a.in[I_WGLU] + (size_t)l * 512 * 512, 512, 512, (bf16*)(ws + WS_WGLU), scr, r, lane, nullptr);
    }
    { const int gt = F.vcu * NTHR + tid;
      if (gt < 4096) {
        const int dir = gt >> 11, g = (gt >> 6) & 31, p = gt & 63; const size_t ix = ((size_t)(l * 2 + dir) * 32 + g) * 64 + p;
        const double are = (double)a.in[I_ARE][ix], aim = (double)a.in[I_AIM][ix]; const double ldt = (double)a.in[I_LDT][(l * 2 + dir) * 32 + g];
        double e = 1.0; { const double x8 = ldt * 0.125; for (int n = 20; n >= 1; --n) e = 1.0 + e * x8 / (double)n; e = e * e; e = e * e; e = e * e; }
        const double dt = e;
        double mag = 1.0; { const double x = are * dt; for (int n = 14; n >= 1; --n) mag = 1.0 + mag * x / (double)n; }
        const double th = aim * dt; const double kq = __builtin_rint(th * 0.15915494309189535); const double r = th - kq * 6.283185307179586476925;
        const double r2 = r * r; double c = 1.0, s = 1.0;
        for (int n = 15; n >= 1; --n) { c = 1.0 - c * r2 / (double)((2 * n - 1) * (2 * n)); s = 1.0 - s * r2 / (double)((2 * n) * (2 * n + 1)); }
        s *= r;
        const double lbr = mag * c, lbi = mag * s, den = are * are + aim * aim, nre = lbr - 1.0, nim = lbi;
        const double cor = (nre * are + nim * aim) / den, coi = (nim * are - nre * aim) / den;
        float* tlb = (float*)(ws + WS_TLB) + (size_t)gt * 2; tlb[0] = (float)lbr; tlb[1] = (float)lbi;
        float* tbb = (float*)(ws + WS_TBB) + (size_t)gt * 32; const float* bre = a.in[I_BRE] + ix * 16; const float* bim = a.in[I_BIM] + ix * 16;
        bf16* bbf = (bf16*)(ws + WS_TBBF);
        for (int h = 0; h < 16; ++h) { const double br = (double)bre[h], bi = (double)bim[h]; const float vr = (float)(cor * br - coi * bi), vi = (float)(cor * bi + coi * br); tbb[h] = vr; tbb[16 + h] = vi;
            const int n = p & 15, gk0 = h >> 3, j = h & 7;
            const unsigned hr = f2bf(vr), hi_ = f2bf(vi); const unsigned lr = f2bf(vr - bf2f(hr)), li = f2bf(vi - bf2f(hi_));
            const size_t fr = ((size_t)((dir * 32 + g) * 8 + (p >> 4)) * 64) * 8, fi = ((size_t)((dir * 32 + g) * 8 + 4 + (p >> 4)) * 64) * 8;
            bbf[fr + (size_t)(n + 16 * gk0) * 8 + j] = (bf16)hr; bbf[fr + (size_t)(n + 16 * (gk0 + 2)) * 8 + j] = (bf16)lr;
            bbf[fi + (size_t)(n + 16 * gk0) * 8 + j] = (bf16)hi_; bbf[fi + (size_t)(n + 16 * (gk0 + 2)) * 8 + j] = (bf16)li; }
      } else if (gt < 4096 + 16384) {
        const int e = gt - 4096, lane_ = e & 63, ks = (e >> 6) & 3, g = (e >> 8) & 31, dir = e >> 13; const int h = lane_ & 15, gk = lane_ >> 4;
        const float* cre = a.in[I_CRE] + (((size_t)(l * 2 + dir) * 32 + g) * 16 + h) * 64; const float* cim = a.in[I_CIM] + (((size_t)(l * 2 + dir) * 32 + g) * 16 + h) * 64;
        bf16* cf = (bf16*)(ws + WS_TCF) + (size_t)e * 8;
        for (int j = 0; j < 8; ++j) { const int P = 16 * (j >> 1) + 4 * ks + gk; cf[j] = (bf16)f2bf((j & 1) ? -cim[P] : cre[P]); }
      } else if (gt >= 20480 && gt < 20480 + 16384) {
        const int e = gt - 20480, lane_ = e & 63, ks = (e >> 6) & 1, cb = (e >> 7) & 3, mat = (e >> 9) & 1, nb = (e >> 10) & 7, dir = e >> 13; const int n = lane_ & 15, gk = lane_ >> 4;
        const float* W = a.in[mat ? I_LWX : I_LWA] + ((size_t)(l * 2 + dir) * 8 + nb) * 4096 + (size_t)(32 * ks + 8 * gk) * 64 + 16 * cb + n;
        bf16* wf = (bf16*)(ws + WS_TWF) + (size_t)e * 8;
        for (int j = 0; j < 8; ++j) wf[j] = (bf16)f2bf(W[j * 64]);
      } }
    if (l == 0) { bf16* XB = (bf16*)(ws + WS_H); unsigned long long* SS = (unsigned long long*)(ws + WS_SSQ);
        for (int m0 = gw; m0 < NTOK; m0 += 2 * NGW) {
            f32x4 v[2][8];
#pragma unroll
            for (int r = 0; r < 2; ++r) { const int m = m0 + r * NGW; const f32x4* xr = (const f32x4*)x_row(a, 0, m < NTOK ? m : m0) + lane;
#pragma unroll
                for (int j = 0; j < 8; ++j) v[r][j] = xr[64 * j]; }
#pragma unroll
            for (int r = 0; r < 2; ++r) { const int m = m0 + r * NGW; float sq = 0.f;
#pragma unroll
                for (int j = 0; j < 8; ++j) sq += (v[r][j].x * v[r][j].x + v[r][j].y * v[r][j].y) + (v[r][j].z * v[r][j].z + v[r][j].w * v[r][j].w);
                sq = wave_sum(sq);
                if (m < NTOK) { if (lane == 0) SS[m] = (unsigned long long)(sq * 1048576.f + 0.5f);
                    v2u* o8 = (v2u*)(XB + (size_t)m * DM) + lane;
#pragma unroll
                    for (int j = 0; j < 8; ++j) { v2u o; o.x = pk2(v[r][j].x, v[r][j].y); o.y = pk2(v[r][j].z, v[r][j].w); o8[64 * j] = o; } } } } }

}

__device__ __forceinline__ void ph_na_simple(const Args& a, const Frame& F, int l) {
    int tid = threadIdx.x; asm volatile("" : "+v"(tid)); int lane = tid & 63; (void)lane;
    const bf16* Z = (const bf16*)(a.ws + WS_Z); bf16* Y = (bf16*)(a.ws + WS_Y);
    const float* rpb = a.in[I_RPB] + (size_t)l * 16 * 15 * 31;
    float* qs = (float*)(F.ldsg + RING_OFF) + F.wave * 64;
    const long U = (long)NTOK * 16; const long u0 = U * F.vcu / F.G, u1 = U * (F.vcu + 1) / F.G;
    for (long u = u0 + F.wave; u < u1; u += NWAVES) {
        const int tok = (int)(u >> 4), h = (int)(u & 15);
        int s0, T; seq_of(tok, s0, T); const int pos = tok - s0, r = pos >> 6, c = pos & 63, R = T >> 6;
        const int rs = min(max(r - 4, 0), R - 8), cs = min(max(c - 8, 0), 48);
        LDS_WAIT();
        qs[lane] = bf2f(Z[(size_t)tok * ZW + h * 64 + lane]);
        LDS_WAIT();
        float sc[2];
#pragma unroll
        for (int i = 0; i < 2; ++i) {
            const int kk = lane + 64 * i, krow = rs + (kk >> 4), kcol = cs + (kk & 15); const int ktok = s0 + krow * 64 + kcol;
            const v4u* kp = (const v4u*)(Z + (size_t)ktok * ZW + ZK + h * 64);
            float d = 0.f;
#pragma unroll
            for (int j = 0; j < 8; ++j) { const v4u w = kp[j]; const f32x4 q0 = *(const f32x4*)(qs + 8 * j), q1 = *(const f32x4*)(qs + 8 * j + 4);
                d += bflo(w.x) * q0.x + bfhi(w.x) * q0.y + bflo(w.y) * q0.z + bfhi(w.y) * q0.w + bflo(w.z) * q1.x + bfhi(w.z) * q1.y + bflo(w.w) * q1.z + bfhi(w.w) * q1.w; }
            sc[i] = d * 0.125f + rpb[(h * 15 + (krow - r + 7)) * 31 + (kcol - c + 15)];
        }
        const float m = wave_max(fmaxf(sc[0], sc[1])); const float p0 = __expf(sc[0] - m), p1 = __expf(sc[1] - m); const float sum = wave_sum(p0 + p1);
        float acc = 0.f;
        for (int kk = 0; kk < 128; ++kk) {
            const float p = __shfl(kk < 64 ? p0 : p1, kk & 63);
            const int krow = rs + (kk >> 4), kcol = cs + (kk & 15); const int vtok = s0 + krow * 64 + kcol;
            acc += p * bf2f(Z[(size_t)vtok * ZW + ZV + h * 64 + lane]);
        }
        Y[(size_t)tok * DM + h * 64 + lane] = (bf16)f2bf(acc / sum);
    }
}

typedef short s16x4_t __attribute__((ext_vector_type(4)));
__device__ __forceinline__ pg8::bf16x8 v_tr_pair(const LAS unsigned char* p) {
    const s16x4_t lo = __builtin_amdgcn_ds_read_tr16_b64_v4i16((LAS s16x4_t*)p), hi = __builtin_amdgcn_ds_read_tr16_b64_v4i16((LAS s16x4_t*)(p + 512));
    return __builtin_shufflevector(lo, hi, 0, 1, 2, 3, 4, 5, 6, 7);
}
__device__ __forceinline__ void glds16_asm(const void* gsrc, unsigned lds_dst) {
    unsigned keep;
    asm volatile("s_mov_b32 %0, m0\n\ts_mov_b32 m0, %2\n\ts_nop 0\n\tglobal_load_lds_dwordx4 %1, off\n\ts_mov_b32 m0, %0" : "=&s"(keep) : "v"(gsrc), "s"(lds_dst) : "memory");
}
__device__ __forceinline__ void ph_na_mfma(const Args& a, const Frame& F, int l) {
    int tid = threadIdx.x; asm volatile("" : "+v"(tid)); int lane = tid & 63; (void)lane;
    const bf16* Z = (const bf16*)(a.ws + WS_Z); bf16* Y = (bf16*)(a.ws + WS_Y);
    constexpr int KR = 0, VR = 73728, BIAS = 147456, MRG = 149504;
    LAS unsigned char* L = F.lds;
    const int w = F.wave, qt = w & 3, half = w >> 2, q = lane & 15, g = lane >> 4;
    const int c0 = 16 * qt, kc0 = (qt == 0) ? 0 : (qt == 1 ? 8 : (qt == 2 ? 24 : 32)), c = c0 + q, cs = min(max(c - 8, 0), 48);
    const int NIT = (NTOK / 64) * 16; const int i0 = (int)((long)NIT * F.vcu / F.G), i1 = (int)((long)NIT * (F.vcu + 1) / F.G);
#define NA_ITEM(it_, s0_, R_, h_, r_) do { if ((it_) < 2048) { const int _col = (it_) >> 5; r_ = (it_) & 31; R_ = 32; s0_ = (_col >> 4) * 2048; h_ = _col & 15; } \
        else { const int _j = (it_) - 2048, _col = _j >> 8; r_ = _j & 255; R_ = 256; s0_ = 8192 + (_col >> 4) * 16384; h_ = _col & 15; } } while (0)
#define NA_SWZ(col_) (((((col_) >> 3) & 3) << 1) | (((col_) >> 1) & 1))
#define NA_ROW_DMA(zoff_, row_, slotbase_) do { \
        _Pragma("unroll") for (int _j = 0; _j < 2; ++_j) { const int _col = c0 + 8 * _j + (lane >> 3); \
            const bf16* _gp = Z + ((size_t)((zoff_) / 64 + h) * NTOK + (s0 + (row_) * 64 + _col)) * 64 + (((lane & 7) ^ NA_SWZ(_col)) * 8); \
            glds16_asm(_gp, (unsigned)(size_t)(L + (slotbase_) + (c0 + 8 * _j) * 128)); } } while (0)
#define NA_BAR() asm volatile("s_barrier" ::: "memory")
    pg8::bf16x8 qn0, qn1;
    { int s0, R, h, r; NA_ITEM(i0, s0, R, h, r); const bf16* qp = Z + ((size_t)h * NTOK + (s0 + r * 64 + c)) * 64 + 8 * g; qn0 = *(const pg8::bf16x8*)qp; qn1 = *(const pg8::bf16x8*)(qp + 32); }
    v2u st0, st1, st2, st3; bf16* stp = Y;
    st0 = st1 = st2 = st3 = (v2u){0u, 0u};
    int it = i0;
    while (it < i1) {
        int s0, R, h, r0; NA_ITEM(it, s0, R, h, r0);
        const int m = min(R - r0, i1 - it);
        {
            const int rs = min(max(r0 - 4, 0), R - 8);
#pragma unroll
            for (int i = 0; i < 16; ++i) { const int id = w * 16 + i, t = id >> 6, ri = (id >> 3) & 7, j8 = id & 7, row = rs + ri;
                const int colw = 8 * j8 + (lane >> 3);
                const bf16* gp = Z + ((size_t)((t ? 32 : 16) + h) * NTOK + (s0 + row * 64 + colw)) * 64 + (((lane & 7) ^ NA_SWZ(colw)) * 8);
                glds16_asm(gp, (unsigned)(size_t)(L + (t ? VR : KR) + (row % 9) * 8192 + j8 * 1024)); }
            if (tid < 465) ((LAS float*)(L + BIAS))[tid] = a.in[I_RPB][((size_t)l * 16 + h) * 465 + tid];
            VM_WAIT(); LDS_WAIT();
            __syncthreads();
        }
        float ti[4][2][4];
        { const LAS float* bt = (const LAS float*)(L + BIAS);
#pragma unroll
          for (int kk = 0; kk < 4; ++kk)
#pragma unroll
              for (int blk = 0; blk < 2; ++blk)
#pragma unroll
                  for (int rg = 0; rg < 4; ++rg) { const int col = kc0 + 8 * g + 4 * blk + rg; const int dc = min(max(col - c + 15, 0), 30); const bool valid = (unsigned)(col - cs) < 16u;
                      ti[kk][blk][rg] = valid ? 8.f * bt[(kk + 4 * half + 3) * 31 + dc] : -INFINITY; } }
        if (half == 1) NA_BAR();
        for (int j = 0; j < m; ++j) {
            const int r = r0 + j, rs = min(max(r - 4, 0), R - 8);
            pg8::bf16x8 qf0 = qn0, qf1 = qn1;
            asm volatile("" : "+v"(qf0), "+v"(qf1) :: "memory");
            if (half == 1 && j > 0) { *(v2u*)(stp) = st0; *(v2u*)(stp + 16) = st1; *(v2u*)(stp + 32) = st2; *(v2u*)(stp + 48) = st3; }
            if (it + j + 1 < i1) {
                int s0n, Rn, hn, rn; NA_ITEM(it + j + 1, s0n, Rn, hn, rn);
                if (half == 0 && j + 1 < m) { const int rsn = min(max(rn - 4, 0), Rn - 8); if (rsn > rs) { NA_ROW_DMA(ZK, rsn + 7, KR + ((rsn + 7) % 9) * 8192); NA_ROW_DMA(ZV, rsn + 7, VR + ((rsn + 7) % 9) * 8192); } }
                const bf16* qp = Z + ((size_t)hn * NTOK + (s0n + rn * 64 + c)) * 64 + 8 * g; qn0 = *(const pg8::bf16x8*)qp; qn1 = *(const pg8::bf16x8*)(qp + 32);
            }
            const int tokrow0 = s0 + r * 64;
            f32x4 sc[4][2];
            pg8::bf16x8 kf[4][2][2];
#pragma unroll
            for (int kk = 0; kk < 4; ++kk) { const int row = rs + 4 * half + kk; const LAS unsigned char* kb = L + KR + (row % 9) * 8192;
#pragma unroll
                for (int blk = 0; blk < 2; ++blk) { const int col = kc0 + 8 * (q >> 2) + 4 * blk + (q & 3); const int sw = NA_SWZ(col);
                    kf[kk][blk][0] = *(const LAS pg8::bf16x8*)(kb + col * 128 + ((g ^ sw) * 16)); kf[kk][blk][1] = *(const LAS pg8::bf16x8*)(kb + col * 128 + (((4 + g) ^ sw) * 16)); } }
            const bool interior = (rs == r - 4);
            __builtin_amdgcn_sched_barrier(0);
#pragma unroll
            for (int kk = 0; kk < 4; ++kk)
#pragma unroll
                for (int blk = 0; blk < 2; ++blk) { f32x4 ini = (f32x4){0.f, 0.f, 0.f, 0.f};
                    if (interior) ini = (f32x4){ti[kk][blk][0], ti[kk][blk][1], ti[kk][blk][2], ti[kk][blk][3]};
                    sc[kk][blk] = __builtin_amdgcn_mfma_f32_16x16x32_bf16(kf[kk][blk][0], qf0, ini, 0, 0, 0); }
#pragma unroll
            for (int kk = 0; kk < 4; ++kk)
#pragma unroll
                for (int blk = 0; blk < 2; ++blk) sc[kk][blk] = __builtin_amdgcn_mfma_f32_16x16x32_bf16(kf[kk][blk][1], qf1, sc[kk][blk], 0, 0, 0);
            __builtin_amdgcn_sched_barrier(0);
            if (!interior) {
                const LAS float* bh = (const LAS float*)(L + BIAS) + (rs + 4 * half - r + 7) * 31;
#pragma unroll
                for (int blk = 0; blk < 2; ++blk)
#pragma unroll
                    for (int rg = 0; rg < 4; ++rg) { const int col = kc0 + 8 * g + 4 * blk + rg; const int dc = min(max(col - c + 15, 0), 30); const bool valid = (unsigned)(col - cs) < 16u;
#pragma unroll
                        for (int kk = 0; kk < 4; ++kk) sc[kk][blk][rg] = valid ? sc[kk][blk][rg] + 8.f * bh[kk * 31 + dc] : -INFINITY; }
            }
            float mx = -INFINITY;
#pragma unroll
            for (int kk = 0; kk < 4; ++kk)
#pragma unroll
                for (int blk = 0; blk < 2; ++blk)
#pragma unroll
                    for (int rg = 0; rg < 4; ++rg) mx = fmaxf(mx, sc[kk][blk][rg]);
            mx = fmaxf(mx, __shfl_xor(mx, 16)); mx = fmaxf(mx, __shfl_xor(mx, 32));
            LDS_WAIT();
            __syncthreads();
            pg8::bf16x8 vfr[4][4];
#pragma unroll
            for (int kk = 0; kk < 4; ++kk) { const int row = rs + 4 * half + kk;
                const int colv = kc0 + 8 * g + ((lane & 15) >> 2), sw0 = NA_SWZ(colv), sw1 = NA_SWZ(colv + 4), pq = lane & 3;
                const LAS unsigned char* vb0 = L + VR + (row % 9) * 8192 + colv * 128 + (pq & 1) * 8; const LAS unsigned char* vb1 = vb0 + 512;
#pragma unroll
                for (int db = 0; db < 4; ++db) { const int ch = 2 * db + (pq >> 1);
                    const s16x4_t lo = __builtin_amdgcn_ds_read_tr16_b64_v4i16((LAS s16x4_t*)(vb0 + ((ch ^ sw0) * 16))), hi = __builtin_amdgcn_ds_read_tr16_b64_v4i16((LAS s16x4_t*)(vb1 + ((ch ^ sw1) * 16)));
                    vfr[kk][db] = __builtin_shufflevector(lo, hi, 0, 1, 2, 3, 4, 5, 6, 7); } }
            __builtin_amdgcn_sched_barrier(0);
            pg8::bf16x8 pf[4];
            constexpr float CS = 0.125f * 1.4426950408889634f;
            const float nm = -mx * CS;
#pragma unroll
            for (int kk = 0; kk < 4; ++kk) { float p[8];
#pragma unroll
                for (int blk = 0; blk < 2; ++blk)
#pragma unroll
                    for (int rg = 0; rg < 4; ++rg) p[4 * blk + rg] = __builtin_amdgcn_exp2f(__builtin_fmaf(sc[kk][blk][rg], CS, nm));
                v4u wv; wv.x = pk2(p[0], p[1]); wv.y = pk2(p[2], p[3]); wv.z = pk2(p[4], p[5]); wv.w = pk2(p[6], p[7]); pf[kk] = __builtin_bit_cast(pg8::bf16x8, wv); }
            f32x4 osum = (f32x4){0.f, 0.f, 0.f, 0.f};
            { const v4u onesw = (v4u){0x3f803f80u, 0x3f803f80u, 0x3f803f80u, 0x3f803f80u}; const pg8::bf16x8 ones = __builtin_bit_cast(pg8::bf16x8, onesw);
#pragma unroll
              for (int kk = 0; kk < 4; ++kk) osum = __builtin_amdgcn_mfma_f32_16x16x32_bf16(ones, pf[kk], osum, 0, 0, 0); }
            const float sum = osum[0];
            f32x4 o[4];
#pragma unroll
            for (int db = 0; db < 4; ++db) o[db] = (f32x4){0.f, 0.f, 0.f, 0.f};
#pragma unroll
            for (int kk = 0; kk < 4; ++kk)
#pragma unroll
                for (int db = 0; db < 4; ++db) o[db] = __builtin_amdgcn_mfma_f32_16x16x32_bf16(vfr[kk][db], pf[kk], o[db], 0, 0, 0);
            LAS unsigned char* mg = L + MRG + (qt * 64 + lane) * 48;
            if (half == 0) {
                v4u w0, w1; w0.x = pk2(o[0][0], o[0][1]); w0.y = pk2(o[0][2], o[0][3]); w0.z = pk2(o[1][0], o[1][1]); w0.w = pk2(o[1][2], o[1][3]);
                w1.x = pk2(o[2][0], o[2][1]); w1.y = pk2(o[2][2], o[2][3]); w1.z = pk2(o[3][0], o[3][1]); w1.w = pk2(o[3][2], o[3][3]);
                *(LAS v4u*)mg = w0; *(LAS v4u*)(mg + 16) = w1; *(LAS f32x2*)(mg + 32) = (f32x2){mx, sum};
                VM_WAIT();
            } else {
                const v4u w0 = *(const LAS v4u*)mg, w1 = *(const LAS v4u*)(mg + 16); const f32x2 ml = *(const LAS f32x2*)(mg + 32);
                const float mm = fmaxf(mx, ml.x), a0 = __builtin_amdgcn_exp2f((mx - mm) * CS), a1 = __builtin_amdgcn_exp2f((ml.x - mm) * CS); const float inv = frcp(sum * a0 + ml.y * a1);
                const float sa = a0 * inv, sb = a1 * inv;
                stp = Y + (size_t)(tokrow0 + c) * DM + h * 64 + 4 * g;
                st0.x = pk2(o[0][0] * sa + bflo(w0.x) * sb, o[0][1] * sa + bfhi(w0.x) * sb); st0.y = pk2(o[0][2] * sa + bflo(w0.y) * sb, o[0][3] * sa + bfhi(w0.y) * sb);
                st1.x = pk2(o[1][0] * sa + bflo(w0.z) * sb, o[1][1] * sa + bfhi(w0.z) * sb); st1.y = pk2(o[1][2] * sa + bflo(w0.w) * sb, o[1][3] * sa + bfhi(w0.w) * sb);
                st2.x = pk2(o[2][0] * sa + bflo(w1.x) * sb, o[2][1] * sa + bfhi(w1.x) * sb); st2.y = pk2(o[2][2] * sa + bflo(w1.y) * sb, o[2][3] * sa + bfhi(w1.y) * sb);
                st3.x = pk2(o[3][0] * sa + bflo(w1.z) * sb, o[3][1] * sa + bfhi(w1.z) * sb); st3.y = pk2(o[3][2] * sa + bflo(w1.w) * sb, o[3][3] * sa + bfhi(w1.w) * sb);
            }
            LDS_WAIT();
            __syncthreads();
        }
        if (half == 1) { *(v2u*)(stp) = st0; *(v2u*)(stp + 16) = st1; *(v2u*)(stp + 32) = st2; *(v2u*)(stp + 48) = st3; }
        if (half == 0) NA_BAR();
        it += m;
    }
#undef NA_BAR
#undef NA_ROW_DMA
#undef NA_SWZ
#undef NA_ITEM
    VM_WAIT(); LDS_WAIT();
    __syncthreads();
}

template <int MODE> __device__ __forceinline__ void ph_lru_simple(const Args& a, const Frame& F, int l) {
    int tid = threadIdx.x; asm volatile("" : "+v"(tid)); int lane = tid & 63; (void)lane;
    const bf16* Z = (const bf16*)(a.ws + WS_Z); bf16* Y = (bf16*)(a.ws + WS_Y); float* HF = (float*)(a.ws + WS_HF);
    float* agg = (float*)(a.ws + WS_LAGG); const float* cin = (const float*)(a.ws + WS_LCIN);
    float* xc = (float*)(F.ldsg + RING_OFF);
    const int c = tid, n = c >> 6, k = c & 63;
    float cw[4];
#pragma unroll
    for (int j = 0; j < 4; ++j) cw[j] = a.in[I_CW][((size_t)l * 4 + j) * 512 + c];
    const float cb = a.in[I_CB][(size_t)l * 512 + c];
    for (int ch = F.vcu; ch < NLCH; ch += F.G) {
        const int tok0 = ch * LCH; int s0, T; seq_of(tok0, s0, T); const int s1 = s0 + T;
        __syncthreads();
        for (int t = 0; t < LCH; ++t) { const int tok = tok0 + t; float v = cb;
#pragma unroll
            for (int j = 0; j < 4; ++j) { const int tt = tok + j - 2; if (tt >= s0 && tt < s1) v += cw[j] * bf2f(Z[(size_t)tt * ZW + ZXR + c]); }
            xc[t * 512 + c] = v; }
        __syncthreads();
        for (int dir = 0; dir < 2; ++dir) {
            float wa[64], wx[64];
            const float* pwa = a.in[I_LWA] + ((size_t)(l * 2 + dir) * 8 + n) * 4096 + k; const float* pwx = a.in[I_LWX] + ((size_t)(l * 2 + dir) * 8 + n) * 4096 + k;
#pragma unroll
            for (int j = 0; j < 64; ++j) { wa[j] = pwa[j * 64]; wx[j] = pwx[j * 64]; }
            const float ba = a.in[I_LBA][(size_t)(l * 2 + dir) * 512 + c], bx = a.in[I_LBX][(size_t)(l * 2 + dir) * 512 + c];
            const float lam = a.in[I_LAM][(size_t)(l * 2 + dir) * 512 + c]; const float ls8 = -8.f * log1pf(__expf(-lam));
            float h = MODE ? cin[((size_t)ch * 2 + dir) * 512 + c] : 0.f, P = 1.f;
            for (int st = 0; st < LCH; ++st) {
                const int t = dir ? (LCH - 1 - st) : st; const float* xr = xc + t * 512 + n * 64;
                float pa = ba, px = bx;
#pragma unroll
                for (int j = 0; j < 64; j += 4) { const f32x4 x4 = *(const f32x4*)(xr + j);
                    pa += x4.x * wa[j] + x4.y * wa[j + 1] + x4.z * wa[j + 2] + x4.w * wa[j + 3]; px += x4.x * wx[j] + x4.y * wx[j + 1] + x4.z * wx[j + 2] + x4.w * wx[j + 3]; }
                const float rr = sigmoidf_(pa), ii = sigmoidf_(px), loga = ls8 * rr, av = __expf(loga), mult = sqrtf(fmaxf(-expm1f(2.f * loga), 0.f));
                const float uu = mult * ii * xc[t * 512 + c];
                h = av * h + uu; P *= av;
                if (MODE) { const size_t tok = (size_t)(tok0 + t);
                    if (dir == 0) HF[tok * 512 + c] = h;
                    else { const float gt = bf2f(Z[tok * ZW + ZGT + c]); Y[tok * DM + 1024 + c] = (bf16)f2bf((HF[tok * 512 + c] + h) * gelu_tanh(gt)); } }
            }
            if (!MODE) { float* ag = agg + (((size_t)ch * 2 + dir) * 512 + c) * 2; ag[0] = P; ag[1] = h; }
        }
    }
}

template <int MODE> __device__ __forceinline__ void ph_s5_simple(const Args& a, const Frame& F, int l) {
    int tid = threadIdx.x; asm volatile("" : "+v"(tid)); int lane = tid & 63; (void)lane;
    const bf16* Z = (const bf16*)(a.ws + WS_Z); bf16* YG = (bf16*)(a.ws + WS_YG);
    float* E = (float*)(a.ws + WS_SEND); const float* CIN = (const float*)(a.ws + WS_SCIN);
    const float* TLB = (const float*)(a.ws + WS_TLB); const float* TBB = (const float*)(a.ws + WS_TBB);
    float* Sst = (float*)(F.ldsg + RING_OFF + F.wave * 16384);
    float* Yf = Sst + 2048;
    float* Ub = (float*)(F.ldsg + XTRA_OFF + F.wave * 1024);
    const int gw = F.vcu * NWAVES + F.wave, NGW = F.G * NWAVES;
    for (int u = gw; u < NSCH * 32; u += NGW) {
        const int ch = u >> 5, g = u & 31, tok0 = ch * SCH;
        for (int dir = 0; dir < 2; ++dir) {
            const int dg = dir * 32 + g;
            const float lbr = TLB[((size_t)dg * 64 + lane) * 2], lbi = TLB[((size_t)dg * 64 + lane) * 2 + 1];
            float bbr[16], bbi[16];
            { const f32x4* tb = (const f32x4*)(TBB + ((size_t)dg * 64 + lane) * 32);
#pragma unroll
              for (int q = 0; q < 4; ++q) { const f32x4 x = tb[q], y = tb[4 + q]; bbr[4 * q] = x.x; bbr[4 * q + 1] = x.y; bbr[4 * q + 2] = x.z; bbr[4 * q + 3] = x.w; bbi[4 * q] = y.x; bbi[4 * q + 1] = y.y; bbi[4 * q + 2] = y.z; bbi[4 * q + 3] = y.w; } }
            float cr[64], ci[64];
            if (MODE) { const int h = lane & 15; const f32x4* pr = (const f32x4*)(a.in[I_CRE] + (((size_t)(l * 2 + dir) * 32 + g) * 16 + h) * 64); const f32x4* pi = (const f32x4*)(a.in[I_CIM] + (((size_t)(l * 2 + dir) * 32 + g) * 16 + h) * 64);
#pragma unroll
              for (int q = 0; q < 16; ++q) { const f32x4 x = pr[q], y = pi[q]; cr[4 * q] = x.x; cr[4 * q + 1] = x.y; cr[4 * q + 2] = x.z; cr[4 * q + 3] = x.w; ci[4 * q] = y.x; ci[4 * q + 1] = y.y; ci[4 * q + 2] = y.z; ci[4 * q + 3] = y.w; } }
            float sr = 0.f, si = 0.f;
            if (MODE) { const float* cp = CIN + ((((size_t)ch * 2 + dir) * 32 + g) * 64 + lane) * 2; sr = cp[0]; si = cp[1]; }
            for (int b = 0; b < SCH / 16; ++b) {
                { const int tt = lane >> 2, hq = lane & 3; const int tl = dir ? (SCH - 1 - (16 * b + tt)) : (16 * b + tt);
                  const v2u w = *(const v2u*)(Z + (size_t)(tok0 + tl) * ZW + ZXS + g * 16 + hq * 4);
                  LDS_WAIT();
                  *(f32x4*)(Ub + tt * 16 + hq * 4) = (f32x4){bflo(w.x), bfhi(w.x), bflo(w.y), bfhi(w.y)};
                  LDS_WAIT(); }
                for (int tt = 0; tt < 16; ++tt) {
                    const f32x4 u0 = *(const f32x4*)(Ub + tt * 16), u1 = *(const f32x4*)(Ub + tt * 16 + 4), u2 = *(const f32x4*)(Ub + tt * 16 + 8), u3 = *(const f32x4*)(Ub + tt * 16 + 12);
                    float ir = u0.x * bbr[0] + u0.y * bbr[1] + u0.z * bbr[2] + u0.w * bbr[3] + u1.x * bbr[4] + u1.y * bbr[5] + u1.z * bbr[6] + u1.w * bbr[7]
                             + u2.x * bbr[8] + u2.y * bbr[9] + u2.z * bbr[10] + u2.w * bbr[11] + u3.x * bbr[12] + u3.y * bbr[13] + u3.z * bbr[14] + u3.w * bbr[15];
                    float ii = u0.x * bbi[0] + u0.y * bbi[1] + u0.z * bbi[2] + u0.w * bbi[3] + u1.x * bbi[4] + u1.y * bbi[5] + u1.z * bbi[6] + u1.w * bbi[7]
                             + u2.x * bbi[8] + u2.y * bbi[9] + u2.z * bbi[10] + u2.w * bbi[11] + u3.x * bbi[12] + u3.y * bbi[13] + u3.z * bbi[14] + u3.w * bbi[15];
                    const float nr = lbr * sr - lbi * si + ir, ni = lbr * si + lbi * sr + ii; sr = nr; si = ni;
                    if (MODE) { Sst[(tt * 64 + lane) * 2] = sr; Sst[(tt * 64 + lane) * 2 + 1] = si; }
                }
                if (MODE) {
                    LDS_WAIT();
                    const int h = lane & 15, tq = lane >> 4;
#pragma unroll
                    for (int j = 0; j < 4; ++j) { const int slot = tq * 4 + j; const float* sp = Sst + slot * 128; float y = 0.f;
#pragma unroll
                        for (int p = 0; p < 64; p += 2) { const f32x4 s4 = *(const f32x4*)(sp + 2 * p); y += s4.x * cr[p] - s4.y * ci[p] + s4.z * cr[p + 1] - s4.w * ci[p + 1]; }
                        const int tl = dir ? (SCH - 1 - (16 * b + slot)) : (16 * b + slot);
                        if (dir == 0) Yf[tl * 16 + h] = y; else Yf[tl * 16 + h] += y; }
                    LDS_WAIT();
                }
            }
            if (!MODE) { float* ep = E + ((((size_t)ch * 2 + dir) * 32 + g) * 64 + lane) * 2; ep[0] = sr; ep[1] = si; }
        }
        if (MODE) {
            LDS_WAIT();
            for (int i = 0; i < 32; ++i) { const int idx = lane + 64 * i, tl = idx >> 4, h = idx & 15; const size_t tok = (size_t)(tok0 + tl);
                const float xs = bf2f(Z[tok * ZW + ZXS + g * 16 + h]); const float y = Yf[tl * 16 + h] + a.in[I_SD][(size_t)l * 512 + g * 16 + h] * xs;
                YG[tok * 512 + g * 16 + h] = (bf16)f2bf(gelu_tanh(y)); }
            LDS_WAIT();
        }
    }
}

template <int MODE, int DIR> __device__ __forceinline__ void s5_dir(const Args& a, int l, int lane, int tok0, int gr, LAS unsigned char* st, bf16* yf) {
    const bf16* Z = (const bf16*)(a.ws + WS_ZR); bf16* YG = (bf16*)(a.ws + WS_YG);
    float* E = (float*)(a.ws + WS_SEND); const float* CIN = (const float*)(a.ws + WS_SCIN); const float* TLB = (const float*)(a.ws + WS_TLB);
    const int n = lane & 15, g = lane >> 4, dg = DIR * 32 + gr, ch = tok0 / SCH + g;
    pg8::bf16x8 bbf[8], cf[4];
    { const pg8::bf16x8* bp = (const pg8::bf16x8*)(a.ws + WS_TBBF) + (size_t)dg * 8 * 64 + lane;
#pragma unroll
      for (int c = 0; c < 8; ++c) bbf[c] = bp[c * 64]; }
    if (MODE) { const pg8::bf16x8* cp = (const pg8::bf16x8*)(a.ws + WS_TCF) + (size_t)dg * 4 * 64 + lane;
#pragma unroll
      for (int c = 0; c < 4; ++c) cf[c] = cp[c * 64]; }
    float lbr[4], lbi[4], sr[4], si[4];
#pragma unroll
    for (int cb = 0; cb < 4; ++cb) { const size_t ix = ((size_t)dg * 64 + 16 * cb + n) * 2; lbr[cb] = TLB[ix]; lbi[cb] = TLB[ix + 1];
        if (MODE) { const size_t cx = ((((size_t)ch * 2 + DIR) * 32 + gr) * 64 + 16 * cb + n) * 2; sr[cb] = CIN[cx]; si[cb] = CIN[cx + 1]; } else { sr[cb] = 0.f; si[cb] = 0.f; } }
    const float dsk = MODE ? a.in[I_SD][(size_t)l * 512 + 16 * gr + n] : 0.f;
    const bf16* ua = Z + (size_t)(tok0 + (n >> 2) * SCH + (n & 3)) * ZRW + RXS + 16 * gr + 8 * (g & 1);
    bf16* yo = YG + (size_t)(tok0 + g * SCH) * 512 + 16 * gr + n;
    const bf16* xo = Z + (size_t)(tok0 + g * SCH) * ZRW + RXS + 16 * gr + n;
    constexpr int NST = SCH / 4, T0 = DIR ? (SCH - 4) : 0, DT = DIR ? -4 : 4;
    pg8::bf16x8 un = *(const pg8::bf16x8*)(ua + (size_t)T0 * ZRW);
    unsigned short ygn[4], xsn[4];
    if (MODE && DIR) {
        VM_WAIT();
#pragma unroll
        for (int rg = 0; rg < 4; ++rg) { ygn[rg] = yf[((T0 >> 2) * 4 + rg) * 64 + lane]; xsn[rg] = xo[(size_t)(T0 + rg) * ZRW]; } }
#pragma unroll 1
    for (int step = 0; step < NST; ++step) {
        const int t4 = T0 + DT * step;
        const pg8::bf16x8 u8 = un; unsigned short ygc[4], xsc[4];
        if (MODE && DIR) {
#pragma unroll
            for (int rg = 0; rg < 4; ++rg) { ygc[rg] = ygn[rg]; xsc[rg] = xsn[rg]; } }
        if (step + 1 < NST) { un = *(const pg8::bf16x8*)(ua + (size_t)(t4 + DT) * ZRW);
            if (MODE && DIR) {
#pragma unroll
                for (int rg = 0; rg < 4; ++rg) { ygn[rg] = yf[(((t4 + DT) >> 2) * 4 + rg) * 64 + lane]; xsn[rg] = xo[(size_t)(t4 + DT + rg) * ZRW]; } } }
        f32x4 in[8];
#pragma unroll
        for (int c = 0; c < 8; ++c) in[c] = __builtin_amdgcn_mfma_f32_16x16x32_bf16(u8, bbf[c], (f32x4){0.f, 0.f, 0.f, 0.f}, 0, 0, 0);
        float str[4][4], sti[4][4];
#pragma unroll
        for (int rr = 0; rr < 4; ++rr) { const int rg = DIR ? 3 - rr : rr;
#pragma unroll
            for (int cb = 0; cb < 4; ++cb) { const float nr = lbr[cb] * sr[cb] - lbi[cb] * si[cb] + in[cb][rg], ni = lbr[cb] * si[cb] + lbi[cb] * sr[cb] + in[4 + cb][rg];
                sr[cb] = nr; si[cb] = ni; str[cb][rg] = nr; sti[cb][rg] = ni; } }
        if (MODE) {
#pragma unroll
            for (int rg = 0; rg < 4; ++rg) { v4u w; w.x = pk2s(str[0][rg], sti[0][rg]); w.y = pk2s(str[1][rg], sti[1][rg]); w.z = pk2s(str[2][rg], sti[2][rg]); w.w = pk2s(str[3][rg], sti[3][rg]);
                *(LAS v4u*)(st + (4 * g + rg) * 272 + n * 16) = w; asm volatile("s_nop 1" ::: "memory"); }
            LDS_WAIT();
            f32x4 y = (f32x4){0.f, 0.f, 0.f, 0.f};
#pragma unroll
            for (int ks = 0; ks < 4; ++ks) { const pg8::bf16x8 sf = *(const LAS pg8::bf16x8*)(st + n * 272 + ks * 64 + g * 16); y = __builtin_amdgcn_mfma_f32_16x16x32_bf16(sf, cf[ks], y, 0, 0, 0); }
            LDS_WAIT();
#pragma unroll
            for (int rg = 0; rg < 4; ++rg) {
                if (DIR == 0) yf[((t4 >> 2) * 4 + rg) * 64 + lane] = (bf16)f2bf(y[rg]);
                else { const float v = y[rg] + bf2f(ygc[rg]) + dsk * bf2f(xsc[rg]); yo[(size_t)(t4 + rg) * 512] = (bf16)f2bf(gelu_tanh(v)); } }
        }
    }
    if (!MODE) {
#pragma unroll
        for (int cb = 0; cb < 4; ++cb) { const size_t cx = ((((size_t)ch * 2 + DIR) * 32 + gr) * 64 + 16 * cb + n) * 2; E[cx] = sr[cb]; E[cx + 1] = si[cb]; } }
}

template <int MODE, int DIR> __device__ __forceinline__ void lru_dir(const Args& a, int l, int lane, int tok0, int nb, int half, const LAS unsigned char* xt, bf16* hf) {
    const bf16* Z = (const bf16*)(a.ws + WS_ZR); bf16* Y = (bf16*)(a.ws + WS_Y);
    float* agg = (float*)(a.ws + WS_LAGG); const float* cin = (const float*)(a.ws + WS_LCIN);
    const int n = lane & 15, g = lane >> 4, ch = tok0 / LCH + g;
    pg8::bf16x8 wa[2][2], wx[2][2];
    { const pg8::bf16x8* wp = (const pg8::bf16x8*)(a.ws + WS_TWF) + (size_t)((DIR * 8 + nb) * 2) * 4 * 2 * 64 + lane;
#pragma unroll
      for (int c2 = 0; c2 < 2; ++c2)
#pragma unroll
          for (int ks = 0; ks < 2; ++ks) { wa[c2][ks] = wp[((2 * half + c2) * 2 + ks) * 64]; wx[c2][ks] = wp[(8 + (2 * half + c2) * 2 + ks) * 64]; } }
    pg8::bf16x8 idn[2];
#pragma unroll
    for (int hf = 0; hf < 2; ++hf) { v4u w;
#pragma unroll
        for (int jj = 0; jj < 4; ++jj) { const int k0 = 8 * g + 2 * jj; w[jj] = ((k0 == 16 * hf + n) ? 0x3f80u : 0u) | ((k0 + 1 == 16 * hf + n) ? 0x3f800000u : 0u); }
        idn[hf] = __builtin_bit_cast(pg8::bf16x8, w); }
    float ba[2], bx[2], ls8[2], h[2], P[2];
    const int cch = 64 * nb + 32 * half + n;
#pragma unroll
    for (int c2 = 0; c2 < 2; ++c2) { const int c = cch + 16 * c2; const size_t ix = (size_t)(l * 2 + DIR) * 512 + c;
        ba[c2] = a.in[I_LBA][ix]; bx[c2] = a.in[I_LBX][ix]; ls8[c2] = -8.f * log1pf(__expf(-a.in[I_LAM][ix]));
        h[c2] = MODE ? cin[((size_t)ch * 2 + DIR) * 512 + c] : 0.f; P[c2] = 1.f; }
    const LAS unsigned char* xa = xt + ((n >> 2) * LCH + (n & 3)) * 128 + g * 16;
    bf16* yo = Y + (size_t)(tok0 + g * LCH) * DM + 1024 + cch;
    const bf16* go = Z + (size_t)(tok0 + g * LCH) * ZRW + RGT + cch;
    constexpr int NST = LCH / 4, T0 = DIR ? (LCH - 4) : 0, DT = DIR ? -4 : 4;
    unsigned short yn[2][4], gn[2][4];
    if (MODE && DIR) {
        VM_WAIT();
#pragma unroll
        for (int rg = 0; rg < 4; ++rg)
#pragma unroll
            for (int c2 = 0; c2 < 2; ++c2) { yn[c2][rg] = hf[(((T0 >> 2) * 4 + rg) * 2 + c2) * 64 + lane]; gn[c2][rg] = go[(size_t)(T0 + rg) * ZRW + 16 * c2]; } }
#pragma unroll 1
    for (int step = 0; step < NST; ++step) {
        const int t4 = T0 + DT * step;
        unsigned short yc[2][4], gc[2][4];
        if (MODE && DIR) {
#pragma unroll
            for (int rg = 0; rg < 4; ++rg)
#pragma unroll
                for (int c2 = 0; c2 < 2; ++c2) { yc[c2][rg] = yn[c2][rg]; gc[c2][rg] = gn[c2][rg]; }
            if (step + 1 < NST) {
#pragma unroll
                for (int rg = 0; rg < 4; ++rg)
#pragma unroll
                    for (int c2 = 0; c2 < 2; ++c2) { yn[c2][rg] = hf[((((t4 + DT) >> 2) * 4 + rg) * 2 + c2) * 64 + lane]; gn[c2][rg] = go[(size_t)(t4 + DT + rg) * ZRW + 16 * c2]; } } }
        const pg8::bf16x8 a0 = *(const LAS pg8::bf16x8*)(xa + t4 * 128), a1 = *(const LAS pg8::bf16x8*)(xa + t4 * 128 + 64);
        const pg8::bf16x8 ah = half ? a1 : a0;
        f32x4 pa[2], px[2], xd[2];
#pragma unroll
        for (int c2 = 0; c2 < 2; ++c2) { const f32x4 z4 = (f32x4){0.f, 0.f, 0.f, 0.f};
            pa[c2] = __builtin_amdgcn_mfma_f32_16x16x32_bf16(a0, wa[c2][0], z4, 0, 0, 0); pa[c2] = __builtin_amdgcn_mfma_f32_16x16x32_bf16(a1, wa[c2][1], pa[c2], 0, 0, 0);
            px[c2] = __builtin_amdgcn_mfma_f32_16x16x32_bf16(a0, wx[c2][0], z4, 0, 0, 0); px[c2] = __builtin_amdgcn_mfma_f32_16x16x32_bf16(a1, wx[c2][1], px[c2], 0, 0, 0);
            xd[c2] = __builtin_amdgcn_mfma_f32_16x16x32_bf16(ah, idn[c2], z4, 0, 0, 0); }
#pragma unroll
        for (int rr = 0; rr < 4; ++rr) { const int rg = DIR ? 3 - rr : rr;
#pragma unroll
            for (int c2 = 0; c2 < 2; ++c2) {
                const float r_ = sigmoidf_(pa[c2][rg] + ba[c2]), i_ = sigmoidf_(px[c2][rg] + bx[c2]); const float loga = ls8[c2] * r_, av = __expf(loga), mult = fsqrt_(fmaxf(1.f - av * av, 0.f));
                h[c2] = av * h[c2] + mult * i_ * xd[c2][rg]; P[c2] *= av;
                if (MODE) {
                    if (DIR == 0) hf[(((t4 >> 2) * 4 + rg) * 2 + c2) * 64 + lane] = (bf16)f2bf(h[c2]);
                    else yo[(size_t)(t4 + rg) * DM + 16 * c2] = (bf16)f2bf((bf2f(yc[c2][rg]) + h[c2]) * gelu_tanh(bf2f(gc[c2][rg]))); } }
        }
    }
    if (!MODE) {
#pragma unroll
        for (int c2 = 0; c2 < 2; ++c2) { float* ag = agg + (((size_t)ch * 2 + DIR) * 512 + cch + 16 * c2) * 2; ag[0] = P[c2]; ag[1] = h[c2]; } }
}
__device__ __forceinline__ void lru_prepass(const Args& a, int l, int lane, int tok0, int nb, LAS unsigned char* xt) {
    const bf16* Z = (const bf16*)(a.ws + WS_ZR);
    int s0, T; seq_of(tok0, s0, T); const int s1 = s0 + T;
    const int oc = lane & 7, tg = lane >> 3, cbase = 64 * nb + 8 * oc; float cw[4][8], cbv[8];
    v4u x[19];
    const int tb = tok0 + 16 * tg - 2;
#pragma unroll
    for (int i = 0; i < 19; ++i) { const int tt = tb + i; x[i] = (v4u){0u, 0u, 0u, 0u}; if (tt >= s0 && tt < s1) x[i] = *(const v4u*)(Z + (size_t)tt * ZRW + RXR + cbase); }
#pragma unroll
    for (int tp = 0; tp < 4; ++tp) { const f32x4* wp = (const f32x4*)(a.in[I_CW] + ((size_t)l * 4 + tp) * 512 + cbase); const f32x4 w0 = wp[0], w1 = wp[1];
        cw[tp][0] = w0.x; cw[tp][1] = w0.y; cw[tp][2] = w0.z; cw[tp][3] = w0.w; cw[tp][4] = w1.x; cw[tp][5] = w1.y; cw[tp][6] = w1.z; cw[tp][7] = w1.w; }
    { const f32x4* bp = (const f32x4*)(a.in[I_CB] + (size_t)l * 512 + cbase); const f32x4 b0 = bp[0], b1 = bp[1]; cbv[0] = b0.x; cbv[1] = b0.y; cbv[2] = b0.z; cbv[3] = b0.w; cbv[4] = b1.x; cbv[5] = b1.y; cbv[6] = b1.z; cbv[7] = b1.w; }
    LDS_WAIT();
#pragma unroll
    for (int i = 0; i < 16; ++i) { float acc[8];
#pragma unroll
        for (int e = 0; e < 8; ++e) acc[e] = cbv[e];
#pragma unroll
        for (int tp = 0; tp < 4; ++tp) { const v4u xx = x[i + tp];
            acc[0] += cw[tp][0] * bflo(xx.x); acc[1] += cw[tp][1] * bfhi(xx.x); acc[2] += cw[tp][2] * bflo(xx.y); acc[3] += cw[tp][3] * bfhi(xx.y);
            acc[4] += cw[tp][4] * bflo(xx.z); acc[5] += cw[tp][5] * bfhi(xx.z); acc[6] += cw[tp][6] * bflo(xx.w); acc[7] += cw[tp][7] * bfhi(xx.w); }
        v4u o; o.x = pk2(acc[0], acc[1]); o.y = pk2(acc[2], acc[3]); o.z = pk2(acc[4], acc[5]); o.w = pk2(acc[6], acc[7]);
        *(LAS v4u*)(xt + (16 * tg + i) * 128 + oc * 16) = o; asm volatile("s_nop 1" ::: "memory"); }
    LDS_WAIT();
}
template <int MODE> __device__ __forceinline__ void ph_scan(const Args& a, const Frame& F, int l) {
    int tid = threadIdx.x; asm volatile("" : "+v"(tid)); int lane = tid & 63; (void)lane;
    LAS unsigned char* slab = F.lds + RING_OFF + F.wave * 16384;
    LAS int* ctr = (LAS int*)(F.lds + MISC_OFF + 64);
    __syncthreads(); if (tid == 0) *ctr = 0; __syncthreads();
    constexpr int NLU = (NLCH / 4) * 16, NSU = (NSCH / 4) * 32;
    const int l0 = (int)((long)NLU * F.vcu / F.G), l1 = (int)((long)NLU * (F.vcu + 1) / F.G), s0u = (int)((long)NSU * F.vcu / F.G), s1u = (int)((long)NSU * (F.vcu + 1) / F.G);
    const int nl = l1 - l0, ntot = nl + (s1u - s0u);
    for (;;) {
        int it = 0; if (lane == 0) it = __hip_atomic_fetch_add(ctr, 1, __ATOMIC_RELAXED, __HIP_MEMORY_SCOPE_WORKGROUP);
        it = __builtin_amdgcn_readfirstlane(it);
        if (it >= ntot) break;
        if (it < nl) { const int u = l0 + it, half = u & 1, nb = (u >> 1) & 7, cq = u >> 4, tok0 = cq * 4 * LCH;
            bf16* hf = (bf16*)(a.ws + WS_HF) + (size_t)u * 4096;
            lru_prepass(a, l, lane, tok0, nb, slab);
            lru_dir<MODE, 0>(a, l, lane, tok0, nb, half, slab, hf); lru_dir<MODE, 1>(a, l, lane, tok0, nb, half, slab, hf);
        } else { const int u = s0u + it - nl, gr = u & 31, cq = u >> 5, tok0 = cq * 4 * SCH;
            bf16* yf = (bf16*)(a.ws + WS_HF + 40 * MiB) + (size_t)u * 4096;
            s5_dir<MODE, 0>(a, l, lane, tok0, gr, slab, yf); s5_dir<MODE, 1>(a, l, lane, tok0, gr, slab, yf); }
    }
    LDS_WAIT();
}

__device__ __forceinline__ void ph_carries(const Args& a, const Frame& F, int l) {
    int tid = threadIdx.x; asm volatile("" : "+v"(tid)); int lane = tid & 63; (void)lane;
    constexpr int NL_LONG = 2 * 2 * 512 * (16384 / LCH / 16), NL_SHORT = 4 * 2 * 512 * (2048 / LCH / 16);
    constexpr int NS_LONG = 2 * 2 * 2048 * (16384 / SCH / 16), NS_SHORT = 4 * 2 * 2048 * (2048 / SCH / 16);
    constexpr int NITEM = NL_LONG + NL_SHORT + NS_LONG + NS_SHORT;
    static_assert(NL_LONG % 512 == 0 && NL_SHORT % 512 == 0 && NS_LONG % 512 == 0 && NS_SHORT % 512 == 0, "item classes are whole workgroups");
    for (int base = F.vcu * NTHR; base < NITEM; base += F.G * NTHR) {
        int it = base + tid;
        if (it < NL_LONG + NL_SHORT) {
            const bool lg = it < NL_LONG; if (!lg) it -= NL_LONG;
            const int W = lg ? (16384 / LCH / 16) : (2048 / LCH / 16); const int seg = it & (W - 1), chain = it / W;
            const int c = chain & 511, dir = (chain >> 9) & 1, sq = chain >> 10; const int s0 = lg ? 8192 + sq * 16384 : sq * 2048, T = lg ? 16384 : 2048; const int c0 = s0 / LCH, nc = T / LCH;
            const f32x2* agg = (const f32x2*)(a.ws + WS_LAGG); float* cin = (float*)(a.ws + WS_LCIN);
            f32x2 v[16]; float A = 1.f, B = 0.f;
#pragma unroll
            for (int j = 0; j < 16; ++j) { const int pos = seg * 16 + j, ch = c0 + (dir ? nc - 1 - pos : pos); v[j] = agg[((size_t)ch * 2 + dir) * 512 + c]; }
#pragma unroll
            for (int j = 0; j < 16; ++j) { B = v[j].x * B + v[j].y; A *= v[j].x; }
            for (int off = 1; off < W; off <<= 1) { const float Ap = __shfl_up(A, off, 64), Bp = __shfl_up(B, off, 64); if (seg >= off) { B = A * Bp + B; A = A * Ap; } }
            float carry = __shfl_up(B, 1, 64); if (seg == 0) carry = 0.f;
#pragma unroll
            for (int j = 0; j < 16; ++j) { const int pos = seg * 16 + j, ch = c0 + (dir ? nc - 1 - pos : pos); cin[((size_t)ch * 2 + dir) * 512 + c] = carry; carry = v[j].x * carry + v[j].y; }
        } else {
            it -= NL_LONG + NL_SHORT;
            const bool lg = it < NS_LONG; if (!lg) it -= NS_LONG;
            const int W = lg ? (16384 / SCH / 16) : (2048 / SCH / 16); const int seg = it & (W - 1), chain = it / W;
            const int p = chain & 63, g = (chain >> 6) & 31, dir = (chain >> 11) & 1, sq = chain >> 12; const int s0 = lg ? 8192 + sq * 16384 : sq * 2048, T = lg ? 16384 : 2048; const int c0 = s0 / SCH, nc = T / SCH;
            const float* TLB = (const float*)(a.ws + WS_TLB); const f32x2* E = (const f32x2*)(a.ws + WS_SEND); f32x2* CIN = (f32x2*)(a.ws + WS_SCIN);
            float pr = TLB[((size_t)(dir * 32 + g) * 64 + p) * 2], pi = TLB[((size_t)(dir * 32 + g) * 64 + p) * 2 + 1];
            static_assert(SCH == 64, "lb^SCH by 6 squarings");
#pragma unroll
            for (int i = 0; i < 6; ++i) { const float nr = pr * pr - pi * pi, ni = 2.f * pr * pi; pr = nr; pi = ni; }
            f32x2 v[16]; float Br = 0.f, Bi = 0.f;
#pragma unroll
            for (int j = 0; j < 16; ++j) { const int pos = seg * 16 + j, ch = c0 + (dir ? nc - 1 - pos : pos); v[j] = E[(((size_t)ch * 2 + dir) * 32 + g) * 64 + p]; }
#pragma unroll
            for (int j = 0; j < 16; ++j) { const float nr = pr * Br - pi * Bi + v[j].x, ni = pr * Bi + pi * Br + v[j].y; Br = nr; Bi = ni; }
            float Ar = pr, Ai = pi;
#pragma unroll
            for (int i = 0; i < 4; ++i) { const float nr = Ar * Ar - Ai * Ai, ni = 2.f * Ar * Ai; Ar = nr; Ai = ni; }
            for (int off = 1; off < W; off <<= 1) { const float Apr = __shfl_up(Ar, off, 64), Api = __shfl_up(Ai, off, 64), Bpr = __shfl_up(Br, off, 64), Bpi = __shfl_up(Bi, off, 64);
                if (seg >= off) { const float nbr = Ar * Bpr - Ai * Bpi + Br, nbi = Ar * Bpi + Ai * Bpr + Bi, nar = Ar * Apr - Ai * Api, nai = Ar * Api + Ai * Apr; Br = nbr; Bi = nbi; Ar = nar; Ai = nai; } }
            float cr = __shfl_up(Br, 1, 64), ci = __shfl_up(Bi, 1, 64); if (seg == 0) { cr = 0.f; ci = 0.f; }
#pragma unroll
            for (int j = 0; j < 16; ++j) { const int pos = seg * 16 + j, ch = c0 + (dir ? nc - 1 - pos : pos); CIN[(((size_t)ch * 2 + dir) * 32 + g) * 64 + p] = (f32x2){cr, ci};
                const float nr = pr * cr - pi * ci + v[j].x, ni = pr * ci + pi * cr + v[j].y; cr = nr; ci = ni; }
        }
    }
}

__device__ __forceinline__ void ph_groupnorm(const Args& a, const Frame& F, int l, bf16* dst = nullptr) {
    int tid = threadIdx.x; asm volatile("" : "+v"(tid)); int lane = tid & 63; (void)lane;
    bf16* Y = (bf16*)(a.ws + WS_Y); const float* g = a.in[I_GOUT] + (size_t)l * DM;
    const int gw = F.vcu * NWAVES + F.wave, NGW = F.G * NWAVES;
    static_assert(NTOK % (256 * NWAVES * 4) == 0 || true, "");
    for (int m0 = gw; m0 < NTOK; m0 += 4 * NGW) {
        v4u w[4][4];
#pragma unroll
        for (int r = 0; r < 4; ++r) { const int m = m0 + r * NGW; const v4u* yr = (const v4u*)(Y + (size_t)(m < NTOK ? m : m0) * DM) + lane;
#pragma unroll
            for (int j = 0; j < 4; ++j) w[r][j] = yr[64 * j]; }
        f32x4 g0[4], g1[4];
#pragma unroll
        for (int j = 0; j < 4; ++j) { const f32x4* gp = (const f32x4*)(g + 8 * (lane + 64 * j)); g0[j] = gp[0]; g1[j] = gp[1]; }
#pragma unroll
        for (int r = 0; r < 4; ++r) { const int m = m0 + r * NGW; float ss[4];
#pragma unroll
            for (int j = 0; j < 4; ++j) { float sq = 0.f;
#pragma unroll
                for (int q = 0; q < 4; ++q) { const float lo = bflo(w[r][j][q]), hi = bfhi(w[r][j][q]); sq += lo * lo + hi * hi; }
                ss[j] = sq; }
            const float sa = wave_sum(ss[0] + ss[1]), sb = wave_sum(ss[2]), sc = wave_sum(ss[3]);
            const float ra = 1.f / sqrtf(sa * (1.f / 1024.f) + EPS), rb = 1.f / sqrtf(sb * (1.f / 512.f) + EPS), rc = 1.f / sqrtf(sc * (1.f / 512.f) + EPS);
            if (m < NTOK) {
                v4u* yo = (dst ? (v4u*)(dst + (size_t)m * DM) : (v4u*)(Y + (size_t)m * DM)) + lane;
#pragma unroll
                for (int j = 0; j < 4; ++j) { const float rr = j < 2 ? ra : (j == 2 ? rb : rc);
                    v4u o; o.x = pk2(bflo(w[r][j].x) * rr * g0[j].x, bfhi(w[r][j].x) * rr * g0[j].y); o.y = pk2(bflo(w[r][j].y) * rr * g0[j].z, bfhi(w[r][j].y) * rr * g0[j].w);
                    o.z = pk2(bflo(w[r][j].z) * rr * g1[j].x, bfhi(w[r][j].z) * rr * g1[j].y); o.w = pk2(bflo(w[r][j].w) * rr * g1[j].z, bfhi(w[r][j].w) * rr * g1[j].w);
                    yo[64 * j] = o; } } }
    }
}

__device__ __forceinline__ void ph_norm2(const Args& a, const Frame& F, int l) {
    int tid = threadIdx.x; asm volatile("" : "+v"(tid)); int lane = tid & 63; (void)lane;
    const int gw = F.vcu * NWAVES + F.wave, NGW = F.G * NWAVES; const float* g = a.in[I_NLG] + (size_t)l * DM; bf16* H = (bf16*)(a.ws + WS_H);
    for (int m = gw; m < NTOK; m += NGW) norm_row_bf16(a.out + (size_t)m * DM, g, H + (size_t)m * DM, lane);
}
__device__ __forceinline__ void ph_final(const Args& a, const Frame& F, float* dst = nullptr) {
    int tid = threadIdx.x; asm volatile("" : "+v"(tid)); int lane = tid & 63; (void)lane;
    const int gw = F.vcu * NWAVES + F.wave, NGW = F.G * NWAVES; const f32x4* gr = (const f32x4*)a.in[I_FING] + lane;
    for (int m0 = gw; m0 < NTOK; m0 += 2 * NGW) {
        f32x4 v[2][8];
#pragma unroll
        for (int r = 0; r < 2; ++r) { const int m = m0 + r * NGW; const f32x4* xr = (const f32x4*)(a.out + (size_t)(m < NTOK ? m : m0) * DM) + lane;
#pragma unroll
            for (int j = 0; j < 8; ++j) v[r][j] = xr[64 * j]; }
#pragma unroll
        for (int r = 0; r < 2; ++r) { const int m = m0 + r * NGW; float sq = 0.f;
#pragma unroll
            for (int j = 0; j < 8; ++j) sq += (v[r][j].x * v[r][j].x + v[r][j].y * v[r][j].y) + (v[r][j].z * v[r][j].z + v[r][j].w * v[r][j].w);
            const float rstd = 1.f / sqrtf(wave_sum(sq) * (1.f / DM) + EPS);
            if (m < NTOK) { f32x4* xo = (dst ? (f32x4*)(dst + (size_t)m * DM) : (f32x4*)(a.out + (size_t)m * DM)) + lane;
#pragma unroll
                for (int j = 0; j < 8; ++j) xo[64 * j] = v[r][j] * rstd * gr[64 * j]; } }
    }
}

__global__ void __launch_bounds__(NTHR, 2) mk_fwd(Args args) {
    extern __shared__ __attribute__((aligned(16))) unsigned char lds[];
    Frame F; F.lds = (LAS unsigned char*)lds; F.ldsg = lds;
    F.tid = threadIdx.x; F.lane = F.tid & 63; F.wave = __builtin_amdgcn_readfirstlane(F.tid >> 6);
    F.G = gridDim.x; { const int bx = blockIdx.x; F.vcu = (F.G % 8 == 0) ? (bx % 8) * (F.G / 8) + bx / 8 : bx; }
    volatile LAS unsigned* MISC = (volatile LAS unsigned*)(F.lds + MISC_OFF);
    for (int u = F.tid; u < (LDS_BYTES - LDSCTL_OFF) / 4; u += NTHR) ((LAS unsigned*)(F.lds + LDSCTL_OFF))[u] = 0u;
    __syncthreads();
    unsigned char* ws = args.ws;
    XcdBarrier bar; bar.bar = (unsigned*)(ws + WS_CTL) + CW_BAR; bar.x = 0; bar.st = nullptr;
#if MK_ONE_LAUNCH
    bar = xcd_barrier_post((unsigned*)(ws + WS_CTL) + CW_BAR, MISC + 8);
#endif
    const int lo = args.ph_lo, hi = args.ph_hi;
#define IN(k) (lo <= (k) && (k) < hi)
#if MK_ONE_LAUNCH
#if PROBE_BAR2
#define SEAM(k) do { if (IN(k) && IN((k) + 1)) { xcd_barrier(bar); xcd_barrier(bar); } } while (0)
#else
#define SEAM(k) do { if (IN(k) && IN((k) + 1)) xcd_barrier(bar); } while (0)
#endif
#else
#define SEAM(k) do { } while (0)
#endif
    for (int l = 0; l < DEPTH; ++l) {
        const int pb = l * PH_PER_LAYER;
        if (IN(pb + 0)) { ph_prologue(args, F, l);
#if PROBE_PRO2
            __syncthreads(); ph_prologue(args, F, l);
#endif
        } SEAM(pb + 0);
        if (IN(pb + 1)) {
            pg8::Gemm g{(const bf16*)(ws + WS_H), (const bf16*)(ws + WS_WIN), NTOK, ZW, DM}; pg8::StaticOrder S; S.init(NTOK, ZW, F.G, (int)blockIdx.x);
            pg8::EpiBf16<2> E{(bf16*)(ws + WS_Z), NTOK, (const unsigned long long*)(ws + WS_SSQ) + (size_t)(l * 2) * NTOK, (LAS float*)(F.lds + XTRA_OFF)};
            pg8::gemm_phase<pg8::EpiBf16<2>, pg8::StaticOrder, true, true>(F.lds + RING_OFF, g, S, E);
#if PROBE_WIN2
            pg8::gemm_phase<pg8::EpiBf16<2>, pg8::StaticOrder, true, true>(F.lds + RING_OFF, g, S, E);
#endif
        } SEAM(pb + 1);
        if (IN(pb + 2)) { ph_na_mfma(args, F, l); ph_scan<0>(args, F, l);
#if PROBE_NA2
            __syncthreads(); ph_na_mfma(args, F, l);
#endif
#if PROBE_SCAN2
            ph_scan<0>(args, F, l);
#endif
        } SEAM(pb + 2);
        if (IN(pb + 3)) { ph_carries(args, F, l);
#if PROBE_SCAN2 || PROBE_CAR2
            ph_carries(args, F, l);
#endif
        } SEAM(pb + 3);
        if (IN(pb + 4)) { ph_scan<1>(args, F, l);
#if PROBE_SCAN2
            ph_scan<1>(args, F, l);
#endif
        } SEAM(pb + 4);
        if (IN(pb + 5)) {
            __syncthreads();
            pg8::Gemm g{(const bf16*)(ws + WS_YG), (const bf16*)(ws + WS_WGLU), NTOK, 512, 512}; pg8::StaticOrder S; S.init(NTOK, 512, F.G, (int)blockIdx.x);
            pg8::EpiGlu E{(const bf16*)(ws + WS_YG), (bf16*)(ws + WS_Y), args.in[I_BGLU] + (size_t)l * 512, DM, 1536};
            pg8::gemm_phase<pg8::EpiGlu, pg8::StaticOrder, true, true>(F.lds + RING_OFF, g, S, E);
#if PROBE_GLU2
            pg8::gemm_phase<pg8::EpiGlu, pg8::StaticOrder, true, true>(F.lds + RING_OFF, g, S, E);
#endif
        } SEAM(pb + 5);
        if (IN(pb + 6)) {
#if PROBE_GN2
            ph_groupnorm(args, F, l, (bf16*)(ws + WS_Z));
#endif
            ph_groupnorm(args, F, l); } SEAM(pb + 6);
        if (IN(pb + 7)) {
            pg8::Gemm g{(const bf16*)(ws + WS_Y), (const bf16*)(ws + WS_WOUT), NTOK, DM, DM}; pg8::StaticOrder S; S.init(NTOK, DM, F.G, (int)blockIdx.x);
#if PROBE_WOUT2
            { pg8::EpiResid E2{l == 0 ? args.in[I_XP] : nullptr, l == 0 ? args.in[I_XS] : nullptr, 8192, (float*)(ws + WS_Z), DM, (bf16*)(ws + WS_H), nullptr};
              pg8::gemm_phase<pg8::EpiResid, pg8::StaticOrder, true, true>(F.lds + RING_OFF, g, S, E2); }
#endif
            pg8::EpiResid E{l == 0 ? args.in[I_XP] : nullptr, l == 0 ? args.in[I_XS] : nullptr, 8192, nullptr, DM, (bf16*)(ws + WS_H), (unsigned long long*)(ws + WS_SSQ) + (size_t)(l * 2 + 1) * NTOK};
            pg8::gemm_phase<pg8::EpiResid, pg8::StaticOrder, true, true>(F.lds + RING_OFF, g, S, E);
        } SEAM(pb + 7);
        for (int s = 0; s <= NMLPC; ++s) {
            if (IN(pb + 8 + s)) {
                if (s > 0) {
                    const int c = s - 1;
                    pg8::Gemm g{(const bf16*)(ws + WS_Z + (size_t)(c & 1) * 128 * MiB), (const bf16*)(ws + WS_WDN), MLPC, DM, DFF}; pg8::StaticOrder S; S.init(MLPC, DM, F.G, (int)blockIdx.x);
                    pg8::EpiResid E{nullptr, nullptr, 1 << 30, l + 1 < DEPTH ? nullptr : args.out + (size_t)c * MLPC * DM, DM,
                                    (bf16*)(ws + WS_H) + (size_t)c * MLPC * DM, (unsigned long long*)(ws + WS_SSQ) + (size_t)((l + 1 < DEPTH ? l + 1 : 0) * 2) * NTOK + (size_t)c * MLPC};
#if PROBE_DN2
                    { pg8::EpiResid E2{nullptr, nullptr, 1 << 30, (float*)(ws + WS_Z + 256 * MiB), DM, (bf16*)(ws + WS_H) + (size_t)c * MLPC * DM, nullptr};
                      pg8::gemm_phase<pg8::EpiResid, pg8::StaticOrder, true, true>(F.lds + RING_OFF, g, S, E2); }
#endif
                    pg8::gemm_phase<pg8::EpiResid, pg8::StaticOrder, true, true>(F.lds + RING_OFF, g, S, E);
                }
                if (s < NMLPC) {
                    const int c = s;
                    pg8::Gemm g{(const bf16*)(ws + WS_H) + (size_t)c * MLPC * DM, (const bf16*)(ws + WS_WUP), MLPC, DFF, DM}; pg8::StaticOrder S; S.init(MLPC, DFF, F.G, (int)blockIdx.x);
                    pg8::EpiBf16<1> E{(bf16*)(ws + WS_Z + (size_t)(c & 1) * 128 * MiB), DFF, (const unsigned long long*)(ws + WS_SSQ) + (size_t)(l * 2 + 1) * NTOK + (size_t)c * MLPC, (LAS float*)(F.lds + XTRA_OFF)};
                    pg8::gemm_phase<pg8::EpiBf16<1>, pg8::StaticOrder, true, true>(F.lds + RING_OFF, g, S, E);
#if PROBE_UP2
                    pg8::gemm_phase<pg8::EpiBf16<1>, pg8::StaticOrder, true, true>(F.lds + RING_OFF, g, S, E);
#endif
                }
            } SEAM(pb + 8 + s);
        }
    }
    if (IN(NPHASE - 1)) {
#if PROBE_FIN2
        ph_final(args, F, (float*)(ws + WS_Z));
#endif
        ph_final(args, F); }
#undef IN
#undef SEAM
}

extern "C" void kernel_launch(void* const* d_in, const int* in_sizes, int n_in, void* d_out, int out_size, void* d_ws, size_t ws_size, hipStream_t stream) {
    static int grid = 0;
    if (grid == 0) {
        if (n_in != 28 || out_size != NTOK * DM || ws_size < WS_END) { fprintf(stderr, "kernel_launch: unexpected shapes (n_in %d out %d ws %zu)\n", n_in, out_size, ws_size); grid = -1; return; }
        int dev = 0, cus = 0, per_cu = 0;
        if (hipGetDevice(&dev) != hipSuccess || hipDeviceGetAttribute(&cus, hipDeviceAttributeMultiprocessorCount, dev) != hipSuccess) { grid = -1; return; }
        if (hipFuncSetAttribute((const void*)mk_fwd, hipFuncAttributeMaxDynamicSharedMemorySize, LDS_BYTES) != hipSuccess) { fprintf(stderr, "kernel_launch: hipFuncSetAttribute failed\n"); grid = -1; return; }
        if (hipOccupancyMaxActiveBlocksPerMultiprocessor(&per_cu, (const void*)mk_fwd, NTHR, LDS_BYTES) != hipSuccess || per_cu < 1) fprintf(stderr, "kernel_launch: occupancy query says %d\n", per_cu);
        (void)hipGetLastError();
        grid = cus;
    }
    if (grid < 0) return;
    if (hipMemsetAsync((char*)d_ws + WS_CTL, 0, CTL_ZERO_BYTES, stream) != hipSuccess) return;
    if (hipMemsetAsync((char*)d_ws + WS_SSQ, 0, SSQ_BYTES, stream) != hipSuccess) return;
    Args a{};
    for (int i = 0; i < 28; ++i) a.in[i] = (const float*)d_in[i];
    a.out = (float*)d_out; a.ws = (unsigned char*)d_ws;
#if MK_ONE_LAUNCH
    a.ph_lo = 0; a.ph_hi = NPHASE;
    hipLaunchKernelGGL(mk_fwd, dim3(grid), dim3(NTHR), LDS_BYTES, stream, a);
#else
    for (int ph = 0; ph < NPHASE; ++ph) { a.ph_lo = ph; a.ph_hi = ph + 1; hipLaunchKernelGGL(mk_fwd, dim3(grid), dim3(NTHR), LDS_BYTES, stream, a); }
#endif
}
```

```cpp
#include <hip/hip_runtime.h>
#include <cstdio>
#include <cstdint>
namespace pg8 {
#define PG8_LAS __attribute__((address_space(3)))
typedef unsigned short bf16_t;
typedef short bf16x8 __attribute__((ext_vector_type(8)));
typedef float f32x4 __attribute__((ext_vector_type(4)));
typedef unsigned u32x4 __attribute__((ext_vector_type(4)));
constexpr int BM = 256, BK = 64, HALF = 128, HTB = HALF * BK * 2  , STAGE_BYTES = 8 * HTB, NXCD = 8, WGM = 8;

__host__ __device__ __forceinline__ int lds_byte(int r, int c) { const int st = (r >> 4) * 2 + (c >> 5), rr = r & 15, cc = c & 31, ob = rr * 64 + cc * 2; return st * 1024 + (ob ^ (((ob >> 9) & 1) << 5)); }
__host__ __device__ __forceinline__ void stage_rc(int b, int& R, int& C) { const int st = b / 1024, sb = b % 1024, swz = sb ^ (((sb >> 9) & 1) << 5); R = (st >> 1) * 16 + swz / 64; C = (st & 1) * 32 + (swz % 64) / 2; }
__host__ __device__ __forceinline__ int perm32(int rho) { const int n = rho >> 4, i = rho & 15; return 8 * (i >> 2) + 4 * n + (i & 3); }

struct Unit { int pm, pn; };
struct Gemm { const bf16_t* A; const bf16_t* Bt; int M, N, K; };

struct StaticOrder {
    int nM, nN, nwg, G, c;
    __host__ __device__ void init(int M, int N, int G_, int c_) { nM = M / BM; nN = N / BM; nwg = nM * nN; G = G_; c = c_; }
    __host__ __device__ bool next(int i, Unit& u) const {
        const long L = (long)i * G + c; if (L >= nwg) return false;
        int wgid = (int)L; { const int q = nwg / NXCD, r = nwg % NXCD, xcd = wgid % NXCD, off = wgid / NXCD; wgid = (xcd < r ? xcd * (q + 1) : r * (q + 1) + (xcd - r) * q) + off; }
        const int nig = WGM * nN, gid = wgid / nig, fm = gid * WGM, gsz = (nM - fm) < WGM ? (nM - fm) : WGM;
        u.pm = fm + ((wgid % nig) % gsz); u.pn = (wgid % nig) / gsz; return true;
    }
    __device__ __forceinline__ void a_ready(const Unit&) const {}
    __device__ __forceinline__ void done(const Unit&) const {}
};
__device__ __forceinline__ unsigned cvt_pk_bf16(float lo, float hi) { unsigned r; asm volatile("v_cvt_pk_bf16_f32 %0, %1, %2" : "=v"(r) : "v"(lo), "v"(hi)); return r; }
template <int ACT> struct EpiBf16 {
    static constexpr bool PERM = true, AFTER_DRAIN = false, HAS_PRE = true;
    bf16_t* O; int ldc; const unsigned long long* SS; PG8_LAS float* tbl;
    template <class Sched> __device__ __forceinline__ void pre_all(const Sched& S, int tid) const {
        unsigned long long v[12]; Unit u;
#pragma unroll
        for (int i = 0; i < 12; ++i) { v[i] = 0ull; if (S.next(i, u)) v[i] = SS[u.pm * BM + (tid & 255)]; }
#pragma unroll
        for (int i = 0; i < 12; ++i) if (tid < 256 && S.next(i, u)) tbl[i * 256 + tid] = 1.f / sqrtf((float)v[i] * (1.f / 1048576.f / 2048.f) + 1e-6f);
    }
    __device__ __forceinline__ void operator()(const f32x4 (&acc)[2][2][4][2], const Unit& u, int wr, int wc, int fr, int fq, int slot) const {
        const int row0 = u.pm * BM + wr * 64 + fr; const int col0 = u.pn * BM + wc * 64 + 8 * fq;
        const unsigned ta = (unsigned)(size_t)(tbl + slot * 256 + wr * 64 + fr);
        float rs[2][4];
#pragma unroll
        for (int ai = 0; ai < 2; ++ai)
#pragma unroll
            for (int m = 0; m < 4; ++m) asm volatile("ds_read_b32 %0, %1 offset:%2" : "=v"(rs[ai][m]) : "v"(ta), "i"((ai * HALF + m * 16) * 4));
        asm volatile("s_waitcnt lgkmcnt(0)" : "+v"(rs[0][0]), "+v"(rs[0][1]), "+v"(rs[0][2]), "+v"(rs[0][3]), "+v"(rs[1][0]), "+v"(rs[1][1]), "+v"(rs[1][2]), "+v"(rs[1][3]));
#pragma unroll
        for (int ai = 0; ai < 2; ++ai)
#pragma unroll
            for (int m = 0; m < 4; ++m) { bf16_t* rowp = O + (size_t)(row0 + ai * HALF + m * 16) * ldc + col0; const float r = rs[ai][m];
                if (ACT == 2) {
                    const size_t row = (size_t)(row0 + ai * HALF + m * 16);
                    rowp = (u.pn < 12) ? O + ((size_t)((u.pn >> 2) * 16 + (u.pn & 3) * 4 + wc) * ldc + row) * 64 + 8 * fq
                                       : O + (size_t)48 * ldc * 64 + row * 1536 + (u.pn - 12) * 256 + wc * 64 + 8 * fq; }
#pragma unroll
                for (int bj = 0; bj < 2; ++bj) { f32x4 v0 = acc[ai][bj][m][0] * r, v1 = acc[ai][bj][m][1] * r;
                    if (ACT == 1) {
#pragma unroll
                        for (int j = 0; j < 4; ++j) { const float a = fmaxf(v0[j], 0.f), b = fmaxf(v1[j], 0.f); v0[j] = a * a; v1[j] = b * b; } }
                    u32x4 w; w.x = cvt_pk_bf16(v0[0], v0[1]); w.y = cvt_pk_bf16(v0[2], v0[3]); w.z = cvt_pk_bf16(v1[0], v1[1]); w.w = cvt_pk_bf16(v1[2], v1[3]);
                    *(u32x4*)(rowp + bj * 32) = w; } }
    }
};
struct EpiResid {
    static constexpr bool PERM = true, AFTER_DRAIN = false, HAS_PRE = false;
    const float* Xin0; const float* Xin1; int split; float* Xout; int ldc; bf16_t* XB; unsigned long long* SS;
    __device__ __forceinline__ void operator()(const f32x4 (&acc)[2][2][4][2], const Unit& u, int wr, int wc, int fr, int fq, int) const {
        const int row0 = u.pm * BM + wr * 64 + fr, col0 = u.pn * BM + wc * 64 + 8 * fq;
        const float* Xin = (u.pm * BM < split) ? Xin0 : Xin1 - (size_t)split * ldc;
#pragma unroll
        for (int am = 0; am < 4; ++am) { const int ai = am >> 1, m0 = (am & 1) * 2;
            f32x4 xf[2][2][2]; u32x4 xr[2][2];
            if (Xin0) {
#pragma unroll
                for (int mm = 0; mm < 2; ++mm) { const size_t ro = (size_t)(row0 + ai * HALF + (m0 + mm) * 16) * ldc + col0;
#pragma unroll
                    for (int bj = 0; bj < 2; ++bj) { xf[mm][bj][0] = *(const f32x4*)(Xin + ro + bj * 32); xf[mm][bj][1] = *(const f32x4*)(Xin + ro + bj * 32 + 4); } }
            } else {
#pragma unroll
                for (int mm = 0; mm < 2; ++mm)
#pragma unroll
                    for (int bj = 0; bj < 2; ++bj) xr[mm][bj] = *(const u32x4*)(XB + (size_t)(row0 + ai * HALF + (m0 + mm) * 16) * ldc + col0 + bj * 32);
            }
            asm volatile("" ::: "memory");
#pragma unroll
            for (int mm = 0; mm < 2; ++mm) { const int m = m0 + mm; const int row = row0 + ai * HALF + m * 16; const size_t ro = (size_t)row * ldc + col0; float ss = 0.f;
#pragma unroll
                for (int bj = 0; bj < 2; ++bj) { f32x4 x0, x1;
                    if (Xin0) { x0 = xf[mm][bj][0]; x1 = xf[mm][bj][1]; }
                    else { const u32x4 w = xr[mm][bj];
                        x0 = (f32x4){__uint_as_float(w.x << 16), __uint_as_float(w.x & 0xffff0000u), __uint_as_float(w.y << 16), __uint_as_float(w.y & 0xffff0000u)};
                        x1 = (f32x4){__uint_as_float(w.z << 16), __uint_as_float(w.z & 0xffff0000u), __uint_as_float(w.w << 16), __uint_as_float(w.w & 0xffff0000u)}; }
                    x0 = x0 + acc[ai][bj][m][0]; x1 = x1 + acc[ai][bj][m][1];
                    if (Xout) { *(f32x4*)(Xout + ro + bj * 32) = x0; *(f32x4*)(Xout + ro + bj * 32 + 4) = x1; }
                    else { u32x4 w; w.x = cvt_pk_bf16(x0[0], x0[1]); w.y = cvt_pk_bf16(x0[2], x0[3]); w.z = cvt_pk_bf16(x1[0], x1[1]); w.w = cvt_pk_bf16(x1[2], x1[3]); *(u32x4*)(XB + ro + bj * 32) = w;
#pragma unroll
                        for (int j = 0; j < 4; ++j) { const float lo = __uint_as_float(w[j] << 16), hi = __uint_as_float(w[j] & 0xffff0000u); ss += lo * lo + hi * hi; } } }
                if (!Xout) { ss += __shfl_xor(ss, 16); ss += __shfl_xor(ss, 32); if (fq == 0) atomicAdd(SS + row, (unsigned long long)(ss * 1048576.f + 0.5f)); } }
            asm volatile("" ::: "memory");
        }
    }
};
struct EpiGlu {
    static constexpr bool PERM = true, AFTER_DRAIN = false, HAS_PRE = false;
    const bf16_t* YG; bf16_t* Y; const float* bias; int ldy; int ycol0;
    __device__ __forceinline__ void operator()(const f32x4 (&acc)[2][2][4][2], const Unit& u, int wr, int wc, int fr, int fq, int) const {
        const int row0 = u.pm * BM + wr * 64 + fr; const int col0 = u.pn * BM + wc * 64 + 8 * fq;
        f32x4 bb[2][2];
#pragma unroll
        for (int bj = 0; bj < 2; ++bj) { bb[bj][0] = *(const f32x4*)(bias + col0 + bj * 32); bb[bj][1] = *(const f32x4*)(bias + col0 + bj * 32 + 4); }
#pragma unroll
        for (int ai = 0; ai < 2; ++ai) {
            u32x4 gl[4][2];
#pragma unroll
            for (int m = 0; m < 4; ++m)
#pragma unroll
                for (int bj = 0; bj < 2; ++bj) gl[m][bj] = *(const u32x4*)(YG + (size_t)(row0 + ai * HALF + m * 16) * 512 + col0 + bj * 32);
            asm volatile("" ::: "memory");
#pragma unroll
            for (int m = 0; m < 4; ++m) { const int row = row0 + ai * HALF + m * 16;
#pragma unroll
                for (int bj = 0; bj < 2; ++bj) { const int col = col0 + bj * 32; const u32x4 g = gl[m][bj];
                    const f32x4 v0 = acc[ai][bj][m][0] + bb[bj][0], v1 = acc[ai][bj][m][1] + bb[bj][1];
                    float o[8];
#pragma unroll
                    for (int j = 0; j < 4; ++j) { const unsigned gw0 = g[j >> 1], gw1 = g[2 + (j >> 1)];
                        const float y0 = __uint_as_float((j & 1) ? (gw0 & 0xffff0000u) : (gw0 << 16)), y1 = __uint_as_float((j & 1) ? (gw1 & 0xffff0000u) : (gw1 << 16));
                        o[j] = y0 * __builtin_amdgcn_rcpf(1.f + __expf(-v0[j])); o[4 + j] = y1 * __builtin_amdgcn_rcpf(1.f + __expf(-v1[j])); }
                    u32x4 w; w.x = cvt_pk_bf16(o[0], o[1]); w.y = cvt_pk_bf16(o[2], o[3]); w.z = cvt_pk_bf16(o[4], o[5]); w.w = cvt_pk_bf16(o[6], o[7]);
                    *(u32x4*)(Y + (size_t)row * ldy + ycol0 + col) = w; } }
            asm volatile("" ::: "memory");
        }
    }
};

template <class Epi, class Sched, bool ALIGN_EPI = false, bool SP2 = false>
__device__ __forceinline__ void gemm_phase(PG8_LAS unsigned char* lds, const Gemm g, const Sched& S, const Epi& E) {
    int tid_ = threadIdx.x; asm volatile("" : "+v"(tid_));
    const int tid = tid_, wid = __builtin_amdgcn_readfirstlane(tid >> 6), lane = tid & 63, wr = wid >> 2, wc = wid & 3, fr = lane & 15, fq = lane >> 4;
    const int K = g.K, nt = K / BK;
    unsigned voffA[2], voffB[2];
#pragma unroll
    for (int i = 0; i < 2; ++i) { int R, C; stage_rc(tid * 16 + i * 8192, R, C); const int Rb = Epi::PERM ? (64 * (R >> 5) + perm32(R & 31)) : R;
        voffA[i] = (unsigned)(R * K + C) * 2u; voffB[i] = (unsigned)(Rb * K + C) * 2u; }
    const size_t kstep = (size_t)(BK * 2);
    const size_t hstep = (size_t)HALF * K * 2;
    const size_t hstepB = Epi::PERM ? (size_t)32 * K * 2 : hstep;
    const size_t tstep = 2 * hstep;
    const unsigned ldsw = (unsigned)wid * 1024u;
    const int aoff = lds_byte(wr * 64 + fr, fq * 8), boff = lds_byte(wc * 32 + fr, fq * 8);
#define PG8_SA(b, h) (((b) * 2 + (h)) * HTB)
#define PG8_SB(b, h) ((4 + (b) * 2 + (h)) * HTB)
#define PG8_STAGE(bufoff, gbase, voff) do { _Pragma("unroll") for (int _i = 0; _i < 2; ++_i) \
        __builtin_amdgcn_global_load_lds((const unsigned*)((const char*)(gbase) + (voff)[_i]), (PG8_LAS unsigned*)(lds + (bufoff) + ldsw + _i * 8192), 16, 0, 0); } while (0)
#define PG8_LDA(dst, b, h) do { _Pragma("unroll") for (int m = 0; m < 4; ++m) _Pragma("unroll") for (int k = 0; k < 2; ++k) dst[m][k] = *(const PG8_LAS bf16x8*)(lds + PG8_SA(b, h) + aoff + m * 2048 + k * 1024); } while (0)
#define PG8_LDB(dst, b, h) do { _Pragma("unroll") for (int n = 0; n < 2; ++n) _Pragma("unroll") for (int k = 0; k < 2; ++k) dst[n][k] = *(const PG8_LAS bf16x8*)(lds + PG8_SB(b, h) + boff + n * 2048 + k * 1024); } while (0)
#define PG8_MMA(ai, bj, At, Bt) do { __builtin_amdgcn_s_setprio(1); _Pragma("unroll") for (int m = 0; m < 4; ++m) _Pragma("unroll") for (int n = 0; n < 2; ++n) _Pragma("unroll") for (int k = 0; k < 2; ++k) \
        acc[ai][bj][m][n] = __builtin_amdgcn_mfma_f32_16x16x32_bf16(Bt[n][k], At[m][k], acc[ai][bj][m][n], 0, 0, 0); __builtin_amdgcn_s_setprio(0); } while (0)
#define PG8_WAIT_V(n) asm volatile("s_waitcnt vmcnt(" #n ")" ::: "memory")
#define PG8_WAIT_L(n) asm volatile("s_waitcnt lgkmcnt(" #n ")" ::: "memory")
#define PG8_BAR __builtin_amdgcn_s_barrier()
#define PG8_SCHED __builtin_amdgcn_sched_barrier(0)
    Unit cur, nxt; int ui = 0;
    if (!S.next(0, cur)) return;
    if constexpr (Epi::HAS_PRE) E.pre_all(S, tid);
    f32x4 acc[2][2][4][2];
#pragma unroll
    for (int a = 0; a < 2; ++a)
#pragma unroll
        for (int b = 0; b < 2; ++b)
#pragma unroll
            for (int m = 0; m < 4; ++m)
#pragma unroll
                for (int n = 0; n < 2; ++n) acc[a][b][m][n] = (f32x4){0.f, 0.f, 0.f, 0.f};
    bf16x8 At[4][2], B0[2][2], B1[2][2];
    const char* cA = (const char*)g.A + (size_t)cur.pm * tstep; const char* cB = (const char*)g.Bt + (size_t)cur.pn * tstep;
    S.a_ready(cur);
    if constexpr (SP2) {
        PG8_STAGE(PG8_SB(0, 0), cB, voffB); PG8_STAGE(PG8_SB(0, 1), cB + hstepB, voffB); PG8_STAGE(PG8_SA(0, 0), cA, voffA); PG8_STAGE(PG8_SA(0, 1), cA + hstep, voffA);
        if (wr == 1) PG8_BAR;
        PG8_WAIT_V(2); PG8_BAR;
        PG8_STAGE(PG8_SB(1, 0), cB + kstep, voffB); PG8_STAGE(PG8_SA(1, 0), cA + kstep, voffA); PG8_STAGE(PG8_SB(1, 1), cB + hstepB + kstep, voffB);
        PG8_WAIT_V(6); PG8_BAR;
    } else {
        PG8_STAGE(PG8_SB(0, 0), cB, voffB); PG8_STAGE(PG8_SA(0, 0), cA, voffA); PG8_STAGE(PG8_SB(0, 1), cB + hstepB, voffB); PG8_STAGE(PG8_SA(0, 1), cA + hstep, voffA);
        if (wr == 1) PG8_BAR;
        PG8_WAIT_V(4); PG8_BAR;
        PG8_STAGE(PG8_SB(1, 0), cB + kstep, voffB); PG8_STAGE(PG8_SA(1, 0), cA + kstep, voffA); PG8_STAGE(PG8_SB(1, 1), cB + hstepB + kstep, voffB);
        PG8_WAIT_V(6); PG8_BAR;
    }
    for (;;) {
        const bool has_next = S.next(ui + 1, nxt);
        const char* nA = has_next ? (const char*)g.A + (size_t)nxt.pm * tstep : cA; const char* nB = has_next ? (const char*)g.Bt + (size_t)nxt.pn * tstep : cB;
        for (int t = 0; t < nt; t += 2) {
            const bool last = (t == nt - 2);
            const char* a1 = cA + (size_t)(t + 1) * kstep;
            const char* a2 = last ? nA : cA + (size_t)(t + 2) * kstep; const char* b2 = last ? nB : cB + (size_t)(t + 2) * kstep;
            const char* a3 = a2 + kstep; const char* b3 = b2 + kstep;
            if (last && has_next) S.a_ready(nxt);
            if constexpr (SP2) {
            PG8_LDB(B0, 0, 0); PG8_LDB(B1, 0, 1); PG8_SCHED; PG8_LDA(At, 0, 0); PG8_STAGE(PG8_SA(1, 1), a1 + hstep, voffA);
            PG8_WAIT_V(8); PG8_WAIT_L(0); PG8_BAR; PG8_MMA(0, 0, At, B0); PG8_MMA(0, 1, At, B1); PG8_BAR; PG8_SCHED;
            PG8_LDA(At, 0, 1); PG8_STAGE(PG8_SB(0, 0), b2, voffB); PG8_STAGE(PG8_SB(0, 1), b2 + hstepB, voffB); PG8_STAGE(PG8_SA(0, 0), a2, voffA);
            PG8_WAIT_V(8); PG8_WAIT_L(0); PG8_BAR; PG8_MMA(1, 0, At, B0); PG8_MMA(1, 1, At, B1); PG8_BAR; PG8_SCHED;
            PG8_LDB(B0, 1, 0); PG8_LDB(B1, 1, 1); PG8_SCHED; PG8_LDA(At, 1, 0); PG8_STAGE(PG8_SA(0, 1), a2 + hstep, voffA);
            PG8_WAIT_V(8); PG8_WAIT_L(0); PG8_BAR; PG8_MMA(0, 0, At, B0); PG8_MMA(0, 1, At, B1); PG8_BAR; PG8_SCHED;
            PG8_LDA(At, 1, 1); PG8_STAGE(PG8_SB(1, 0), b3, voffB); PG8_STAGE(PG8_SB(1, 1), b3 + hstepB, voffB); PG8_STAGE(PG8_SA(1, 0), a3, voffA);
            PG8_WAIT_V(8); PG8_WAIT_L(0); PG8_BAR; PG8_MMA(1, 0, At, B0); PG8_MMA(1, 1, At, B1); PG8_BAR; PG8_SCHED;
            } else {
            PG8_LDB(B0, 0, 0); PG8_SCHED; PG8_LDA(At, 0, 0); PG8_STAGE(PG8_SA(1, 1), a1 + hstep, voffA);
            PG8_WAIT_L(8); PG8_BAR; PG8_WAIT_L(0); PG8_MMA(0, 0, At, B0); PG8_BAR; PG8_SCHED;
            PG8_LDB(B1, 0, 1); PG8_STAGE(PG8_SB(0, 0), b2, voffB);
            PG8_BAR; PG8_WAIT_L(0); PG8_MMA(0, 1, At, B1); PG8_BAR;
            PG8_LDA(At, 0, 1); PG8_STAGE(PG8_SA(0, 0), a2, voffA);
            PG8_BAR; PG8_WAIT_L(0); PG8_MMA(1, 0, At, B0); PG8_BAR; PG8_SCHED;
            PG8_STAGE(PG8_SB(0, 1), b2 + hstepB, voffB);
            PG8_WAIT_V(6); PG8_BAR; PG8_MMA(1, 1, At, B1); PG8_BAR;
            PG8_LDB(B0, 1, 0); PG8_SCHED; PG8_LDA(At, 1, 0); PG8_STAGE(PG8_SA(0, 1), a2 + hstep, voffA);
            PG8_WAIT_L(8); PG8_BAR; PG8_WAIT_L(0); PG8_MMA(0, 0, At, B0); PG8_BAR; PG8_SCHED;
            PG8_LDB(B1, 1, 1); PG8_STAGE(PG8_SB(1, 0), b3, voffB);
            PG8_BAR; PG8_WAIT_L(0); PG8_MMA(0, 1, At, B1); PG8_BAR;
            PG8_LDA(At, 1, 1); PG8_STAGE(PG8_SA(1, 0), a3, voffA);
            PG8_BAR; PG8_WAIT_L(0); PG8_MMA(1, 0, At, B0); PG8_BAR; PG8_SCHED;
            PG8_STAGE(PG8_SB(1, 1), b3 + hstepB, voffB);
            PG8_WAIT_V(6); PG8_BAR; PG8_MMA(1, 1, At, B1); PG8_BAR;
            }
        }
        if constexpr (ALIGN_EPI) { if (wr == 0) PG8_BAR; }
        if constexpr (!Epi::AFTER_DRAIN) { E(acc, cur, wr, wc, fr, fq, ui); S.done(cur); }
        if (!has_next) break;
#pragma unroll
        for (int a = 0; a < 2; ++a)
#pragma unroll
            for (int b = 0; b < 2; ++b)
#pragma unroll
                for (int m = 0; m < 4; ++m)
#pragma unroll
                    for (int n = 0; n < 2; ++n) acc[a][b][m][n] = (f32x4){0.f, 0.f, 0.f, 0.f};
        cur = nxt; cA = nA; cB = nB; ++ui;
        if constexpr (ALIGN_EPI) { if (wr == 1) PG8_BAR; }
    }
    PG8_WAIT_V(0);
    if constexpr (!ALIGN_EPI) { if (wr == 0) PG8_BAR; }
    PG8_BAR;
    if constexpr (Epi::AFTER_DRAIN) { E.fused(acc, cur, wr, wc, fr, fq, lds, wid, lane); S.done(cur); }
#undef PG8_SA
#undef PG8_SB
#undef PG8_STAGE
#undef PG8_LDA
#undef PG8_LDB
#undef PG8_MMA
#undef PG8_WAIT_V
#undef PG8_WAIT_L
#undef PG8_BAR
#undef PG8_SCHED
}
}

#ifndef MK_ONE_LAUNCH
#define MK_ONE_LAUNCH 1
#endif
#ifndef PROBE_GN2
#define PROBE_GN2 0
#endif
#ifndef PROBE_FIN2
#define PROBE_FIN2 0
#endif
#ifndef PROBE_CAR2
#define PROBE_CAR2 0
#endif
#ifndef PROBE_BAR2
#define PROBE_BAR2 0
#endif
#ifndef PROBE_WIN2
#define PROBE_WIN2 0
#endif
#ifndef PROBE_GLU2
#define PROBE_GLU2 0
#endif
#ifndef PROBE_WOUT2
#define PROBE_WOUT2 0
#endif
#ifndef PROBE_DN2
#define PROBE_DN2 0
#endif
#ifndef PROBE_UP2
#define PROBE_UP2 0
#endif
#ifndef PROBE_PRO2
#define PROBE_PRO2 0
#endif
#ifndef PROBE_NA2
#define PROBE_NA2 0
#endif
#ifndef PROBE_SCAN2
#define PROBE_SCAN2 0
#endif
constexpr int NWAVES = 8, NTHR = 512;
constexpr int DM = 2048, NTOK = 40960, ZW = 4608, DFF = 8192, DEPTH = 4;
constexpr int ZK = 1024, ZV = 2048, ZXR = 3072, ZGT = 3584, ZXS = 4096;
constexpr int MLPC = 8192, NMLPC = NTOK / MLPC;
constexpr int LCH = 32, NLCH = NTOK / LCH;
constexpr int SCH = 64, NSCH = NTOK / SCH;
constexpr float EPS = 1e-6f;
constexpr int PH_PER_LAYER = 14, NPHASE = DEPTH * PH_PER_LAYER + 1;

constexpr size_t MiB = 1u << 20;
constexpr size_t WS_CTL = 0, CTL_ZERO_BYTES = 2 * MiB;
constexpr size_t WS_SS = 65536;
constexpr size_t WS_WIN = 2 * MiB, WS_WOUT = 20 * MiB, WS_WUP = 28 * MiB, WS_WDN = 60 * MiB, WS_WGLU = 92 * MiB;
constexpr size_t WS_TLB = 93 * MiB;
constexpr size_t WS_TBB = 93 * MiB + 65536;
constexpr size_t WS_H = 96 * MiB;
constexpr size_t WS_ZR = 256 * MiB + (size_t)48 * NTOK * 64 * 2;
constexpr int ZRW = 1536, RXR = 0, RGT = 512, RXS = 1024;
constexpr size_t WS_Z = 256 * MiB;
constexpr size_t WS_Y = 616 * MiB;
constexpr size_t WS_YG = 776 * MiB;
constexpr size_t WS_HF = 816 * MiB;
constexpr size_t WS_TBBF = 94 * MiB;
constexpr size_t WS_TCF = 94 * MiB + 524288;
constexpr size_t WS_TWF = 95 * MiB;
constexpr size_t WS_LAGG = 896 * MiB;
constexpr size_t WS_LCIN = 906 * MiB;
constexpr size_t WS_SEND = 912 * MiB;
constexpr size_t WS_SCIN = 932 * MiB;
constexpr size_t WS_SSQ = 952 * MiB, SSQ_BYTES = (size_t)DEPTH * 2 * NTOK * 8;
constexpr size_t WS_END = 956 * MiB;
constexpr int CW_BAR = 4096;

constexpr int RING_OFF = 0, RING_BYTES = 131072;
constexpr int XTRA_OFF = RING_BYTES, XTRA_BYTES = 12288;
constexpr int LDSCTL_OFF = 163840 - 1024, MISC_OFF = LDSCTL_OFF + 320;
constexpr int LDS_BYTES = 163840;
static_assert(MISC_OFF + 128 <= LDS_BYTES, "LDS map");

#define GAS __attribute__((address_space(1)))
#define LAS __attribute__((address_space(3)))
typedef unsigned short bf16;
typedef unsigned v4u __attribute__((ext_vector_type(4)));
typedef unsigned v2u __attribute__((ext_vector_type(2)));
typedef float f32x4 __attribute__((ext_vector_type(4)));
typedef float f32x2 __attribute__((ext_vector_type(2)));
#define LDS_WAIT() asm volatile("s_waitcnt lgkmcnt(0)" ::: "memory")
#define VM_WAIT() asm volatile("s_waitcnt vmcnt(0)" ::: "memory")
__device__ __forceinline__ unsigned f2bf(float f) { unsigned u = __builtin_bit_cast(unsigned, f); return (u + 0x7fffu + ((u >> 16) & 1u)) >> 16; }
typedef __bf16 bf16x2_t __attribute__((ext_vector_type(2)));
__device__ __forceinline__ unsigned pk2(float lo, float hi) { const f32x2 v = {lo, hi}; return __builtin_bit_cast(unsigned, __builtin_convertvector(v, bf16x2_t)); }
__device__ __forceinline__ unsigned pk2s(float lo, float hi) { return f2bf(lo) | (f2bf(hi) << 16); }
__device__ __forceinline__ float frcp(float x) { return __builtin_amdgcn_rcpf(x); }
__device__ __forceinline__ float fsqrt_(float x) { return __builtin_amdgcn_sqrtf(x); }
__device__ __forceinline__ float bf2f(unsigned b) { return __builtin_bit_cast(float, b << 16); }
__device__ __forceinline__ float bflo(unsigned w) { return __builtin_bit_cast(float, w << 16); }
__device__ __forceinline__ float bfhi(unsigned w) { return __builtin_bit_cast(float, w & 0xffff0000u); }
__device__ __forceinline__ float wave_sum(float v) {
#pragma unroll
    for (int o = 1; o < 64; o <<= 1) v += __shfl_xor(v, o);
    return v;
}
__device__ __forceinline__ float wave_max(float v) {
#pragma unroll
    for (int o = 1; o < 64; o <<= 1) v = fmaxf(v, __shfl_xor(v, o));
    return v;
}
__device__ __forceinline__ float sigmoidf_(float x) { return frcp(1.f + __expf(-x)); }
__device__ __forceinline__ float gelu_tanh(float x) { const float x2 = x * x; const float y2 = (2.302208198f * x) * __builtin_fmaf(0.044715f, x2, 1.f); const float e = __builtin_amdgcn_exp2f(y2); return x - x * frcp(e + 1.f); }
__device__ __forceinline__ void seq_of(int tok, int& s0, int& T) { if (tok < 8192) { s0 = tok & ~2047; T = 2048; } else { s0 = 8192 + ((tok - 8192) & ~16383); T = 16384; } }

#define XB_TMO      128
#define XB_XCNT(j)  (256  + 64 * (j))
#define XB_XSUB(j)  (1280 + 64 * (j))
#define XB_XGEN(j)  (2304 + 64 * (j))
#define XB_TOP      3328
#define XB_TOPGEN   3392
#define XCD_BAR_WORDS 3456
#define XB_SPIN_CAP (1u << 18)

__device__ __forceinline__ unsigned xb_ld(unsigned* p)              { return __hip_atomic_load(p, __ATOMIC_RELAXED, __HIP_MEMORY_SCOPE_AGENT); }
__device__ __forceinline__ unsigned xb_add(unsigned* p, unsigned v) { return __hip_atomic_fetch_add(p, v, __ATOMIC_RELAXED, __HIP_MEMORY_SCOPE_AGENT); }
__device__ __forceinline__ unsigned xb_xcc_id() { return (unsigned)__builtin_amdgcn_s_getreg((3 << 11) | 20) & 0xFu; }
#define XB_SPIN(cond, bar) do { unsigned _sp = 0; while (cond) { __builtin_amdgcn_s_sleep(1); \
    if ((++_sp & 255u) == 0u) { if (xb_ld(&(bar)[XB_TMO])) break; if (_sp > XB_SPIN_CAP) { atomicAdd(&(bar)[XB_TMO], 1u); break; } } } } while (0)

struct XcdBarrier {
    unsigned* bar; unsigned x;
    volatile LAS unsigned* st;
};

__device__ __forceinline__ XcdBarrier xcd_barrier_post(unsigned* bar, volatile LAS unsigned* st) {
    XcdBarrier b; b.bar = bar; b.x = xb_xcc_id(); b.st = st;
    if (threadIdx.x == 0) (void)xb_add(&bar[XB_XCNT(b.x)], 1u);
    return b;
}
__device__ __forceinline__ void xcd_barrier_complete(unsigned* bar, unsigned x, unsigned& nloc, unsigned& nx) {
    const unsigned G = gridDim.x * gridDim.y * gridDim.z;
    unsigned sum, cnt, mine, sp = 0u;
    for (;;) {
        sum = 0u; cnt = 0u; mine = 0u;
#pragma unroll
        for (unsigned j = 0; j < 16; ++j) { const unsigned c = xb_ld(&bar[XB_XCNT(j)]); sum += c; cnt += (c > 0u) ? 1u : 0u; mine = (j == x) ? c : mine; }
        if (sum == G) break;
        __builtin_amdgcn_s_sleep(1);
        if ((++sp & 255u) == 0u) { if (xb_ld(&bar[XB_TMO])) break; if (sp > XB_SPIN_CAP) { atomicAdd(&bar[XB_TMO], 1u); break; } }
    }
    nloc = mine > 0u ? mine : 1u; nx = cnt > 0u ? cnt : 1u;
}

__device__ __forceinline__ void xcd_barrier(const XcdBarrier& b) {
    asm volatile("s_waitcnt vmcnt(0)" ::: "memory");
    __syncthreads();
    if (threadIdx.x == 0) {
        unsigned* bar = b.bar;
        __builtin_amdgcn_s_waitcnt(0);
        unsigned nloc = b.st[0], nx = b.st[1];
        if (nloc == 0u) { xcd_barrier_complete(bar, b.x, nloc, nx); b.st[0] = nloc; b.st[1] = nx; }
        const unsigned old = xb_add(&bar[XB_XSUB(b.x)], 1u);
        const unsigned gen = old / nloc;
        if (old + 1u == (gen + 1u) * nloc) {
            __builtin_amdgcn_fence(__ATOMIC_RELEASE, "agent");
            asm volatile("s_waitcnt vmcnt(0)" ::: "memory");
            const unsigned og = xb_add(&bar[XB_TOP], 1u);
            const unsigned tg = og / nx;
            if (og + 1u == (tg + 1u) * nx) xb_add(&bar[XB_TOPGEN], 1u);
            else XB_SPIN(xb_ld(&bar[XB_TOPGEN]) == tg, bar);
            __builtin_amdgcn_fence(__ATOMIC_ACQUIRE, "agent");
            xb_add(&bar[XB_XGEN(b.x)], 1u);
            asm volatile("s_waitcnt vmcnt(0)" ::: "memory");
        } else {
            XB_SPIN(xb_ld(&bar[XB_XGEN(b.x)]) == gen, bar);
            __builtin_amdgcn_fence(__ATOMIC_ACQUIRE, "agent");
            asm volatile("s_waitcnt vmcnt(0)" ::: "memory");
        }
    }
    __syncthreads();
}


struct Args { const float* in[28]; float* out; unsigned char* ws; int ph_lo, ph_hi; };
struct Frame {
    LAS unsigned char* lds; unsigned char* ldsg;
    int tid, lane, wave, vcu, G;
};
enum { I_XP = 0, I_XS, I_NMG, I_WIN, I_RPB, I_CW, I_CB, I_LWA, I_LBA, I_LWX, I_LBX, I_LAM, I_ARE, I_AIM, I_LDT, I_BRE, I_BIM, I_CRE, I_CIM, I_SD, I_WGLU, I_BGLU, I_GOUT, I_WOUT, I_NLG, I_WUP, I_WDN, I_FING };

__device__ __forceinline__ void transpose_item(const float* W, int K, int N, bf16* WT, LAS float* scr, int item, int lane, const float* gk) {
    const int nblk = N / 32, kb = item / nblk, nb = item % nblk, k0 = 64 * kb, n0 = 32 * nb;
    float wv[32];
#pragma unroll
    for (int i = 0; i < 32; ++i) wv[i] = W[(size_t)(k0 + 2 * i + (lane >> 5)) * N + n0 + (lane & 31)];
    if (gk) {
#pragma unroll
        for (int i = 0; i < 32; ++i) wv[i] *= gk[k0 + 2 * i + (lane >> 5)]; }
#pragma unroll
    for (int i = 0; i < 32; ++i) scr[(2 * i + (lane >> 5)) * 33 + (lane & 31)] = wv[i];
    LDS_WAIT();
    const int c = lane & 7;
#pragma unroll
    for (int j = 0; j < 4; ++j) { const int n = (lane >> 3) + 8 * j; const LAS float* s = scr + (8 * c) * 33 + n;
        v4u o; o.x = pk2(s[0 * 33], s[1 * 33]); o.y = pk2(s[2 * 33], s[3 * 33]); o.z = pk2(s[4 * 33], s[5 * 33]); o.w = pk2(s[6 * 33], s[7 * 33]);
        *(v4u*)(WT + (size_t)(n0 + n) * K + k0 + 8 * c) = o; }
    LDS_WAIT();
}

__device__ __forceinline__ void xb_row(const float* xrow, bf16* orow, unsigned long long* ss, int lane) {
    const f32x4* xr = (const f32x4*)xrow + lane; f32x4 v[8]; float s = 0.f;
#pragma unroll
    for (int j = 0; j < 8; ++j) { v[j] = xr[64 * j]; s += (v[j].x * v[j].x + v[j].y * v[j].y) + (v[j].z * v[j].z + v[j].w * v[j].w); }
    s = wave_sum(s); if (lane == 0) *ss = (unsigned long long)(s * 1048576.f + 0.5f);
    v2u* o8 = (v2u*)orow + lane;
#pragma unroll
    for (int j = 0; j < 8; ++j) { v2u o; o.x = pk2(v[j].x, v[j].y); o.y = pk2(v[j].z, v[j].w); o8[64 * j] = o; }
}

__device__ __forceinline__ void norm_row_bf16(const float* xrow, const float* g, bf16* orow, int lane) {
    const f32x4* xr = (const f32x4*)xrow + lane; const f32x4* gr = (const f32x4*)g + lane;
    f32x4 v[8]; float s = 0.f;
#pragma unroll
    for (int j = 0; j < 8; ++j) { v[j] = xr[64 * j]; s += (v[j].x * v[j].x + v[j].y * v[j].y) + (v[j].z * v[j].z + v[j].w * v[j].w); }
    const float rstd = 1.f / sqrtf(wave_sum(s) * (1.f / DM) + EPS);
    v2u* o8 = (v2u*)orow + lane;
#pragma unroll
    for (int j = 0; j < 8; ++j) { const f32x4 gg = gr[64 * j]; v2u o; o.x = pk2(v[j].x * rstd * gg.x, v[j].y * rstd * gg.y); o.y = pk2(v[j].z * rstd * gg.z, v[j].w * rstd * gg.w); o8[64 * j] = o; }
}
__device__ __forceinline__ const float* x_row(const Args& a, int l, int row) {
    if (l == 0) return row < 8192 ? a.in[I_XP] + (size_t)row * DM : a.in[I_XS] + (size_t)(row - 8192) * DM;
    return a.out + (size_t)row * DM;
}

__device__ __forceinline__ void ph_prologue(const Args& a, const Frame& F, int l) {
    int tid = threadIdx.x; asm volatile("" : "+v"(tid)); int lane = tid & 63; (void)lane;
    LAS float* scr = (LAS float*)(F.lds + RING_OFF + F.wave * 16384);
    const int gw = F.vcu * NWAVES + F.wave, NGW = F.G * NWAVES;
    constexpr int I_IN = (DM / 64) * (ZW / 32), I_OUT = (DM / 64) * (DM / 32), I_UP = (DM / 64) * (DFF / 32), I_DN = (DFF / 64) * (DM / 32), I_GL = (512 / 64) * (512 / 32);
    constexpr int NITEMS = I_IN + I_OUT + I_UP + I_DN + I_GL;
    unsigned char* ws = a.ws;
    for (int it = gw; it < NITEMS; it += NGW) {
        int r = it;
        if (r < I_IN) { transpose_item(a.in[I_WIN] + (size_t)l * DM * ZW, DM, ZW, (bf16*)(ws + WS_WIN), scr, r, lane, a.in[I_NMG] + (size_t)l * DM); continue; } r -= I_IN;
        if (r < I_OUT) { transpose_item(a.in[I_WOUT] + (size_t)l * DM * DM, DM, DM, (bf16*)(ws + WS_WOUT), scr, r, lane, nullptr); continue; } r -= I_OUT;
        if (r < I_UP) { transpose_item(a.in[I_WUP] + (size_t)l * DM * DFF, DM, DFF, (bf16*)(ws + WS_WUP), scr, r, lane, a.in[I_NLG] + (size_t)l * DM); continue; } r -= I_UP;
        if (r < I_DN) { transpose_item(a.in[I_WDN] + (size_t)l * DFF * DM, DFF, DM, (bf16*)(ws + WS_WDN), scr, r, lane, nullptr); continue; } r -= I_DN;
        transpose_item(a.in[I_WGLU] + (size_t)l * 512 * 512, 512, 512, (bf16*)(ws + WS_WGLU), scr, r, lane, nullptr);
    }
    { const int gt = F.vcu * NTHR + tid;
      if (gt < 4096) {
        const int dir = gt >> 11, g = (gt >> 6) & 31, p = gt & 63; const size_t ix = ((size_t)(l * 2 + dir) * 32 + g) * 64 + p;
        const double are = (double)a.in[I_ARE][ix], aim = (double)a.in[I_AIM][ix]; const double ldt = (double)a.in[I_LDT][(l * 2 + dir) * 32 + g];
        double e = 1.0; { const double x8 = ldt * 0.125; for (int n = 20; n >= 1; --n) e = 1.0 + e * x8 / (double)n; e = e * e; e = e * e; e = e * e; }
        const double dt = e;
        double mag = 1.0; { const double x = are * dt; for (int n = 14; n >= 1; --n) mag = 1.0 + mag * x / (double)n; }
        const double th = aim * dt; const double kq = __builtin_rint(th * 0.15915494309189535); const double r = th - kq * 6.283185307179586476925;
        const double r2 = r * r; double c = 1.0, s = 1.0;
        for (int n = 15; n >= 1; --n) { c = 1.0 - c * r2 / (double)((2 * n - 1) * (2 * n)); s = 1.0 - s * r2 / (double)((2 * n) * (2 * n + 1)); }
        s *= r;
        const double lbr = mag * c, lbi = mag * s, den = are * are + aim * aim, nre = lbr - 1.0, nim = lbi;
        const double cor = (nre * are + nim * aim) / den, coi = (nim * are - nre * aim) / den;
        float* tlb = (float*)(ws + WS_TLB) + (size_t)gt * 2; tlb[0] = (float)lbr; tlb[1] = (float)lbi;
        float* tbb = (float*)(ws + WS_TBB) + (size_t)gt * 32; const float* bre = a.in[I_BRE] + ix * 16; const float* bim = a.in[I_BIM] + ix * 16;
        bf16* bbf = (bf16*)(ws + WS_TBBF);
        for (int h = 0; h < 16; ++h) { const double br = (double)bre[h], bi = (double)bim[h]; const float vr = (float)(cor * br - coi * bi), vi = (float)(cor * bi + coi * br); tbb[h] = vr; tbb[16 + h] = vi;
            const int n = p & 15, gk0 = h >> 3, j = h & 7;
            const unsigned hr = f2bf(vr), hi_ = f2bf(vi); const unsigned lr = f2bf(vr - bf2f(hr)), li = f2bf(vi - bf2f(hi_));
            const size_t fr = ((size_t)((dir * 32 + g) * 8 + (p >> 4)) * 64) * 8, fi = ((size_t)((dir * 32 + g) * 8 + 4 + (p >> 4)) * 64) * 8;
            bbf[fr + (size_t)(n + 16 * gk0) * 8 + j] = (bf16)hr; bbf[fr + (size_t)(n + 16 * (gk0 + 2)) * 8 + j] = (bf16)lr;
            bbf[fi + (size_t)(n + 16 * gk0) * 8 + j] = (bf16)hi_; bbf[fi + (size_t)(n + 16 * (gk0 + 2)) * 8 + j] = (bf16)li; }
      } else if (gt < 4096 + 16384) {
        const int e = gt - 4096, lane_ = e & 63, ks = (e >> 6) & 3, g = (e >> 8) & 31, dir = e >> 13; const int h = lane_ & 15, gk = lane_ >> 4;
        const float* cre = a.in[I_CRE] + (((size_t)(l * 2 + dir) * 32 + g) * 16 + h) * 64; const float* cim = a.in[I_CIM] + (((size_t)(l * 2 + dir) * 32 + g) * 16 + h) * 64;
        bf16* cf = (bf16*)(ws + WS_TCF) + (size_t)e * 8;
        for (int j = 0; j < 8; ++j) { const int P = 16 * (j >> 1) + 4 * ks + gk; cf[j] = (bf16)f2bf((j & 1) ? -cim[P] : cre[P]); }
      } else if (gt >= 20480 && gt < 20480 + 16384) {
        const int e = gt - 20480, lane_ = e & 63, ks = (e >> 6) & 1, cb = (e >> 7) & 3, mat = (e >> 9) & 1, nb = (e >> 10) & 7, dir = e >> 13; const int n = lane_ & 15, gk = lane_ >> 4;
        const float* W = a.in[mat ? I_LWX : I_LWA] + ((size_t)(l * 2 + dir) * 8 + nb) * 4096 + (size_t)(32 * ks + 8 * gk) * 64 + 16 * cb + n;
        bf16* wf = (bf16*)(ws + WS_TWF) + (size_t)e * 8;
        for (int j = 0; j < 8; ++j) wf[j] = (bf16)f2bf(W[j * 64]);
      } }
    if (l == 0) { bf16* XB = (bf16*)(ws + WS_H); unsigned long long* SS = (unsigned long long*)(ws + WS_SSQ);
        for (int m0 = gw; m0 < NTOK; m0 += 2 * NGW) {
            f32x4 v[2][8];
#pragma unroll
            for (int r = 0; r < 2; ++r) { const int m = m0 + r * NGW; const f32x4* xr = (const f32x4*)x_row(a, 0, m < NTOK ? m : m0) + lane;
#pragma unroll
                for (int j = 0; j < 8; ++j) v[r][j] = xr[64 * j]; }
#pragma unroll
            for (int r = 0; r < 2; ++r) { const int m = m0 + r * NGW; float sq = 0.f;
#pragma unroll
                for (int j = 0; j < 8; ++j) sq += (v[r][j].x * v[r][j].x + v[r][j].y * v[r][j].y) + (v[r][j].z * v[r][j].z + v[r][j].w * v[r][j].w);
                sq = wave_sum(sq);
                if (m < NTOK) { if (lane == 0) SS[m] = (unsigned long long)(sq * 1048576.f + 0.5f);
                    v2u* o8 = (v2u*)(XB + (size_t)m * DM) + lane;
#pragma unroll
                    for (int j = 0; j < 8; ++j) { v2u o; o.x = pk2(v[r][j].x, v[r][j].y); o.y = pk2(v[r][j].z, v[r][j].w); o8[64 * j] = o; } } } } }

}

__device__ __forceinline__ void ph_na_simple(const Args& a, const Frame& F, int l) {
    int tid = threadIdx.x; asm volatile("" : "+v"(tid)); int lane = tid & 63; (void)lane;
    const bf16* Z = (const bf16*)(a.ws + WS_Z); bf16* Y = (bf16*)(a.ws + WS_Y);
    const float* rpb = a.in[I_RPB] + (size_t)l * 16 * 15 * 31;
    float* qs = (float*)(F.ldsg + RING_OFF) + F.wave * 64;
    const long U = (long)NTOK * 16; const long u0 = U * F.vcu / F.G, u1 = U * (F.vcu + 1) / F.G;
    for (long u = u0 + F.wave; u < u1; u += NWAVES) {
        const int tok = (int)(u >> 4), h = (int)(u & 15);
        int s0, T; seq_of(tok, s0, T); const int pos = tok - s0, r = pos >> 6, c = pos & 63, R = T >> 6;
        const int rs = min(max(r - 4, 0), R - 8), cs = min(max(c - 8, 0), 48);
        LDS_WAIT();
        qs[lane] = bf2f(Z[(size_t)tok * ZW + h * 64 + lane]);
        LDS_WAIT();
        float sc[2];
#pragma unroll
        for (int i = 0; i < 2; ++i) {
            const int kk = lane + 64 * i, krow = rs + (kk >> 4), kcol = cs + (kk & 15); const int ktok = s0 + krow * 64 + kcol;
            const v4u* kp = (const v4u*)(Z + (size_t)ktok * ZW + ZK + h * 64);
            float d = 0.f;
#pragma unroll
            for (int j = 0; j < 8; ++j) { const v4u w = kp[j]; const f32x4 q0 = *(const f32x4*)(qs + 8 * j), q1 = *(const f32x4*)(qs + 8 * j + 4);
                d += bflo(w.x) * q0.x + bfhi(w.x) * q0.y + bflo(w.y) * q0.z + bfhi(w.y) * q0.w + bflo(w.z) * q1.x + bfhi(w.z) * q1.y + bflo(w.w) * q1.z + bfhi(w.w) * q1.w; }
            sc[i] = d * 0.125f + rpb[(h * 15 + (krow - r + 7)) * 31 + (kcol - c + 15)];
        }
        const float m = wave_max(fmaxf(sc[0], sc[1])); const float p0 = __expf(sc[0] - m), p1 = __expf(sc[1] - m); const float sum = wave_sum(p0 + p1);
        float acc = 0.f;
        for (int kk = 0; kk < 128; ++kk) {
            const float p = __shfl(kk < 64 ? p0 : p1, kk & 63);
            const int krow = rs + (kk >> 4), kcol = cs + (kk & 15); const int vtok = s0 + krow * 64 + kcol;
            acc += p * bf2f(Z[(size_t)vtok * ZW + ZV + h * 64 + lane]);
        }
        Y[(size_t)tok * DM + h * 64 + lane] = (bf16)f2bf(acc / sum);
    }
}

typedef short s16x4_t __attribute__((ext_vector_type(4)));
__device__ __forceinline__ pg8::bf16x8 v_tr_pair(const LAS unsigned char* p) {
    const s16x4_t lo = __builtin_amdgcn_ds_read_tr16_b64_v4i16((LAS s16x4_t*)p), hi = __builtin_amdgcn_ds_read_tr16_b64_v4i16((LAS s16x4_t*)(p + 512));
    return __builtin_shufflevector(lo, hi, 0, 1, 2, 3, 4, 5, 6, 7);
}
__device__ __forceinline__ void glds16_asm(const void* gsrc, unsigned lds_dst) {
    unsigned keep;
    asm volatile("s_mov_b32 %0, m0\n\ts_mov_b32 m0, %2\n\ts_nop 0\n\tglobal_load_lds_dwordx4 %1, off\n\ts_mov_b32 m0, %0" : "=&s"(keep) : "v"(gsrc), "s"(lds_dst) : "memory");
}
__device__ __forceinline__ void ph_na_mfma(const Args& a, const Frame& F, int l) {
    int tid = threadIdx.x; asm volatile("" : "+v"(tid)); int lane = tid & 63; (void)lane;
    const bf16* Z = (const bf16*)(a.ws + WS_Z); bf16* Y = (bf16*)(a.ws + WS_Y);
    constexpr int KR = 0, VR = 73728, BIAS = 147456, MRG = 149504;
    LAS unsigned char* L = F.lds;
    const int w = F.wave, qt = w & 3, half = w >> 2, q = lane & 15, g = lane >> 4;
    const int c0 = 16 * qt, kc0 = (qt == 0) ? 0 : (qt == 1 ? 8 : (qt == 2 ? 24 : 32)), c = c0 + q, cs = min(max(c - 8, 0), 48);
    const int NIT = (NTOK / 64) * 16; const int i0 = (int)((long)NIT * F.vcu / F.G), i1 = (int)((long)NIT * (F.vcu + 1) / F.G);
#define NA_ITEM(it_, s0_, R_, h_, r_) do { if ((it_) < 2048) { const int _col = (it_) >> 5; r_ = (it_) & 31; R_ = 32; s0_ = (_col >> 4) * 2048; h_ = _col & 15; } \
        else { const int _j = (it_) - 2048, _col = _j >> 8; r_ = _j & 255; R_ = 256; s0_ = 8192 + (_col >> 4) * 16384; h_ = _col & 15; } } while (0)
#define NA_SWZ(col_) (((((col_) >> 3) & 3) << 1) | (((col_) >> 1) & 1))
#define NA_ROW_DMA(zoff_, row_, slotbase_) do { \
        _Pragma("unroll") for (int _j = 0; _j < 2; ++_j) { const int _col = c0 + 8 * _j + (lane >> 3); \
            const bf16* _gp = Z + ((size_t)((zoff_) / 64 + h) * NTOK + (s0 + (row_) * 64 + _col)) * 64 + (((lane & 7) ^ NA_SWZ(_col)) * 8); \
            glds16_asm(_gp, (unsigned)(size_t)(L + (slotbase_) + (c0 + 8 * _j) * 128)); } } while (0)
#define NA_BAR() asm volatile("s_barrier" ::: "memory")
    pg8::bf16x8 qn0, qn1;
    { int s0, R, h, r; NA_ITEM(i0, s0, R, h, r); const bf16* qp = Z + ((size_t)h * NTOK + (s0 + r * 64 + c)) * 64 + 8 * g; qn0 = *(const pg8::bf16x8*)qp; qn1 = *(const pg8::bf16x8*)(qp + 32); }
    v2u st0, st1, st2, st3; bf16* stp = Y;
    st0 = st1 = st2 = st3 = (v2u){0u, 0u};
    int it = i0;
    while (it < i1) {
        int s0, R, h, r0; NA_ITEM(it, s0, R, h, r0);
        const int m = min(R - r0, i1 - it);
        {
            const int rs = min(max(r0 - 4, 0), R - 8);
#pragma unroll
            for (int i = 0; i < 16; ++i) { const int id = w * 16 + i, t = id >> 6, ri = (id >> 3) & 7, j8 = id & 7, row = rs + ri;
                const int colw = 8 * j8 + (lane >> 3);
                const bf16* gp = Z + ((size_t)((t ? 32 : 16) + h) * NTOK + (s0 + row * 64 + colw)) * 64 + (((lane & 7) ^ NA_SWZ(colw)) * 8);
                glds16_asm(gp, (unsigned)(size_t)(L + (t ? VR : KR) + (row % 9) * 8192 + j8 * 1024)); }
            if (tid < 465) ((LAS float*)(L + BIAS))[tid] = a.in[I_RPB][((size_t)l * 16 + h) * 465 + tid];
            VM_WAIT(); LDS_WAIT();
            __syncthreads();
        }
        float ti[4][2][4];
        { const LAS float* bt = (const LAS float*)(L + BIAS);
#pragma unroll
          for (int kk = 0; kk < 4; ++kk)
#pragma unroll
              for (int blk = 0; blk < 2; ++blk)
#pragma unroll
                  for (int rg = 0; rg < 4; ++rg) { const int col = kc0 + 8 * g + 4 * blk + rg; const int dc = min(max(col - c + 15, 0), 30); const bool valid = (unsigned)(col - cs) < 16u;
                      ti[kk][blk][rg] = valid ? 8.f * bt[(kk + 4 * half + 3) * 31 + dc] : -INFINITY; } }
        if (half == 1) NA_BAR();
        for (int j = 0; j < m; ++j) {
            const int r = r0 + j, rs = min(max(r - 4, 0), R - 8);
            pg8::bf16x8 qf0 = qn0, qf1 = qn1;
            asm volatile("" : "+v"(qf0), "+v"(qf1) :: "memory");
            if (half == 1 && j > 0) { *(v2u*)(stp) = st0; *(v2u*)(stp + 16) = st1; *(v2u*)(stp + 32) = st2; *(v2u*)(stp + 48) = st3; }
            if (it + j + 1 < i1) {
                int s0n, Rn, hn, rn; NA_ITEM(it + j + 1, s0n, Rn, hn, rn);
                if (half == 0 && j + 1 < m) { const int rsn = min(max(rn - 4, 0), Rn - 8); if (rsn > rs) { NA_ROW_DMA(ZK, rsn + 7, KR + ((rsn + 7) % 9) * 8192); NA_ROW_DMA(ZV, rsn + 7, VR + ((rsn + 7) % 9) * 8192); } }
                const bf16* qp = Z + ((size_t)hn * NTOK + (s0n + rn * 64 + c)) * 64 + 8 * g; qn0 = *(const pg8::bf16x8*)qp; qn1 = *(const pg8::bf16x8*)(qp + 32);
            }
            const int tokrow0 = s0 + r * 64;
            f32x4 sc[4][2];
            pg8::bf16x8 kf[4][2][2];
#pragma unroll
            for (int kk = 0; kk < 4; ++kk) { const int row = rs + 4 * half + kk; const LAS unsigned char* kb = L + KR + (row % 9) * 8192;
#pragma unroll
                for (int blk = 0; blk < 2; ++blk) { const int col = kc0 + 8 * (q >> 2) + 4 * blk + (q & 3); const int sw = NA_SWZ(col);
                    kf[kk][blk][0] = *(const LAS pg8::bf16x8*)(kb + col * 128 + ((g ^ sw) * 16)); kf[kk][blk][1] = *(const LAS pg8::bf16x8*)(kb + col * 128 + (((4 + g) ^ sw) * 16)); } }
            const bool interior = (rs == r - 4);
            __builtin_amdgcn_sched_barrier(0);
#pragma unroll
            for (int kk = 0; kk < 4; ++kk)
#pragma unroll
                for (int blk = 0; blk < 2; ++blk) { f32x4 ini = (f32x4){0.f, 0.f, 0.f, 0.f};
                    if (interior) ini = (f32x4){ti[kk][blk][0], ti[kk][blk][1], ti[kk][blk][2], ti[kk][blk][3]};
                    sc[kk][blk] = __builtin_amdgcn_mfma_f32_16x16x32_bf16(kf[kk][blk][0], qf0, ini, 0, 0, 0); }
#pragma unroll
            for (int kk = 0; kk < 4; ++kk)
#pragma unroll
                for (int blk = 0; blk < 2; ++blk) sc[kk][blk] = __builtin_amdgcn_mfma_f32_16x16x32_bf16(kf[kk][blk][1], qf1, sc[kk][blk], 0, 0, 0);
            __builtin_amdgcn_sched_barrier(0);
            if (!interior) {
                const LAS float* bh = (const LAS float*)(L + BIAS) + (rs + 4 * half - r + 7) * 31;
#pragma unroll
                for (int blk = 0; blk < 2; ++blk)
#pragma unroll
                    for (int rg = 0; rg < 4; ++rg) { const int col = kc0 + 8 * g + 4 * blk + rg; const int dc = min(max(col - c + 15, 0), 30); const bool valid = (unsigned)(col - cs) < 16u;
#pragma unroll
                        for (int kk = 0; kk < 4; ++kk) sc[kk][blk][rg] = valid ? sc[kk][blk][rg] + 8.f * bh[kk * 31 + dc] : -INFINITY; }
            }
            float mx = -INFINITY;
#pragma unroll
            for (int kk = 0; kk < 4; ++kk)
#pragma unroll
                for (int blk = 0; blk < 2; ++blk)
#pragma unroll
                    for (int rg = 0; rg < 4; ++rg) mx = fmaxf(mx, sc[kk][blk][rg]);
            mx = fmaxf(mx, __shfl_xor(mx, 16)); mx = fmaxf(mx, __shfl_xor(mx, 32));
            LDS_WAIT();
            __syncthreads();
            pg8::bf16x8 vfr[4][4];
#pragma unroll
            for (int kk = 0; kk < 4; ++kk) { const int row = rs + 4 * half + kk;
                const int colv = kc0 + 8 * g + ((lane & 15) >> 2), sw0 = NA_SWZ(colv), sw1 = NA_SWZ(colv + 4), pq = lane & 3;
                const LAS unsigned char* vb0 = L + VR + (row % 9) * 8192 + colv * 128 + (pq & 1) * 8; const LAS unsigned char* vb1 = vb0 + 512;
#pragma unroll
                for (int db = 0; db < 4; ++db) { const int ch = 2 * db + (pq >> 1);
                    const s16x4_t lo = __builtin_amdgcn_ds_read_tr16_b64_v4i16((LAS s16x4_t*)(vb0 + ((ch ^ sw0) * 16))), hi = __builtin_amdgcn_ds_read_tr16_b64_v4i16((LAS s16x4_t*)(vb1 + ((ch ^ sw1) * 16)));
                    vfr[kk][db] = __builtin_shufflevector(lo, hi, 0, 1, 2, 3, 4, 5, 6, 7); } }
            __builtin_amdgcn_sched_barrier(0);
            pg8::bf16x8 pf[4];
            constexpr float CS = 0.125f * 1.4426950408889634f;
            const float nm = -mx * CS;
#pragma unroll
            for (int kk = 0; kk < 4; ++kk) { float p[8];
#pragma unroll
                for (int blk = 0; blk < 2; ++blk)
#pragma unroll
                    for (int rg = 0; rg < 4; ++rg) p[4 * blk + rg] = __builtin_amdgcn_exp2f(__builtin_fmaf(sc[kk][blk][rg], CS, nm));
                v4u wv; wv.x = pk2(p[0], p[1]); wv.y = pk2(p[2], p[3]); wv.z = pk2(p[4], p[5]); wv.w = pk2(p[6], p[7]); pf[kk] = __builtin_bit_cast(pg8::bf16x8, wv); }
            f32x4 osum = (f32x4){0.f, 0.f, 0.f, 0.f};
            { const v4u onesw = (v4u){0x3f803f80u, 0x3f803f80u, 0x3f803f80u, 0x3f803f80u}; const pg8::bf16x8 ones = __builtin_bit_cast(pg8::bf16x8, onesw);
#pragma unroll
              for (int kk = 0; kk < 4; ++kk) osum = __builtin_amdgcn_mfma_f32_16x16x32_bf16(ones, pf[kk], osum, 0, 0, 0); }
            const float sum = osum[0];
            f32x4 o[4];
#pragma unroll
            for (int db = 0; db < 4; ++db) o[db] = (f32x4){0.f, 0.f, 0.f, 0.f};
#pragma unroll
            for (int kk = 0; kk < 4; ++kk)
#pragma unroll
                for (int db = 0; db < 4; ++db) o[db] = __builtin_amdgcn_mfma_f32_16x16x32_bf16(vfr[kk][db], pf[kk], o[db], 0, 0, 0);
            LAS unsigned char* mg = L + MRG + (qt * 64 + lane) * 48;
            if (half == 0) {
                v4u w0, w1; w0.x = pk2(o[0][0], o[0][1]); w0.y = pk2(o[0][2], o[0][3]); w0.z = pk2(o[1][0], o[1][1]); w0.w = pk2(o[1][2], o[1][3]);
                w1.x = pk2(o[2][0], o[2][1]); w1.y = pk2(o[2][2], o[2][3]); w1.z = pk2(o[3][0], o[3][1]); w1.w = pk2(o[3][2], o[3][3]);
                *(LAS v4u*)mg = w0; *(LAS v4u*)(mg + 16) = w1; *(LAS f32x2*)(mg + 32) = (f32x2){mx, sum};
                VM_WAIT();
            } else {
                const v4u w0 = *(const LAS v4u*)mg, w1 = *(const LAS v4u*)(mg + 16); const f32x2 ml = *(const LAS f32x2*)(mg + 32);
                const float mm = fmaxf(mx, ml.x), a0 = __builtin_amdgcn_exp2f((mx - mm) * CS), a1 = __builtin_amdgcn_exp2f((ml.x - mm) * CS); const float inv = frcp(sum * a0 + ml.y * a1);
                const float sa = a0 * inv, sb = a1 * inv;
                stp = Y + (size_t)(tokrow0 + c) * DM + h * 64 + 4 * g;
                st0.x = pk2(o[0][0] * sa + bflo(w0.x) * sb, o[0][1] * sa + bfhi(w0.x) * sb); st0.y = pk2(o[0][2] * sa + bflo(w0.y) * sb, o[0][3] * sa + bfhi(w0.y) * sb);
                st1.x = pk2(o[1][0] * sa + bflo(w0.z) * sb, o[1][1] * sa + bfhi(w0.z) * sb); st1.y = pk2(o[1][2] * sa + bflo(w0.w) * sb, o[1][3] * sa + bfhi(w0.w) * sb);
                st2.x = pk2(o[2][0] * sa + bflo(w1.x) * sb, o[2][1] * sa + bfhi(w1.x) * sb); st2.y = pk2(o[2][2] * sa + bflo(w1.y) * sb, o[2][3] * sa + bfhi(w1.y) * sb);
                st3.x = pk2(o[3][0] * sa + bflo(w1.z) * sb, o[3][1] * sa + bfhi(w1.z) * sb); st3.y = pk2(o[3][2] * sa + bflo(w1.w) * sb, o[3][3] * sa + bfhi(w1.w) * sb);
            }
            LDS_WAIT();
            __syncthreads();
        }
        if (half == 1) { *(v2u*)(stp) = st0; *(v2u*)(stp + 16) = st1; *(v2u*)(stp + 32) = st2; *(v2u*)(stp + 48) = st3; }
        if (half == 0) NA_BAR();
        it += m;
    }
#undef NA_BAR
#undef NA_ROW_DMA
#undef NA_SWZ
#undef NA_ITEM
    VM_WAIT(); LDS_WAIT();
    __syncthreads();
}

template <int MODE> __device__ __forceinline__ void ph_lru_simple(const Args& a, const Frame& F, int l) {
    int tid = threadIdx.x; asm volatile("" : "+v"(tid)); int lane = tid & 63; (void)lane;
    const bf16* Z = (const bf16*)(a.ws + WS_Z); bf16* Y = (bf16*)(a.ws + WS_Y); float* HF = (float*)(a.ws + WS_HF);
    float* agg = (float*)(a.ws + WS_LAGG); const float* cin = (const float*)(a.ws + WS_LCIN);
    float* xc = (float*)(F.ldsg + RING_OFF);
    const int c = tid, n = c >> 6, k = c & 63;
    float cw[4];
#pragma unroll
    for (int j = 0; j < 4; ++j) cw[j] = a.in[I_CW][((size_t)l * 4 + j) * 512 + c];
    const float cb = a.in[I_CB][(size_t)l * 512 + c];
    for (int ch = F.vcu; ch < NLCH; ch += F.G) {
        const int tok0 = ch * LCH; int s0, T; seq_of(tok0, s0, T); const int s1 = s0 + T;
        __syncthreads();
        for (int t = 0; t < LCH; ++t) { const int tok = tok0 + t; float v = cb;
#pragma unroll
            for (int j = 0; j < 4; ++j) { const int tt = tok + j - 2; if (tt >= s0 && tt < s1) v += cw[j] * bf2f(Z[(size_t)tt * ZW + ZXR + c]); }
            xc[t * 512 + c] = v; }
        __syncthreads();
        for (int dir = 0; dir < 2; ++dir) {
            float wa[64], wx[64];
            const float* pwa = a.in[I_LWA] + ((size_t)(l * 2 + dir) * 8 + n) * 4096 + k; const float* pwx = a.in[I_LWX] + ((size_t)(l * 2 + dir) * 8 + n) * 4096 + k;
#pragma unroll
            for (int j = 0; j < 64; ++j) { wa[j] = pwa[j * 64]; wx[j] = pwx[j * 64]; }
            const float ba = a.in[I_LBA][(size_t)(l * 2 + dir) * 512 + c], bx = a.in[I_LBX][(size_t)(l * 2 + dir) * 512 + c];
            const float lam = a.in[I_LAM][(size_t)(l * 2 + dir) * 512 + c]; const float ls8 = -8.f * log1pf(__expf(-lam));
            float h = MODE ? cin[((size_t)ch * 2 + dir) * 512 + c] : 0.f, P = 1.f;
            for (int st = 0; st < LCH; ++st) {
                const int t = dir ? (LCH - 1 - st) : st; const float* xr = xc + t * 512 + n * 64;
                float pa = ba, px = bx;
#pragma unroll
                for (int j = 0; j < 64; j += 4) { const f32x4 x4 = *(const f32x4*)(xr + j);
                    pa += x4.x * wa[j] + x4.y * wa[j + 1] + x4.z * wa[j + 2] + x4.w * wa[j + 3]; px += x4.x * wx[j] + x4.y * wx[j + 1] + x4.z * wx[j + 2] + x4.w * wx[j + 3]; }
                const float rr = sigmoidf_(pa), ii = sigmoidf_(px), loga = ls8 * rr, av = __expf(loga), mult = sqrtf(fmaxf(-expm1f(2.f * loga), 0.f));
                const float uu = mult * ii * xc[t * 512 + c];
                h = av * h + uu; P *= av;
                if (MODE) { const size_t tok = (size_t)(tok0 + t);
                    if (dir == 0) HF[tok * 512 + c] = h;
                    else { const float gt = bf2f(Z[tok * ZW + ZGT + c]); Y[tok * DM + 1024 + c] = (bf16)f2bf((HF[tok * 512 + c] + h) * gelu_tanh(gt)); } }
            }
            if (!MODE) { float* ag = agg + (((size_t)ch * 2 + dir) * 512 + c) * 2; ag[0] = P; ag[1] = h; }
        }
    }
}

template <int MODE> __device__ __forceinline__ void ph_s5_simple(const Args& a, const Frame& F, int l) {
    int tid = threadIdx.x; asm volatile("" : "+v"(tid)); int lane = tid & 63; (void)lane;
    const bf16* Z = (const bf16*)(a.ws + WS_Z); bf16* YG = (bf16*)(a.ws + WS_YG);
    float* E = (float*)(a.ws + WS_SEND); const float* CIN = (const float*)(a.ws + WS_SCIN);
    const float* TLB = (const float*)(a.ws + WS_TLB); const float* TBB = (const float*)(a.ws + WS_TBB);
    float* Sst = (float*)(F.ldsg + RING_OFF + F.wave * 16384);
    float* Yf = Sst + 2048;
    float* Ub = (float*)(F.ldsg + XTRA_OFF + F.wave * 1024);
    const int gw = F.vcu * NWAVES + F.wave, NGW = F.G * NWAVES;
    for (int u = gw; u < NSCH * 32; u += NGW) {
        const int ch = u >> 5, g = u & 31, tok0 = ch * SCH;
        for (int dir = 0; dir < 2; ++dir) {
            const int dg = dir * 32 + g;
            const float lbr = TLB[((size_t)dg * 64 + lane) * 2], lbi = TLB[((size_t)dg * 64 + lane) * 2 + 1];
            float bbr[16], bbi[16];
            { const f32x4* tb = (const f32x4*)(TBB + ((size_t)dg * 64 + lane) * 32);
#pragma unroll
              for (int q = 0; q < 4; ++q) { const f32x4 x = tb[q], y = tb[4 + q]; bbr[4 * q] = x.x; bbr[4 * q + 1] = x.y; bbr[4 * q + 2] = x.z; bbr[4 * q + 3] = x.w; bbi[4 * q] = y.x; bbi[4 * q + 1] = y.y; bbi[4 * q + 2] = y.z; bbi[4 * q + 3] = y.w; } }
            float cr[64], ci[64];
            if (MODE) { const int h = lane & 15; const f32x4* pr = (const f32x4*)(a.in[I_CRE] + (((size_t)(l * 2 + dir) * 32 + g) * 16 + h) * 64); const f32x4* pi = (const f32x4*)(a.in[I_CIM] + (((size_t)(l * 2 + dir) * 32 + g) * 16 + h) * 64);
#pragma unroll
              for (int q = 0; q < 16; ++q) { const f32x4 x = pr[q], y = pi[q]; cr[4 * q] = x.x; cr[4 * q + 1] = x.y; cr[4 * q + 2] = x.z; cr[4 * q + 3] = x.w; ci[4 * q] = y.x; ci[4 * q + 1] = y.y; ci[4 * q + 2] = y.z; ci[4 * q + 3] = y.w; } }
            float sr = 0.f, si = 0.f;
            if (MODE) { const float* cp = CIN + ((((size_t)ch * 2 + dir) * 32 + g) * 64 + lane) * 2; sr = cp[0]; si = cp[1]; }
            for (int b = 0; b < SCH / 16; ++b) {
                { const int tt = lane >> 2, hq = lane & 3; const int tl = dir ? (SCH - 1 - (16 * b + tt)) : (16 * b + tt);
                  const v2u w = *(const v2u*)(Z + (size_t)(tok0 + tl) * ZW + ZXS + g * 16 + hq * 4);
                  LDS_WAIT();
                  *(f32x4*)(Ub + tt * 16 + hq * 4) = (f32x4){bflo(w.x), bfhi(w.x), bflo(w.y), bfhi(w.y)};
                  LDS_WAIT(); }
                for (int tt = 0; tt < 16; ++tt) {
                    const f32x4 u0 = *(const f32x4*)(Ub + tt * 16), u1 = *(const f32x4*)(Ub + tt * 16 + 4), u2 = *(const f32x4*)(Ub + tt * 16 + 8), u3 = *(const f32x4*)(Ub + tt * 16 + 12);
                    float ir = u0.x * bbr[0] + u0.y * bbr[1] + u0.z * bbr[2] + u0.w * bbr[3] + u1.x * bbr[4] + u1.y * bbr[5] + u1.z * bbr[6] + u1.w * bbr[7]
                             + u2.x * bbr[8] + u2.y * bbr[9] + u2.z * bbr[10] + u2.w * bbr[11] + u3.x * bbr[12] + u3.y * bbr[13] + u3.z * bbr[14] + u3.w * bbr[15];
                    float ii = u0.x * bbi[0] + u0.y * bbi[1] + u0.z * bbi[2] + u0.w * bbi[3] + u1.x * bbi[4] + u1.y * bbi[5] + u1.z * bbi[6] + u1.w * bbi[7]
                             + u2.x * bbi[8] + u2.y * bbi[9] + u2.z * bbi[10] + u2.w * bbi[11] + u3.x * bbi[12] + u3.y * bbi[13] + u3.z * bbi[14] + u3.w * bbi[15];
                    const float nr = lbr * sr - lbi * si + ir, ni = lbr * si + lbi * sr + ii; sr = nr; si = ni;
                    if (MODE) { Sst[(tt * 64 + lane) * 2] = sr; Sst[(tt * 64 + lane) * 2 + 1] = si; }
                }
                if (MODE) {
                    LDS_WAIT();
                    const int h = lane & 15, tq = lane >> 4;
#pragma unroll
                    for (int j = 0; j < 4; ++j) { const int slot = tq * 4 + j; const float* sp = Sst + slot * 128; float y = 0.f;
#pragma unroll
                        for (int p = 0; p < 64; p += 2) { const f32x4 s4 = *(const f32x4*)(sp + 2 * p); y += s4.x * cr[p] - s4.y * ci[p] + s4.z * cr[p + 1] - s4.w * ci[p + 1]; }
                        const int tl = dir ? (SCH - 1 - (16 * b + slot)) : (16 * b + slot);
                        if (dir == 0) Yf[tl * 16 + h] = y; else Yf[tl * 16 + h] += y; }
                    LDS_WAIT();
                }
            }
            if (!MODE) { float* ep = E + ((((size_t)ch * 2 + dir) * 32 + g) * 64 + lane) * 2; ep[0] = sr; ep[1] = si; }
        }
        if (MODE) {
            LDS_WAIT();
            for (int i = 0; i < 32; ++i) { const int idx = lane + 64 * i, tl = idx >> 4, h = idx & 15; const size_t tok = (size_t)(tok0 + tl);
                const float xs = bf2f(Z[tok * ZW + ZXS + g * 16 + h]); const float y = Yf[tl * 16 + h] + a.in[I_SD][(size_t)l * 512 + g * 16 + h] * xs;
                YG[tok * 512 + g * 16 + h] = (bf16)f2bf(gelu_tanh(y)); }
            LDS_WAIT();
        }
    }
}

template <int MODE, int DIR> __device__ __forceinline__ void s5_dir(const Args& a, int l, int lane, int tok0, int gr, LAS unsigned char* st, bf16* yf) {
    const bf16* Z = (const bf16*)(a.ws + WS_ZR); bf16* YG = (bf16*)(a.ws + WS_YG);
    float* E = (float*)(a.ws + WS_SEND); const float* CIN = (const float*)(a.ws + WS_SCIN); const float* TLB = (const float*)(a.ws + WS_TLB);
    const int n = lane & 15, g = lane >> 4, dg = DIR * 32 + gr, ch = tok0 / SCH + g;
    pg8::bf16x8 bbf[8], cf[4];
    { const pg8::bf16x8* bp = (const pg8::bf16x8*)(a.ws + WS_TBBF) + (size_t)dg * 8 * 64 + lane;
#pragma unroll
      for (int c = 0; c < 8; ++c) bbf[c] = bp[c * 64]; }
    if (MODE) { const pg8::bf16x8* cp = (const pg8::bf16x8*)(a.ws + WS_TCF) + (size_t)dg * 4 * 64 + lane;
#pragma unroll
      for (int c = 0; c < 4; ++c) cf[c] = cp[c * 64]; }
    float lbr[4], lbi[4], sr[4], si[4];
#pragma unroll
    for (int cb = 0; cb < 4; ++cb) { const size_t ix = ((size_t)dg * 64 + 16 * cb + n) * 2; lbr[cb] = TLB[ix]; lbi[cb] = TLB[ix + 1];
        if (MODE) { const size_t cx = ((((size_t)ch * 2 + DIR) * 32 + gr) * 64 + 16 * cb + n) * 2; sr[cb] = CIN[cx]; si[cb] = CIN[cx + 1]; } else { sr[cb] = 0.f; si[cb] = 0.f; } }
    const float dsk = MODE ? a.in[I_SD][(size_t)l * 512 + 16 * gr + n] : 0.f;
    const bf16* ua = Z + (size_t)(tok0 + (n >> 2) * SCH + (n & 3)) * ZRW + RXS + 16 * gr + 8 * (g & 1);
    bf16* yo = YG + (size_t)(tok0 + g * SCH) * 512 + 16 * gr + n;
    const bf16* xo = Z + (size_t)(tok0 + g * SCH) * ZRW + RXS + 16 * gr + n;
    constexpr int NST = SCH / 4, T0 = DIR ? (SCH - 4) : 0, DT = DIR ? -4 : 4;
    pg8::bf16x8 un = *(const pg8::bf16x8*)(ua + (size_t)T0 * ZRW);
    unsigned short ygn[4], xsn[4];
    if (MODE && DIR) {
        VM_WAIT();
#pragma unroll
        for (int rg = 0; rg < 4; ++rg) { ygn[rg] = yf[((T0 >> 2) * 4 + rg) * 64 + lane]; xsn[rg] = xo[(size_t)(T0 + rg) * ZRW]; } }
#pragma unroll 1
    for (int step = 0; step < NST; ++step) {
        const int t4 = T0 + DT * step;
        const pg8::bf16x8 u8 = un; unsigned short ygc[4], xsc[4];
        if (MODE && DIR) {
#pragma unroll
            for (int rg = 0; rg < 4; ++rg) { ygc[rg] = ygn[rg]; xsc[rg] = xsn[rg]; } }
        if (step + 1 < NST) { un = *(const pg8::bf16x8*)(ua + (size_t)(t4 + DT) * ZRW);
            if (MODE && DIR) {
#pragma unroll
                for (int rg = 0; rg < 4; ++rg) { ygn[rg] = yf[(((t4 + DT) >> 2) * 4 + rg) * 64 + lane]; xsn[rg] = xo[(size_t)(t4 + DT + rg) * ZRW]; } } }
        f32x4 in[8];
#pragma unroll
        for (int c = 0; c < 8; ++c) in[c] = __builtin_amdgcn_mfma_f32_16x16x32_bf16(u8, bbf[c], (f32x4){0.f, 0.f, 0.f, 0.f}, 0, 0, 0);
        float str[4][4], sti[4][4];
#pragma unroll
        for (int rr = 0; rr < 4; ++rr) { const int rg = DIR ? 3 - rr : rr;
#pragma unroll
            for (int cb = 0; cb < 4; ++cb) { const float nr = lbr[cb] * sr[cb] - lbi[cb] * si[cb] + in[cb][rg], ni = lbr[cb] * si[cb] + lbi[cb] * sr[cb] + in[4 + cb][rg];
                sr[cb] = nr; si[cb] = ni; str[cb][rg] = nr; sti[cb][rg] = ni; } }
        if (MODE) {
#pragma unroll
            for (int rg = 0; rg < 4; ++rg) { v4u w; w.x = pk2s(str[0][rg], sti[0][rg]); w.y = pk2s(str[1][rg], sti[1][rg]); w.z = pk2s(str[2][rg], sti[2][rg]); w.w = pk2s(str[3][rg], sti[3][rg]);
                *(LAS v4u*)(st + (4 * g + rg) * 272 + n * 16) = w; asm volatile("s_nop 1" ::: "memory"); }
            LDS_WAIT();
            f32x4 y = (f32x4){0.f, 0.f, 0.f, 0.f};
#pragma unroll
            for (int ks = 0; ks < 4; ++ks) { const pg8::bf16x8 sf = *(const LAS pg8::bf16x8*)(st + n * 272 + ks * 64 + g * 16); y = __builtin_amdgcn_mfma_f32_16x16x32_bf16(sf, cf[ks], y, 0, 0, 0); }
            LDS_WAIT();
#pragma unroll
            for (int rg = 0; rg < 4; ++rg) {
                if (DIR == 0) yf[((t4 >> 2) * 4 + rg) * 64 + lane] = (bf16)f2bf(y[rg]);
                else { const float v = y[rg] + bf2f(ygc[rg]) + dsk * bf2f(xsc[rg]); yo[(size_t)(t4 + rg) * 512] = (bf16)f2bf(gelu_tanh(v)); } }
        }
    }
    if (!MODE) {
#pragma unroll
        for (int cb = 0; cb < 4; ++cb) { const size_t cx = ((((size_t)ch * 2 + DIR) * 32 + gr) * 64 + 16 * cb + n) * 2; E[cx] = sr[cb]; E[cx + 1] = si[cb]; } }
}

template <int MODE, int DIR> __device__ __forceinline__ void lru_dir(const Args& a, int l, int lane, int tok0, int nb, int half, const LAS unsigned char* xt, bf16* hf) {
    const bf16* Z = (const bf16*)(a.ws + WS_ZR); bf16* Y = (bf16*)(a.ws + WS_Y);
    float* agg = (float*)(a.ws + WS_LAGG); const float* cin = (const float*)(a.ws + WS_LCIN);
    const int n = lane & 15, g = lane >> 4, ch = tok0 / LCH + g;
    pg8::bf16x8 wa[2][2], wx[2][2];
    { const pg8::bf16x8* wp = (const pg8::bf16x8*)(a.ws + WS_TWF) + (size_t)((DIR * 8 + nb) * 2) * 4 * 2 * 64 + lane;
#pragma unroll
      for (int c2 = 0; c2 < 2; ++c2)
#pragma unroll
          for (int ks = 0; ks < 2; ++ks) { wa[c2][ks] = wp[((2 * half + c2) * 2 + ks) * 64]; wx[c2][ks] = wp[(8 + (2 * half + c2) * 2 + ks) * 64]; } }
    pg8::bf16x8 idn[2];
#pragma unroll
    for (int hf = 0; hf < 2; ++hf) { v4u w;
#pragma unroll
        for (int jj = 0; jj < 4; ++jj) { const int k0 = 8 * g + 2 * jj; w[jj] = ((k0 == 16 * hf + n) ? 0x3f80u : 0u) | ((k0 + 1 == 16 * hf + n) ? 0x3f800000u : 0u); }
        idn[hf] = __builtin_bit_cast(pg8::bf16x8, w); }
    float ba[2], bx[2], ls8[2], h[2], P[2];
    const int cch = 64 * nb + 32 * half + n;
#pragma unroll
    for (int c2 = 0; c2 < 2; ++c2) { const int c = cch + 16 * c2; const size_t ix = (size_t)(l * 2 + DIR) * 512 + c;
        ba[c2] = -1.4426950408889634f * a.in[I_LBA][ix]; bx[c2] = -1.4426950408889634f * a.in[I_LBX][ix]; ls8[c2] = (-8.f * 1.4426950408889634f) * log1pf(__expf(-a.in[I_LAM][ix]));
        h[c2] = MODE ? cin[((size_t)ch * 2 + DIR) * 512 + c] : 0.f; P[c2] = 1.f; }
    const LAS unsigned char* xa = xt + ((n >> 2) * LCH + (n & 3)) * 128 + g * 16;
    bf16* yo = Y + (size_t)(tok0 + g * LCH) * DM + 1024 + cch;
    const bf16* go = Z + (size_t)(tok0 + g * LCH) * ZRW + RGT + cch;
    constexpr int NST = LCH / 4, T0 = DIR ? (LCH - 4) : 0, DT = DIR ? -4 : 4;
    unsigned short yn[2][4], gn[2][4];
    if (MODE && DIR) {
        VM_WAIT();
#pragma unroll
        for (int rg = 0; rg < 4; ++rg)
#pragma unroll
            for (int c2 = 0; c2 < 2; ++c2) { yn[c2][rg] = hf[(((T0 >> 2) * 4 + rg) * 2 + c2) * 64 + lane]; gn[c2][rg] = go[(size_t)(T0 + rg) * ZRW + 16 * c2]; } }
#pragma unroll 1
    for (int step = 0; step < NST; ++step) {
        const int t4 = T0 + DT * step;
        unsigned short yc[2][4], gc[2][4];
        if (MODE && DIR) {
#pragma unroll
            for (int rg = 0; rg < 4; ++rg)
#pragma unroll
                for (int c2 = 0; c2 < 2; ++c2) { yc[c2][rg] = yn[c2][rg]; gc[c2][rg] = gn[c2][rg]; }
            if (step + 1 < NST) {
#pragma unroll
                for (int rg = 0; rg < 4; ++rg)
#pragma unroll
                    for (int c2 = 0; c2 < 2; ++c2) { yn[c2][rg] = hf[((((t4 + DT) >> 2) * 4 + rg) * 2 + c2) * 64 + lane]; gn[c2][rg] = go[(size_t)(t4 + DT + rg) * ZRW + 16 * c2]; } } }
        const pg8::bf16x8 a0 = *(const LAS pg8::bf16x8*)(xa + t4 * 128), a1 = *(const LAS pg8::bf16x8*)(xa + t4 * 128 + 64);
        const pg8::bf16x8 ah = half ? a1 : a0;
        f32x4 pa[2], px[2], xd[2];
#pragma unroll
        for (int c2 = 0; c2 < 2; ++c2) { const f32x4 z4 = (f32x4){0.f, 0.f, 0.f, 0.f};
            pa[c2] = __builtin_amdgcn_mfma_f32_16x16x32_bf16(a0, wa[c2][0], z4, 0, 0, 0); pa[c2] = __builtin_amdgcn_mfma_f32_16x16x32_bf16(a1, wa[c2][1], pa[c2], 0, 0, 0);
            px[c2] = __builtin_amdgcn_mfma_f32_16x16x32_bf16(a0, wx[c2][0], z4, 0, 0, 0); px[c2] = __builtin_amdgcn_mfma_f32_16x16x32_bf16(a1, wx[c2][1], px[c2], 0, 0, 0);
            xd[c2] = __builtin_amdgcn_mfma_f32_16x16x32_bf16(ah, idn[c2], z4, 0, 0, 0); }
#pragma unroll
        for (int rr = 0; rr < 4; ++rr) { const int rg = DIR ? 3 - rr : rr;
#pragma unroll
            for (int c2 = 0; c2 < 2; ++c2) {
                const float r_ = frcp(1.f + __builtin_amdgcn_exp2f(__builtin_fmaf(pa[c2][rg], -1.4426950408889634f, ba[c2]))), i_ = frcp(1.f + __builtin_amdgcn_exp2f(__builtin_fmaf(px[c2][rg], -1.4426950408889634f, bx[c2])));
                const float av = __builtin_amdgcn_exp2f(ls8[c2] * r_), mult = fsqrt_(fmaxf(1.f - av * av, 0.f));
                h[c2] = av * h[c2] + mult * i_ * xd[c2][rg]; P[c2] *= av;
                if (MODE) {
                    if (DIR == 0) hf[(((t4 >> 2) * 4 + rg) * 2 + c2) * 64 + lane] = (bf16)f2bf(h[c2]);
                    else yo[(size_t)(t4 + rg) * DM + 16 * c2] = (bf16)f2bf((bf2f(yc[c2][rg]) + h[c2]) * gelu_tanh(bf2f(gc[c2][rg]))); } }
        }
    }
    if (!MODE) {
#pragma unroll
        for (int c2 = 0; c2 < 2; ++c2) { float* ag = agg + (((size_t)ch * 2 + DIR) * 512 + cch + 16 * c2) * 2; ag[0] = P[c2]; ag[1] = h[c2]; } }
}
__device__ __forceinline__ void lru_prepass(const Args& a, int l, int lane, int tok0, int nb, LAS unsigned char* xt) {
    const bf16* Z = (const bf16*)(a.ws + WS_ZR);
    int s0, T; seq_of(tok0, s0, T); const int s1 = s0 + T;
    const int oc = lane & 7, tg = lane >> 3, cbase = 64 * nb + 8 * oc; float cw[4][8], cbv[8];
    v4u x[19];
    const int tb = tok0 + 16 * tg - 2;
#pragma unroll
    for (int i = 0; i < 19; ++i) { const int tt = tb + i; x[i] = (v4u){0u, 0u, 0u, 0u}; if (tt >= s0 && tt < s1) x[i] = *(const v4u*)(Z + (size_t)tt * ZRW + RXR + cbase); }
#pragma unroll
    for (int tp = 0; tp < 4; ++tp) { const f32x4* wp = (const f32x4*)(a.in[I_CW] + ((size_t)l * 4 + tp) * 512 + cbase); const f32x4 w0 = wp[0], w1 = wp[1];
        cw[tp][0] = w0.x; cw[tp][1] = w0.y; cw[tp][2] = w0.z; cw[tp][3] = w0.w; cw[tp][4] = w1.x; cw[tp][5] = w1.y; cw[tp][6] = w1.z; cw[tp][7] = w1.w; }
    { const f32x4* bp = (const f32x4*)(a.in[I_CB] + (size_t)l * 512 + cbase); const f32x4 b0 = bp[0], b1 = bp[1]; cbv[0] = b0.x; cbv[1] = b0.y; cbv[2] = b0.z; cbv[3] = b0.w; cbv[4] = b1.x; cbv[5] = b1.y; cbv[6] = b1.z; cbv[7] = b1.w; }
    LDS_WAIT();
#pragma unroll
    for (int i = 0; i < 16; ++i) { float acc[8];
#pragma unroll
        for (int e = 0; e < 8; ++e) acc[e] = cbv[e];
#pragma unroll
        for (int tp = 0; tp < 4; ++tp) { const v4u xx = x[i + tp];
            acc[0] += cw[tp][0] * bflo(xx.x); acc[1] += cw[tp][1] * bfhi(xx.x); acc[2] += cw[tp][2] * bflo(xx.y); acc[3] += cw[tp][3] * bfhi(xx.y);
            acc[4] += cw[tp][4] * bflo(xx.z); acc[5] += cw[tp][5] * bfhi(xx.z); acc[6] += cw[tp][6] * bflo(xx.w); acc[7] += cw[tp][7] * bfhi(xx.w); }
        v4u o; o.x = pk2(acc[0], acc[1]); o.y = pk2(acc[2], acc[3]); o.z = pk2(acc[4], acc[5]); o.w = pk2(acc[6], acc[7]);
        *(LAS v4u*)(xt + (16 * tg + i) * 128 + oc * 16) = o; asm volatile("s_nop 1" ::: "memory"); }
    LDS_WAIT();
}
template <int MODE> __device__ __forceinline__ void ph_scan(const Args& a, const Frame& F, int l) {
    int tid = threadIdx.x; asm volatile("" : "+v"(tid)); int lane = tid & 63; (void)lane;
    LAS unsigned char* slab = F.lds + RING_OFF + F.wave * 16384;
    LAS int* ctr = (LAS int*)(F.lds + MISC_OFF + 64);
    __syncthreads(); if (tid == 0) *ctr = 0; __syncthreads();
    constexpr int NLU = (NLCH / 4) * 16, NSU = (NSCH / 4) * 32;
    const int l0 = (int)((long)NLU * F.vcu / F.G), l1 = (int)((long)NLU * (F.vcu + 1) / F.G), s0u = (int)((long)NSU * F.vcu / F.G), s1u = (int)((long)NSU * (F.vcu + 1) / F.G);
    const int nl = l1 - l0, ntot = nl + (s1u - s0u);
    for (;;) {
        int it = 0; if (lane == 0) it = __hip_atomic_fetch_add(ctr, 1, __ATOMIC_RELAXED, __HIP_MEMORY_SCOPE_WORKGROUP);
        it = __builtin_amdgcn_readfirstlane(it);
        if (it >= ntot) break;
        if (it < nl) { const int u = l0 + it, half = u & 1, nb = (u >> 1) & 7, cq = u >> 4, tok0 = cq * 4 * LCH;
            bf16* hf = (bf16*)(a.ws + WS_HF) + (size_t)u * 4096;
            lru_prepass(a, l, lane, tok0, nb, slab);
            lru_dir<MODE, 0>(a, l, lane, tok0, nb, half, slab, hf); lru_dir<MODE, 1>(a, l, lane, tok0, nb, half, slab, hf);
        } else { const int u = s0u + it - nl, gr = u & 31, cq = u >> 5, tok0 = cq * 4 * SCH;
            bf16* yf = (bf16*)(a.ws + WS_HF + 40 * MiB) + (size_t)u * 4096;
            s5_dir<MODE, 0>(a, l, lane, tok0, gr, slab, yf); s5_dir<MODE, 1>(a, l, lane, tok0, gr, slab, yf); }
    }
    LDS_WAIT();
}

__device__ __forceinline__ void ph_carries(const Args& a, const Frame& F, int l) {
    int tid = threadIdx.x; asm volatile("" : "+v"(tid)); int lane = tid & 63; (void)lane;
    constexpr int NL_LONG = 2 * 2 * 512 * (16384 / LCH / 16), NL_SHORT = 4 * 2 * 512 * (2048 / LCH / 16);
    constexpr int NS_LONG = 2 * 2 * 2048 * (16384 / SCH / 16), NS_SHORT = 4 * 2 * 2048 * (2048 / SCH / 16);
    constexpr int NITEM = NL_LONG + NL_SHORT + NS_LONG + NS_SHORT;
    static_assert(NL_LONG % 512 == 0 && NL_SHORT % 512 == 0 && NS_LONG % 512 == 0 && NS_SHORT % 512 == 0, "item classes are whole workgroups");
    for (int base = F.vcu * NTHR; base < NITEM; base += F.G * NTHR) {
        int it = base + tid;
        if (it < NL_LONG + NL_SHORT) {
            const bool lg = it < NL_LONG; if (!lg) it -= NL_LONG;
            const int W = lg ? (16384 / LCH / 16) : (2048 / LCH / 16); const int seg = it & (W - 1), chain = it / W;
            const int c = chain & 511, dir = (chain >> 9) & 1, sq = chain >> 10; const int s0 = lg ? 8192 + sq * 16384 : sq * 2048, T = lg ? 16384 : 2048; const int c0 = s0 / LCH, nc = T / LCH;
            const f32x2* agg = (const f32x2*)(a.ws + WS_LAGG); float* cin = (float*)(a.ws + WS_LCIN);
            f32x2 v[16]; float A = 1.f, B = 0.f;
#pragma unroll
            for (int j = 0; j < 16; ++j) { const int pos = seg * 16 + j, ch = c0 + (dir ? nc - 1 - pos : pos); v[j] = agg[((size_t)ch * 2 + dir) * 512 + c]; }
#pragma unroll
            for (int j = 0; j < 16; ++j) { B = v[j].x * B + v[j].y; A *= v[j].x; }
            for (int off = 1; off < W; off <<= 1) { const float Ap = __shfl_up(A, off, 64), Bp = __shfl_up(B, off, 64); if (seg >= off) { B = A * Bp + B; A = A * Ap; } }
            float carry = __shfl_up(B, 1, 64); if (seg == 0) carry = 0.f;
#pragma unroll
            for (int j = 0; j < 16; ++j) { const int pos = seg * 16 + j, ch = c0 + (dir ? nc - 1 - pos : pos); cin[((size_t)ch * 2 + dir) * 512 + c] = carry; carry = v[j].x * carry + v[j].y; }
        } else {
            it -= NL_LONG + NL_SHORT;
            const bool lg = it < NS_LONG; if (!lg) it -= NS_LONG;
            const int W = lg ? (16384 / SCH / 16) : (2048 / SCH / 16); const int seg = it & (W - 1), chain = it / W;
            const int p = chain & 63, g = (chain >> 6) & 31, dir = (chain >> 11) & 1, sq = chain >> 12; const int s0 = lg ? 8192 + sq * 16384 : sq * 2048, T = lg ? 16384 : 2048; const int c0 = s0 / SCH, nc = T / SCH;
            const float* TLB = (const float*)(a.ws + WS_TLB); const f32x2* E = (const f32x2*)(a.ws + WS_SEND); f32x2* CIN = (f32x2*)(a.ws + WS_SCIN);
            float pr = TLB[((size_t)(dir * 32 + g) * 64 + p) * 2], pi = TLB[((size_t)(dir * 32 + g) * 64 + p) * 2 + 1];
            static_assert(SCH == 64, "lb^SCH by 6 squarings");
#pragma unroll
            for (int i = 0; i < 6; ++i) { const float nr = pr * pr - pi * pi, ni = 2.f * pr * pi; pr = nr; pi = ni; }
            f32x2 v[16]; float Br = 0.f, Bi = 0.f;
#pragma unroll
            for (int j = 0; j < 16; ++j) { const int pos = seg * 16 + j, ch = c0 + (dir ? nc - 1 - pos : pos); v[j] = E[(((size_t)ch * 2 + dir) * 32 + g) * 64 + p]; }
#pragma unroll
            for (int j = 0; j < 16; ++j) { const float nr = pr * Br - pi * Bi + v[j].x, ni = pr * Bi + pi * Br + v[j].y; Br = nr; Bi = ni; }
            float Ar = pr, Ai = pi;
#pragma unroll
            for (int i = 0; i < 4; ++i) { const float nr = Ar * Ar - Ai * Ai, ni = 2.f * Ar * Ai; Ar = nr; Ai = ni; }
            for (int off = 1; off < W; off <<= 1) { const float Apr = __shfl_up(Ar, off, 64), Api = __shfl_up(Ai, off, 64), Bpr = __shfl_up(Br, off, 64), Bpi = __shfl_up(Bi, off, 64);
                if (seg >= off) { const float nbr = Ar * Bpr - Ai * Bpi + Br, nbi = Ar * Bpi + Ai * Bpr + Bi, nar = Ar * Apr - Ai * Api, nai = Ar * Api + Ai * Apr; Br = nbr; Bi = nbi; Ar = nar; Ai = nai; } }
            float cr = __shfl_up(Br, 1, 64), ci = __shfl_up(Bi, 1, 64); if (seg == 0) { cr = 0.f; ci = 0.f; }
#pragma unroll
            for (int j = 0; j < 16; ++j) { const int pos = seg * 16 + j, ch = c0 + (dir ? nc - 1 - pos : pos); CIN[(((size_t)ch * 2 + dir) * 32 + g) * 64 + p] = (f32x2){cr, ci};
                const float nr = pr * cr - pi * ci + v[j].x, ni = pr * ci + pi * cr + v[j].y; cr = nr; ci = ni; }
        }
    }
}

__device__ __forceinline__ void ph_groupnorm(const Args& a, const Frame& F, int l, bf16* dst = nullptr) {
    int tid = threadIdx.x; asm volatile("" : "+v"(tid)); int lane = tid & 63; (void)lane;
    bf16* Y = (bf16*)(a.ws + WS_Y); const float* g = a.in[I_GOUT] + (size_t)l * DM;
    const int gw = F.vcu * NWAVES + F.wave, NGW = F.G * NWAVES;
    static_assert(NTOK % (256 * NWAVES * 4) == 0 || true, "");
    for (int m0 = gw; m0 < NTOK; m0 += 4 * NGW) {
        v4u w[4][4];
#pragma unroll
        for (int r = 0; r < 4; ++r) { const int m = m0 + r * NGW; const v4u* yr = (const v4u*)(Y + (size_t)(m < NTOK ? m : m0) * DM) + lane;
#pragma unroll
            for (int j = 0; j < 4; ++j) w[r][j] = yr[64 * j]; }
        f32x4 g0[4], g1[4];
#pragma unroll
        for (int j = 0; j < 4; ++j) { const f32x4* gp = (const f32x4*)(g + 8 * (lane + 64 * j)); g0[j] = gp[0]; g1[j] = gp[1]; }
#pragma unroll
        for (int r = 0; r < 4; ++r) { const int m = m0 + r * NGW; float ss[4];
#pragma unroll
            for (int j = 0; j < 4; ++j) { float sq = 0.f;
#pragma unroll
                for (int q = 0; q < 4; ++q) { const float lo = bflo(w[r][j][q]), hi = bfhi(w[r][j][q]); sq += lo * lo + hi * hi; }
                ss[j] = sq; }
            const float sa = wave_sum(ss[0] + ss[1]), sb = wave_sum(ss[2]), sc = wave_sum(ss[3]);
            const float ra = 1.f / sqrtf(sa * (1.f / 1024.f) + EPS), rb = 1.f / sqrtf(sb * (1.f / 512.f) + EPS), rc = 1.f / sqrtf(sc * (1.f / 512.f) + EPS);
            if (m < NTOK) {
                v4u* yo = (dst ? (v4u*)(dst + (size_t)m * DM) : (v4u*)(Y + (size_t)m * DM)) + lane;
#pragma unroll
                for (int j = 0; j < 4; ++j) { const float rr = j < 2 ? ra : (j == 2 ? rb : rc);
                    v4u o; o.x = pk2(bflo(w[r][j].x) * rr * g0[j].x, bfhi(w[r][j].x) * rr * g0[j].y); o.y = pk2(bflo(w[r][j].y) * rr * g0[j].z, bfhi(w[r][j].y) * rr * g0[j].w);
                    o.z = pk2(bflo(w[r][j].z) * rr * g1[j].x, bfhi(w[r][j].z) * rr * g1[j].y); o.w = pk2(bflo(w[r][j].w) * rr * g1[j].z, bfhi(w[r][j].w) * rr * g1[j].w);
                    yo[64 * j] = o; } } }
    }
}

__device__ __forceinline__ void ph_norm2(const Args& a, const Frame& F, int l) {
    int tid = threadIdx.x; asm volatile("" : "+v"(tid)); int lane = tid & 63; (void)lane;
    const int gw = F.vcu * NWAVES + F.wave, NGW = F.G * NWAVES; const float* g = a.in[I_NLG] + (size_t)l * DM; bf16* H = (bf16*)(a.ws + WS_H);
    for (int m = gw; m < NTOK; m += NGW) norm_row_bf16(a.out + (size_t)m * DM, g, H + (size_t)m * DM, lane);
}
__device__ __forceinline__ void ph_final(const Args& a, const Frame& F, float* dst = nullptr) {
    int tid = threadIdx.x; asm volatile("" : "+v"(tid)); int lane = tid & 63; (void)lane;
    const int gw = F.vcu * NWAVES + F.wave, NGW = F.G * NWAVES; const f32x4* gr = (const f32x4*)a.in[I_FING] + lane;
    for (int m0 = gw; m0 < NTOK; m0 += 2 * NGW) {
        f32x4 v[2][8];
#pragma unroll
        for (int r = 0; r < 2; ++r) { const int m = m0 + r * NGW; const f32x4* xr = (const f32x4*)(a.out + (size_t)(m < NTOK ? m : m0) * DM) + lane;
#pragma unroll
            for (int j = 0; j < 8; ++j) v[r][j] = xr[64 * j]; }
#pragma unroll
        for (int r = 0; r < 2; ++r) { const int m = m0 + r * NGW; float sq = 0.f;
#pragma unroll
            for (int j = 0; j < 8; ++j) sq += (v[r][j].x * v[r][j].x + v[r][j].y * v[r][j].y) + (v[r][j].z * v[r][j].z + v[r][j].w * v[r][j].w);
            const float rstd = 1.f / sqrtf(wave_sum(sq) * (1.f / DM) + EPS);
            if (m < NTOK) { f32x4* xo = (dst ? (f32x4*)(dst + (size_t)m * DM) : (f32x4*)(a.out + (size_t)m * DM)) + lane;
#pragma unroll
                for (int j = 0; j < 8; ++j) xo[64 * j] = v[r][j] * rstd * gr[64 * j]; } }
    }
}

__global__ void __launch_bounds__(NTHR, 2) mk_fwd(Args args) {
    extern __shared__ __attribute__((aligned(16))) unsigned char lds[];
    Frame F; F.lds = (LAS unsigned char*)lds; F.ldsg = lds;
    F.tid = threadIdx.x; F.lane = F.tid & 63; F.wave = __builtin_amdgcn_readfirstlane(F.tid >> 6);
    F.G = gridDim.x; { const int bx = blockIdx.x; F.vcu = (F.G % 8 == 0) ? (bx % 8) * (F.G / 8) + bx / 8 : bx; }
    volatile LAS unsigned* MISC = (volatile LAS unsigned*)(F.lds + MISC_OFF);
    for (int u = F.tid; u < (LDS_BYTES - LDSCTL_OFF) / 4; u += NTHR) ((LAS unsigned*)(F.lds + LDSCTL_OFF))[u] = 0u;
    __syncthreads();
    unsigned char* ws = args.ws;
    XcdBarrier bar; bar.bar = (unsigned*)(ws + WS_CTL) + CW_BAR; bar.x = 0; bar.st = nullptr;
#if MK_ONE_LAUNCH
    bar = xcd_barrier_post((unsigned*)(ws + WS_CTL) + CW_BAR, MISC + 8);
#endif
    const int lo = args.ph_lo, hi = args.ph_hi;
#define IN(k) (lo <= (k) && (k) < hi)
#if MK_ONE_LAUNCH
#if PROBE_BAR2
#define SEAM(k) do { if (IN(k) && IN((k) + 1)) { xcd_barrier(bar); xcd_barrier(bar); } } while (0)
#else
#define SEAM(k) do { if (IN(k) && IN((k) + 1)) xcd_barrier(bar); } while (0)
#endif
#else
#define SEAM(k) do { } while (0)
#endif
    for (int l = 0; l < DEPTH; ++l) {
        const int pb = l * PH_PER_LAYER;
        if (IN(pb + 0)) { ph_prologue(args, F, l);
#if PROBE_PRO2
            __syncthreads(); ph_prologue(args, F, l);
#endif
        } SEAM(pb + 0);
        if (IN(pb + 1)) {
            pg8::Gemm g{(const bf16*)(ws + WS_H), (const bf16*)(ws + WS_WIN), NTOK, ZW, DM}; pg8::StaticOrder S; S.init(NTOK, ZW, F.G, (int)blockIdx.x);
            pg8::EpiBf16<2> E{(bf16*)(ws + WS_Z), NTOK, (const unsigned long long*)(ws + WS_SSQ) + (size_t)(l * 2) * NTOK, (LAS float*)(F.lds + XTRA_OFF)};
            pg8::gemm_phase<pg8::EpiBf16<2>, pg8::StaticOrder, true, true>(F.lds + RING_OFF, g, S, E);
#if PROBE_WIN2
            pg8::gemm_phase<pg8::EpiBf16<2>, pg8::StaticOrder, true, true>(F.lds + RING_OFF, g, S, E);
#endif
        } SEAM(pb + 1);
        if (IN(pb + 2)) { ph_na_mfma(args, F, l); ph_scan<0>(args, F, l);
#if PROBE_NA2
            __syncthreads(); ph_na_mfma(args, F, l);
#endif
#if PROBE_SCAN2
            ph_scan<0>(args, F, l);
#endif
        } SEAM(pb + 2);
        if (IN(pb + 3)) { ph_carries(args, F, l);
#if PROBE_SCAN2 || PROBE_CAR2
            ph_carries(args, F, l);
#endif
        } SEAM(pb + 3);
        if (IN(pb + 4)) { ph_scan<1>(args, F, l);
#if PROBE_SCAN2
            ph_scan<1>(args, F, l);
#endif
        } SEAM(pb + 4);
        if (IN(pb + 5)) {
            __syncthreads();
            pg8::Gemm g{(const bf16*)(ws + WS_YG), (const bf16*)(ws + WS_WGLU), NTOK, 512, 512}; pg8::StaticOrder S; S.init(NTOK, 512, F.G, (int)blockIdx.x);
            pg8::EpiGlu E{(const bf16*)(ws + WS_YG), (bf16*)(ws + WS_Y), args.in[I_BGLU] + (size_t)l * 512, DM, 1536};
            pg8::gemm_phase<pg8::EpiGlu, pg8::StaticOrder, true, true>(F.lds + RING_OFF, g, S, E);
#if PROBE_GLU2
            pg8::gemm_phase<pg8::EpiGlu, pg8::StaticOrder, true, true>(F.lds + RING_OFF, g, S, E);
#endif
        } SEAM(pb + 5);
        if (IN(pb + 6)) {
#if PROBE_GN2
            ph_groupnorm(args, F, l, (bf16*)(ws + WS_Z));
#endif
            ph_groupnorm(args, F, l); } SEAM(pb + 6);
        if (IN(pb + 7)) {
            pg8::Gemm g{(const bf16*)(ws + WS_Y), (const bf16*)(ws + WS_WOUT), NTOK, DM, DM}; pg8::StaticOrder S; S.init(NTOK, DM, F.G, (int)blockIdx.x);
#if PROBE_WOUT2
            { pg8::EpiResid E2{l == 0 ? args.in[I_XP] : nullptr, l == 0 ? args.in[I_XS] : nullptr, 8192, (float*)(ws + WS_Z), DM, (bf16*)(ws + WS_H), nullptr};
              pg8::gemm_phase<pg8::EpiResid, pg8::StaticOrder, true, true>(F.lds + RING_OFF, g, S, E2); }
#endif
            pg8::EpiResid E{l == 0 ? args.in[I_XP] : nullptr, l == 0 ? args.in[I_XS] : nullptr, 8192, nullptr, DM, (bf16*)(ws + WS_H), (unsigned long long*)(ws + WS_SSQ) + (size_t)(l * 2 + 1) * NTOK};
            pg8::gemm_phase<pg8::EpiResid, pg8::StaticOrder, true, true>(F.lds + RING_OFF, g, S, E);
        } SEAM(pb + 7);
        for (int s = 0; s <= NMLPC; ++s) {
            if (IN(pb + 8 + s)) {
                if (s > 0) {
                    const int c = s - 1;
                    pg8::Gemm g{(const bf16*)(ws + WS_Z + (size_t)(c & 1) * 128 * MiB), (const bf16*)(ws + WS_WDN), MLPC, DM, DFF}; pg8::StaticOrder S; S.init(MLPC, DM, F.G, (int)blockIdx.x);
                    pg8::EpiResid E{nullptr, nullptr, 1 << 30, l + 1 < DEPTH ? nullptr : args.out + (size_t)c * MLPC * DM, DM,
                                    (bf16*)(ws + WS_H) + (size_t)c * MLPC * DM, (unsigned long long*)(ws + WS_SSQ) + (size_t)((l + 1 < DEPTH ? l + 1 : 0) * 2) * NTOK + (size_t)c * MLPC};
#if PROBE_DN2
                    { pg8::EpiResid E2{nullptr, nullptr, 1 << 30, (float*)(ws + WS_Z + 256 * MiB), DM, (bf16*)(ws + WS_H) + (size_t)c * MLPC * DM, nullptr};
                      pg8::gemm_phase<pg8::EpiResid, pg8::StaticOrder, true, true>(F.lds + RING_OFF, g, S, E2); }
#endif
                    pg8::gemm_phase<pg8::EpiResid, pg8::StaticOrder, true, true>(F.lds + RING_OFF, g, S, E);
                }
                if (s < NMLPC) {
                    const int c = s;
                    pg8::Gemm g{(const bf16*)(ws + WS_H) + (size_t)c * MLPC * DM, (const bf16*)(ws + WS_WUP), MLPC, DFF, DM}; pg8::StaticOrder S; S.init(MLPC, DFF, F.G, (int)blockIdx.x);
                    pg8::EpiBf16<1> E{(bf16*)(ws + WS_Z + (size_t)(c & 1) * 128 * MiB), DFF, (const unsigned long long*)(ws + WS_SSQ) + (size_t)(l * 2 + 1) * NTOK + (size_t)c * MLPC, (LAS float*)(F.lds + XTRA_OFF)};
                    pg8::gemm_phase<pg8::EpiBf16<1>, pg8::StaticOrder, true, true>(F.lds + RING_OFF, g, S, E);
#if PROBE_UP2
                    pg8::gemm_phase<pg8::EpiBf16<1>, pg8::StaticOrder, true, true>(F.lds + RING_OFF, g, S, E);
#endif
                }
            } SEAM(pb + 8 + s);
        }
    }
    if (IN(NPHASE - 1)) {
#if PROBE_FIN2
        ph_final(args, F, (float*)(ws + WS_Z));
#endif
        ph_final(args, F); }
#undef IN
#undef SEAM
}

extern "C" void kernel_launch(void* const* d_in, const int* in_sizes, int n_in, void* d_out, int out_size, void* d_ws, size_t ws_size, hipStream_t stream) {
    static int grid = 0;
    if (grid == 0) {
        if (n_in != 28 || out_size != NTOK * DM || ws_size < WS_END) { fprintf(stderr, "kernel_launch: unexpected shapes (n_in %d out %d ws %zu)\n", n_in, out_size, ws_size); grid = -1; return; }
        int dev = 0, cus = 0, per_cu = 0;
        if (hipGetDevice(&dev) != hipSuccess || hipDeviceGetAttribute(&cus, hipDeviceAttributeMultiprocessorCount, dev) != hipSuccess) { grid = -1; return; }
        if (hipFuncSetAttribute((const void*)mk_fwd, hipFuncAttributeMaxDynamicSharedMemorySize, LDS_BYTES) != hipSuccess) { fprintf(stderr, "kernel_launch: hipFuncSetAttribute failed\n"); grid = -1; return; }
        if (hipOccupancyMaxActiveBlocksPerMultiprocessor(&per_cu, (const void*)mk_fwd, NTHR, LDS_BYTES) != hipSuccess || per_cu < 1) fprintf(stderr, "kernel_launch: occupancy query says %d\n", per_cu);
        (void)hipGetLastError();
        grid = cus;
    }
    if (grid < 0) return;
    if (hipMemsetAsync((char*)d_ws + WS_CTL, 0, CTL_ZERO_BYTES, stream) != hipSuccess) return;
    if (hipMemsetAsync((char*)d_ws + WS_SSQ, 0, SSQ_BYTES, stream) != hipSuccess) return;
    Args a{};
    for (int i = 0; i < 28; ++i) a.in[i] = (const float*)d_in[i];
    a.out = (float*)d_out; a.ws = (unsigned char*)d_ws;
#if MK_ONE_LAUNCH
    a.ph_lo = 0; a.ph_hi = NPHASE;
    hipLaunchKernelGGL(mk_fwd, dim3(grid), dim3(NTHR), LDS_BYTES, stream, a);
#else
    for (int ph = 0; ph < NPHASE; ++ph) { a.ph_lo = ph; a.ph_hi = ph + 1; hipLaunchKernelGGL(mk_fwd, dim3(grid), dim3(NTHR), LDS_BYTES, stream, a); }
#endif
}
```

```cpp
#include <hip/hip_runtime.h>
#include <cstdio>
#include <cstdint>
namespace pg8 {
#define PG8_LAS __attribute__((address_space(3)))
typedef unsigned short bf16_t;
typedef short bf16x8 __attribute__((ext_vector_type(8)));
typedef float f32x4 __attribute__((ext_vector_type(4)));
typedef unsigned u32x4 __attribute__((ext_vector_type(4)));
constexpr int BM = 256, BK = 64, HALF = 128, HTB = HALF * BK * 2  , STAGE_BYTES = 8 * HTB, NXCD = 8, WGM = 8;

__host__ __device__ __forceinline__ int lds_byte(int r, int c) { const int st = (r >> 4) * 2 + (c >> 5), rr = r & 15, cc = c & 31, ob = rr * 64 + cc * 2; return st * 1024 + (ob ^ (((ob >> 9) & 1) << 5)); }
__host__ __device__ __forceinline__ void stage_rc(int b, int& R, int& C) { const int st = b / 1024, sb = b % 1024, swz = sb ^ (((sb >> 9) & 1) << 5); R = (st >> 1) * 16 + swz / 64; C = (st & 1) * 32 + (swz % 64) / 2; }
__host__ __device__ __forceinline__ int perm32(int rho) { const int n = rho >> 4, i = rho & 15; return 8 * (i >> 2) + 4 * n + (i & 3); }

struct Unit { int pm, pn; };
struct Gemm { const bf16_t* A; const bf16_t* Bt; int M, N, K; };

struct StaticOrder {
    int nM, nN, nwg, G, c;
    __host__ __device__ void init(int M, int N, int G_, int c_) { nM = M / BM; nN = N / BM; nwg = nM * nN; G = G_; c = c_; }
    __host__ __device__ bool next(int i, Unit& u) const {
        const long L = (long)i * G + c; if (L >= nwg) return false;
        int wgid = (int)L; { const int q = nwg / NXCD, r = nwg % NXCD, xcd = wgid % NXCD, off = wgid / NXCD; wgid = (xcd < r ? xcd * (q + 1) : r * (q + 1) + (xcd - r) * q) + off; }
        const int nig = WGM * nN, gid = wgid / nig, fm = gid * WGM, gsz = (nM - fm) < WGM ? (nM - fm) : WGM;
        u.pm = fm + ((wgid % nig) % gsz); u.pn = (wgid % nig) / gsz; return true;
    }
    __device__ __forceinline__ void a_ready(const Unit&) const {}
    __device__ __forceinline__ void done(const Unit&) const {}
};
__device__ __forceinline__ unsigned cvt_pk_bf16(float lo, float hi) { unsigned r; asm volatile("v_cvt_pk_bf16_f32 %0, %1, %2" : "=v"(r) : "v"(lo), "v"(hi)); return r; }
template <int ACT> struct EpiBf16 {
    static constexpr bool PERM = true, AFTER_DRAIN = false, HAS_PRE = true;
    bf16_t* O; int ldc; const unsigned long long* SS; PG8_LAS float* tbl;
    template <class Sched> __device__ __forceinline__ void pre_all(const Sched& S, int tid) const {
        unsigned long long v[12]; Unit u;
#pragma unroll
        for (int i = 0; i < 12; ++i) { v[i] = 0ull; if (S.next(i, u)) v[i] = SS[u.pm * BM + (tid & 255)]; }
#pragma unroll
        for (int i = 0; i < 12; ++i) if (tid < 256 && S.next(i, u)) tbl[i * 256 + tid] = 1.f / sqrtf((float)v[i] * (1.f / 1048576.f / 2048.f) + 1e-6f);
    }
    __device__ __forceinline__ void operator()(const f32x4 (&acc)[2][2][4][2], const Unit& u, int wr, int wc, int fr, int fq, int slot) const {
        const int row0 = u.pm * BM + wr * 64 + fr; const int col0 = u.pn * BM + wc * 64 + 8 * fq;
        const unsigned ta = (unsigned)(size_t)(tbl + slot * 256 + wr * 64 + fr);
        float rs[2][4];
#pragma unroll
        for (int ai = 0; ai < 2; ++ai)
#pragma unroll
            for (int m = 0; m < 4; ++m) asm volatile("ds_read_b32 %0, %1 offset:%2" : "=v"(rs[ai][m]) : "v"(ta), "i"((ai * HALF + m * 16) * 4));
        asm volatile("s_waitcnt lgkmcnt(0)" : "+v"(rs[0][0]), "+v"(rs[0][1]), "+v"(rs[0][2]), "+v"(rs[0][3]), "+v"(rs[1][0]), "+v"(rs[1][1]), "+v"(rs[1][2]), "+v"(rs[1][3]));
#pragma unroll
        for (int ai = 0; ai < 2; ++ai)
#pragma unroll
            for (int m = 0; m < 4; ++m) { bf16_t* rowp = O + (size_t)(row0 + ai * HALF + m * 16) * ldc + col0; const float r = rs[ai][m];
                if (ACT == 2) {
                    const size_t row = (size_t)(row0 + ai * HALF + m * 16);
                    rowp = (u.pn < 12) ? O + ((size_t)((u.pn >> 2) * 16 + (u.pn & 3) * 4 + wc) * ldc + row) * 64 + 8 * fq
                                       : O + (size_t)48 * ldc * 64 + row * 1536 + (u.pn - 12) * 256 + wc * 64 + 8 * fq; }
#pragma unroll
                for (int bj = 0; bj < 2; ++bj) { f32x4 v0 = acc[ai][bj][m][0] * r, v1 = acc[ai][bj][m][1] * r;
                    if (ACT == 1) {
#pragma unroll
                        for (int j = 0; j < 4; ++j) { const float a = fmaxf(v0[j], 0.f), b = fmaxf(v1[j], 0.f); v0[j] = a * a; v1[j] = b * b; } }
                    u32x4 w; w.x = cvt_pk_bf16(v0[0], v0[1]); w.y = cvt_pk_bf16(v0[2], v0[3]); w.z = cvt_pk_bf16(v1[0], v1[1]); w.w = cvt_pk_bf16(v1[2], v1[3]);
                    *(u32x4*)(rowp + bj * 32) = w; } }
    }
};
struct EpiResid {
    static constexpr bool PERM = true, AFTER_DRAIN = false, HAS_PRE = false;
    const float* Xin0; const float* Xin1; int split; float* Xout; int ldc; bf16_t* XB; unsigned long long* SS;
    __device__ __forceinline__ void operator()(const f32x4 (&acc)[2][2][4][2], const Unit& u, int wr, int wc, int fr, int fq, int) const {
        const int row0 = u.pm * BM + wr * 64 + fr, col0 = u.pn * BM + wc * 64 + 8 * fq;
        const float* Xin = (u.pm * BM < split) ? Xin0 : Xin1 - (size_t)split * ldc;
#pragma unroll
        for (int am = 0; am < 4; ++am) { const int ai = am >> 1, m0 = (am & 1) * 2;
            f32x4 xf[2][2][2]; u32x4 xr[2][2];
            if (Xin0) {
#pragma unroll
                for (int mm = 0; mm < 2; ++mm) { const size_t ro = (size_t)(row0 + ai * HALF + (m0 + mm) * 16) * ldc + col0;
#pragma unroll
                    for (int bj = 0; bj < 2; ++bj) { xf[mm][bj][0] = *(const f32x4*)(Xin + ro + bj * 32); xf[mm][bj][1] = *(const f32x4*)(Xin + ro + bj * 32 + 4); } }
            } else {
#pragma unroll
                for (int mm = 0; mm < 2; ++mm)
#pragma unroll
                    for (int bj = 0; bj < 2; ++bj) xr[mm][bj] = *(const u32x4*)(XB + (size_t)(row0 + ai * HALF + (m0 + mm) * 16) * ldc + col0 + bj * 32);
            }
            asm volatile("" ::: "memory");
#pragma unroll
            for (int mm = 0; mm < 2; ++mm) { const int m = m0 + mm; const int row = row0 + ai * HALF + m * 16; const size_t ro = (size_t)row * ldc + col0; float ss = 0.f;
#pragma unroll
                for (int bj = 0; bj < 2; ++bj) { f32x4 x0, x1;
                    if (Xin0) { x0 = xf[mm][bj][0]; x1 = xf[mm][bj][1]; }
                    else { const u32x4 w = xr[mm][bj];
                        x0 = (f32x4){__uint_as_float(w.x << 16), __uint_as_float(w.x & 0xffff0000u), __uint_as_float(w.y << 16), __uint_as_float(w.y & 0xffff0000u)};
                        x1 = (f32x4){__uint_as_float(w.z << 16), __uint_as_float(w.z & 0xffff0000u), __uint_as_float(w.w << 16), __uint_as_float(w.w & 0xffff0000u)}; }
                    x0 = x0 + acc[ai][bj][m][0]; x1 = x1 + acc[ai][bj][m][1];
                    if (Xout) { *(f32x4*)(Xout + ro + bj * 32) = x0; *(f32x4*)(Xout + ro + bj * 32 + 4) = x1; }
                    else { u32x4 w; w.x = cvt_pk_bf16(x0[0], x0[1]); w.y = cvt_pk_bf16(x0[2], x0[3]); w.z = cvt_pk_bf16(x1[0], x1[1]); w.w = cvt_pk_bf16(x1[2], x1[3]); *(u32x4*)(XB + ro + bj * 32) = w;
#pragma unroll
                        for (int j = 0; j < 4; ++j) { const float lo = __uint_as_float(w[j] << 16), hi = __uint_as_float(w[j] & 0xffff0000u); ss += lo * lo + hi * hi; } } }
                if (!Xout) { ss += __shfl_xor(ss, 16); ss += __shfl_xor(ss, 32); if (fq == 0) atomicAdd(SS + row, (unsigned long long)(ss * 1048576.f + 0.5f)); } }
            asm volatile("" ::: "memory");
        }
    }
};
struct EpiGlu {
    static constexpr bool PERM = true, AFTER_DRAIN = false, HAS_PRE = false;
    const bf16_t* YG; bf16_t* Y; const float* bias; int ldy; int ycol0;
    __device__ __forceinline__ void operator()(const f32x4 (&acc)[2][2][4][2], const Unit& u, int wr, int wc, int fr, int fq, int) const {
        const int row0 = u.pm * BM + wr * 64 + fr; const int col0 = u.pn * BM + wc * 64 + 8 * fq;
        f32x4 bb[2][2];
#pragma unroll
        for (int bj = 0; bj < 2; ++bj) { bb[bj][0] = *(const f32x4*)(bias + col0 + bj * 32); bb[bj][1] = *(const f32x4*)(bias + col0 + bj * 32 + 4); }
#pragma unroll
        for (int ai = 0; ai < 2; ++ai) {
            u32x4 gl[4][2];
#pragma unroll
            for (int m = 0; m < 4; ++m)
#pragma unroll
                for (int bj = 0; bj < 2; ++bj) gl[m][bj] = *(const u32x4*)(YG + (size_t)(row0 + ai * HALF + m * 16) * 512 + col0 + bj * 32);
            asm volatile("" ::: "memory");
#pragma unroll
            for (int m = 0; m < 4; ++m) { const int row = row0 + ai * HALF + m * 16;
#pragma unroll
                for (int bj = 0; bj < 2; ++bj) { const int col = col0 + bj * 32; const u32x4 g = gl[m][bj];
                    const f32x4 v0 = acc[ai][bj][m][0] + bb[bj][0], v1 = acc[ai][bj][m][1] + bb[bj][1];
                    float o[8];
#pragma unroll
                    for (int j = 0; j < 4; ++j) { const unsigned gw0 = g[j >> 1], gw1 = g[2 + (j >> 1)];
                        const float y0 = __uint_as_float((j & 1) ? (gw0 & 0xffff0000u) : (gw0 << 16)), y1 = __uint_as_float((j & 1) ? (gw1 & 0xffff0000u) : (gw1 << 16));
                        o[j] = y0 * __builtin_amdgcn_rcpf(1.f + __expf(-v0[j])); o[4 + j] = y1 * __builtin_amdgcn_rcpf(1.f + __expf(-v1[j])); }
                    u32x4 w; w.x = cvt_pk_bf16(o[0], o[1]); w.y = cvt_pk_bf16(o[2], o[3]); w.z = cvt_pk_bf16(o[4], o[5]); w.w = cvt_pk_bf16(o[6], o[7]);
                    *(u32x4*)(Y + (size_t)row * ldy + ycol0 + col) = w; } }
            asm volatile("" ::: "memory");
        }
    }
};

template <class Epi, class Sched, bool ALIGN_EPI = false, bool SP2 = false>
__device__ __forceinline__ void gemm_phase(PG8_LAS unsigned char* lds, const Gemm g, const Sched& S, const Epi& E) {
    int tid_ = threadIdx.x; asm volatile("" : "+v"(tid_));
    const int tid = tid_, wid = __builtin_amdgcn_readfirstlane(tid >> 6), lane = tid & 63, wr = wid >> 2, wc = wid & 3, fr = lane & 15, fq = lane >> 4;
    const int K = g.K, nt = K / BK;
    unsigned voffA[2], voffB[2];
#pragma unroll
    for (int i = 0; i < 2; ++i) { int R, C; stage_rc(tid * 16 + i * 8192, R, C); const int Rb = Epi::PERM ? (64 * (R >> 5) + perm32(R & 31)) : R;
        voffA[i] = (unsigned)(R * K + C) * 2u; voffB[i] = (unsigned)(Rb * K + C) * 2u; }
    const size_t kstep = (size_t)(BK * 2);
    const size_t hstep = (size_t)HALF * K * 2;
    const size_t hstepB = Epi::PERM ? (size_t)32 * K * 2 : hstep;
    const size_t tstep = 2 * hstep;
    const unsigned ldsw = (unsigned)wid * 1024u;
    const int aoff = lds_byte(wr * 64 + fr, fq * 8), boff = lds_byte(wc * 32 + fr, fq * 8);
#define PG8_SA(b, h) (((b) * 2 + (h)) * HTB)
#define PG8_SB(b, h) ((4 + (b) * 2 + (h)) * HTB)
#define PG8_STAGE(bufoff, gbase, voff) do { _Pragma("unroll") for (int _i = 0; _i < 2; ++_i) \
        __builtin_amdgcn_global_load_lds((const unsigned*)((const char*)(gbase) + (voff)[_i]), (PG8_LAS unsigned*)(lds + (bufoff) + ldsw + _i * 8192), 16, 0, 0); } while (0)
#define PG8_LDA(dst, b, h) do { _Pragma("unroll") for (int m = 0; m < 4; ++m) _Pragma("unroll") for (int k = 0; k < 2; ++k) dst[m][k] = *(const PG8_LAS bf16x8*)(lds + PG8_SA(b, h) + aoff + m * 2048 + k * 1024); } while (0)
#define PG8_LDB(dst, b, h) do { _Pragma("unroll") for (int n = 0; n < 2; ++n) _Pragma("unroll") for (int k = 0; k < 2; ++k) dst[n][k] = *(const PG8_LAS bf16x8*)(lds + PG8_SB(b, h) + boff + n * 2048 + k * 1024); } while (0)
#define PG8_MMA(ai, bj, At, Bt) do { __builtin_amdgcn_s_setprio(1); _Pragma("unroll") for (int m = 0; m < 4; ++m) _Pragma("unroll") for (int n = 0; n < 2; ++n) _Pragma("unroll") for (int k = 0; k < 2; ++k) \
        acc[ai][bj][m][n] = __builtin_amdgcn_mfma_f32_16x16x32_bf16(Bt[n][k], At[m][k], acc[ai][bj][m][n], 0, 0, 0); __builtin_amdgcn_s_setprio(0); } while (0)
#define PG8_WAIT_V(n) asm volatile("s_waitcnt vmcnt(" #n ")" ::: "memory")
#define PG8_WAIT_L(n) asm volatile("s_waitcnt lgkmcnt(" #n ")" ::: "memory")
#define PG8_BAR __builtin_amdgcn_s_barrier()
#define PG8_SCHED __builtin_amdgcn_sched_barrier(0)
    Unit cur, nxt; int ui = 0;
    if (!S.next(0, cur)) return;
    if constexpr (Epi::HAS_PRE) E.pre_all(S, tid);
    f32x4 acc[2][2][4][2];
#pragma unroll
    for (int a = 0; a < 2; ++a)
#pragma unroll
        for (int b = 0; b < 2; ++b)
#pragma unroll
            for (int m = 0; m < 4; ++m)
#pragma unroll
                for (int n = 0; n < 2; ++n) acc[a][b][m][n] = (f32x4){0.f, 0.f, 0.f, 0.f};
    bf16x8 At[4][2], B0[2][2], B1[2][2];
    const char* cA = (const char*)g.A + (size_t)cur.pm * tstep; const char* cB = (const char*)g.Bt + (size_t)cur.pn * tstep;
    S.a_ready(cur);
    if constexpr (SP2) {
        PG8_STAGE(PG8_SB(0, 0), cB, voffB); PG8_STAGE(PG8_SB(0, 1), cB + hstepB, voffB); PG8_STAGE(PG8_SA(0, 0), cA, voffA); PG8_STAGE(PG8_SA(0, 1), cA + hstep, voffA);
        if (wr == 1) PG8_BAR;
        PG8_WAIT_V(2); PG8_BAR;
        PG8_STAGE(PG8_SB(1, 0), cB + kstep, voffB); PG8_STAGE(PG8_SA(1, 0), cA + kstep, voffA); PG8_STAGE(PG8_SB(1, 1), cB + hstepB + kstep, voffB);
        PG8_WAIT_V(6); PG8_BAR;
    } else {
        PG8_STAGE(PG8_SB(0, 0), cB, voffB); PG8_STAGE(PG8_SA(0, 0), cA, voffA); PG8_STAGE(PG8_SB(0, 1), cB + hstepB, voffB); PG8_STAGE(PG8_SA(0, 1), cA + hstep, voffA);
        if (wr == 1) PG8_BAR;
        PG8_WAIT_V(4); PG8_BAR;
        PG8_STAGE(PG8_SB(1, 0), cB + kstep, voffB); PG8_STAGE(PG8_SA(1, 0), cA + kstep, voffA); PG8_STAGE(PG8_SB(1, 1), cB + hstepB + kstep, voffB);
        PG8_WAIT_V(6); PG8_BAR;
    }
    for (;;) {
        const bool has_next = S.next(ui + 1, nxt);
        const char* nA = has_next ? (const char*)g.A + (size_t)nxt.pm * tstep : cA; const char* nB = has_next ? (const char*)g.Bt + (size_t)nxt.pn * tstep : cB;
        for (int t = 0; t < nt; t += 2) {
            const bool last = (t == nt - 2);
            const char* a1 = cA + (size_t)(t + 1) * kstep;
            const char* a2 = last ? nA : cA + (size_t)(t + 2) * kstep; const char* b2 = last ? nB : cB + (size_t)(t + 2) * kstep;
            const char* a3 = a2 + kstep; const char* b3 = b2 + kstep;
            if (last && has_next) S.a_ready(nxt);
            if constexpr (SP2) {
            PG8_LDB(B0, 0, 0); PG8_LDB(B1, 0, 1); PG8_SCHED; PG8_LDA(At, 0, 0); PG8_STAGE(PG8_SA(1, 1), a1 + hstep, voffA);
            PG8_WAIT_V(8); PG8_WAIT_L(0); PG8_BAR; PG8_MMA(0, 0, At, B0); PG8_MMA(0, 1, At, B1); PG8_BAR; PG8_SCHED;
            PG8_LDA(At, 0, 1); PG8_STAGE(PG8_SB(0, 0), b2, voffB); PG8_STAGE(PG8_SB(0, 1), b2 + hstepB, voffB); PG8_STAGE(PG8_SA(0, 0), a2, voffA);
            PG8_WAIT_V(8); PG8_WAIT_L(0); PG8_BAR; PG8_MMA(1, 0, At, B0); PG8_MMA(1, 1, At, B1); PG8_BAR; PG8_SCHED;
            PG8_LDB(B0, 1, 0); PG8_LDB(B1, 1, 1); PG8_SCHED; PG8_LDA(At, 1, 0); PG8_STAGE(PG8_SA(0, 1), a2 + hstep, voffA);
            PG8_WAIT_V(8); PG8_WAIT_L(0); PG8_BAR; PG8_MMA(0, 0, At, B0); PG8_MMA(0, 1, At, B1); PG8_BAR; PG8_SCHED;
            PG8_LDA(At, 1, 1); PG8_STAGE(PG8_SB(1, 0), b3, voffB); PG8_STAGE(PG8_SB(1, 1), b3 + hstepB, voffB); PG8_STAGE(PG8_SA(1, 0), a3, voffA);
            PG8_WAIT_V(8); PG8_WAIT_L(0); PG8_BAR; PG8_MMA(1, 0, At, B0); PG8_MMA(1, 1, At, B1); PG8_BAR; PG8_SCHED;
            } else {
            PG8_LDB(B0, 0, 0); PG8_SCHED; PG8_LDA(At, 0, 0); PG8_STAGE(PG8_SA(1, 1), a1 + hstep, voffA);
            PG8_WAIT_L(8); PG8_BAR; PG8_WAIT_L(0); PG8_MMA(0, 0, At, B0); PG8_BAR; PG8_SCHED;
            PG8_LDB(B1, 0, 1); PG8_STAGE(PG8_SB(0, 0), b2, voffB);
            PG8_BAR; PG8_WAIT_L(0); PG8_MMA(0, 1, At, B1); PG8_BAR;
            PG8_LDA(At, 0, 1); PG8_STAGE(PG8_SA(0, 0), a2, voffA);
            PG8_BAR; PG8_WAIT_L(0); PG8_MMA(1, 0, At, B0); PG8_BAR; PG8_SCHED;
            PG8_STAGE(PG8_SB(0, 1), b2 + hstepB, voffB);
            PG8_WAIT_V(6); PG8_BAR; PG8_MMA(1, 1, At, B1); PG8_BAR;
            PG8_LDB(B0, 1, 0); PG8_SCHED; PG8_LDA(At, 1, 0); PG8_STAGE(PG8_SA(0, 1), a2 + hstep, voffA);
            PG8_WAIT_L(8); PG8_BAR; PG8_WAIT_L(0); PG8_MMA(0, 0, At, B0); PG8_BAR; PG8_SCHED;
            PG8_LDB(B1, 1, 1); PG8_STAGE(PG8_SB(1, 0), b3, voffB);
            PG8_BAR; PG8_WAIT_L(0); PG8_MMA(0, 1, At, B1); PG8_BAR;
            PG8_LDA(At, 1, 1); PG8_STAGE(PG8_SA(1, 0), a3, voffA);
            PG8_BAR; PG8_WAIT_L(0); PG8_MMA(1, 0, At, B0); PG8_BAR; PG8_SCHED;
            PG8_STAGE(PG8_SB(1, 1), b3 + hstepB, voffB);
            PG8_WAIT_V(6); PG8_BAR; PG8_MMA(1, 1, At, B1); PG8_BAR;
            }
        }
        if constexpr (ALIGN_EPI) { if (wr == 0) PG8_BAR; }
        if constexpr (!Epi::AFTER_DRAIN) { E(acc, cur, wr, wc, fr, fq, ui); S.done(cur); }
        if (!has_next) break;
#pragma unroll
        for (int a = 0; a < 2; ++a)
#pragma unroll
            for (int b = 0; b < 2; ++b)
#pragma unroll
                for (int m = 0; m < 4; ++m)
#pragma unroll
                    for (int n = 0; n < 2; ++n) acc[a][b][m][n] = (f32x4){0.f, 0.f, 0.f, 0.f};
        cur = nxt; cA = nA; cB = nB; ++ui;
        if constexpr (ALIGN_EPI) { if (wr == 1) PG8_BAR; }
    }
    PG8_WAIT_V(0);
    if constexpr (!ALIGN_EPI) { if (wr == 0) PG8_BAR; }
    PG8_BAR;
    if constexpr (Epi::AFTER_DRAIN) { E.fused(acc, cur, wr, wc, fr, fq, lds, wid, lane); S.done(cur); }
#undef PG8_SA
#undef PG8_SB
#undef PG8_STAGE
#undef PG8_LDA
#undef PG8_LDB
#undef PG8_MMA
#undef PG8_WAIT_V
#undef PG8_WAIT_L
#undef PG8_BAR
#undef PG8_SCHED
}
}

#ifndef MK_ONE_LAUNCH
#define MK_ONE_LAUNCH 1
#endif
#ifndef PROBE_GN2
#define PROBE_GN2 0
#endif
#ifndef PROBE_FIN2
#define PROBE_FIN2 0
#endif
#ifndef PROBE_CAR2
#define PROBE_CAR2 0
#endif
#ifndef PROBE_BAR2
#define PROBE_BAR2 0
#endif
#ifndef PROBE_WIN2
#define PROBE_WIN2 0
#endif
#ifndef PROBE_GLU2
#define PROBE_GLU2 0
#endif
#ifndef PROBE_WOUT2
#define PROBE_WOUT2 0
#endif
#ifndef PROBE_DN2
#define PROBE_DN2 0
#endif
#ifndef PROBE_UP2
#define PROBE_UP2 0
#endif
#ifndef PROBE_PRO2
#define PROBE_PRO2 0
#endif
#ifndef PROBE_NA2
#define PROBE_NA2 0
#endif
#ifndef PROBE_SCAN2
#define PROBE_SCAN2 0
#endif
constexpr int NWAVES = 8, NTHR = 512;
constexpr int DM = 2048, NTOK = 40960, ZW = 4608, DFF = 8192, DEPTH = 4;
constexpr int ZK = 1024, ZV = 2048, ZXR = 3072, ZGT = 3584, ZXS = 4096;
constexpr int MLPC = 8192, NMLPC = NTOK / MLPC;
constexpr int LCH = 32, NLCH = NTOK / LCH;
constexpr int SCH = 64, NSCH = NTOK / SCH;
constexpr float EPS = 1e-6f;
constexpr int PH_PER_LAYER = 14, NPHASE = DEPTH * PH_PER_LAYER + 1;

constexpr size_t MiB = 1u << 20;
constexpr size_t WS_CTL = 0, CTL_ZERO_BYTES = 2 * MiB;
constexpr size_t WS_SS = 65536;
constexpr size_t WS_WIN = 2 * MiB, WS_WOUT = 20 * MiB, WS_WUP = 28 * MiB, WS_WDN = 60 * MiB, WS_WGLU = 92 * MiB;
constexpr size_t WS_TLB = 93 * MiB;
constexpr size_t WS_TBB = 93 * MiB + 65536;
constexpr size_t WS_H = 96 * MiB;
constexpr size_t WS_ZR = 256 * MiB + (size_t)48 * NTOK * 64 * 2;
constexpr int ZRW = 1536, RXR = 0, RGT = 512, RXS = 1024;
constexpr size_t WS_Z = 256 * MiB;
constexpr size_t WS_Y = 616 * MiB;
constexpr size_t WS_YG = 776 * MiB;
constexpr size_t WS_HF = 816 * MiB;
constexpr size_t WS_TBBF = 94 * MiB;
constexpr size_t WS_TCF = 94 * MiB + 524288;
constexpr size_t WS_TWF = 95 * MiB;
constexpr size_t WS_LAGG = 896 * MiB;
constexpr size_t WS_LCIN = 906 * MiB;
constexpr size_t WS_SEND = 912 * MiB;
constexpr size_t WS_SCIN = 932 * MiB;
constexpr size_t WS_SSQ = 952 * MiB, SSQ_BYTES = (size_t)DEPTH * 2 * NTOK * 8;
constexpr size_t WS_END = 956 * MiB;
constexpr int CW_BAR = 4096;

constexpr int RING_OFF = 0, RING_BYTES = 131072;
constexpr int XTRA_OFF = RING_BYTES, XTRA_BYTES = 12288;
constexpr int LDSCTL_OFF = 163840 - 1024, MISC_OFF = LDSCTL_OFF + 320;
constexpr int LDS_BYTES = 163840;
static_assert(MISC_OFF + 128 <= LDS_BYTES, "LDS map");

#define GAS __attribute__((address_space(1)))
#define LAS __attribute__((address_space(3)))
typedef unsigned short bf16;
typedef unsigned v4u __attribute__((ext_vector_type(4)));
typedef unsigned v2u __attribute__((ext_vector_type(2)));
typedef float f32x4 __attribute__((ext_vector_type(4)));
typedef float f32x2 __attribute__((ext_vector_type(2)));
#define LDS_WAIT() asm volatile("s_waitcnt lgkmcnt(0)" ::: "memory")
#define VM_WAIT() asm volatile("s_waitcnt vmcnt(0)" ::: "memory")
__device__ __forceinline__ unsigned f2bf(float f) { unsigned u = __builtin_bit_cast(unsigned, f); return (u + 0x7fffu + ((u >> 16) & 1u)) >> 16; }
typedef __bf16 bf16x2_t __attribute__((ext_vector_type(2)));
__device__ __forceinline__ unsigned pk2(float lo, float hi) { const f32x2 v = {lo, hi}; return __builtin_bit_cast(unsigned, __builtin_convertvector(v, bf16x2_t)); }
__device__ __forceinline__ unsigned pk2s(float lo, float hi) { return f2bf(lo) | (f2bf(hi) << 16); }
__device__ __forceinline__ float frcp(float x) { return __builtin_amdgcn_rcpf(x); }
__device__ __forceinline__ float fsqrt_(float x) { return __builtin_amdgcn_sqrtf(x); }
__device__ __forceinline__ float bf2f(unsigned b) { return __builtin_bit_cast(float, b << 16); }
__device__ __forceinline__ float bflo(unsigned w) { return __builtin_bit_cast(float, w << 16); }
__device__ __forceinline__ float bfhi(unsigned w) { return __builtin_bit_cast(float, w & 0xffff0000u); }
__device__ __forceinline__ float wave_sum(float v) {
#pragma unroll
    for (int o = 1; o < 64; o <<= 1) v += __shfl_xor(v, o);
    return v;
}
__device__ __forceinline__ float wave_max(float v) {
#pragma unroll
    for (int o = 1; o < 64; o <<= 1) v = fmaxf(v, __shfl_xor(v, o));
    return v;
}
__device__ __forceinline__ float sigmoidf_(float x) { return frcp(1.f + __expf(-x)); }
__device__ __forceinline__ float gelu_tanh(float x) { const float x2 = x * x; const float y2 = (2.302208198f * x) * __builtin_fmaf(0.044715f, x2, 1.f); const float e = __builtin_amdgcn_exp2f(y2); return x - x * frcp(e + 1.f); }
__device__ __forceinline__ void seq_of(int tok, int& s0, int& T) { if (tok < 8192) { s0 = tok & ~2047; T = 2048; } else { s0 = 8192 + ((tok - 8192) & ~16383); T = 16384; } }

#define XB_TMO      128
#define XB_XCNT(j)  (256  + 64 * (j))
#define XB_XSUB(j)  (1280 + 64 * (j))
#define XB_XGEN(j)  (2304 + 64 * (j))
#define XB_TOP      3328
#define XB_TOPGEN   3392
#define XCD_BAR_WORDS 3456
#define XB_SPIN_CAP (1u << 18)

__device__ __forceinline__ unsigned xb_ld(unsigned* p)              { return __hip_atomic_load(p, __ATOMIC_RELAXED, __HIP_MEMORY_SCOPE_AGENT); }
__device__ __forceinline__ unsigned xb_add(unsigned* p, unsigned v) { return __hip_atomic_fetch_add(p, v, __ATOMIC_RELAXED, __HIP_MEMORY_SCOPE_AGENT); }
__device__ __forceinline__ unsigned xb_xcc_id() { return (unsigned)__builtin_amdgcn_s_getreg((3 << 11) | 20) & 0xFu; }
#define XB_SPIN(cond, bar) do { unsigned _sp = 0; while (cond) { __builtin_amdgcn_s_sleep(1); \
    if ((++_sp & 255u) == 0u) { if (xb_ld(&(bar)[XB_TMO])) break; if (_sp > XB_SPIN_CAP) { atomicAdd(&(bar)[XB_TMO], 1u); break; } } } } while (0)

struct XcdBarrier {
    unsigned* bar; unsigned x;
    volatile LAS unsigned* st;
};

__device__ __forceinline__ XcdBarrier xcd_barrier_post(unsigned* bar, volatile LAS unsigned* st) {
    XcdBarrier b; b.bar = bar; b.x = xb_xcc_id(); b.st = st;
    if (threadIdx.x == 0) (void)xb_add(&bar[XB_XCNT(b.x)], 1u);
    return b;
}
__device__ __forceinline__ void xcd_barrier_complete(unsigned* bar, unsigned x, unsigned& nloc, unsigned& nx) {
    const unsigned G = gridDim.x * gridDim.y * gridDim.z;
    unsigned sum, cnt, mine, sp = 0u;
    for (;;) {
        sum = 0u; cnt = 0u; mine = 0u;
#pragma unroll
        for (unsigned j = 0; j < 16; ++j) { const unsigned c = xb_ld(&bar[XB_XCNT(j)]); sum += c; cnt += (c > 0u) ? 1u : 0u; mine = (j == x) ? c : mine; }
        if (sum == G) break;
        __builtin_amdgcn_s_sleep(1);
        if ((++sp & 255u) == 0u) { if (xb_ld(&bar[XB_TMO])) break; if (sp > XB_SPIN_CAP) { atomicAdd(&bar[XB_TMO], 1u); break; } }
    }
    nloc = mine > 0u ? mine : 1u; nx = cnt > 0u ? cnt : 1u;
}

__device__ __forceinline__ void xcd_barrier(const XcdBarrier& b) {
    asm volatile("s_waitcnt vmcnt(0)" ::: "memory");
    __syncthreads();
    if (threadIdx.x == 0) {
        unsigned* bar = b.bar;
        __builtin_amdgcn_s_waitcnt(0);
        unsigned nloc = b.st[0], nx = b.st[1];
        if (nloc == 0u) { xcd_barrier_complete(bar, b.x, nloc, nx); b.st[0] = nloc; b.st[1] = nx; }
        const unsigned old = xb_add(&bar[XB_XSUB(b.x)], 1u);
        const unsigned gen = old / nloc;
        if (old + 1u == (gen + 1u) * nloc) {
            __builtin_amdgcn_fence(__ATOMIC_RELEASE, "agent");
            asm volatile("s_waitcnt vmcnt(0)" ::: "memory");
            const unsigned og = xb_add(&bar[XB_TOP], 1u);
            const unsigned tg = og / nx;
            if (og + 1u == (tg + 1u) * nx) xb_add(&bar[XB_TOPGEN], 1u);
            else XB_SPIN(xb_ld(&bar[XB_TOPGEN]) == tg, bar);
            __builtin_amdgcn_fence(__ATOMIC_ACQUIRE, "agent");
            xb_add(&bar[XB_XGEN(b.x)], 1u);
            asm volatile("s_waitcnt vmcnt(0)" ::: "memory");
        } else {
            XB_SPIN(xb_ld(&bar[XB_XGEN(b.x)]) == gen, bar);
            __builtin_amdgcn_fence(__ATOMIC_ACQUIRE, "agent");
            asm volatile("s_waitcnt vmcnt(0)" ::: "memory");
        }
    }
    __syncthreads();
}


struct Args { const float* in[28]; float* out; unsigned char* ws; int ph_lo, ph_hi; };
struct Frame {
    LAS unsigned char* lds; unsigned char* ldsg;
    int tid, lane, wave, vcu, G;
};
enum { I_XP = 0, I_XS, I_NMG, I_WIN, I_RPB, I_CW, I_CB, I_LWA, I_LBA, I_LWX, I_LBX, I_LAM, I_ARE, I_AIM, I_LDT, I_BRE, I_BIM, I_CRE, I_CIM, I_SD, I_WGLU, I_BGLU, I_GOUT, I_WOUT, I_NLG, I_WUP, I_WDN, I_FING };

__device__ __forceinline__ void transpose_item(const float* W, int K, int N, bf16* WT, LAS float* scr, int item, int lane, const float* gk) {
    const int nblk = N / 32, kb = item / nblk, nb = item % nblk, k0 = 64 * kb, n0 = 32 * nb;
    float wv[32];
#pragma unroll
    for (int i = 0; i < 32; ++i) wv[i] = W[(size_t)(k0 + 2 * i + (lane >> 5)) * N + n0 + (lane & 31)];
    if (gk) {
#pragma unroll
        for (int i = 0; i < 32; ++i) wv[i] *= gk[k0 + 2 * i + (lane >> 5)]; }
#pragma unroll
    for (int i = 0; i < 32; ++i) scr[(2 * i + (lane >> 5)) * 33 + (lane & 31)] = wv[i];
    LDS_WAIT();
    const int c = lane & 7;
#pragma unroll
    for (int j = 0; j < 4; ++j) { const int n = (lane >> 3) + 8 * j; const LAS float* s = scr + (8 * c) * 33 + n;
        v4u o; o.x = pk2(s[0 * 33], s[1 * 33]); o.y = pk2(s[2 * 33], s[3 * 33]); o.z = pk2(s[4 * 33], s[5 * 33]); o.w = pk2(s[6 * 33], s[7 * 33]);
        *(v4u*)(WT + (size_t)(n0 + n) * K + k0 + 8 * c) = o; }
    LDS_WAIT();
}

__device__ __forceinline__ void xb_row(const float* xrow, bf16* orow, unsigned long long* ss, int lane) {
    const f32x4* xr = (const f32x4*)xrow + lane; f32x4 v[8]; float s = 0.f;
#pragma unroll
    for (int j = 0; j < 8; ++j) { v[j] = xr[64 * j]; s += (v[j].x * v[j].x + v[j].y * v[j].y) + (v[j].z * v[j].z + v[j].w * v[j].w); }
    s = wave_sum(s); if (lane == 0) *ss = (unsigned long long)(s * 1048576.f + 0.5f);
    v2u* o8 = (v2u*)orow + lane;
#pragma unroll
    for (int j = 0; j < 8; ++j) { v2u o; o.x = pk2(v[j].x, v[j].y); o.y = pk2(v[j].z, v[j].w); o8[64 * j] = o; }
}

__device__ __forceinline__ void norm_row_bf16(const float* xrow, const float* g, bf16* orow, int lane) {
    const f32x4* xr = (const f32x4*)xrow + lane; const f32x4* gr = (const f32x4*)g + lane;
    f32x4 v[8]; float s = 0.f;
#pragma unroll
    for (int j = 0; j < 8; ++j) { v[j] = xr[64 * j]; s += (v[j].x * v[j].x + v[j].y * v[j].y) + (v[j].z * v[j].z + v[j].w * v[j].w); }
    const float rstd = 1.f / sqrtf(wave_sum(s) * (1.f / DM) + EPS);
    v2u* o8 = (v2u*)orow + lane;
#pragma unroll
    for (int j = 0; j < 8; ++j) { const f32x4 gg = gr[64 * j]; v2u o; o.x = pk2(v[j].x * rstd * gg.x, v[j].y * rstd * gg.y); o.y = pk2(v[j].z * rstd * gg.z, v[j].w * rstd * gg.w); o8[64 * j] = o; }
}
__device__ __forceinline__ const float* x_row(const Args& a, int l, int row) {
    if (l == 0) return row < 8192 ? a.in[I_XP] + (size_t)row * DM : a.in[I_XS] + (size_t)(row - 8192) * DM;
    return a.out + (size_t)row * DM;
}

__device__ __forceinline__ void ph_prologue(const Args& a, const Frame& F, int l) {
    int tid = threadIdx.x; asm volatile("" : "+v"(tid)); int lane = tid & 63; (void)lane;
    LAS float* scr = (LAS float*)(F.lds + RING_OFF + F.wave * 16384);
    const int gw = F.vcu * NWAVES + F.wave, NGW = F.G * NWAVES;
    constexpr int I_IN = (DM / 64) * (ZW / 32), I_OUT = (DM / 64) * (DM / 32), I_UP = (DM / 64) * (DFF / 32), I_DN = (DFF / 64) * (DM / 32), I_GL = (512 / 64) * (512 / 32);
    constexpr int NITEMS = I_IN + I_OUT + I_UP + I_DN + I_GL;
    unsigned char* ws = a.ws;
    for (int it = gw; it < NITEMS; it += NGW) {
        int r = it;
        if (r < I_IN) { transpose_item(a.in[I_WIN] + (size_t)l * DM * ZW, DM, ZW, (bf16*)(ws + WS_WIN), scr, r, lane, a.in[I_NMG] + (size_t)l * DM); continue; } r -= I_IN;
        if (r < I_OUT) { transpose_item(a.in[I_WOUT] + (size_t)l * DM * DM, DM, DM, (bf16*)(ws + WS_WOUT), scr, r, lane, nullptr); continue; } r -= I_OUT;
        if (r < I_UP) { transpose_item(a.in[I_WUP] + (size_t)l * DM * DFF, DM, DFF, (bf16*)(ws + WS_WUP), scr, r, lane, a.in[I_NLG] + (size_t)l * DM); continue; } r -= I_UP;
        if (r < I_DN) { transpose_item(a.in[I_WDN] + (size_t)l * DFF * DM, DFF, DM, (bf16*)(ws + WS_WDN), scr, r, lane, nullptr); continue; } r -= I_DN;
        transpose_item(a.in[I_WGLU] + (size_t)l * 512 * 512, 512, 512, (bf16*)(ws + WS_WGLU), scr, r, lane, nullptr);
    }
    { const int gt = F.vcu * NTHR + tid;
      if (gt < 4096) {
        const int dir = gt >> 11, g = (gt >> 6) & 31, p = gt & 63; const size_t ix = ((size_t)(l * 2 + dir) * 32 + g) * 64 + p;
        const double are = (double)a.in[I_ARE][ix], aim = (double)a.in[I_AIM][ix]; const double ldt = (double)a.in[I_LDT][(l * 2 + dir) * 32 + g];
        double e = 1.0; { const double x8 = ldt * 0.125; for (int n = 20; n >= 1; --n) e = 1.0 + e * x8 / (double)n; e = e * e; e = e * e; e = e * e; }
        const double dt = e;
        double mag = 1.0; { const double x = are * dt; for (int n = 14; n >= 1; --n) mag = 1.0 + mag * x / (double)n; }
        const double th = aim * dt; const double kq = __builtin_rint(th * 0.15915494309189535); const double r = th - kq * 6.283185307179586476925;
        const double r2 = r * r; double c = 1.0, s = 1.0;
        for (int n = 15; n >= 1; --n) { c = 1.0 - c * r2 / (double)((2 * n - 1) * (2 * n)); s = 1.0 - s * r2 / (double)((2 * n) * (2 * n + 1)); }
        s *= r;
        const double lbr = mag * c, lbi = mag * s, den = are * are + aim * aim, nre = lbr - 1.0, nim = lbi;
        const double cor = (nre * are + nim * aim) / den, coi = (nim * are - nre * aim) / den;
        float* tlb = (float*)(ws + WS_TLB) + (size_t)gt * 2; tlb[0] = (float)lbr; tlb[1] = (float)lbi;
        float* tbb = (float*)(ws + WS_TBB) + (size_t)gt * 32; const float* bre = a.in[I_BRE] + ix * 16; const float* bim = a.in[I_BIM] + ix * 16;
        bf16* bbf = (bf16*)(ws + WS_TBBF);
        for (int h = 0; h < 16; ++h) { const double br = (double)bre[h], bi = (double)bim[h]; const float vr = (float)(cor * br - coi * bi), vi = (float)(cor * bi + coi * br); tbb[h] = vr; tbb[16 + h] = vi;
            const int n = p & 15, gk0 = h >> 3, j = h & 7;
            const unsigned hr = f2bf(vr), hi_ = f2bf(vi); const unsigned lr = f2bf(vr - bf2f(hr)), li = f2bf(vi - bf2f(hi_));
            const size_t fr = ((size_t)((dir * 32 + g) * 8 + (p >> 4)) * 64) * 8, fi = ((size_t)((dir * 32 + g) * 8 + 4 + (p >> 4)) * 64) * 8;
            bbf[fr + (size_t)(n + 16 * gk0) * 8 + j] = (bf16)hr; bbf[fr + (size_t)(n + 16 * (gk0 + 2)) * 8 + j] = (bf16)lr;
            bbf[fi + (size_t)(n + 16 * gk0) * 8 + j] = (bf16)hi_; bbf[fi + (size_t)(n + 16 * (gk0 + 2)) * 8 + j] = (bf16)li; }
      } else if (gt < 4096 + 16384) {
        const int e = gt - 4096, lane_ = e & 63, ks = (e >> 6) & 3, g = (e >> 8) & 31, dir = e >> 13; const int h = lane_ & 15, gk = lane_ >> 4;
        const float* cre = a.in[I_CRE] + (((size_t)(l * 2 + dir) * 32 + g) * 16 + h) * 64; const float* cim = a.in[I_CIM] + (((size_t)(l * 2 + dir) * 32 + g) * 16 + h) * 64;
        bf16* cf = (bf16*)(ws + WS_TCF) + (size_t)e * 8;
        for (int j = 0; j < 8; ++j) { const int P = 16 * (j >> 1) + 4 * ks + gk; cf[j] = (bf16)f2bf((j & 1) ? -cim[P] : cre[P]); }
      } else if (gt >= 20480 && gt < 20480 + 16384) {
        const int e = gt - 20480, lane_ = e & 63, ks = (e >> 6) & 1, cb = (e >> 7) & 3, mat = (e >> 9) & 1, nb = (e >> 10) & 7, dir = e >> 13; const int n = lane_ & 15, gk = lane_ >> 4;
        const float* W = a.in[mat ? I_LWX : I_LWA] + ((size_t)(l * 2 + dir) * 8 + nb) * 4096 + (size_t)(32 * ks + 8 * gk) * 64 + 16 * cb + n;
        bf16* wf = (bf16*)(ws + WS_TWF) + (size_t)e * 8;
        for (int j = 0; j < 8; ++j) wf[j] = (bf16)f2bf(W[j * 64]);
      } }
    if (l == 0) { bf16* XB = (bf16*)(ws + WS_H); unsigned long long* SS = (unsigned long long*)(ws + WS_SSQ);
        for (int m0 = gw; m0 < NTOK; m0 += 2 * NGW) {
            f32x4 v[2][8];
#pragma unroll
            for (int r = 0; r < 2; ++r) { const int m = m0 + r * NGW; const f32x4* xr = (const f32x4*)x_row(a, 0, m < NTOK ? m : m0) + lane;
#pragma unroll
                for (int j = 0; j < 8; ++j) v[r][j] = xr[64 * j]; }
#pragma unroll
            for (int r = 0; r < 2; ++r) { const int m = m0 + r * NGW; float sq = 0.f;
#pragma unroll
                for (int j = 0; j < 8; ++j) sq += (v[r][j].x * v[r][j].x + v[r][j].y * v[r][j].y) + (v[r][j].z * v[r][j].z + v[r][j].w * v[r][j].w);
                sq = wave_sum(sq);
                if (m < NTOK) { if (lane == 0) SS[m] = (unsigned long long)(sq * 1048576.f + 0.5f);
                    v2u* o8 = (v2u*)(XB + (size_t)m * DM) + lane;
#pragma unroll
                    for (int j = 0; j < 8; ++j) { v2u o; o.x = pk2(v[r][j].x, v[r][j].y); o.y = pk2(v[r][j].z, v[r][j].w); o8[64 * j] = o; } } } } }

}

__device__ __forceinline__ void ph_na_simple(const Args& a, const Frame& F, int l) {
    int tid = threadIdx.x; asm volatile("" : "+v"(tid)); int lane = tid & 63; (void)lane;
    const bf16* Z = (const bf16*)(a.ws + WS_Z); bf16* Y = (bf16*)(a.ws + WS_Y);
    const float* rpb = a.in[I_RPB] + (size_t)l * 16 * 15 * 31;
    float* qs = (float*)(F.ldsg + RING_OFF) + F.wave * 64;
    const long U = (long)NTOK * 16; const long u0 = U * F.vcu / F.G, u1 = U * (F.vcu + 1) / F.G;
    for (long u = u0 + F.wave; u < u1; u += NWAVES) {
        const int tok = (int)(u >> 4), h = (int)(u & 15);
        int s0, T; seq_of(tok, s0, T); const int pos = tok - s0, r = pos >> 6, c = pos & 63, R = T >> 6;
        const int rs = min(max(r - 4, 0), R - 8), cs = min(max(c - 8, 0), 48);
        LDS_WAIT();
        qs[lane] = bf2f(Z[(size_t)tok * ZW + h * 64 + lane]);
        LDS_WAIT();
        float sc[2];
#pragma unroll
        for (int i = 0; i < 2; ++i) {
            const int kk = lane + 64 * i, krow = rs + (kk >> 4), kcol = cs + (kk & 15); const int ktok = s0 + krow * 64 + kcol;
            const v4u* kp = (const v4u*)(Z + (size_t)ktok * ZW + ZK + h * 64);
            float d = 0.f;
#pragma unroll
            for (int j = 0; j < 8; ++j) { const v4u w = kp[j]; const f32x4 q0 = *(const f32x4*)(qs + 8 * j), q1 = *(const f32x4*)(qs + 8 * j + 4);
                d += bflo(w.x) * q0.x + bfhi(w.x) * q0.y + bflo(w.y) * q0.z + bfhi(w.y) * q0.w + bflo(w.z) * q1.x + bfhi(w.z) * q1.y + bflo(w.w) * q1.z + bfhi(w.w) * q1.w; }
            sc[i] = d * 0.125f + rpb[(h * 15 + (krow - r + 7)) * 31 + (kcol - c + 15)];
        }
        const float m = wave_max(fmaxf(sc[0], sc[1])); const float p0 = __expf(sc[0] - m), p1 = __expf(sc[1] - m); const float sum = wave_sum(p0 + p1);
        float acc = 0.f;
        for (int kk = 0; kk < 128; ++kk) {
            const float p = __shfl(kk < 64 ? p0 : p1, kk & 63);
            const int krow = rs + (kk >> 4), kcol = cs + (kk & 15); const int vtok = s0 + krow * 64 + kcol;
            acc += p * bf2f(Z[(size_t)vtok * ZW + ZV + h * 64 + lane]);
        }
        Y[(size_t)tok * DM + h * 64 + lane] = (bf16)f2bf(acc / sum);
    }
}

typedef short s16x4_t __attribute__((ext_vector_type(4)));
__device__ __forceinline__ pg8::bf16x8 v_tr_pair(const LAS unsigned char* p) {
    const s16x4_t lo = __builtin_amdgcn_ds_read_tr16_b64_v4i16((LAS s16x4_t*)p), hi = __builtin_amdgcn_ds_read_tr16_b64_v4i16((LAS s16x4_t*)(p + 512));
    return __builtin_shufflevector(lo, hi, 0, 1, 2, 3, 4, 5, 6, 7);
}
__device__ __forceinline__ void glds16_asm(const void* gsrc, unsigned lds_dst) {
    unsigned keep;
    asm volatile("s_mov_b32 %0, m0\n\ts_mov_b32 m0, %2\n\ts_nop 0\n\tglobal_load_lds_dwordx4 %1, off\n\ts_mov_b32 m0, %0" : "=&s"(keep) : "v"(gsrc), "s"(lds_dst) : "memory");
}
__device__ __forceinline__ void ph_na_mfma(const Args& a, const Frame& F, int l) {
    int tid = threadIdx.x; asm volatile("" : "+v"(tid)); int lane = tid & 63; (void)lane;
    const bf16* Z = (const bf16*)(a.ws + WS_Z); bf16* Y = (bf16*)(a.ws + WS_Y);
    constexpr int KR = 0, VR = 73728, BIAS = 147456, MRG = 149504;
    LAS unsigned char* L = F.lds;
    const int w = F.wave, qt = w & 3, half = w >> 2, q = lane & 15, g = lane >> 4;
    const int c0 = 16 * qt, kc0 = (qt == 0) ? 0 : (qt == 1 ? 8 : (qt == 2 ? 24 : 32)), c = c0 + q, cs = min(max(c - 8, 0), 48);
    const int NIT = (NTOK / 64) * 16; const int i0 = (int)((long)NIT * F.vcu / F.G), i1 = (int)((long)NIT * (F.vcu + 1) / F.G);
#define NA_ITEM(it_, s0_, R_, h_, r_) do { if ((it_) < 2048) { const int _col = (it_) >> 5; r_ = (it_) & 31; R_ = 32; s0_ = (_col >> 4) * 2048; h_ = _col & 15; } \
        else { const int _j = (it_) - 2048, _col = _j >> 8; r_ = _j & 255; R_ = 256; s0_ = 8192 + (_col >> 4) * 16384; h_ = _col & 15; } } while (0)
#define NA_SWZ(col_) (((((col_) >> 3) & 3) << 1) | (((col_) >> 1) & 1))
#define NA_ROW_DMA(zoff_, row_, slotbase_) do { \
        _Pragma("unroll") for (int _j = 0; _j < 2; ++_j) { const int _col = c0 + 8 * _j + (lane >> 3); \
            const bf16* _gp = Z + ((size_t)((zoff_) / 64 + h) * NTOK + (s0 + (row_) * 64 + _col)) * 64 + (((lane & 7) ^ NA_SWZ(_col)) * 8); \
            glds16_asm(_gp, (unsigned)(size_t)(L + (slotbase_) + (c0 + 8 * _j) * 128)); } } while (0)
#define NA_BAR() asm volatile("s_barrier" ::: "memory")
    pg8::bf16x8 qn0, qn1;
    { int s0, R, h, r; NA_ITEM(i0, s0, R, h, r); const bf16* qp = Z + ((size_t)h * NTOK + (s0 + r * 64 + c)) * 64 + 8 * g; qn0 = *(const pg8::bf16x8*)qp; qn1 = *(const pg8::bf16x8*)(qp + 32); }
    v2u st0, st1, st2, st3; bf16* stp = Y;
    st0 = st1 = st2 = st3 = (v2u){0u, 0u};
    int it = i0;
    while (it < i1) {
        int s0, R, h, r0; NA_ITEM(it, s0, R, h, r0);
        const int m = min(R - r0, i1 - it);
        {
            const int rs = min(max(r0 - 4, 0), R - 8);
#pragma unroll
            for (int i = 0; i < 16; ++i) { const int id = w * 16 + i, t = id >> 6, ri = (id >> 3) & 7, j8 = id & 7, row = rs + ri;
                const int colw = 8 * j8 + (lane >> 3);
                const bf16* gp = Z + ((size_t)((t ? 32 : 16) + h) * NTOK + (s0 + row * 64 + colw)) * 64 + (((lane & 7) ^ NA_SWZ(colw)) * 8);
                glds16_asm(gp, (unsigned)(size_t)(L + (t ? VR : KR) + (row % 9) * 8192 + j8 * 1024)); }
            if (tid < 465) ((LAS float*)(L + BIAS))[tid] = a.in[I_RPB][((size_t)l * 16 + h) * 465 + tid];
            VM_WAIT(); LDS_WAIT();
            __syncthreads();
        }
        float ti[4][2][4];
        { const LAS float* bt = (const LAS float*)(L + BIAS);
#pragma unroll
          for (int kk = 0; kk < 4; ++kk)
#pragma unroll
              for (int blk = 0; blk < 2; ++blk)
#pragma unroll
                  for (int rg = 0; rg < 4; ++rg) { const int col = kc0 + 8 * g + 4 * blk + rg; const int dc = min(max(col - c + 15, 0), 30); const bool valid = (unsigned)(col - cs) < 16u;
                      ti[kk][blk][rg] = valid ? 8.f * bt[(kk + 4 * half + 3) * 31 + dc] : -INFINITY; } }
        if (half == 1) NA_BAR();
        for (int j = 0; j < m; ++j) {
            const int r = r0 + j, rs = min(max(r - 4, 0), R - 8);
            pg8::bf16x8 qf0 = qn0, qf1 = qn1;
            asm volatile("" : "+v"(qf0), "+v"(qf1) :: "memory");
            if (half == 1 && j > 0) { *(v2u*)(stp) = st0; *(v2u*)(stp + 16) = st1; *(v2u*)(stp + 32) = st2; *(v2u*)(stp + 48) = st3; }
            if (it + j + 1 < i1) {
                int s0n, Rn, hn, rn; NA_ITEM(it + j + 1, s0n, Rn, hn, rn);
                if (half == 0 && j + 1 < m) { const int rsn = min(max(rn - 4, 0), Rn - 8); if (rsn > rs) { NA_ROW_DMA(ZK, rsn + 7, KR + ((rsn + 7) % 9) * 8192); NA_ROW_DMA(ZV, rsn + 7, VR + ((rsn + 7) % 9) * 8192); } }
                const bf16* qp = Z + ((size_t)hn * NTOK + (s0n + rn * 64 + c)) * 64 + 8 * g; qn0 = *(const pg8::bf16x8*)qp; qn1 = *(const pg8::bf16x8*)(qp + 32);
            }
            const int tokrow0 = s0 + r * 64;
            f32x4 sc[4][2];
            pg8::bf16x8 kf[4][2][2];
#pragma unroll
            for (int kk = 0; kk < 4; ++kk) { const int row = rs + 4 * half + kk; const LAS unsigned char* kb = L + KR + (row % 9) * 8192;
#pragma unroll
                for (int blk = 0; blk < 2; ++blk) { const int col = kc0 + 8 * (q >> 2) + 4 * blk + (q & 3); const int sw = NA_SWZ(col);
                    kf[kk][blk][0] = *(const LAS pg8::bf16x8*)(kb + col * 128 + ((g ^ sw) * 16)); kf[kk][blk][1] = *(const LAS pg8::bf16x8*)(kb + col * 128 + (((4 + g) ^ sw) * 16)); } }
            const bool interior = (rs == r - 4);
            __builtin_amdgcn_sched_barrier(0);
#pragma unroll
            for (int kk = 0; kk < 4; ++kk)
#pragma unroll
                for (int blk = 0; blk < 2; ++blk) { f32x4 ini = (f32x4){0.f, 0.f, 0.f, 0.f};
                    if (interior) ini = (f32x4){ti[kk][blk][0], ti[kk][blk][1], ti[kk][blk][2], ti[kk][blk][3]};
                    sc[kk][blk] = __builtin_amdgcn_mfma_f32_16x16x32_bf16(kf[kk][blk][0], qf0, ini, 0, 0, 0); }
#pragma unroll
            for (int kk = 0; kk < 4; ++kk)
#pragma unroll
                for (int blk = 0; blk < 2; ++blk) sc[kk][blk] = __builtin_amdgcn_mfma_f32_16x16x32_bf16(kf[kk][blk][1], qf1, sc[kk][blk], 0, 0, 0);
            __builtin_amdgcn_sched_barrier(0);
            if (!interior) {
                const LAS float* bh = (const LAS float*)(L + BIAS) + (rs + 4 * half - r + 7) * 31;
#pragma unroll
                for (int blk = 0; blk < 2; ++blk)
#pragma unroll
                    for (int rg = 0; rg < 4; ++rg) { const int col = kc0 + 8 * g + 4 * blk + rg; const int dc = min(max(col - c + 15, 0), 30); const bool valid = (unsigned)(col - cs) < 16u;
#pragma unroll
                        for (int kk = 0; kk < 4; ++kk) sc[kk][blk][rg] = valid ? sc[kk][blk][rg] + 8.f * bh[kk * 31 + dc] : -INFINITY; }
            }
            float mx = -INFINITY;
#pragma unroll
            for (int kk = 0; kk < 4; ++kk)
#pragma unroll
                for (int blk = 0; blk < 2; ++blk)
#pragma unroll
                    for (int rg = 0; rg < 4; ++rg) mx = fmaxf(mx, sc[kk][blk][rg]);
            mx = fmaxf(mx, __shfl_xor(mx, 16)); mx = fmaxf(mx, __shfl_xor(mx, 32));
            LDS_WAIT();
            __syncthreads();
            pg8::bf16x8 vfr[4][4];
#pragma unroll
            for (int kk = 0; kk < 4; ++kk) { const int row = rs + 4 * half + kk;
                const int colv = kc0 + 8 * g + ((lane & 15) >> 2), sw0 = NA_SWZ(colv), sw1 = NA_SWZ(colv + 4), pq = lane & 3;
                const LAS unsigned char* vb0 = L + VR + (row % 9) * 8192 + colv * 128 + (pq & 1) * 8; const LAS unsigned char* vb1 = vb0 + 512;
#pragma unroll
                for (int db = 0; db < 4; ++db) { const int ch = 2 * db + (pq >> 1);
                    const s16x4_t lo = __builtin_amdgcn_ds_read_tr16_b64_v4i16((LAS s16x4_t*)(vb0 + ((ch ^ sw0) * 16))), hi = __builtin_amdgcn_ds_read_tr16_b64_v4i16((LAS s16x4_t*)(vb1 + ((ch ^ sw1) * 16)));
                    vfr[kk][db] = __builtin_shufflevector(lo, hi, 0, 1, 2, 3, 4, 5, 6, 7); } }
            __builtin_amdgcn_sched_barrier(0);
            pg8::bf16x8 pf[4];
            constexpr float CS = 0.125f * 1.4426950408889634f;
            const float nm = -mx * CS;
#pragma unroll
            for (int kk = 0; kk < 4; ++kk) { float p[8];
#pragma unroll
                for (int blk = 0; blk < 2; ++blk)
#pragma unroll
                    for (int rg = 0; rg < 4; ++rg) p[4 * blk + rg] = __builtin_amdgcn_exp2f(__builtin_fmaf(sc[kk][blk][rg], CS, nm));
                v4u wv; wv.x = pk2(p[0], p[1]); wv.y = pk2(p[2], p[3]); wv.z = pk2(p[4], p[5]); wv.w = pk2(p[6], p[7]); pf[kk] = __builtin_bit_cast(pg8::bf16x8, wv); }
            f32x4 osum = (f32x4){0.f, 0.f, 0.f, 0.f};
            { const v4u onesw = (v4u){0x3f803f80u, 0x3f803f80u, 0x3f803f80u, 0x3f803f80u}; const pg8::bf16x8 ones = __builtin_bit_cast(pg8::bf16x8, onesw);
#pragma unroll
              for (int kk = 0; kk < 4; ++kk) osum = __builtin_amdgcn_mfma_f32_16x16x32_bf16(ones, pf[kk], osum, 0, 0, 0); }
            const float sum = osum[0];
            f32x4 o[4];
#pragma unroll
            for (int db = 0; db < 4; ++db) o[db] = (f32x4){0.f, 0.f, 0.f, 0.f};
#pragma unroll
            for (int kk = 0; kk < 4; ++kk)
#pragma unroll
                for (int db = 0; db < 4; ++db) o[db] = __builtin_amdgcn_mfma_f32_16x16x32_bf16(vfr[kk][db], pf[kk], o[db], 0, 0, 0);
            LAS unsigned char* mg = L + MRG + (qt * 64 + lane) * 48;
            if (half == 0) {
                v4u w0, w1; w0.x = pk2(o[0][0], o[0][1]); w0.y = pk2(o[0][2], o[0][3]); w0.z = pk2(o[1][0], o[1][1]); w0.w = pk2(o[1][2], o[1][3]);
                w1.x = pk2(o[2][0], o[2][1]); w1.y = pk2(o[2][2], o[2][3]); w1.z = pk2(o[3][0], o[3][1]); w1.w = pk2(o[3][2], o[3][3]);
                *(LAS v4u*)mg = w0; *(LAS v4u*)(mg + 16) = w1; *(LAS f32x2*)(mg + 32) = (f32x2){mx, sum};
                VM_WAIT();
            } else {
                const v4u w0 = *(const LAS v4u*)mg, w1 = *(const LAS v4u*)(mg + 16); const f32x2 ml = *(const LAS f32x2*)(mg + 32);
                const float mm = fmaxf(mx, ml.x), a0 = __builtin_amdgcn_exp2f((mx - mm) * CS), a1 = __builtin_amdgcn_exp2f((ml.x - mm) * CS); const float inv = frcp(sum * a0 + ml.y * a1);
                const float sa = a0 * inv, sb = a1 * inv;
                stp = Y + (size_t)(tokrow0 + c) * DM + h * 64 + 4 * g;
                st0.x = pk2(o[0][0] * sa + bflo(w0.x) * sb, o[0][1] * sa + bfhi(w0.x) * sb); st0.y = pk2(o[0][2] * sa + bflo(w0.y) * sb, o[0][3] * sa + bfhi(w0.y) * sb);
                st1.x = pk2(o[1][0] * sa + bflo(w0.z) * sb, o[1][1] * sa + bfhi(w0.z) * sb); st1.y = pk2(o[1][2] * sa + bflo(w0.w) * sb, o[1][3] * sa + bfhi(w0.w) * sb);
                st2.x = pk2(o[2][0] * sa + bflo(w1.x) * sb, o[2][1] * sa + bfhi(w1.x) * sb); st2.y = pk2(o[2][2] * sa + bflo(w1.y) * sb, o[2][3] * sa + bfhi(w1.y) * sb);
                st3.x = pk2(o[3][0] * sa + bflo(w1.z) * sb, o[3][1] * sa + bfhi(w1.z) * sb); st3.y = pk2(o[3][2] * sa + bflo(w1.w) * sb, o[3][3] * sa + bfhi(w1.w) * sb);
            }
            LDS_WAIT();
            __syncthreads();
        }
        if (half == 1) { *(v2u*)(stp) = st0; *(v2u*)(stp + 16) = st1; *(v2u*)(stp + 32) = st2; *(v2u*)(stp + 48) = st3; }
        if (half == 0) NA_BAR();
        it += m;
    }
#undef NA_BAR
#undef NA_ROW_DMA
#undef NA_SWZ
#undef NA_ITEM
    VM_WAIT(); LDS_WAIT();
    __syncthreads();
}

template <int MODE> __device__ __forceinline__ void ph_lru_simple(const Args& a, const Frame& F, int l) {
    int tid = threadIdx.x; asm volatile("" : "+v"(tid)); int lane = tid & 63; (void)lane;
    const bf16* Z = (const bf16*)(a.ws + WS_Z); bf16* Y = (bf16*)(a.ws + WS_Y); float* HF = (float*)(a.ws + WS_HF);
    float* agg = (float*)(a.ws + WS_LAGG); const float* cin = (const float*)(a.ws + WS_LCIN);
    float* xc = (float*)(F.ldsg + RING_OFF);
    const int c = tid, n = c >> 6, k = c & 63;
    float cw[4];
#pragma unroll
    for (int j = 0; j < 4; ++j) cw[j] = a.in[I_CW][((size_t)l * 4 + j) * 512 + c];
    const float cb = a.in[I_CB][(size_t)l * 512 + c];
    for (int ch = F.vcu; ch < NLCH; ch += F.G) {
        const int tok0 = ch * LCH; int s0, T; seq_of(tok0, s0, T); const int s1 = s0 + T;
        __syncthreads();
        for (int t = 0; t < LCH; ++t) { const int tok = tok0 + t; float v = cb;
#pragma unroll
            for (int j = 0; j < 4; ++j) { const int tt = tok + j - 2; if (tt >= s0 && tt < s1) v += cw[j] * bf2f(Z[(size_t)tt * ZW + ZXR + c]); }
            xc[t * 512 + c] = v; }
        __syncthreads();
        for (int dir = 0; dir < 2; ++dir) {
            float wa[64], wx[64];
            const float* pwa = a.in[I_LWA] + ((size_t)(l * 2 + dir) * 8 + n) * 4096 + k; const float* pwx = a.in[I_LWX] + ((size_t)(l * 2 + dir) * 8 + n) * 4096 + k;
#pragma unroll
            for (int j = 0; j < 64; ++j) { wa[j] = pwa[j * 64]; wx[j] = pwx[j * 64]; }
            const float ba = a.in[I_LBA][(size_t)(l * 2 + dir) * 512 + c], bx = a.in[I_LBX][(size_t)(l * 2 + dir) * 512 + c];
            const float lam = a.in[I_LAM][(size_t)(l * 2 + dir) * 512 + c]; const float ls8 = -8.f * log1pf(__expf(-lam));
            float h = MODE ? cin[((size_t)ch * 2 + dir) * 512 + c] : 0.f, P = 1.f;
            for (int st = 0; st < LCH; ++st) {
                const int t = dir ? (LCH - 1 - st) : st; const float* xr = xc + t * 512 + n * 64;
                float pa = ba, px = bx;
#pragma unroll
                for (int j = 0; j < 64; j += 4) { const f32x4 x4 = *(const f32x4*)(xr + j);
                    pa += x4.x * wa[j] + x4.y * wa[j + 1] + x4.z * wa[j + 2] + x4.w * wa[j + 3]; px += x4.x * wx[j] + x4.y * wx[j + 1] + x4.z * wx[j + 2] + x4.w * wx[j + 3]; }
                const float rr = sigmoidf_(pa), ii = sigmoidf_(px), loga = ls8 * rr, av = __expf(loga), mult = sqrtf(fmaxf(-expm1f(2.f * loga), 0.f));
                const float uu = mult * ii * xc[t * 512 + c];
                h = av * h + uu; P *= av;
                if (MODE) { const size_t tok = (size_t)(tok0 + t);
                    if (dir == 0) HF[tok * 512 + c] = h;
                    else { const float gt = bf2f(Z[tok * ZW + ZGT + c]); Y[tok * DM + 1024 + c] = (bf16)f2bf((HF[tok * 512 + c] + h) * gelu_tanh(gt)); } }
            }
            if (!MODE) { float* ag = agg + (((size_t)ch * 2 + dir) * 512 + c) * 2; ag[0] = P; ag[1] = h; }
        }
    }
}

template <int MODE> __device__ __forceinline__ void ph_s5_simple(const Args& a, const Frame& F, int l) {
    int tid = threadIdx.x; asm volatile("" : "+v"(tid)); int lane = tid & 63; (void)lane;
    const bf16* Z = (const bf16*)(a.ws + WS_Z); bf16* YG = (bf16*)(a.ws + WS_YG);
    float* E = (float*)(a.ws + WS_SEND); const float* CIN = (const float*)(a.ws + WS_SCIN);
    const float* TLB = (const float*)(a.ws + WS_TLB); const float* TBB = (const float*)(a.ws + WS_TBB);
    float* Sst = (float*)(F.ldsg + RING_OFF + F.wave * 16384);
    float* Yf = Sst + 2048;
    float* Ub = (float*)(F.ldsg + XTRA_OFF + F.wave * 1024);
    const int gw = F.vcu * NWAVES + F.wave, NGW = F.G * NWAVES;
    for (int u = gw; u < NSCH * 32; u += NGW) {
        const int ch = u >> 5, g = u & 31, tok0 = ch * SCH;
        for (int dir = 0; dir < 2; ++dir) {
            const int dg = dir * 32 + g;
            const float lbr = TLB[((size_t)dg * 64 + lane) * 2], lbi = TLB[((size_t)dg * 64 + lane) * 2 + 1];
            float bbr[16], bbi[16];
            { const f32x4* tb = (const f32x4*)(TBB + ((size_t)dg * 64 + lane) * 32);
#pragma unroll
              for (int q = 0; q < 4; ++q) { const f32x4 x = tb[q], y = tb[4 + q]; bbr[4 * q] = x.x; bbr[4 * q + 1] = x.y; bbr[4 * q + 2] = x.z; bbr[4 * q + 3] = x.w; bbi[4 * q] = y.x; bbi[4 * q + 1] = y.y; bbi[4 * q + 2] = y.z; bbi[4 * q + 3] = y.w; } }
            float cr[64], ci[64];
            if (MODE) { const int h = lane & 15; const f32x4* pr = (const f32x4*)(a.in[I_CRE] + (((size_t)(l * 2 + dir) * 32 + g) * 16 + h) * 64); const f32x4* pi = (const f32x4*)(a.in[I_CIM] + (((size_t)(l * 2 + dir) * 32 + g) * 16 + h) * 64);
#pragma unroll
              for (int q = 0; q < 16; ++q) { const f32x4 x = pr[q], y = pi[q]; cr[4 * q] = x.x; cr[4 * q + 1] = x.y; cr[4 * q + 2] = x.z; cr[4 * q + 3] = x.w; ci[4 * q] = y.x; ci[4 * q + 1] = y.y; ci[4 * q + 2] = y.z; ci[4 * q + 3] = y.w; } }
            float sr = 0.f, si = 0.f;
            if (MODE) { const float* cp = CIN + ((((size_t)ch * 2 + dir) * 32 + g) * 64 + lane) * 2; sr = cp[0]; si = cp[1]; }
            for (int b = 0; b < SCH / 16; ++b) {
                { const int tt = lane >> 2, hq = lane & 3; const int tl = dir ? (SCH - 1 - (16 * b + tt)) : (16 * b + tt);
                  const v2u w = *(const v2u*)(Z + (size_t)(tok0 + tl) * ZW + ZXS + g * 16 + hq * 4);
                  LDS_WAIT();
                  *(f32x4*)(Ub + tt * 16 + hq * 4) = (f32x4){bflo(w.x), bfhi(w.x), bflo(w.y), bfhi(w.y)};
                  LDS_WAIT(); }
                for (int tt = 0; tt < 16; ++tt) {
                    const f32x4 u0 = *(const f32x4*)(Ub + tt * 16), u1 = *(const f32x4*)(Ub + tt * 16 + 4), u2 = *(const f32x4*)(Ub + tt * 16 + 8), u3 = *(const f32x4*)(Ub + tt * 16 + 12);
                    float ir = u0.x * bbr[0] + u0.y * bbr[1] + u0.z * bbr[2] + u0.w * bbr[3] + u1.x * bbr[4] + u1.y * bbr[5] + u1.z * bbr[6] + u1.w * bbr[7]
                             + u2.x * bbr[8] + u2.y * bbr[9] + u2.z * bbr[10] + u2.w * bbr[11] + u3.x * bbr[12] + u3.y * bbr[13] + u3.z * bbr[14] + u3.w * bbr[15];
                    float ii = u0.x * bbi[0] + u0.y * bbi[1] + u0.z * bbi[2] + u0.w * bbi[3] + u1.x * bbi[4] + u1.y * bbi[5] + u1.z * bbi[6] + u1.w * bbi[7]
                             + u2.x * bbi[8] + u2.y * bbi[9] + u2.z * bbi[10] + u2.w * bbi[11] + u3.x * bbi[12] + u3.y * bbi[13] + u3.z * bbi[14] + u3.w * bbi[15];
                    const float nr = lbr * sr - lbi * si + ir, ni = lbr * si + lbi * sr + ii; sr = nr; si = ni;
                    if (MODE) { Sst[(tt * 64 + lane) * 2] = sr; Sst[(tt * 64 + lane) * 2 + 1] = si; }
                }
                if (MODE) {
                    LDS_WAIT();
                    const int h = lane & 15, tq = lane >> 4;
#pragma unroll
                    for (int j = 0; j < 4; ++j) { const int slot = tq * 4 + j; const float* sp = Sst + slot * 128; float y = 0.f;
#pragma unroll
                        for (int p = 0; p < 64; p += 2) { const f32x4 s4 = *(const f32x4*)(sp + 2 * p); y += s4.x * cr[p] - s4.y * ci[p] + s4.z * cr[p + 1] - s4.w * ci[p + 1]; }
                        const int tl = dir ? (SCH - 1 - (16 * b + slot)) : (16 * b + slot);
                        if (dir == 0) Yf[tl * 16 + h] = y; else Yf[tl * 16 + h] += y; }
                    LDS_WAIT();
                }
            }
            if (!MODE) { float* ep = E + ((((size_t)ch * 2 + dir) * 32 + g) * 64 + lane) * 2; ep[0] = sr; ep[1] = si; }
        }
        if (MODE) {
            LDS_WAIT();
            for (int i = 0; i < 32; ++i) { const int idx = lane + 64 * i, tl = idx >> 4, h = idx & 15; const size_t tok = (size_t)(tok0 + tl);
                const float xs = bf2f(Z[tok * ZW + ZXS + g * 16 + h]); const float y = Yf[tl * 16 + h] + a.in[I_SD][(size_t)l * 512 + g * 16 + h] * xs;
                YG[tok * 512 + g * 16 + h] = (bf16)f2bf(gelu_tanh(y)); }
            LDS_WAIT();
        }
    }
}

template <int MODE, int DIR> __device__ __forceinline__ void s5_dir(const Args& a, int l, int lane, int tok0, int gr, LAS unsigned char* st, bf16* yf) {
    const bf16* Z = (const bf16*)(a.ws + WS_ZR); bf16* YG = (bf16*)(a.ws + WS_YG);
    float* E = (float*)(a.ws + WS_SEND); const float* CIN = (const float*)(a.ws + WS_SCIN); const float* TLB = (const float*)(a.ws + WS_TLB);
    const int n = lane & 15, g = lane >> 4, dg = DIR * 32 + gr, ch = tok0 / SCH + g;
    pg8::bf16x8 bbf[8], cf[4];
    { const pg8::bf16x8* bp = (const pg8::bf16x8*)(a.ws + WS_TBBF) + (size_t)dg * 8 * 64 + lane;
#pragma unroll
      for (int c = 0; c < 8; ++c) bbf[c] = bp[c * 64]; }
    if (MODE) { const pg8::bf16x8* cp = (const pg8::bf16x8*)(a.ws + WS_TCF) + (size_t)dg * 4 * 64 + lane;
#pragma unroll
      for (int c = 0; c < 4; ++c) cf[c] = cp[c * 64]; }
    float lbr[4], lbi[4], sr[4], si[4];
#pragma unroll
    for (int cb = 0; cb < 4; ++cb) { const size_t ix = ((size_t)dg * 64 + 16 * cb + n) * 2; lbr[cb] = TLB[ix]; lbi[cb] = TLB[ix + 1];
        if (MODE) { const size_t cx = ((((size_t)ch * 2 + DIR) * 32 + gr) * 64 + 16 * cb + n) * 2; sr[cb] = CIN[cx]; si[cb] = CIN[cx + 1]; } else { sr[cb] = 0.f; si[cb] = 0.f; } }
    const float dsk = MODE ? a.in[I_SD][(size_t)l * 512 + 16 * gr + n] : 0.f;
    const bf16* ua = Z + (size_t)(tok0 + (n >> 2) * SCH + (n & 3)) * ZRW + RXS + 16 * gr + 8 * (g & 1);
    bf16* yo = YG + (size_t)(tok0 + g * SCH) * 512 + 16 * gr + n;
    const bf16* xo = Z + (size_t)(tok0 + g * SCH) * ZRW + RXS + 16 * gr + n;
    constexpr int NST = SCH / 4, T0 = DIR ? (SCH - 4) : 0, DT = DIR ? -4 : 4;
    pg8::bf16x8 un = *(const pg8::bf16x8*)(ua + (size_t)T0 * ZRW);
    unsigned short ygn[4], xsn[4];
    if (MODE && DIR) {
        VM_WAIT();
#pragma unroll
        for (int rg = 0; rg < 4; ++rg) { ygn[rg] = yf[((T0 >> 2) * 4 + rg) * 64 + lane]; xsn[rg] = xo[(size_t)(T0 + rg) * ZRW]; } }
#pragma unroll 1
    for (int step = 0; step < NST; ++step) {
        const int t4 = T0 + DT * step;
        const pg8::bf16x8 u8 = un; unsigned short ygc[4], xsc[4];
        if (MODE && DIR) {
#pragma unroll
            for (int rg = 0; rg < 4; ++rg) { ygc[rg] = ygn[rg]; xsc[rg] = xsn[rg]; } }
        if (step + 1 < NST) { un = *(const pg8::bf16x8*)(ua + (size_t)(t4 + DT) * ZRW);
            if (MODE && DIR) {
#pragma unroll
                for (int rg = 0; rg < 4; ++rg) { ygn[rg] = yf[(((t4 + DT) >> 2) * 4 + rg) * 64 + lane]; xsn[rg] = xo[(size_t)(t4 + DT + rg) * ZRW]; } } }
        f32x4 in[8];
#pragma unroll
        for (int c = 0; c < 8; ++c) in[c] = __builtin_amdgcn_mfma_f32_16x16x32_bf16(u8, bbf[c], (f32x4){0.f, 0.f, 0.f, 0.f}, 0, 0, 0);
        float str[4][4], sti[4][4];
#pragma unroll
        for (int rr = 0; rr < 4; ++rr) { const int rg = DIR ? 3 - rr : rr;
#pragma unroll
            for (int cb = 0; cb < 4; ++cb) { const float nr = lbr[cb] * sr[cb] - lbi[cb] * si[cb] + in[cb][rg], ni = lbr[cb] * si[cb] + lbi[cb] * sr[cb] + in[4 + cb][rg];
                sr[cb] = nr; si[cb] = ni; str[cb][rg] = nr; sti[cb][rg] = ni; } }
        if (MODE) {
#pragma unroll
            for (int rg = 0; rg < 4; ++rg) { v4u w; w.x = pk2s(str[0][rg], sti[0][rg]); w.y = pk2s(str[1][rg], sti[1][rg]); w.z = pk2s(str[2][rg], sti[2][rg]); w.w = pk2s(str[3][rg], sti[3][rg]);
                *(LAS v4u*)(st + (4 * g + rg) * 272 + n * 16) = w; asm volatile("s_nop 1" ::: "memory"); }
            LDS_WAIT();
            f32x4 y = (f32x4){0.f, 0.f, 0.f, 0.f};
#pragma unroll
            for (int ks = 0; ks < 4; ++ks) { const pg8::bf16x8 sf = *(const LAS pg8::bf16x8*)(st + n * 272 + ks * 64 + g * 16); y = __builtin_amdgcn_mfma_f32_16x16x32_bf16(sf, cf[ks], y, 0, 0, 0); }
            LDS_WAIT();
#pragma unroll
            for (int rg = 0; rg < 4; ++rg) {
                if (DIR == 0) yf[((t4 >> 2) * 4 + rg) * 64 + lane] = (bf16)f2bf(y[rg]);
                else { const float v = y[rg] + bf2f(ygc[rg]) + dsk * bf2f(xsc[rg]); yo[(size_t)(t4 + rg) * 512] = (bf16)f2bf(gelu_tanh(v)); } }
        }
    }
    if (!MODE) {
#pragma unroll
        for (int cb = 0; cb < 4; ++cb) { const size_t cx = ((((size_t)ch * 2 + DIR) * 32 + gr) * 64 + 16 * cb + n) * 2; E[cx] = sr[cb]; E[cx + 1] = si[cb]; } }
}

template <int MODE, int DIR> __device__ __forceinline__ void lru_dir(const Args& a, int l, int lane, int tok0, int nb, int half, const LAS unsigned char* xt, bf16* hf) {
    const bf16* Z = (const bf16*)(a.ws + WS_ZR); bf16* Y = (bf16*)(a.ws + WS_Y);
    float* agg = (float*)(a.ws + WS_LAGG); const float* cin = (const float*)(a.ws + WS_LCIN);
    const int n = lane & 15, g = lane >> 4, ch = tok0 / LCH + g;
    pg8::bf16x8 wa[2][2], wx[2][2];
    { const pg8::bf16x8* wp = (const pg8::bf16x8*)(a.ws + WS_TWF) + (size_t)((DIR * 8 + nb) * 2) * 4 * 2 * 64 + lane;
#pragma unroll
      for (int c2 = 0; c2 < 2; ++c2)
#pragma unroll
          for (int ks = 0; ks < 2; ++ks) { wa[c2][ks] = wp[((2 * half + c2) * 2 + ks) * 64]; wx[c2][ks] = wp[(8 + (2 * half + c2) * 2 + ks) * 64]; } }
    pg8::bf16x8 idn[2];
#pragma unroll
    for (int hf = 0; hf < 2; ++hf) { v4u w;
#pragma unroll
        for (int jj = 0; jj < 4; ++jj) { const int k0 = 8 * g + 2 * jj; w[jj] = ((k0 == 16 * hf + n) ? 0x3f80u : 0u) | ((k0 + 1 == 16 * hf + n) ? 0x3f800000u : 0u); }
        idn[hf] = __builtin_bit_cast(pg8::bf16x8, w); }
    float ba[2], bx[2], ls8[2], h[2], P[2];
    const int cch = 64 * nb + 32 * half + n;
#pragma unroll
    for (int c2 = 0; c2 < 2; ++c2) { const int c = cch + 16 * c2; const size_t ix = (size_t)(l * 2 + DIR) * 512 + c;
        ba[c2] = -1.4426950408889634f * a.in[I_LBA][ix]; bx[c2] = -1.4426950408889634f * a.in[I_LBX][ix]; ls8[c2] = (-8.f * 1.4426950408889634f) * log1pf(__expf(-a.in[I_LAM][ix]));
        h[c2] = MODE ? cin[((size_t)ch * 2 + DIR) * 512 + c] : 0.f; P[c2] = 1.f; }
    const LAS unsigned char* xa = xt + ((n >> 2) * LCH + (n & 3)) * 128 + g * 16;
    bf16* yo = Y + (size_t)(tok0 + g * LCH) * DM + 1024 + cch;
    const bf16* go = Z + (size_t)(tok0 + g * LCH) * ZRW + RGT + cch;
    constexpr int NST = LCH / 4, T0 = DIR ? (LCH - 4) : 0, DT = DIR ? -4 : 4;
    unsigned short yn[2][4], gn[2][4];
    if (MODE && DIR) {
        VM_WAIT();
#pragma unroll
        for (int rg = 0; rg < 4; ++rg)
#pragma unroll
            for (int c2 = 0; c2 < 2; ++c2) { yn[c2][rg] = hf[(((T0 >> 2) * 4 + rg) * 2 + c2) * 64 + lane]; gn[c2][rg] = go[(size_t)(T0 + rg) * ZRW + 16 * c2]; } }
#pragma unroll 1
    for (int step = 0; step < NST; ++step) {
        const int t4 = T0 + DT * step;
        unsigned short yc[2][4], gc[2][4];
        if (MODE && DIR) {
#pragma unroll
            for (int rg = 0; rg < 4; ++rg)
#pragma unroll
                for (int c2 = 0; c2 < 2; ++c2) { yc[c2][rg] = yn[c2][rg]; gc[c2][rg] = gn[c2][rg]; }
            if (step + 1 < NST) {
#pragma unroll
                for (int rg = 0; rg < 4; ++rg)
#pragma unroll
                    for (int c2 = 0; c2 < 2; ++c2) { yn[c2][rg] = hf[((((t4 + DT) >> 2) * 4 + rg) * 2 + c2) * 64 + lane]; gn[c2][rg] = go[(size_t)(t4 + DT + rg) * ZRW + 16 * c2]; } } }
        const pg8::bf16x8 a0 = *(const LAS pg8::bf16x8*)(xa + t4 * 128), a1 = *(const LAS pg8::bf16x8*)(xa + t4 * 128 + 64);
        const pg8::bf16x8 ah = half ? a1 : a0;
        f32x4 pa[2], px[2], xd[2];
#pragma unroll
        for (int c2 = 0; c2 < 2; ++c2) { const f32x4 z4 = (f32x4){0.f, 0.f, 0.f, 0.f};
            pa[c2] = __builtin_amdgcn_mfma_f32_16x16x32_bf16(a0, wa[c2][0], z4, 0, 0, 0); pa[c2] = __builtin_amdgcn_mfma_f32_16x16x32_bf16(a1, wa[c2][1], pa[c2], 0, 0, 0);
            px[c2] = __builtin_amdgcn_mfma_f32_16x16x32_bf16(a0, wx[c2][0], z4, 0, 0, 0); px[c2] = __builtin_amdgcn_mfma_f32_16x16x32_bf16(a1, wx[c2][1], px[c2], 0, 0, 0);
            xd[c2] = __builtin_amdgcn_mfma_f32_16x16x32_bf16(ah, idn[c2], z4, 0, 0, 0); }
#pragma unroll
        for (int rr = 0; rr < 4; ++rr) { const int rg = DIR ? 3 - rr : rr;
#pragma unroll
            for (int c2 = 0; c2 < 2; ++c2) {
                const float r_ = frcp(1.f + __builtin_amdgcn_exp2f(__builtin_fmaf(pa[c2][rg], -1.4426950408889634f, ba[c2]))), i_ = frcp(1.f + __builtin_amdgcn_exp2f(__builtin_fmaf(px[c2][rg], -1.4426950408889634f, bx[c2])));
                const float av = __builtin_amdgcn_exp2f(ls8[c2] * r_), mult = fsqrt_(fmaxf(1.f - av * av, 0.f));
                h[c2] = av * h[c2] + mult * i_ * xd[c2][rg]; P[c2] *= av;
                if (MODE) {
                    if (DIR == 0) hf[(((t4 >> 2) * 4 + rg) * 2 + c2) * 64 + lane] = (bf16)f2bf(h[c2]);
                    else yo[(size_t)(t4 + rg) * DM + 16 * c2] = (bf16)f2bf((bf2f(yc[c2][rg]) + h[c2]) * gelu_tanh(bf2f(gc[c2][rg]))); } }
        }
    }
    if (!MODE) {
#pragma unroll
        for (int c2 = 0; c2 < 2; ++c2) { float* ag = agg + (((size_t)ch * 2 + DIR) * 512 + cch + 16 * c2) * 2; ag[0] = P[c2]; ag[1] = h[c2]; } }
}
__device__ __forceinline__ void lru_prepass(const Args& a, int l, int lane, int tok0, int nb, LAS unsigned char* xt) {
    const bf16* Z = (const bf16*)(a.ws + WS_ZR);
    int s0, T; seq_of(tok0, s0, T); const int s1 = s0 + T;
    const int oc = lane & 7, tg = lane >> 3, cbase = 64 * nb + 8 * oc; float cw[4][8], cbv[8];
    v4u x[19];
    const int tb = tok0 + 16 * tg - 2;
#pragma unroll
    for (int i = 0; i < 19; ++i) { const int tt = tb + i; x[i] = (v4u){0u, 0u, 0u, 0u}; if (tt >= s0 && tt < s1) x[i] = *(const v4u*)(Z + (size_t)tt * ZRW + RXR + cbase); }
#pragma unroll
    for (int tp = 0; tp < 4; ++tp) { const f32x4* wp = (const f32x4*)(a.in[I_CW] + ((size_t)l * 4 + tp) * 512 + cbase); const f32x4 w0 = wp[0], w1 = wp[1];
        cw[tp][0] = w0.x; cw[tp][1] = w0.y; cw[tp][2] = w0.z; cw[tp][3] = w0.w; cw[tp][4] = w1.x; cw[tp][5] = w1.y; cw[tp][6] = w1.z; cw[tp][7] = w1.w; }
    { const f32x4* bp = (const f32x4*)(a.in[I_CB] + (size_t)l * 512 + cbase); const f32x4 b0 = bp[0], b1 = bp[1]; cbv[0] = b0.x; cbv[1] = b0.y; cbv[2] = b0.z; cbv[3] = b0.w; cbv[4] = b1.x; cbv[5] = b1.y; cbv[6] = b1.z; cbv[7] = b1.w; }
    LDS_WAIT();
#pragma unroll
    for (int i = 0; i < 16; ++i) { float acc[8];
#pragma unroll
        for (int e = 0; e < 8; ++e) acc[e] = cbv[e];
#pragma unroll
        for (int tp = 0; tp < 4; ++tp) { const v4u xx = x[i + tp];
            acc[0] += cw[tp][0] * bflo(xx.x); acc[1] += cw[tp][1] * bfhi(xx.x); acc[2] += cw[tp][2] * bflo(xx.y); acc[3] += cw[tp][3] * bfhi(xx.y);
            acc[4] += cw[tp][4] * bflo(xx.z); acc[5] += cw[tp][5] * bfhi(xx.z); acc[6] += cw[tp][6] * bflo(xx.w); acc[7] += cw[tp][7] * bfhi(xx.w); }
        v4u o; o.x = pk2(acc[0], acc[1]); o.y = pk2(acc[2], acc[3]); o.z = pk2(acc[4], acc[5]); o.w = pk2(acc[6], acc[7]);
        *(LAS v4u*)(xt + (16 * tg + i) * 128 + oc * 16) = o; asm volatile("s_nop 1" ::: "memory"); }
    LDS_WAIT();
}
template <int MODE> __device__ __forceinline__ void ph_scan(const Args& a, const Frame& F, int l) {
    int tid = threadIdx.x; asm volatile("" : "+v"(tid)); int lane = tid & 63; (void)lane;
    LAS unsigned char* slab = F.lds + RING_OFF + F.wave * 16384;
    LAS int* ctr = (LAS int*)(F.lds + MISC_OFF + 64);
    __syncthreads(); if (tid == 0) *ctr = 0; __syncthreads();
    constexpr int NLU = (NLCH / 4) * 8, NSU = (NSCH / 4) * 32;
    const int l0 = (int)((long)NLU * F.vcu / F.G), l1 = (int)((long)NLU * (F.vcu + 1) / F.G), s0u = (int)((long)NSU * F.vcu / F.G), s1u = (int)((long)NSU * (F.vcu + 1) / F.G);
    const int nl = l1 - l0, ntot = nl + (s1u - s0u);
    for (;;) {
        int it = 0; if (lane == 0) it = __hip_atomic_fetch_add(ctr, 1, __ATOMIC_RELAXED, __HIP_MEMORY_SCOPE_WORKGROUP);
        it = __builtin_amdgcn_readfirstlane(it);
        if (it >= ntot) break;
        if (it < nl) { const int v = l0 + it, nb = v & 7, cq = v >> 3, tok0 = cq * 4 * LCH;
            lru_prepass(a, l, lane, tok0, nb, slab);
#pragma unroll 1
            for (int half = 0; half < 2; ++half) { bf16* hf = (bf16*)(a.ws + WS_HF) + (size_t)(2 * v + half) * 4096;
                lru_dir<MODE, 0>(a, l, lane, tok0, nb, half, slab, hf); lru_dir<MODE, 1>(a, l, lane, tok0, nb, half, slab, hf); }
        } else { const int u = s0u + it - nl, gr = u & 31, cq = u >> 5, tok0 = cq * 4 * SCH;
            bf16* yf = (bf16*)(a.ws + WS_HF + 40 * MiB) + (size_t)u * 4096;
            s5_dir<MODE, 0>(a, l, lane, tok0, gr, slab, yf); s5_dir<MODE, 1>(a, l, lane, tok0, gr, slab, yf); }
    }
    LDS_WAIT();
}

__device__ __forceinline__ void ph_carries(const Args& a, const Frame& F, int l) {
    int tid = threadIdx.x; asm volatile("" : "+v"(tid)); int lane = tid & 63; (void)lane;
    constexpr int NL_LONG = 2 * 2 * 512 * (16384 / LCH / 16), NL_SHORT = 4 * 2 * 512 * (2048 / LCH / 16);
    constexpr int NS_LONG = 2 * 2 * 2048 * (16384 / SCH / 16), NS_SHORT = 4 * 2 * 2048 * (2048 / SCH / 16);
    constexpr int NITEM = NL_LONG + NL_SHORT + NS_LONG + NS_SHORT;
    static_assert(NL_LONG % 512 == 0 && NL_SHORT % 512 == 0 && NS_LONG % 512 == 0 && NS_SHORT % 512 == 0, "item classes are whole workgroups");
    for (int base = F.vcu * NTHR; base < NITEM; base += F.G * NTHR) {
        int it = base + tid;
        if (it < NL_LONG + NL_SHORT) {
            const bool lg = it < NL_LONG; if (!lg) it -= NL_LONG;
            const int W = lg ? (16384 / LCH / 16) : (2048 / LCH / 16); const int seg = it & (W - 1), chain = it / W;
            const int c = chain & 511, dir = (chain >> 9) & 1, sq = chain >> 10; const int s0 = lg ? 8192 + sq * 16384 : sq * 2048, T = lg ? 16384 : 2048; const int c0 = s0 / LCH, nc = T / LCH;
            const f32x2* agg = (const f32x2*)(a.ws + WS_LAGG); float* cin = (float*)(a.ws + WS_LCIN);
            f32x2 v[16]; float A = 1.f, B = 0.f;
#pragma unroll
            for (int j = 0; j < 16; ++j) { const int pos = seg * 16 + j, ch = c0 + (dir ? nc - 1 - pos : pos); v[j] = agg[((size_t)ch * 2 + dir) * 512 + c]; }
#pragma unroll
            for (int j = 0; j < 16; ++j) { B = v[j].x * B + v[j].y; A *= v[j].x; }
            for (int off = 1; off < W; off <<= 1) { const float Ap = __shfl_up(A, off, 64), Bp = __shfl_up(B, off, 64); if (seg >= off) { B = A * Bp + B; A = A * Ap; } }
            float carry = __shfl_up(B, 1, 64); if (seg == 0) carry = 0.f;
#pragma unroll
            for (int j = 0; j < 16; ++j) { const int pos = seg * 16 + j, ch = c0 + (dir ? nc - 1 - pos : pos); cin[((size_t)ch * 2 + dir) * 512 + c] = carry; carry = v[j].x * carry + v[j].y; }
        } else {
            it -= NL_LONG + NL_SHORT;
            const bool lg = it < NS_LONG; if (!lg) it -= NS_LONG;
            const int W = lg ? (16384 / SCH / 16) : (2048 / SCH / 16); const int seg = it & (W - 1), chain = it / W;
            const int p = chain & 63, g = (chain >> 6) & 31, dir = (chain >> 11) & 1, sq = chain >> 12; const int s0 = lg ? 8192 + sq * 16384 : sq * 2048, T = lg ? 16384 : 2048; const int c0 = s0 / SCH, nc = T / SCH;
            const float* TLB = (const float*)(a.ws + WS_TLB); const f32x2* E = (const f32x2*)(a.ws + WS_SEND); f32x2* CIN = (f32x2*)(a.ws + WS_SCIN);
            float pr = TLB[((size_t)(dir * 32 + g) * 64 + p) * 2], pi = TLB[((size_t)(dir * 32 + g) * 64 + p) * 2 + 1];
            static_assert(SCH == 64, "lb^SCH by 6 squarings");
#pragma unroll
            for (int i = 0; i < 6; ++i) { const float nr = pr * pr - pi * pi, ni = 2.f * pr * pi; pr = nr; pi = ni; }
            f32x2 v[16]; float Br = 0.f, Bi = 0.f;
#pragma unroll
            for (int j = 0; j < 16; ++j) { const int pos = seg * 16 + j, ch = c0 + (dir ? nc - 1 - pos : pos); v[j] = E[(((size_t)ch * 2 + dir) * 32 + g) * 64 + p]; }
#pragma unroll
            for (int j = 0; j < 16; ++j) { const float nr = pr * Br - pi * Bi + v[j].x, ni = pr * Bi + pi * Br + v[j].y; Br = nr; Bi = ni; }
            float Ar = pr, Ai = pi;
#pragma unroll
            for (int i = 0; i < 4; ++i) { const float nr = Ar * Ar - Ai * Ai, ni = 2.f * Ar * Ai; Ar = nr; Ai = ni; }
            for (int off = 1; off < W; off <<= 1) { const float Apr = __shfl_up(Ar, off, 64), Api = __shfl_up(Ai, off, 64), Bpr = __shfl_up(Br, off, 64), Bpi = __shfl_up(Bi, off, 64);
                if (seg >= off) { const float nbr = Ar * Bpr - Ai * Bpi + Br, nbi = Ar * Bpi + Ai * Bpr + Bi, nar = Ar * Apr - Ai * Api, nai = Ar * Api + Ai * Apr; Br = nbr; Bi = nbi; Ar = nar; Ai = nai; } }
            float cr = __shfl_up(Br, 1, 64), ci = __shfl_up(Bi, 1, 64); if (seg == 0) { cr = 0.f; ci = 0.f; }
#pragma unroll
            for (int j = 0; j < 16; ++j) { const int pos = seg * 16 + j, ch = c0 + (dir ? nc - 1 - pos : pos); CIN[(((size_t)ch * 2 + dir) * 32 + g) * 64 + p] = (f32x2){cr, ci};
                const float nr = pr * cr - pi * ci + v[j].x, ni = pr * ci + pi * cr + v[j].y; cr = nr; ci = ni; }
        }
    }
}

__device__ __forceinline__ void ph_groupnorm(const Args& a, const Frame& F, int l, bf16* dst = nullptr) {
    int tid = threadIdx.x; asm volatile("" : "+v"(tid)); int lane = tid & 63; (void)lane;
    bf16* Y = (bf16*)(a.ws + WS_Y); const float* g = a.in[I_GOUT] + (size_t)l * DM;
    const int gw = F.vcu * NWAVES + F.wave, NGW = F.G * NWAVES;
    static_assert(NTOK % (256 * NWAVES * 4) == 0 || true, "");
    for (int m0 = gw; m0 < NTOK; m0 += 4 * NGW) {
        v4u w[4][4];
#pragma unroll
        for (int r = 0; r < 4; ++r) { const int m = m0 + r * NGW; const v4u* yr = (const v4u*)(Y + (size_t)(m < NTOK ? m : m0) * DM) + lane;
#pragma unroll
            for (int j = 0; j < 4; ++j) w[r][j] = yr[64 * j]; }
        f32x4 g0[4], g1[4];
#pragma unroll
        for (int j = 0; j < 4; ++j) { const f32x4* gp = (const f32x4*)(g + 8 * (lane + 64 * j)); g0[j] = gp[0]; g1[j] = gp[1]; }
#pragma unroll
        for (int r = 0; r < 4; ++r) { const int m = m0 + r * NGW; float ss[4];
#pragma unroll
            for (int j = 0; j < 4; ++j) { float sq = 0.f;
#pragma unroll
                for (int q = 0; q < 4; ++q) { const float lo = bflo(w[r][j][q]), hi = bfhi(w[r][j][q]); sq += lo * lo + hi * hi; }
                ss[j] = sq; }
            const float sa = wave_sum(ss[0] + ss[1]), sb = wave_sum(ss[2]), sc = wave_sum(ss[3]);
            const float ra = 1.f / sqrtf(sa * (1.f / 1024.f) + EPS), rb = 1.f / sqrtf(sb * (1.f / 512.f) + EPS), rc = 1.f / sqrtf(sc * (1.f / 512.f) + EPS);
            if (m < NTOK) {
                v4u* yo = (dst ? (v4u*)(dst + (size_t)m * DM) : (v4u*)(Y + (size_t)m * DM)) + lane;
#pragma unroll
                for (int j = 0; j < 4; ++j) { const float rr = j < 2 ? ra : (j == 2 ? rb : rc);
                    v4u o; o.x = pk2(bflo(w[r][j].x) * rr * g0[j].x, bfhi(w[r][j].x) * rr * g0[j].y); o.y = pk2(bflo(w[r][j].y) * rr * g0[j].z, bfhi(w[r][j].y) * rr * g0[j].w);
                    o.z = pk2(bflo(w[r][j].z) * rr * g1[j].x, bfhi(w[r][j].z) * rr * g1[j].y); o.w = pk2(bflo(w[r][j].w) * rr * g1[j].z, bfhi(w[r][j].w) * rr * g1[j].w);
                    yo[64 * j] = o; } } }
    }
}

__device__ __forceinline__ void ph_norm2(const Args& a, const Frame& F, int l) {
    int tid = threadIdx.x; asm volatile("" : "+v"(tid)); int lane = tid & 63; (void)lane;
    const int gw = F.vcu * NWAVES + F.wave, NGW = F.G * NWAVES; const float* g = a.in[I_NLG] + (size_t)l * DM; bf16* H = (bf16*)(a.ws + WS_H);
    for (int m = gw; m < NTOK; m += NGW) norm_row_bf16(a.out + (size_t)m * DM, g, H + (size_t)m * DM, lane);
}
__device__ __forceinline__ void ph_final(const Args& a, const Frame& F, float* dst = nullptr) {
    int tid = threadIdx.x; asm volatile("" : "+v"(tid)); int lane = tid & 63; (void)lane;
    const int gw = F.vcu * NWAVES + F.wave, NGW = F.G * NWAVES; const f32x4* gr = (const f32x4*)a.in[I_FING] + lane;
    for (int m0 = gw; m0 < NTOK; m0 += 2 * NGW) {
        f32x4 v[2][8];
#pragma unroll
        for (int r = 0; r < 2; ++r) { const int m = m0 + r * NGW; const f32x4* xr = (const f32x4*)(a.out + (size_t)(m < NTOK ? m : m0) * DM) + lane;
#pragma unroll
            for (int j = 0; j < 8; ++j) v[r][j] = xr[64 * j]; }
#pragma unroll
        for (int r = 0; r < 2; ++r) { const int m = m0 + r * NGW; float sq = 0.f;
#pragma unroll
            for (int j = 0; j < 8; ++j) sq += (v[r][j].x * v[r][j].x + v[r][j].y * v[r][j].y) + (v[r][j].z * v[r][j].z + v[r][j].w * v[r][j].w);
            const float rstd = 1.f / sqrtf(wave_sum(sq) * (1.f / DM) + EPS);
            if (m < NTOK) { f32x4* xo = (dst ? (f32x4*)(dst + (size_t)m * DM) : (f32x4*)(a.out + (size_t)m * DM)) + lane;
#pragma unroll
                for (int j = 0; j < 8; ++j) xo[64 * j] = v[r][j] * rstd * gr[64 * j]; } }
    }
}

__global__ void __launch_bounds__(NTHR, 2) mk_fwd(Args args) {
    extern __shared__ __attribute__((aligned(16))) unsigned char lds[];
    Frame F; F.lds = (LAS unsigned char*)lds; F.ldsg = lds;
    F.tid = threadIdx.x; F.lane = F.tid & 63; F.wave = __builtin_amdgcn_readfirstlane(F.tid >> 6);
    F.G = gridDim.x; { const int bx = blockIdx.x; F.vcu = (F.G % 8 == 0) ? (bx % 8) * (F.G / 8) + bx / 8 : bx; }
    volatile LAS unsigned* MISC = (volatile LAS unsigned*)(F.lds + MISC_OFF);
    for (int u = F.tid; u < (LDS_BYTES - LDSCTL_OFF) / 4; u += NTHR) ((LAS unsigned*)(F.lds + LDSCTL_OFF))[u] = 0u;
    __syncthreads();
    unsigned char* ws = args.ws;
    XcdBarrier bar; bar.bar = (unsigned*)(ws + WS_CTL) + CW_BAR; bar.x = 0; bar.st = nullptr;
#if MK_ONE_LAUNCH
    bar = xcd_barrier_post((unsigned*)(ws + WS_CTL) + CW_BAR, MISC + 8);
#endif
    const int lo = args.ph_lo, hi = args.ph_hi;
#define IN(k) (lo <= (k) && (k) < hi)
#if MK_ONE_LAUNCH
#if PROBE_BAR2
#define SEAM(k) do { if (IN(k) && IN((k) + 1)) { xcd_barrier(bar); xcd_barrier(bar); } } while (0)
#else
#define SEAM(k) do { if (IN(k) && IN((k) + 1)) xcd_barrier(bar); } while (0)
#endif
#else
#define SEAM(k) do { } while (0)
#endif
    for (int l = 0; l < DEPTH; ++l) {
        const int pb = l * PH_PER_LAYER;
        if (IN(pb + 0)) { ph_prologue(args, F, l);
#if PROBE_PRO2
            __syncthreads(); ph_prologue(args, F, l);
#endif
        } SEAM(pb + 0);
        if (IN(pb + 1)) {
            pg8::Gemm g{(const bf16*)(ws + WS_H), (const bf16*)(ws + WS_WIN), NTOK, ZW, DM}; pg8::StaticOrder S; S.init(NTOK, ZW, F.G, (int)blockIdx.x);
            pg8::EpiBf16<2> E{(bf16*)(ws + WS_Z), NTOK, (const unsigned long long*)(ws + WS_SSQ) + (size_t)(l * 2) * NTOK, (LAS float*)(F.lds + XTRA_OFF)};
            pg8::gemm_phase<pg8::EpiBf16<2>, pg8::StaticOrder, true, true>(F.lds + RING_OFF, g, S, E);
#if PROBE_WIN2
            pg8::gemm_phase<pg8::EpiBf16<2>, pg8::StaticOrder, true, true>(F.lds + RING_OFF, g, S, E);
#endif
        } SEAM(pb + 1);
        if (IN(pb + 2)) { ph_na_mfma(args, F, l); ph_scan<0>(args, F, l);
#if PROBE_NA2
            __syncthreads(); ph_na_mfma(args, F, l);
#endif
#if PROBE_SCAN2
            ph_scan<0>(args, F, l);
#endif
        } SEAM(pb + 2);
        if (IN(pb + 3)) { ph_carries(args, F, l);
#if PROBE_SCAN2 || PROBE_CAR2
            ph_carries(args, F, l);
#endif
        } SEAM(pb + 3);
        if (IN(pb + 4)) { ph_scan<1>(args, F, l);
#if PROBE_SCAN2
            ph_scan<1>(args, F, l);
#endif
        } SEAM(pb + 4);
        if (IN(pb + 5)) {
            __syncthreads();
            pg8::Gemm g{(const bf16*)(ws + WS_YG), (const bf16*)(ws + WS_WGLU), NTOK, 512, 512}; pg8::StaticOrder S; S.init(NTOK, 512, F.G, (int)blockIdx.x);
            pg8::EpiGlu E{(const bf16*)(ws + WS_YG), (bf16*)(ws + WS_Y), args.in[I_BGLU] + (size_t)l * 512, DM, 1536};
            pg8::gemm_phase<pg8::EpiGlu, pg8::StaticOrder, true, true>(F.lds + RING_OFF, g, S, E);
#if PROBE_GLU2
            pg8::gemm_phase<pg8::EpiGlu, pg8::StaticOrder, true, true>(F.lds + RING_OFF, g, S, E);
#endif
        } SEAM(pb + 5);
        if (IN(pb + 6)) {
#if PROBE_GN2
            ph_groupnorm(args, F, l, (bf16*)(ws + WS_Z));
#endif
            ph_groupnorm(args, F, l); } SEAM(pb + 6);
        if (IN(pb + 7)) {
            pg8::Gemm g{(const bf16*)(ws + WS_Y), (const bf16*)(ws + WS_WOUT), NTOK, DM, DM}; pg8::StaticOrder S; S.init(NTOK, DM, F.G, (int)blockIdx.x);
#if PROBE_WOUT2
            { pg8::EpiResid E2{l == 0 ? args.in[I_XP] : nullptr, l == 0 ? args.in[I_XS] : nullptr, 8192, (float*)(ws + WS_Z), DM, (bf16*)(ws + WS_H), nullptr};
              pg8::gemm_phase<pg8::EpiResid, pg8::StaticOrder, true, true>(F.lds + RING_OFF, g, S, E2); }
#endif
            pg8::EpiResid E{l == 0 ? args.in[I_XP] : nullptr, l == 0 ? args.in[I_XS] : nullptr, 8192, nullptr, DM, (bf16*)(ws + WS_H), (unsigned long long*)(ws + WS_SSQ) + (size_t)(l * 2 + 1) * NTOK};
            pg8::gemm_phase<pg8::EpiResid, pg8::StaticOrder, true, true>(F.lds + RING_OFF, g, S, E);
        } SEAM(pb + 7);
        for (int s = 0; s <= NMLPC; ++s) {
            if (IN(pb + 8 + s)) {
                if (s > 0) {
                    const int c = s - 1;
                    pg8::Gemm g{(const bf16*)(ws + WS_Z + (size_t)(c & 1) * 128 * MiB), (const bf16*)(ws + WS_WDN), MLPC, DM, DFF}; pg8::StaticOrder S; S.init(MLPC, DM, F.G, (int)blockIdx.x);
                    pg8::EpiResid E{nullptr, nullptr, 1 << 30, l + 1 < DEPTH ? nullptr : args.out + (size_t)c * MLPC * DM, DM,
                                    (bf16*)(ws + WS_H) + (size_t)c * MLPC * DM, (unsigned long long*)(ws + WS_SSQ) + (size_t)((l + 1 < DEPTH ? l + 1 : 0) * 2) * NTOK + (size_t)c * MLPC};
#if PROBE_DN2
                    { pg8::EpiResid E2{nullptr, nullptr, 1 << 30, (float*)(ws + WS_Z + 256 * MiB), DM, (bf16*)(ws + WS_H) + (size_t)c * MLPC * DM, nullptr};
                      pg8::gemm_phase<pg8::EpiResid, pg8::StaticOrder, true, true>(F.lds + RING_OFF, g, S, E2); }
#endif
                    pg8::gemm_phase<pg8::EpiResid, pg8::StaticOrder, true, true>(F.lds + RING_OFF, g, S, E);
                }
                if (s < NMLPC) {
                    const int c = s;
                    pg8::Gemm g{(const bf16*)(ws + WS_H) + (size_t)c * MLPC * DM, (const bf16*)(ws + WS_WUP), MLPC, DFF, DM}; pg8::StaticOrder S; S.init(MLPC, DFF, F.G, (int)blockIdx.x);
                    pg8::EpiBf16<1> E{(bf16*)(ws + WS_Z + (size_t)(c & 1) * 128 * MiB), DFF, (const unsigned long long*)(ws + WS_SSQ) + (size_t)(l * 2 + 1) * NTOK + (size_t)c * MLPC, (LAS float*)(F.lds + XTRA_OFF)};
                    pg8::gemm_phase<pg8::EpiBf16<1>, pg8::StaticOrder, true, true>(F.lds + RING_OFF, g, S, E);
#if PROBE_UP2
                    pg8::gemm_phase<pg8::EpiBf16<1>, pg8::StaticOrder, true, true>(F.lds + RING_OFF, g, S, E);
#endif
                }
            } SEAM(pb + 8 + s);
        }
    }
    if (IN(NPHASE - 1)) {
#if PROBE_FIN2
        ph_final(args, F, (float*)(ws + WS_Z));
#endif
        ph_final(args, F); }
#undef IN
#undef SEAM
}

extern "C" void kernel_launch(void* const* d_in, const int* in_sizes, int n_in, void* d_out, int out_size, void* d_ws, size_t ws_size, hipStream_t stream) {
    static int grid = 0;
    if (grid == 0) {
        if (n_in != 28 || out_size != NTOK * DM || ws_size < WS_END) { fprintf(stderr, "kernel_launch: unexpected shapes (n_in %d out %d ws %zu)\n", n_in, out_size, ws_size); grid = -1; return; }
        int dev = 0, cus = 0, per_cu = 0;
        if (hipGetDevice(&dev) != hipSuccess || hipDeviceGetAttribute(&cus, hipDeviceAttributeMultiprocessorCount, dev) != hipSuccess) { grid = -1; return; }
        if (hipFuncSetAttribute((const void*)mk_fwd, hipFuncAttributeMaxDynamicSharedMemorySize, LDS_BYTES) != hipSuccess) { fprintf(stderr, "kernel_launch: hipFuncSetAttribute failed\n"); grid = -1; return; }
        if (hipOccupancyMaxActiveBlocksPerMultiprocessor(&per_cu, (const void*)mk_fwd, NTHR, LDS_BYTES) != hipSuccess || per_cu < 1) fprintf(stderr, "kernel_launch: occupancy query says %d\n", per_cu);
        (void)hipGetLastError();
        grid = cus;
    }
    if (grid < 0) return;
    if (hipMemsetAsync((char*)d_ws + WS_CTL, 0, CTL_ZERO_BYTES, stream) != hipSuccess) return;
    if (hipMemsetAsync((char*)d_ws + WS_SSQ, 0, SSQ_BYTES, stream) != hipSuccess) return;
    Args a{};
    for (int i = 0; i < 28; ++i) a.in[i] = (const float*)d_in[i];
    a.out = (float*)d_out; a.ws = (unsigned char*)d_ws;
#if MK_ONE_LAUNCH
    a.ph_lo = 0; a.ph_hi = NPHASE;
    hipLaunchKernelGGL(mk_fwd, dim3(grid), dim3(NTHR), LDS_BYTES, stream, a);
#else
    for (int ph = 0; ph < NPHASE; ++ph) { a.ph_lo = ph; a.ph_hi = ph + 1; hipLaunchKernelGGL(mk_fwd, dim3(grid), dim3(NTHR), LDS_BYTES, stream, a); }
#endif
}
```

```cpp
#include <hip/hip_runtime.h>
#include <cstdio>
#include <cstdint>
namespace pg8 {
#define PG8_LAS __attribute__((address_space(3)))
typedef unsigned short bf16_t;
typedef short bf16x8 __attribute__((ext_vector_type(8)));
typedef float f32x4 __attribute__((ext_vector_type(4)));
typedef unsigned u32x4 __attribute__((ext_vector_type(4)));
constexpr int BM = 256, BK = 64, HALF = 128, HTB = HALF * BK * 2  , STAGE_BYTES = 8 * HTB, NXCD = 8, WGM = 8;

__host__ __device__ __forceinline__ int lds_byte(int r, int c) { const int st = (r >> 4) * 2 + (c >> 5), rr = r & 15, cc = c & 31, ob = rr * 64 + cc * 2; return st * 1024 + (ob ^ (((ob >> 9) & 1) << 5)); }
__host__ __device__ __forceinline__ void stage_rc(int b, int& R, int& C) { const int st = b / 1024, sb = b % 1024, swz = sb ^ (((sb >> 9) & 1) << 5); R = (st >> 1) * 16 + swz / 64; C = (st & 1) * 32 + (swz % 64) / 2; }
__host__ __device__ __forceinline__ int perm32(int rho) { const int n = rho >> 4, i = rho & 15; return 8 * (i >> 2) + 4 * n + (i & 3); }

struct Unit { int pm, pn; };
struct Gemm { const bf16_t* A; const bf16_t* Bt; int M, N, K; };

struct StaticOrder {
    int nM, nN, nwg, G, c;
    __host__ __device__ void init(int M, int N, int G_, int c_) { nM = M / BM; nN = N / BM; nwg = nM * nN; G = G_; c = c_; }
    __host__ __device__ bool next(int i, Unit& u) const {
        const long L = (long)i * G + c; if (L >= nwg) return false;
        int wgid = (int)L; { const int q = nwg / NXCD, r = nwg % NXCD, xcd = wgid % NXCD, off = wgid / NXCD; wgid = (xcd < r ? xcd * (q + 1) : r * (q + 1) + (xcd - r) * q) + off; }
        const int nig = WGM * nN, gid = wgid / nig, fm = gid * WGM, gsz = (nM - fm) < WGM ? (nM - fm) : WGM;
        u.pm = fm + ((wgid % nig) % gsz); u.pn = (wgid % nig) / gsz; return true;
    }
    __device__ __forceinline__ void a_ready(const Unit&) const {}
    __device__ __forceinline__ void done(const Unit&) const {}
};
__device__ __forceinline__ unsigned cvt_pk_bf16(float lo, float hi) { unsigned r; asm volatile("v_cvt_pk_bf16_f32 %0, %1, %2" : "=v"(r) : "v"(lo), "v"(hi)); return r; }
template <int ACT> struct EpiBf16 {
    static constexpr bool PERM = true, AFTER_DRAIN = false, HAS_PRE = true;
    bf16_t* O; int ldc; const unsigned long long* SS; PG8_LAS float* tbl;
    template <class Sched> __device__ __forceinline__ void pre_all(const Sched& S, int tid) const {
        unsigned long long v[12]; Unit u;
#pragma unroll
        for (int i = 0; i < 12; ++i) { v[i] = 0ull; if (S.next(i, u)) v[i] = SS[u.pm * BM + (tid & 255)]; }
#pragma unroll
        for (int i = 0; i < 12; ++i) if (tid < 256 && S.next(i, u)) tbl[i * 256 + tid] = 1.f / sqrtf((float)v[i] * (1.f / 1048576.f / 2048.f) + 1e-6f);
    }
    __device__ __forceinline__ void operator()(const f32x4 (&acc)[2][2][4][2], const Unit& u, int wr, int wc, int fr, int fq, int slot) const {
        const int row0 = u.pm * BM + wr * 64 + fr; const int col0 = u.pn * BM + wc * 64 + 8 * fq;
        const unsigned ta = (unsigned)(size_t)(tbl + slot * 256 + wr * 64 + fr);
        float rs[2][4];
#pragma unroll
        for (int ai = 0; ai < 2; ++ai)
#pragma unroll
            for (int m = 0; m < 4; ++m) asm volatile("ds_read_b32 %0, %1 offset:%2" : "=v"(rs[ai][m]) : "v"(ta), "i"((ai * HALF + m * 16) * 4));
        asm volatile("s_waitcnt lgkmcnt(0)" : "+v"(rs[0][0]), "+v"(rs[0][1]), "+v"(rs[0][2]), "+v"(rs[0][3]), "+v"(rs[1][0]), "+v"(rs[1][1]), "+v"(rs[1][2]), "+v"(rs[1][3]));
#pragma unroll
        for (int ai = 0; ai < 2; ++ai)
#pragma unroll
            for (int m = 0; m < 4; ++m) { bf16_t* rowp = O + (size_t)(row0 + ai * HALF + m * 16) * ldc + col0; const float r = rs[ai][m];
                if (ACT == 2) {
                    const size_t row = (size_t)(row0 + ai * HALF + m * 16);
                    rowp = (u.pn < 12) ? O + ((size_t)((u.pn >> 2) * 16 + (u.pn & 3) * 4 + wc) * ldc + row) * 64 + 8 * fq
                                       : O + (size_t)48 * ldc * 64 + row * 1536 + (u.pn - 12) * 256 + wc * 64 + 8 * fq; }
#pragma unroll
                for (int bj = 0; bj < 2; ++bj) { f32x4 v0 = acc[ai][bj][m][0] * r, v1 = acc[ai][bj][m][1] * r;
                    if (ACT == 1) {
#pragma unroll
                        for (int j = 0; j < 4; ++j) { const float a = fmaxf(v0[j], 0.f), b = fmaxf(v1[j], 0.f); v0[j] = a * a; v1[j] = b * b; } }
                    u32x4 w; w.x = cvt_pk_bf16(v0[0], v0[1]); w.y = cvt_pk_bf16(v0[2], v0[3]); w.z = cvt_pk_bf16(v1[0], v1[1]); w.w = cvt_pk_bf16(v1[2], v1[3]);
                    *(u32x4*)(rowp + bj * 32) = w; } }
    }
};
struct EpiResid {
    static constexpr bool PERM = true, AFTER_DRAIN = false, HAS_PRE = false;
    const float* Xin0; const float* Xin1; int split; float* Xout; int ldc; bf16_t* XB; unsigned long long* SS;
    __device__ __forceinline__ void operator()(const f32x4 (&acc)[2][2][4][2], const Unit& u, int wr, int wc, int fr, int fq, int) const {
        const int row0 = u.pm * BM + wr * 64 + fr, col0 = u.pn * BM + wc * 64 + 8 * fq;
        const float* Xin = (u.pm * BM < split) ? Xin0 : Xin1 - (size_t)split * ldc;
#pragma unroll
        for (int am = 0; am < 4; ++am) { const int ai = am >> 1, m0 = (am & 1) * 2;
            f32x4 xf[2][2][2]; u32x4 xr[2][2];
            if (Xin0) {
#pragma unroll
                for (int mm = 0; mm < 2; ++mm) { const size_t ro = (size_t)(row0 + ai * HALF + (m0 + mm) * 16) * ldc + col0;
#pragma unroll
                    for (int bj = 0; bj < 2; ++bj) { xf[mm][bj][0] = *(const f32x4*)(Xin + ro + bj * 32); xf[mm][bj][1] = *(const f32x4*)(Xin + ro + bj * 32 + 4); } }
            } else {
#pragma unroll
                for (int mm = 0; mm < 2; ++mm)
#pragma unroll
                    for (int bj = 0; bj < 2; ++bj) xr[mm][bj] = *(const u32x4*)(XB + (size_t)(row0 + ai * HALF + (m0 + mm) * 16) * ldc + col0 + bj * 32);
            }
            asm volatile("" ::: "memory");
#pragma unroll
            for (int mm = 0; mm < 2; ++mm) { const int m = m0 + mm; const int row = row0 + ai * HALF + m * 16; const size_t ro = (size_t)row * ldc + col0; float ss = 0.f;
#pragma unroll
                for (int bj = 0; bj < 2; ++bj) { f32x4 x0, x1;
                    if (Xin0) { x0 = xf[mm][bj][0]; x1 = xf[mm][bj][1]; }
                    else { const u32x4 w = xr[mm][bj];
                        x0 = (f32x4){__uint_as_float(w.x << 16), __uint_as_float(w.x & 0xffff0000u), __uint_as_float(w.y << 16), __uint_as_float(w.y & 0xffff0000u)};
                        x1 = (f32x4){__uint_as_float(w.z << 16), __uint_as_float(w.z & 0xffff0000u), __uint_as_float(w.w << 16), __uint_as_float(w.w & 0xffff0000u)}; }
                    x0 = x0 + acc[ai][bj][m][0]; x1 = x1 + acc[ai][bj][m][1];
                    if (Xout) { *(f32x4*)(Xout + ro + bj * 32) = x0; *(f32x4*)(Xout + ro + bj * 32 + 4) = x1; }
                    else { u32x4 w; w.x = cvt_pk_bf16(x0[0], x0[1]); w.y = cvt_pk_bf16(x0[2], x0[3]); w.z = cvt_pk_bf16(x1[0], x1[1]); w.w = cvt_pk_bf16(x1[2], x1[3]); *(u32x4*)(XB + ro + bj * 32) = w;
#pragma unroll
                        for (int j = 0; j < 4; ++j) { const float lo = __uint_as_float(w[j] << 16), hi = __uint_as_float(w[j] & 0xffff0000u); ss += lo * lo + hi * hi; } } }
                if (!Xout) { ss += __shfl_xor(ss, 16); ss += __shfl_xor(ss, 32); if (fq == 0) atomicAdd(SS + row, (unsigned long long)(ss * 1048576.f + 0.5f)); } }
            asm volatile("" ::: "memory");
        }
    }
};
struct EpiGlu {
    static constexpr bool PERM = true, AFTER_DRAIN = false, HAS_PRE = false;
    const bf16_t* YG; bf16_t* Y; const float* bias; int ldy; int ycol0;
    __device__ __forceinline__ void operator()(const f32x4 (&acc)[2][2][4][2], const Unit& u, int wr, int wc, int fr, int fq, int) const {
        const int row0 = u.pm * BM + wr * 64 + fr; const int col0 = u.pn * BM + wc * 64 + 8 * fq;
        f32x4 bb[2][2];
#pragma unroll
        for (int bj = 0; bj < 2; ++bj) { bb[bj][0] = *(const f32x4*)(bias + col0 + bj * 32); bb[bj][1] = *(const f32x4*)(bias + col0 + bj * 32 + 4); }
#pragma unroll
        for (int ai = 0; ai < 2; ++ai) {
            u32x4 gl[4][2];
#pragma unroll
            for (int m = 0; m < 4; ++m)
#pragma unroll
                for (int bj = 0; bj < 2; ++bj) gl[m][bj] = *(const u32x4*)(YG + (size_t)(row0 + ai * HALF + m * 16) * 512 + col0 + bj * 32);
            asm volatile("" ::: "memory");
#pragma unroll
            for (int m = 0; m < 4; ++m) { const int row = row0 + ai * HALF + m * 16;
#pragma unroll
                for (int bj = 0; bj < 2; ++bj) { const int col = col0 + bj * 32; const u32x4 g = gl[m][bj];
                    const f32x4 v0 = acc[ai][bj][m][0] + bb[bj][0], v1 = acc[ai][bj][m][1] + bb[bj][1];
                    float o[8];
#pragma unroll
                    for (int j = 0; j < 4; ++j) { const unsigned gw0 = g[j >> 1], gw1 = g[2 + (j >> 1)];
                        const float y0 = __uint_as_float((j & 1) ? (gw0 & 0xffff0000u) : (gw0 << 16)), y1 = __uint_as_float((j & 1) ? (gw1 & 0xffff0000u) : (gw1 << 16));
                        o[j] = y0 * __builtin_amdgcn_rcpf(1.f + __expf(-v0[j])); o[4 + j] = y1 * __builtin_amdgcn_rcpf(1.f + __expf(-v1[j])); }
                    u32x4 w; w.x = cvt_pk_bf16(o[0], o[1]); w.y = cvt_pk_bf16(o[2], o[3]); w.z = cvt_pk_bf16(o[4], o[5]); w.w = cvt_pk_bf16(o[6], o[7]);
                    *(u32x4*)(Y + (size_t)row * ldy + ycol0 + col) = w; } }
            asm volatile("" ::: "memory");
        }
    }
};

template <class Epi, class Sched, bool ALIGN_EPI = false, bool SP2 = false>
__device__ __forceinline__ void gemm_phase(PG8_LAS unsigned char* lds, const Gemm g, const Sched& S, const Epi& E) {
    int tid_ = threadIdx.x; asm volatile("" : "+v"(tid_));
    const int tid = tid_, wid = __builtin_amdgcn_readfirstlane(tid >> 6), lane = tid & 63, wr = wid >> 2, wc = wid & 3, fr = lane & 15, fq = lane >> 4;
    const int K = g.K, nt = K / BK;
    unsigned voffA[2], voffB[2];
#pragma unroll
    for (int i = 0; i < 2; ++i) { int R, C; stage_rc(tid * 16 + i * 8192, R, C); const int Rb = Epi::PERM ? (64 * (R >> 5) + perm32(R & 31)) : R;
        voffA[i] = (unsigned)(R * K + C) * 2u; voffB[i] = (unsigned)(Rb * K + C) * 2u; }
    const size_t kstep = (size_t)(BK * 2);
    const size_t hstep = (size_t)HALF * K * 2;
    const size_t hstepB = Epi::PERM ? (size_t)32 * K * 2 : hstep;
    const size_t tstep = 2 * hstep;
    const unsigned ldsw = (unsigned)wid * 1024u;
    const int aoff = lds_byte(wr * 64 + fr, fq * 8), boff = lds_byte(wc * 32 + fr, fq * 8);
#define PG8_SA(b, h) (((b) * 2 + (h)) * HTB)
#define PG8_SB(b, h) ((4 + (b) * 2 + (h)) * HTB)
#define PG8_STAGE(bufoff, gbase, voff) do { _Pragma("unroll") for (int _i = 0; _i < 2; ++_i) \
        __builtin_amdgcn_global_load_lds((const unsigned*)((const char*)(gbase) + (voff)[_i]), (PG8_LAS unsigned*)(lds + (bufoff) + ldsw + _i * 8192), 16, 0, 0); } while (0)
#define PG8_LDA(dst, b, h) do { _Pragma("unroll") for (int m = 0; m < 4; ++m) _Pragma("unroll") for (int k = 0; k < 2; ++k) dst[m][k] = *(const PG8_LAS bf16x8*)(lds + PG8_SA(b, h) + aoff + m * 2048 + k * 1024); } while (0)
#define PG8_LDB(dst, b, h) do { _Pragma("unroll") for (int n = 0; n < 2; ++n) _Pragma("unroll") for (int k = 0; k < 2; ++k) dst[n][k] = *(const PG8_LAS bf16x8*)(lds + PG8_SB(b, h) + boff + n * 2048 + k * 1024); } while (0)
#define PG8_MMA(ai, bj, At, Bt) do { __builtin_amdgcn_s_setprio(1); _Pragma("unroll") for (int m = 0; m < 4; ++m) _Pragma("unroll") for (int n = 0; n < 2; ++n) _Pragma("unroll") for (int k = 0; k < 2; ++k) \
        acc[ai][bj][m][n] = __builtin_amdgcn_mfma_f32_16x16x32_bf16(Bt[n][k], At[m][k], acc[ai][bj][m][n], 0, 0, 0); __builtin_amdgcn_s_setprio(0); } while (0)
#define PG8_WAIT_V(n) asm volatile("s_waitcnt vmcnt(" #n ")" ::: "memory")
#define PG8_WAIT_L(n) asm volatile("s_waitcnt lgkmcnt(" #n ")" ::: "memory")
#define PG8_BAR __builtin_amdgcn_s_barrier()
#define PG8_SCHED __builtin_amdgcn_sched_barrier(0)
    Unit cur, nxt; int ui = 0;
    if (!S.next(0, cur)) return;
    if constexpr (Epi::HAS_PRE) E.pre_all(S, tid);
    f32x4 acc[2][2][4][2];
#pragma unroll
    for (int a = 0; a < 2; ++a)
#pragma unroll
        for (int b = 0; b < 2; ++b)
#pragma unroll
            for (int m = 0; m < 4; ++m)
#pragma unroll
                for (int n = 0; n < 2; ++n) acc[a][b][m][n] = (f32x4){0.f, 0.f, 0.f, 0.f};
    bf16x8 At[4][2], B0[2][2], B1[2][2];
    const char* cA = (const char*)g.A + (size_t)cur.pm * tstep; const char* cB = (const char*)g.Bt + (size_t)cur.pn * tstep;
    S.a_ready(cur);
    if constexpr (SP2) {
        PG8_STAGE(PG8_SB(0, 0), cB, voffB); PG8_STAGE(PG8_SB(0, 1), cB + hstepB, voffB); PG8_STAGE(PG8_SA(0, 0), cA, voffA); PG8_STAGE(PG8_SA(0, 1), cA + hstep, voffA);
        if (wr == 1) PG8_BAR;
        PG8_WAIT_V(2); PG8_BAR;
        PG8_STAGE(PG8_SB(1, 0), cB + kstep, voffB); PG8_STAGE(PG8_SA(1, 0), cA + kstep, voffA); PG8_STAGE(PG8_SB(1, 1), cB + hstepB + kstep, voffB);
        PG8_WAIT_V(6); PG8_BAR;
    } else {
        PG8_STAGE(PG8_SB(0, 0), cB, voffB); PG8_STAGE(PG8_SA(0, 0), cA, voffA); PG8_STAGE(PG8_SB(0, 1), cB + hstepB, voffB); PG8_STAGE(PG8_SA(0, 1), cA + hstep, voffA);
        if (wr == 1) PG8_BAR;
        PG8_WAIT_V(4); PG8_BAR;
        PG8_STAGE(PG8_SB(1, 0), cB + kstep, voffB); PG8_STAGE(PG8_SA(1, 0), cA + kstep, voffA); PG8_STAGE(PG8_SB(1, 1), cB + hstepB + kstep, voffB);
        PG8_WAIT_V(6); PG8_BAR;
    }
    for (;;) {
        const bool has_next = S.next(ui + 1, nxt);
        const char* nA = has_next ? (const char*)g.A + (size_t)nxt.pm * tstep : cA; const char* nB = has_next ? (const char*)g.Bt + (size_t)nxt.pn * tstep : cB;
        for (int t = 0; t < nt; t += 2) {
            const bool last = (t == nt - 2);
            const char* a1 = cA + (size_t)(t + 1) * kstep;
            const char* a2 = last ? nA : cA + (size_t)(t + 2) * kstep; const char* b2 = last ? nB : cB + (size_t)(t + 2) * kstep;
            const char* a3 = a2 + kstep; const char* b3 = b2 + kstep;
            if (last && has_next) S.a_ready(nxt);
            if constexpr (SP2) {
            PG8_LDB(B0, 0, 0); PG8_LDB(B1, 0, 1); PG8_SCHED; PG8_LDA(At, 0, 0); PG8_STAGE(PG8_SA(1, 1), a1 + hstep, voffA);
            PG8_WAIT_V(8); PG8_WAIT_L(0); PG8_BAR; PG8_MMA(0, 0, At, B0); PG8_MMA(0, 1, At, B1); PG8_BAR; PG8_SCHED;
            PG8_LDA(At, 0, 1); PG8_STAGE(PG8_SB(0, 0), b2, voffB); PG8_STAGE(PG8_SB(0, 1), b2 + hstepB, voffB); PG8_STAGE(PG8_SA(0, 0), a2, voffA);
            PG8_WAIT_V(8); PG8_WAIT_L(0); PG8_BAR; PG8_MMA(1, 0, At, B0); PG8_MMA(1, 1, At, B1); PG8_BAR; PG8_SCHED;
            PG8_LDB(B0, 1, 0); PG8_LDB(B1, 1, 1); PG8_SCHED; PG8_LDA(At, 1, 0); PG8_STAGE(PG8_SA(0, 1), a2 + hstep, voffA);
            PG8_WAIT_V(8); PG8_WAIT_L(0); PG8_BAR; PG8_MMA(0, 0, At, B0); PG8_MMA(0, 1, At, B1); PG8_BAR; PG8_SCHED;
            PG8_LDA(At, 1, 1); PG8_STAGE(PG8_SB(1, 0), b3, voffB); PG8_STAGE(PG8_SB(1, 1), b3 + hstepB, voffB); PG8_STAGE(PG8_SA(1, 0), a3, voffA);
            PG8_WAIT_V(8); PG8_WAIT_L(0); PG8_BAR; PG8_MMA(1, 0, At, B0); PG8_MMA(1, 1, At, B1); PG8_BAR; PG8_SCHED;
            } else {
            PG8_LDB(B0, 0, 0); PG8_SCHED; PG8_LDA(At, 0, 0); PG8_STAGE(PG8_SA(1, 1), a1 + hstep, voffA);
            PG8_WAIT_L(8); PG8_BAR; PG8_WAIT_L(0); PG8_MMA(0, 0, At, B0); PG8_BAR; PG8_SCHED;
            PG8_LDB(B1, 0, 1); PG8_STAGE(PG8_SB(0, 0), b2, voffB);
            PG8_BAR; PG8_WAIT_L(0); PG8_MMA(0, 1, At, B1); PG8_BAR;
            PG8_LDA(At, 0, 1); PG8_STAGE(PG8_SA(0, 0), a2, voffA);
            PG8_BAR; PG8_WAIT_L(0); PG8_MMA(1, 0, At, B0); PG8_BAR; PG8_SCHED;
            PG8_STAGE(PG8_SB(0, 1), b2 + hstepB, voffB);
            PG8_WAIT_V(6); PG8_BAR; PG8_MMA(1, 1, At, B1); PG8_BAR;
            PG8_LDB(B0, 1, 0); PG8_SCHED; PG8_LDA(At, 1, 0); PG8_STAGE(PG8_SA(0, 1), a2 + hstep, voffA);
            PG8_WAIT_L(8); PG8_BAR; PG8_WAIT_L(0); PG8_MMA(0, 0, At, B0); PG8_BAR; PG8_SCHED;
            PG8_LDB(B1, 1, 1); PG8_STAGE(PG8_SB(1, 0), b3, voffB);
            PG8_BAR; PG8_WAIT_L(0); PG8_MMA(0, 1, At, B1); PG8_BAR;
            PG8_LDA(At, 1, 1); PG8_STAGE(PG8_SA(1, 0), a3, voffA);
            PG8_BAR; PG8_WAIT_L(0); PG8_MMA(1, 0, At, B0); PG8_BAR; PG8_SCHED;
            PG8_STAGE(PG8_SB(1, 1), b3 + hstepB, voffB);
            PG8_WAIT_V(6); PG8_BAR; PG8_MMA(1, 1, At, B1); PG8_BAR;
            }
        }
        if constexpr (ALIGN_EPI) { if (wr == 0) PG8_BAR; }
        if constexpr (!Epi::AFTER_DRAIN) { E(acc, cur, wr, wc, fr, fq, ui); S.done(cur); }
        if (!has_next) break;
#pragma unroll
        for (int a = 0; a < 2; ++a)
#pragma unroll
            for (int b = 0; b < 2; ++b)
#pragma unroll
                for (int m = 0; m < 4; ++m)
#pragma unroll
                    for (int n = 0; n < 2; ++n) acc[a][b][m][n] = (f32x4){0.f, 0.f, 0.f, 0.f};
        cur = nxt; cA = nA; cB = nB; ++ui;
        if constexpr (ALIGN_EPI) { if (wr == 1) PG8_BAR; }
    }
    PG8_WAIT_V(0);
    if constexpr (!ALIGN_EPI) { if (wr == 0) PG8_BAR; }
    PG8_BAR;
    if constexpr (Epi::AFTER_DRAIN) { E.fused(acc, cur, wr, wc, fr, fq, lds, wid, lane); S.done(cur); }
#undef PG8_SA
#undef PG8_SB
#undef PG8_STAGE
#undef PG8_LDA
#undef PG8_LDB
#undef PG8_MMA
#undef PG8_WAIT_V
#undef PG8_WAIT_L
#undef PG8_BAR
#undef PG8_SCHED
}
}

#ifndef MK_ONE_LAUNCH
#define MK_ONE_LAUNCH 1
#endif
#ifndef PROBE_GN2
#define PROBE_GN2 0
#endif
#ifndef PROBE_FIN2
#define PROBE_FIN2 0
#endif
#ifndef PROBE_CAR2
#define PROBE_CAR2 0
#endif
#ifndef PROBE_BAR2
#define PROBE_BAR2 0
#endif
#ifndef PROBE_WIN2
#define PROBE_WIN2 0
#endif
#ifndef PROBE_GLU2
#define PROBE_GLU2 0
#endif
#ifndef PROBE_WOUT2
#define PROBE_WOUT2 0
#endif
#ifndef PROBE_DN2
#define PROBE_DN2 0
#endif
#ifndef PROBE_UP2
#define PROBE_UP2 0
#endif
#ifndef PROBE_PRO2
#define PROBE_PRO2 0
#endif
#ifndef PROBE_NA2
#define PROBE_NA2 0
#endif
#ifndef PROBE_SCAN2
#define PROBE_SCAN2 0
#endif
constexpr int NWAVES = 8, NTHR = 512;
constexpr int DM = 2048, NTOK = 40960, ZW = 4608, DFF = 8192, DEPTH = 4;
constexpr int ZK = 1024, ZV = 2048, ZXR = 3072, ZGT = 3584, ZXS = 4096;
constexpr int MLPC = 8192, NMLPC = NTOK / MLPC;
constexpr int LCH = 32, NLCH = NTOK / LCH;
constexpr int SCH = 64, NSCH = NTOK / SCH;
constexpr float EPS = 1e-6f;
constexpr int PH_PER_LAYER = 14, NPHASE = DEPTH * PH_PER_LAYER + 1;

constexpr size_t MiB = 1u << 20;
constexpr size_t WS_CTL = 0, CTL_ZERO_BYTES = 2 * MiB;
constexpr size_t WS_SS = 65536;
constexpr size_t WS_WIN = 2 * MiB, WS_WOUT = 20 * MiB, WS_WUP = 28 * MiB, WS_WDN = 60 * MiB, WS_WGLU = 92 * MiB;
constexpr size_t WS_TLB = 93 * MiB;
constexpr size_t WS_TBB = 93 * MiB + 65536;
constexpr size_t WS_H = 96 * MiB;
constexpr size_t WS_ZR = 256 * MiB + (size_t)48 * NTOK * 64 * 2;
constexpr int ZRW = 1536, RXR = 0, RGT = 512, RXS = 1024;
constexpr size_t WS_Z = 256 * MiB;
constexpr size_t WS_Y = 616 * MiB;
constexpr size_t WS_YG = 776 * MiB;
constexpr size_t WS_HF = 816 * MiB;
constexpr size_t WS_TBBF = 94 * MiB;
constexpr size_t WS_TCF = 94 * MiB + 524288;
constexpr size_t WS_TWF = 95 * MiB;
constexpr size_t WS_LAGG = 896 * MiB;
constexpr size_t WS_LCIN = 906 * MiB;
constexpr size_t WS_SEND = 912 * MiB;
constexpr size_t WS_SCIN = 932 * MiB;
constexpr size_t WS_SSQ = 952 * MiB, SSQ_BYTES = (size_t)DEPTH * 2 * NTOK * 8;
constexpr size_t WS_END = 956 * MiB;
constexpr int CW_BAR = 4096;

constexpr int RING_OFF = 0, RING_BYTES = 131072;
constexpr int XTRA_OFF = RING_BYTES, XTRA_BYTES = 12288;
constexpr int LDSCTL_OFF = 163840 - 1024, MISC_OFF = LDSCTL_OFF + 320;
constexpr int LDS_BYTES = 163840;
static_assert(MISC_OFF + 128 <= LDS_BYTES, "LDS map");

#define GAS __attribute__((address_space(1)))
#define LAS __attribute__((address_space(3)))
typedef unsigned short bf16;
typedef unsigned v4u __attribute__((ext_vector_type(4)));
typedef unsigned v2u __attribute__((ext_vector_type(2)));
typedef float f32x4 __attribute__((ext_vector_type(4)));
typedef float f32x2 __attribute__((ext_vector_type(2)));
#define LDS_WAIT() asm volatile("s_waitcnt lgkmcnt(0)" ::: "memory")
#define VM_WAIT() asm volatile("s_waitcnt vmcnt(0)" ::: "memory")
__device__ __forceinline__ unsigned f2bf(float f) { unsigned u = __builtin_bit_cast(unsigned, f); return (u + 0x7fffu + ((u >> 16) & 1u)) >> 16; }
typedef __bf16 bf16x2_t __attribute__((ext_vector_type(2)));
__device__ __forceinline__ unsigned pk2(float lo, float hi) { const f32x2 v = {lo, hi}; return __builtin_bit_cast(unsigned, __builtin_convertvector(v, bf16x2_t)); }
__device__ __forceinline__ unsigned pk2s(float lo, float hi) { return f2bf(lo) | (f2bf(hi) << 16); }
__device__ __forceinline__ float frcp(float x) { return __builtin_amdgcn_rcpf(x); }
__device__ __forceinline__ float fsqrt_(float x) { return __builtin_amdgcn_sqrtf(x); }
__device__ __forceinline__ float bf2f(unsigned b) { return __builtin_bit_cast(float, b << 16); }
__device__ __forceinline__ float bflo(unsigned w) { return __builtin_bit_cast(float, w << 16); }
__device__ __forceinline__ float bfhi(unsigned w) { return __builtin_bit_cast(float, w & 0xffff0000u); }
__device__ __forceinline__ float wave_sum(float v) {
#pragma unroll
    for (int o = 1; o < 64; o <<= 1) v += __shfl_xor(v, o);
    return v;
}
__device__ __forceinline__ float wave_max(float v) {
#pragma unroll
    for (int o = 1; o < 64; o <<= 1) v = fmaxf(v, __shfl_xor(v, o));
    return v;
}
__device__ __forceinline__ float sigmoidf_(float x) { return frcp(1.f + __expf(-x)); }
__device__ __forceinline__ float gelu_tanh(float x) { const float x2 = x * x; const float y2 = (2.302208198f * x) * __builtin_fmaf(0.044715f, x2, 1.f); const float e = __builtin_amdgcn_exp2f(y2); return x - x * frcp(e + 1.f); }
__device__ __forceinline__ void seq_of(int tok, int& s0, int& T) { if (tok < 8192) { s0 = tok & ~2047; T = 2048; } else { s0 = 8192 + ((tok - 8192) & ~16383); T = 16384; } }

#define XB_TMO      128
#define XB_XCNT(j)  (256  + 64 * (j))
#define XB_XSUB(j)  (1280 + 64 * (j))
#define XB_XGEN(j)  (2304 + 64 * (j))
#define XB_TOP      3328
#define XB_TOPGEN   3392
#define XCD_BAR_WORDS 3456
#define XB_SPIN_CAP (1u << 18)

__device__ __forceinline__ unsigned xb_ld(unsigned* p)              { return __hip_atomic_load(p, __ATOMIC_RELAXED, __HIP_MEMORY_SCOPE_AGENT); }
__device__ __forceinline__ unsigned xb_add(unsigned* p, unsigned v) { return __hip_atomic_fetch_add(p, v, __ATOMIC_RELAXED, __HIP_MEMORY_SCOPE_AGENT); }
__device__ __forceinline__ unsigned xb_xcc_id() { return (unsigned)__builtin_amdgcn_s_getreg((3 << 11) | 20) & 0xFu; }
#define XB_SPIN(cond, bar) do { unsigned _sp = 0; while (cond) { __builtin_amdgcn_s_sleep(1); \
    if ((++_sp & 255u) == 0u) { if (xb_ld(&(bar)[XB_TMO])) break; if (_sp > XB_SPIN_CAP) { atomicAdd(&(bar)[XB_TMO], 1u); break; } } } } while (0)

struct XcdBarrier {
    unsigned* bar; unsigned x;
    volatile LAS unsigned* st;
};

__device__ __forceinline__ XcdBarrier xcd_barrier_post(unsigned* bar, volatile LAS unsigned* st) {
    XcdBarrier b; b.bar = bar; b.x = xb_xcc_id(); b.st = st;
    if (threadIdx.x == 0) (void)xb_add(&bar[XB_XCNT(b.x)], 1u);
    return b;
}
__device__ __forceinline__ void xcd_barrier_complete(unsigned* bar, unsigned x, unsigned& nloc, unsigned& nx) {
    const unsigned G = gridDim.x * gridDim.y * gridDim.z;
    unsigned sum, cnt, mine, sp = 0u;
    for (;;) {
        sum = 0u; cnt = 0u; mine = 0u;
#pragma unroll
        for (unsigned j = 0; j < 16; ++j) { const unsigned c = xb_ld(&bar[XB_XCNT(j)]); sum += c; cnt += (c > 0u) ? 1u : 0u; mine = (j == x) ? c : mine; }
        if (sum == G) break;
        __builtin_amdgcn_s_sleep(1);
        if ((++sp & 255u) == 0u) { if (xb_ld(&bar[XB_TMO])) break; if (sp > XB_SPIN_CAP) { atomicAdd(&bar[XB_TMO], 1u); break; } }
    }
    nloc = mine > 0u ? mine : 1u; nx = cnt > 0u ? cnt : 1u;
}

__device__ __forceinline__ void xcd_barrier(const XcdBarrier& b) {
    asm volatile("s_waitcnt vmcnt(0)" ::: "memory");
    __syncthreads();
    if (threadIdx.x == 0) {
        unsigned* bar = b.bar;
        __builtin_amdgcn_s_waitcnt(0);
        unsigned nloc = b.st[0], nx = b.st[1];
        if (nloc == 0u) { xcd_barrier_complete(bar, b.x, nloc, nx); b.st[0] = nloc; b.st[1] = nx; }
        const unsigned old = xb_add(&bar[XB_XSUB(b.x)], 1u);
        const unsigned gen = old / nloc;
        if (old + 1u == (gen + 1u) * nloc) {
            __builtin_amdgcn_fence(__ATOMIC_RELEASE, "agent");
            asm volatile("s_waitcnt vmcnt(0)" ::: "memory");
            const unsigned og = xb_add(&bar[XB_TOP], 1u);
            const unsigned tg = og / nx;
            if (og + 1u == (tg + 1u) * nx) xb_add(&bar[XB_TOPGEN], 1u);
            else XB_SPIN(xb_ld(&bar[XB_TOPGEN]) == tg, bar);
            __builtin_amdgcn_fence(__ATOMIC_ACQUIRE, "agent");
            xb_add(&bar[XB_XGEN(b.x)], 1u);
            asm volatile("s_waitcnt vmcnt(0)" ::: "memory");
        } else {
            XB_SPIN(xb_ld(&bar[XB_XGEN(b.x)]) == gen, bar);
            __builtin_amdgcn_fence(__ATOMIC_ACQUIRE, "agent");
            asm volatile("s_waitcnt vmcnt(0)" ::: "memory");
        }
    }
    __syncthreads();
}


struct Args { const float* in[28]; float* out; unsigned char* ws; int ph_lo, ph_hi; };
struct Frame {
    LAS unsigned char* lds; unsigned char* ldsg;
    int tid, lane, wave, vcu, G;
};
enum { I_XP = 0, I_XS, I_NMG, I_WIN, I_RPB, I_CW, I_CB, I_LWA, I_LBA, I_LWX, I_LBX, I_LAM, I_ARE, I_AIM, I_LDT, I_BRE, I_BIM, I_CRE, I_CIM, I_SD, I_WGLU, I_BGLU, I_GOUT, I_WOUT, I_NLG, I_WUP, I_WDN, I_FING };

__device__ __forceinline__ void transpose_item(const float* W, int K, int N, bf16* WT, LAS float* scr, int item, int lane, const float* gk) {
    const int nblk = N / 32, kb = item / nblk, nb = item % nblk, k0 = 64 * kb, n0 = 32 * nb;
    float wv[32];
#pragma unroll
    for (int i = 0; i < 32; ++i) wv[i] = W[(size_t)(k0 + 2 * i + (lane >> 5)) * N + n0 + (lane & 31)];
    if (gk) {
#pragma unroll
        for (int i = 0; i < 32; ++i) wv[i] *= gk[k0 + 2 * i + (lane >> 5)]; }
#pragma unroll
    for (int i = 0; i < 32; ++i) scr[(2 * i + (lane >> 5)) * 33 + (lane & 31)] = wv[i];
    LDS_WAIT();
    const int c = lane & 7;
#pragma unroll
    for (int j = 0; j < 4; ++j) { const int n = (lane >> 3) + 8 * j; const LAS float* s = scr + (8 * c) * 33 + n;
        v4u o; o.x = pk2(s[0 * 33], s[1 * 33]); o.y = pk2(s[2 * 33], s[3 * 33]); o.z = pk2(s[4 * 33], s[5 * 33]); o.w = pk2(s[6 * 33], s[7 * 33]);
        *(v4u*)(WT + (size_t)(n0 + n) * K + k0 + 8 * c) = o; }
    LDS_WAIT();
}

__device__ __forceinline__ void xb_row(const float* xrow, bf16* orow, unsigned long long* ss, int lane) {
    const f32x4* xr = (const f32x4*)xrow + lane; f32x4 v[8]; float s = 0.f;
#pragma unroll
    for (int j = 0; j < 8; ++j) { v[j] = xr[64 * j]; s += (v[j].x * v[j].x + v[j].y * v[j].y) + (v[j].z * v[j].z + v[j].w * v[j].w); }
    s = wave_sum(s); if (lane == 0) *ss = (unsigned long long)(s * 1048576.f + 0.5f);
    v2u* o8 = (v2u*)orow + lane;
#pragma unroll
    for (int j = 0; j < 8; ++j) { v2u o; o.x = pk2(v[j].x, v[j].y); o.y = pk2(v[j].z, v[j].w); o8[64 * j] = o; }
}

__device__ __forceinline__ void norm_row_bf16(const float* xrow, const float* g, bf16* orow, int lane) {
    const f32x4* xr = (const f32x4*)xrow + lane; const f32x4* gr = (const f32x4*)g + lane;
    f32x4 v[8]; float s = 0.f;
#pragma unroll
    for (int j = 0; j < 8; ++j) { v[j] = xr[64 * j]; s += (v[j].x * v[j].x + v[j].y * v[j].y) + (v[j].z * v[j].z + v[j].w * v[j].w); }
    const float rstd = 1.f / sqrtf(wave_sum(s) * (1.f / DM) + EPS);
    v2u* o8 = (v2u*)orow + lane;
#pragma unroll
    for (int j = 0; j < 8; ++j) { const f32x4 gg = gr[64 * j]; v2u o; o.x = pk2(v[j].x * rstd * gg.x, v[j].y * rstd * gg.y); o.y = pk2(v[j].z * rstd * gg.z, v[j].w * rstd * gg.w); o8[64 * j] = o; }
}
__device__ __forceinline__ const float* x_row(const Args& a, int l, int row) {
    if (l == 0) return row < 8192 ? a.in[I_XP] + (size_t)row * DM : a.in[I_XS] + (size_t)(row - 8192) * DM;
    return a.out + (size_t)row * DM;
}

__device__ __forceinline__ void ph_prologue(const Args& a, const Frame& F, int l) {
    int tid = threadIdx.x; asm volatile("" : "+v"(tid)); int lane = tid & 63; (void)lane;
    LAS float* scr = (LAS float*)(F.lds + RING_OFF + F.wave * 16384);
    const int gw = F.vcu * NWAVES + F.wave, NGW = F.G * NWAVES;
    constexpr int I_IN = (DM / 64) * (ZW / 32), I_OUT = (DM / 64) * (DM / 32), I_UP = (DM / 64) * (DFF / 32), I_DN = (DFF / 64) * (DM / 32), I_GL = (512 / 64) * (512 / 32);
    constexpr int NITEMS = I_IN + I_OUT + I_UP + I_DN + I_GL;
    unsigned char* ws = a.ws;
    for (int it = gw; it < NITEMS; it += NGW) {
        int r = it;
        if (r < I_IN) { transpose_item(a.in[I_WIN] + (size_t)l * DM * ZW, DM, ZW, (bf16*)(ws + WS_WIN), scr, r, lane, a.in[I_NMG] + (size_t)l * DM); continue; } r -= I_IN;
        if (r < I_OUT) { transpose_item(a.in[I_WOUT] + (size_t)l * DM * DM, DM, DM, (bf16*)(ws + WS_WOUT), scr, r, lane, nullptr); continue; } r -= I_OUT;
        if (r < I_UP) { transpose_item(a.in[I_WUP] + (size_t)l * DM * DFF, DM, DFF, (bf16*)(ws + WS_WUP), scr, r, lane, a.in[I_NLG] + (size_t)l * DM); continue; } r -= I_UP;
        if (r < I_DN) { transpose_item(a.in[I_WDN] + (size_t)l * DFF * DM, DFF, DM, (bf16*)(ws + WS_WDN), scr, r, lane, nullptr); continue; } r -= I_DN;
        transpose_item(a.in[I_WGLU] + (size_t)l * 512 * 512, 512, 512, (bf16*)(ws + WS_WGLU), scr, r, lane, nullptr);
    }
    { const int gt = F.vcu * NTHR + tid;
      if (gt < 4096) {
        const int dir = gt >> 11, g = (gt >> 6) & 31, p = gt & 63; const size_t ix = ((size_t)(l * 2 + dir) * 32 + g) * 64 + p;
        const double are = (double)a.in[I_ARE][ix], aim = (double)a.in[I_AIM][ix]; const double ldt = (double)a.in[I_LDT][(l * 2 + dir) * 32 + g];
        double e = 1.0; { const double x8 = ldt * 0.125; for (int n = 20; n >= 1; --n) e = 1.0 + e * x8 / (double)n; e = e * e; e = e * e; e = e * e; }
        const double dt = e;
        double mag = 1.0; { const double x = are * dt; for (int n = 14; n >= 1; --n) mag = 1.0 + mag * x / (double)n; }
        const double th = aim * dt; const double kq = __builtin_rint(th * 0.15915494309189535); const double r = th - kq * 6.283185307179586476925;
        const double r2 = r * r; double c = 1.0, s = 1.0;
        for (int n = 15; n >= 1; --n) { c = 1.0 - c * r2 / (double)((2 * n - 1) * (2 * n)); s = 1.0 - s * r2 / (double)((2 * n) * (2 * n + 1)); }
        s *= r;
        const double lbr = mag * c, lbi = mag * s, den = are * are + aim * aim, nre = lbr - 1.0, nim = lbi;
        const double cor = (nre * are + nim * aim) / den, coi = (nim * are - nre * aim) / den;
        float* tlb = (float*)(ws + WS_TLB) + (size_t)gt * 2; tlb[0] = (float)lbr; tlb[1] = (float)lbi;
        float* tbb = (float*)(ws + WS_TBB) + (size_t)gt * 32; const float* bre = a.in[I_BRE] + ix * 16; const float* bim = a.in[I_BIM] + ix * 16;
        bf16* bbf = (bf16*)(ws + WS_TBBF);
        for (int h = 0; h < 16; ++h) { const double br = (double)bre[h], bi = (double)bim[h]; const float vr = (float)(cor * br - coi * bi), vi = (float)(cor * bi + coi * br); tbb[h] = vr; tbb[16 + h] = vi;
            const int n = p & 15, gk0 = h >> 3, j = h & 7;
            const unsigned hr = f2bf(vr), hi_ = f2bf(vi); const unsigned lr = f2bf(vr - bf2f(hr)), li = f2bf(vi - bf2f(hi_));
            const size_t fr = ((size_t)((dir * 32 + g) * 8 + (p >> 4)) * 64) * 8, fi = ((size_t)((dir * 32 + g) * 8 + 4 + (p >> 4)) * 64) * 8;
            bbf[fr + (size_t)(n + 16 * gk0) * 8 + j] = (bf16)hr; bbf[fr + (size_t)(n + 16 * (gk0 + 2)) * 8 + j] = (bf16)lr;
            bbf[fi + (size_t)(n + 16 * gk0) * 8 + j] = (bf16)hi_; bbf[fi + (size_t)(n + 16 * (gk0 + 2)) * 8 + j] = (bf16)li; }
      } else if (gt < 4096 + 16384) {
        const int e = gt - 4096, lane_ = e & 63, ks = (e >> 6) & 3, g = (e >> 8) & 31, dir = e >> 13; const int h = lane_ & 15, gk = lane_ >> 4;
        const float* cre = a.in[I_CRE] + (((size_t)(l * 2 + dir) * 32 + g) * 16 + h) * 64; const float* cim = a.in[I_CIM] + (((size_t)(l * 2 + dir) * 32 + g) * 16 + h) * 64;
        bf16* cf = (bf16*)(ws + WS_TCF) + (size_t)e * 8;
        for (int j = 0; j < 8; ++j) { const int P = 16 * (j >> 1) + 4 * ks + gk; cf[j] = (bf16)f2bf((j & 1) ? -cim[P] : cre[P]); }
      } else if (gt >= 20480 && gt < 20480 + 16384) {
        const int e = gt - 20480, lane_ = e & 63, ks = (e >> 6) & 1, cb = (e >> 7) & 3, mat = (e >> 9) & 1, nb = (e >> 10) & 7, dir = e >> 13; const int n = lane_ & 15, gk = lane_ >> 4;
        const float* W = a.in[mat ? I_LWX : I_LWA] + ((size_t)(l * 2 + dir) * 8 + nb) * 4096 + (size_t)(32 * ks + 8 * gk) * 64 + 16 * cb + n;
        bf16* wf = (bf16*)(ws + WS_TWF) + (size_t)e * 8;
        for (int j = 0; j < 8; ++j) wf[j] = (bf16)f2bf(W[j * 64]);
      } }
    if (l == 0) { bf16* XB = (bf16*)(ws + WS_H); unsigned long long* SS = (unsigned long long*)(ws + WS_SSQ);
        for (int m0 = gw; m0 < NTOK; m0 += 2 * NGW) {
            f32x4 v[2][8];
#pragma unroll
            for (int r = 0; r < 2; ++r) { const int m = m0 + r * NGW; const f32x4* xr = (const f32x4*)x_row(a, 0, m < NTOK ? m : m0) + lane;
#pragma unroll
                for (int j = 0; j < 8; ++j) v[r][j] = xr[64 * j]; }
#pragma unroll
            for (int r = 0; r < 2; ++r) { const int m = m0 + r * NGW; float sq = 0.f;
#pragma unroll
                for (int j = 0; j < 8; ++j) sq += (v[r][j].x * v[r][j].x + v[r][j].y * v[r][j].y) + (v[r][j].z * v[r][j].z + v[r][j].w * v[r][j].w);
                sq = wave_sum(sq);
                if (m < NTOK) { if (lane == 0) SS[m] = (unsigned long long)(sq * 1048576.f + 0.5f);
                    v2u* o8 = (v2u*)(XB + (size_t)m * DM) + lane;
#pragma unroll
                    for (int j = 0; j < 8; ++j) { v2u o; o.x = pk2(v[r][j].x, v[r][j].y); o.y = pk2(v[r][j].z, v[r][j].w); o8[64 * j] = o; } } } } }

}

__device__ __forceinline__ void ph_na_simple(const Args& a, const Frame& F, int l) {
    int tid = threadIdx.x; asm volatile("" : "+v"(tid)); int lane = tid & 63; (void)lane;
    const bf16* Z = (const bf16*)(a.ws + WS_Z); bf16* Y = (bf16*)(a.ws + WS_Y);
    const float* rpb = a.in[I_RPB] + (size_t)l * 16 * 15 * 31;
    float* qs = (float*)(F.ldsg + RING_OFF) + F.wave * 64;
    const long U = (long)NTOK * 16; const long u0 = U * F.vcu / F.G, u1 = U * (F.vcu + 1) / F.G;
    for (long u = u0 + F.wave; u < u1; u += NWAVES) {
        const int tok = (int)(u >> 4), h = (int)(u & 15);
        int s0, T; seq_of(tok, s0, T); const int pos = tok - s0, r = pos >> 6, c = pos & 63, R = T >> 6;
        const int rs = min(max(r - 4, 0), R - 8), cs = min(max(c - 8, 0), 48);
        LDS_WAIT();
        qs[lane] = bf2f(Z[(size_t)tok * ZW + h * 64 + lane]);
        LDS_WAIT();
        float sc[2];
#pragma unroll
        for (int i = 0; i < 2; ++i) {
            const int kk = lane + 64 * i, krow = rs + (kk >> 4), kcol = cs + (kk & 15); const int ktok = s0 + krow * 64 + kcol;
            const v4u* kp = (const v4u*)(Z + (size_t)ktok * ZW + ZK + h * 64);
            float d = 0.f;
#pragma unroll
            for (int j = 0; j < 8; ++j) { const v4u w = kp[j]; const f32x4 q0 = *(const f32x4*)(qs + 8 * j), q1 = *(const f32x4*)(qs + 8 * j + 4);
                d += bflo(w.x) * q0.x + bfhi(w.x) * q0.y + bflo(w.y) * q0.z + bfhi(w.y) * q0.w + bflo(w.z) * q1.x + bfhi(w.z) * q1.y + bflo(w.w) * q1.z + bfhi(w.w) * q1.w; }
            sc[i] = d * 0.125f + rpb[(h * 15 + (krow - r + 7)) * 31 + (kcol - c + 15)];
        }
        const float m = wave_max(fmaxf(sc[0], sc[1])); const float p0 = __expf(sc[0] - m), p1 = __expf(sc[1] - m); const float sum = wave_sum(p0 + p1);
        float acc = 0.f;
        for (int kk = 0; kk < 128; ++kk) {
            const float p = __shfl(kk < 64 ? p0 : p1, kk & 63);
            const int krow = rs + (kk >> 4), kcol = cs + (kk & 15); const int vtok = s0 + krow * 64 + kcol;
            acc += p * bf2f(Z[(size_t)vtok * ZW + ZV + h * 64 + lane]);
        }
        Y[(size_t)tok * DM + h * 64 + lane] = (bf16)f2bf(acc / sum);
    }
}

typedef short s16x4_t __attribute__((ext_vector_type(4)));
__device__ __forceinline__ pg8::bf16x8 v_tr_pair(const LAS unsigned char* p) {
    const s16x4_t lo = __builtin_amdgcn_ds_read_tr16_b64_v4i16((LAS s16x4_t*)p), hi = __builtin_amdgcn_ds_read_tr16_b64_v4i16((LAS s16x4_t*)(p + 512));
    return __builtin_shufflevector(lo, hi, 0, 1, 2, 3, 4, 5, 6, 7);
}
__device__ __forceinline__ void glds16_asm(const void* gsrc, unsigned lds_dst) {
    unsigned keep;
    asm volatile("s_mov_b32 %0, m0\n\ts_mov_b32 m0, %2\n\ts_nop 0\n\tglobal_load_lds_dwordx4 %1, off\n\ts_mov_b32 m0, %0" : "=&s"(keep) : "v"(gsrc), "s"(lds_dst) : "memory");
}
__device__ __forceinline__ void ph_na_mfma(const Args& a, const Frame& F, int l) {
    int tid = threadIdx.x; asm volatile("" : "+v"(tid)); int lane = tid & 63; (void)lane;
    const bf16* Z = (const bf16*)(a.ws + WS_Z); bf16* Y = (bf16*)(a.ws + WS_Y);
    constexpr int KR = 0, VR = 73728, BIAS = 147456, MRG = 149504;
    LAS unsigned char* L = F.lds;
    const int w = F.wave, qt = w & 3, half = w >> 2, q = lane & 15, g = lane >> 4;
    const int c0 = 16 * qt, kc0 = (qt == 0) ? 0 : (qt == 1 ? 8 : (qt == 2 ? 24 : 32)), c = c0 + q, cs = min(max(c - 8, 0), 48);
    const int NIT = (NTOK / 64) * 16; const int i0 = (int)((long)NIT * F.vcu / F.G), i1 = (int)((long)NIT * (F.vcu + 1) / F.G);
#define NA_ITEM(it_, s0_, R_, h_, r_) do { if ((it_) < 2048) { const int _col = (it_) >> 5; r_ = (it_) & 31; R_ = 32; s0_ = (_col >> 4) * 2048; h_ = _col & 15; } \
        else { const int _j = (it_) - 2048, _col = _j >> 8; r_ = _j & 255; R_ = 256; s0_ = 8192 + (_col >> 4) * 16384; h_ = _col & 15; } } while (0)
#define NA_SWZ(col_) (((((col_) >> 3) & 3) << 1) | (((col_) >> 1) & 1))
#define NA_ROW_DMA(zoff_, row_, slotbase_) do { \
        _Pragma("unroll") for (int _j = 0; _j < 2; ++_j) { const int _col = c0 + 8 * _j + (lane >> 3); \
            const bf16* _gp = Z + ((size_t)((zoff_) / 64 + h) * NTOK + (s0 + (row_) * 64 + _col)) * 64 + (((lane & 7) ^ NA_SWZ(_col)) * 8); \
            glds16_asm(_gp, (unsigned)(size_t)(L + (slotbase_) + (c0 + 8 * _j) * 128)); } } while (0)
#define NA_BAR() asm volatile("s_barrier" ::: "memory")
    pg8::bf16x8 qn0, qn1;
    { int s0, R, h, r; NA_ITEM(i0, s0, R, h, r); const bf16* qp = Z + ((size_t)h * NTOK + (s0 + r * 64 + c)) * 64 + 8 * g; qn0 = *(const pg8::bf16x8*)qp; qn1 = *(const pg8::bf16x8*)(qp + 32); }
    v2u st0, st1, st2, st3; bf16* stp = Y;
    st0 = st1 = st2 = st3 = (v2u){0u, 0u};
    int it = i0;
    while (it < i1) {
        int s0, R, h, r0; NA_ITEM(it, s0, R, h, r0);
        const int m = min(R - r0, i1 - it);
        {
            const int rs = min(max(r0 - 4, 0), R - 8);
#pragma unroll
            for (int i = 0; i < 16; ++i) { const int id = w * 16 + i, t = id >> 6, ri = (id >> 3) & 7, j8 = id & 7, row = rs + ri;
                const int colw = 8 * j8 + (lane >> 3);
                const bf16* gp = Z + ((size_t)((t ? 32 : 16) + h) * NTOK + (s0 + row * 64 + colw)) * 64 + (((lane & 7) ^ NA_SWZ(colw)) * 8);
                glds16_asm(gp, (unsigned)(size_t)(L + (t ? VR : KR) + (row % 9) * 8192 + j8 * 1024)); }
            if (tid < 465) ((LAS float*)(L + BIAS))[tid] = a.in[I_RPB][((size_t)l * 16 + h) * 465 + tid];
            VM_WAIT(); LDS_WAIT();
            __syncthreads();
        }
        float ti[4][2][4];
        { const LAS float* bt = (const LAS float*)(L + BIAS);
#pragma unroll
          for (int kk = 0; kk < 4; ++kk)
#pragma unroll
              for (int blk = 0; blk < 2; ++blk)
#pragma unroll
                  for (int rg = 0; rg < 4; ++rg) { const int col = kc0 + 8 * g + 4 * blk + rg; const int dc = min(max(col - c + 15, 0), 30); const bool valid = (unsigned)(col - cs) < 16u;
                      ti[kk][blk][rg] = valid ? 8.f * bt[(kk + 4 * half + 3) * 31 + dc] : -INFINITY; } }
        if (half == 1) NA_BAR();
        for (int j = 0; j < m; ++j) {
            const int r = r0 + j, rs = min(max(r - 4, 0), R - 8);
            pg8::bf16x8 qf0 = qn0, qf1 = qn1;
            asm volatile("" : "+v"(qf0), "+v"(qf1) :: "memory");
            if (half == 1 && j > 0) { *(v2u*)(stp) = st0; *(v2u*)(stp + 16) = st1; *(v2u*)(stp + 32) = st2; *(v2u*)(stp + 48) = st3; }
            if (it + j + 1 < i1) {
                int s0n, Rn, hn, rn; NA_ITEM(it + j + 1, s0n, Rn, hn, rn);
                if (half == 0 && j + 1 < m) { const int rsn = min(max(rn - 4, 0), Rn - 8); if (rsn > rs) { NA_ROW_DMA(ZK, rsn + 7, KR + ((rsn + 7) % 9) * 8192); NA_ROW_DMA(ZV, rsn + 7, VR + ((rsn + 7) % 9) * 8192); } }
                const bf16* qp = Z + ((size_t)hn * NTOK + (s0n + rn * 64 + c)) * 64 + 8 * g; qn0 = *(const pg8::bf16x8*)qp; qn1 = *(const pg8::bf16x8*)(qp + 32);
            }
            const int tokrow0 = s0 + r * 64;
            f32x4 sc[4][2];
            pg8::bf16x8 kf[4][2][2];
#pragma unroll
            for (int kk = 0; kk < 4; ++kk) { const int row = rs + 4 * half + kk; const LAS unsigned char* kb = L + KR + (row % 9) * 8192;
#pragma unroll
                for (int blk = 0; blk < 2; ++blk) { const int col = kc0 + 8 * (q >> 2) + 4 * blk + (q & 3); const int sw = NA_SWZ(col);
                    kf[kk][blk][0] = *(const LAS pg8::bf16x8*)(kb + col * 128 + ((g ^ sw) * 16)); kf[kk][blk][1] = *(const LAS pg8::bf16x8*)(kb + col * 128 + (((4 + g) ^ sw) * 16)); } }
            const bool interior = (rs == r - 4);
            __builtin_amdgcn_sched_barrier(0);
#pragma unroll
            for (int kk = 0; kk < 4; ++kk)
#pragma unroll
                for (int blk = 0; blk < 2; ++blk) { f32x4 ini = (f32x4){0.f, 0.f, 0.f, 0.f};
                    if (interior) ini = (f32x4){ti[kk][blk][0], ti[kk][blk][1], ti[kk][blk][2], ti[kk][blk][3]};
                    sc[kk][blk] = __builtin_amdgcn_mfma_f32_16x16x32_bf16(kf[kk][blk][0], qf0, ini, 0, 0, 0); }
#pragma unroll
            for (int kk = 0; kk < 4; ++kk)
#pragma unroll
                for (int blk = 0; blk < 2; ++blk) sc[kk][blk] = __builtin_amdgcn_mfma_f32_16x16x32_bf16(kf[kk][blk][1], qf1, sc[kk][blk], 0, 0, 0);
            __builtin_amdgcn_sched_barrier(0);
            if (!interior) {
                const LAS float* bh = (const LAS float*)(L + BIAS) + (rs + 4 * half - r + 7) * 31;
#pragma unroll
                for (int blk = 0; blk < 2; ++blk)
#pragma unroll
                    for (int rg = 0; rg < 4; ++rg) { const int col = kc0 + 8 * g + 4 * blk + rg; const int dc = min(max(col - c + 15, 0), 30); const bool valid = (unsigned)(col - cs) < 16u;
#pragma unroll
                        for (int kk = 0; kk < 4; ++kk) sc[kk][blk][rg] = valid ? sc[kk][blk][rg] + 8.f * bh[kk * 31 + dc] : -INFINITY; }
            }
            float mx = -INFINITY;
#pragma unroll
            for (int kk = 0; kk < 4; ++kk)
#pragma unroll
                for (int blk = 0; blk < 2; ++blk)
#pragma unroll
                    for (int rg = 0; rg < 4; ++rg) mx = fmaxf(mx, sc[kk][blk][rg]);
            mx = fmaxf(mx, __shfl_xor(mx, 16)); mx = fmaxf(mx, __shfl_xor(mx, 32));
            LDS_WAIT();
            __syncthreads();
            pg8::bf16x8 vfr[4][4];
#pragma unroll
            for (int kk = 0; kk < 4; ++kk) { const int row = rs + 4 * half + kk;
                const int colv = kc0 + 8 * g + ((lane & 15) >> 2), sw0 = NA_SWZ(colv), sw1 = NA_SWZ(colv + 4), pq = lane & 3;
                const LAS unsigned char* vb0 = L + VR + (row % 9) * 8192 + colv * 128 + (pq & 1) * 8; const LAS unsigned char* vb1 = vb0 + 512;
#pragma unroll
                for (int db = 0; db < 4; ++db) { const int ch = 2 * db + (pq >> 1);
                    const s16x4_t lo = __builtin_amdgcn_ds_read_tr16_b64_v4i16((LAS s16x4_t*)(vb0 + ((ch ^ sw0) * 16))), hi = __builtin_amdgcn_ds_read_tr16_b64_v4i16((LAS s16x4_t*)(vb1 + ((ch ^ sw1) * 16)));
                    vfr[kk][db] = __builtin_shufflevector(lo, hi, 0, 1, 2, 3, 4, 5, 6, 7); } }
            __builtin_amdgcn_sched_barrier(0);
            pg8::bf16x8 pf[4];
            constexpr float CS = 0.125f * 1.4426950408889634f;
            const float nm = -mx * CS;
#pragma unroll
            for (int kk = 0; kk < 4; ++kk) { float p[8];
#pragma unroll
                for (int blk = 0; blk < 2; ++blk)
#pragma unroll
                    for (int rg = 0; rg < 4; ++rg) p[4 * blk + rg] = __builtin_amdgcn_exp2f(__builtin_fmaf(sc[kk][blk][rg], CS, nm));
                v4u wv; wv.x = pk2(p[0], p[1]); wv.y = pk2(p[2], p[3]); wv.z = pk2(p[4], p[5]); wv.w = pk2(p[6], p[7]); pf[kk] = __builtin_bit_cast(pg8::bf16x8, wv); }
            f32x4 osum = (f32x4){0.f, 0.f, 0.f, 0.f};
            { const v4u onesw = (v4u){0x3f803f80u, 0x3f803f80u, 0x3f803f80u, 0x3f803f80u}; const pg8::bf16x8 ones = __builtin_bit_cast(pg8::bf16x8, onesw);
#pragma unroll
              for (int kk = 0; kk < 4; ++kk) osum = __builtin_amdgcn_mfma_f32_16x16x32_bf16(ones, pf[kk], osum, 0, 0, 0); }
            const float sum = osum[0];
            f32x4 o[4];
#pragma unroll
            for (int db = 0; db < 4; ++db) o[db] = (f32x4){0.f, 0.f, 0.f, 0.f};
#pragma unroll
            for (int kk = 0; kk < 4; ++kk)
#pragma unroll
                for (int db = 0; db < 4; ++db) o[db] = __builtin_amdgcn_mfma_f32_16x16x32_bf16(vfr[kk][db], pf[kk], o[db], 0, 0, 0);
            LAS unsigned char* mg = L + MRG + (qt * 64 + lane) * 48;
            if (half == 0) {
                v4u w0, w1; w0.x = pk2(o[0][0], o[0][1]); w0.y = pk2(o[0][2], o[0][3]); w0.z = pk2(o[1][0], o[1][1]); w0.w = pk2(o[1][2], o[1][3]);
                w1.x = pk2(o[2][0], o[2][1]); w1.y = pk2(o[2][2], o[2][3]); w1.z = pk2(o[3][0], o[3][1]); w1.w = pk2(o[3][2], o[3][3]);
                *(LAS v4u*)mg = w0; *(LAS v4u*)(mg + 16) = w1; *(LAS f32x2*)(mg + 32) = (f32x2){mx, sum};
                VM_WAIT();
            } else {
                const v4u w0 = *(const LAS v4u*)mg, w1 = *(const LAS v4u*)(mg + 16); const f32x2 ml = *(const LAS f32x2*)(mg + 32);
                const float mm = fmaxf(mx, ml.x), a0 = __builtin_amdgcn_exp2f((mx - mm) * CS), a1 = __builtin_amdgcn_exp2f((ml.x - mm) * CS); const float inv = frcp(sum * a0 + ml.y * a1);
                const float sa = a0 * inv, sb = a1 * inv;
                stp = Y + (size_t)(tokrow0 + c) * DM + h * 64 + 4 * g;
                st0.x = pk2(o[0][0] * sa + bflo(w0.x) * sb, o[0][1] * sa + bfhi(w0.x) * sb); st0.y = pk2(o[0][2] * sa + bflo(w0.y) * sb, o[0][3] * sa + bfhi(w0.y) * sb);
                st1.x = pk2(o[1][0] * sa + bflo(w0.z) * sb, o[1][1] * sa + bfhi(w0.z) * sb); st1.y = pk2(o[1][2] * sa + bflo(w0.w) * sb, o[1][3] * sa + bfhi(w0.w) * sb);
                st2.x = pk2(o[2][0] * sa + bflo(w1.x) * sb, o[2][1] * sa + bfhi(w1.x) * sb); st2.y = pk2(o[2][2] * sa + bflo(w1.y) * sb, o[2][3] * sa + bfhi(w1.y) * sb);
                st3.x = pk2(o[3][0] * sa + bflo(w1.z) * sb, o[3][1] * sa + bfhi(w1.z) * sb); st3.y = pk2(o[3][2] * sa + bflo(w1.w) * sb, o[3][3] * sa + bfhi(w1.w) * sb);
            }
            LDS_WAIT();
            __syncthreads();
        }
        if (half == 1) { *(v2u*)(stp) = st0; *(v2u*)(stp + 16) = st1; *(v2u*)(stp + 32) = st2; *(v2u*)(stp + 48) = st3; }
        if (half == 0) NA_BAR();
        it += m;
    }
#undef NA_BAR
#undef NA_ROW_DMA
#undef NA_SWZ
#undef NA_ITEM
    VM_WAIT(); LDS_WAIT();
    __syncthreads();
}

template <int MODE> __device__ __forceinline__ void ph_lru_simple(const Args& a, const Frame& F, int l) {
    int tid = threadIdx.x; asm volatile("" : "+v"(tid)); int lane = tid & 63; (void)lane;
    const bf16* Z = (const bf16*)(a.ws + WS_Z); bf16* Y = (bf16*)(a.ws + WS_Y); float* HF = (float*)(a.ws + WS_HF);
    float* agg = (float*)(a.ws + WS_LAGG); const float* cin = (const float*)(a.ws + WS_LCIN);
    float* xc = (float*)(F.ldsg + RING_OFF);
    const int c = tid, n = c >> 6, k = c & 63;
    float cw[4];
#pragma unroll
    for (int j = 0; j < 4; ++j) cw[j] = a.in[I_CW][((size_t)l * 4 + j) * 512 + c];
    const float cb = a.in[I_CB][(size_t)l * 512 + c];
    for (int ch = F.vcu; ch < NLCH; ch += F.G) {
        const int tok0 = ch * LCH; int s0, T; seq_of(tok0, s0, T); const int s1 = s0 + T;
        __syncthreads();
        for (int t = 0; t < LCH; ++t) { const int tok = tok0 + t; float v = cb;
#pragma unroll
            for (int j = 0; j < 4; ++j) { const int tt = tok + j - 2; if (tt >= s0 && tt < s1) v += cw[j] * bf2f(Z[(size_t)tt * ZW + ZXR + c]); }
            xc[t * 512 + c] = v; }
        __syncthreads();
        for (int dir = 0; dir < 2; ++dir) {
            float wa[64], wx[64];
            const float* pwa = a.in[I_LWA] + ((size_t)(l * 2 + dir) * 8 + n) * 4096 + k; const float* pwx = a.in[I_LWX] + ((size_t)(l * 2 + dir) * 8 + n) * 4096 + k;
#pragma unroll
            for (int j = 0; j < 64; ++j) { wa[j] = pwa[j * 64]; wx[j] = pwx[j * 64]; }
            const float ba = a.in[I_LBA][(size_t)(l * 2 + dir) * 512 + c], bx = a.in[I_LBX][(size_t)(l * 2 + dir) * 512 + c];
            const float lam = a.in[I_LAM][(size_t)(l * 2 + dir) * 512 + c]; const float ls8 = -8.f * log1pf(__expf(-lam));
            float h = MODE ? cin[((size_t)ch * 2 + dir) * 512 + c] : 0.f, P = 1.f;
            for (int st = 0; st < LCH; ++st) {
                const int t = dir ? (LCH - 1 - st) : st; const float* xr = xc + t * 512 + n * 64;
                float pa = ba, px = bx;
#pragma unroll
                for (int j = 0; j < 64; j += 4) { const f32x4 x4 = *(const f32x4*)(xr + j);
                    pa += x4.x * wa[j] + x4.y * wa[j + 1] + x4.z * wa[j + 2] + x4.w * wa[j + 3]; px += x4.x * wx[j] + x4.y * wx[j + 1] + x4.z * wx[j + 2] + x4.w * wx[j + 3]; }
                const float rr = sigmoidf_(pa), ii = sigmoidf_(px), loga = ls8 * rr, av = __expf(loga), mult = sqrtf(fmaxf(-expm1f(2.f * loga), 0.f));
                const float uu = mult * ii * xc[t * 512 + c];
                h = av * h + uu; P *= av;
                if (MODE) { const size_t tok = (size_t)(tok0 + t);
                    if (dir == 0) HF[tok * 512 + c] = h;
                    else { const float gt = bf2f(Z[tok * ZW + ZGT + c]); Y[tok * DM + 1024 + c] = (bf16)f2bf((HF[tok * 512 + c] + h) * gelu_tanh(gt)); } }
            }
            if (!MODE) { float* ag = agg + (((size_t)ch * 2 + dir) * 512 + c) * 2; ag[0] = P; ag[1] = h; }
        }
    }
}

template <int MODE> __device__ __forceinline__ void ph_s5_simple(const Args& a, const Frame& F, int l) {
    int tid = threadIdx.x; asm volatile("" : "+v"(tid)); int lane = tid & 63; (void)lane;
    const bf16* Z = (const bf16*)(a.ws + WS_Z); bf16* YG = (bf16*)(a.ws + WS_YG);
    float* E = (float*)(a.ws + WS_SEND); const float* CIN = (const float*)(a.ws + WS_SCIN);
    const float* TLB = (const float*)(a.ws + WS_TLB); const float* TBB = (const float*)(a.ws + WS_TBB);
    float* Sst = (float*)(F.ldsg + RING_OFF + F.wave * 16384);
    float* Yf = Sst + 2048;
    float* Ub = (float*)(F.ldsg + XTRA_OFF + F.wave * 1024);
    const int gw = F.vcu * NWAVES + F.wave, NGW = F.G * NWAVES;
    for (int u = gw; u < NSCH * 32; u += NGW) {
        const int ch = u >> 5, g = u & 31, tok0 = ch * SCH;
        for (int dir = 0; dir < 2; ++dir) {
            const int dg = dir * 32 + g;
            const float lbr = TLB[((size_t)dg * 64 + lane) * 2], lbi = TLB[((size_t)dg * 64 + lane) * 2 + 1];
            float bbr[16], bbi[16];
            { const f32x4* tb = (const f32x4*)(TBB + ((size_t)dg * 64 + lane) * 32);
#pragma unroll
              for (int q = 0; q < 4; ++q) { const f32x4 x = tb[q], y = tb[4 + q]; bbr[4 * q] = x.x; bbr[4 * q + 1] = x.y; bbr[4 * q + 2] = x.z; bbr[4 * q + 3] = x.w; bbi[4 * q] = y.x; bbi[4 * q + 1] = y.y; bbi[4 * q + 2] = y.z; bbi[4 * q + 3] = y.w; } }
            float cr[64], ci[64];
            if (MODE) { const int h = lane & 15; const f32x4* pr = (const f32x4*)(a.in[I_CRE] + (((size_t)(l * 2 + dir) * 32 + g) * 16 + h) * 64); const f32x4* pi = (const f32x4*)(a.in[I_CIM] + (((size_t)(l * 2 + dir) * 32 + g) * 16 + h) * 64);
#pragma unroll
              for (int q = 0; q < 16; ++q) { const f32x4 x = pr[q], y = pi[q]; cr[4 * q] = x.x; cr[4 * q + 1] = x.y; cr[4 * q + 2] = x.z; cr[4 * q + 3] = x.w; ci[4 * q] = y.x; ci[4 * q + 1] = y.y; ci[4 * q + 2] = y.z; ci[4 * q + 3] = y.w; } }
            float sr = 0.f, si = 0.f;
            if (MODE) { const float* cp = CIN + ((((size_t)ch * 2 + dir) * 32 + g) * 64 + lane) * 2; sr = cp[0]; si = cp[1]; }
            for (int b = 0; b < SCH / 16; ++b) {
                { const int tt = lane >> 2, hq = lane & 3; const int tl = dir ? (SCH - 1 - (16 * b + tt)) : (16 * b + tt);
                  const v2u w = *(const v2u*)(Z + (size_t)(tok0 + tl) * ZW + ZXS + g * 16 + hq * 4);
                  LDS_WAIT();
                  *(f32x4*)(Ub + tt * 16 + hq * 4) = (f32x4){bflo(w.x), bfhi(w.x), bflo(w.y), bfhi(w.y)};
                  LDS_WAIT(); }
                for (int tt = 0; tt < 16; ++tt) {
                    const f32x4 u0 = *(const f32x4*)(Ub + tt * 16), u1 = *(const f32x4*)(Ub + tt * 16 + 4), u2 = *(const f32x4*)(Ub + tt * 16 + 8), u3 = *(const f32x4*)(Ub + tt * 16 + 12);
                    float ir = u0.x * bbr[0] + u0.y * bbr[1] + u0.z * bbr[2] + u0.w * bbr[3] + u1.x * bbr[4] + u1.y * bbr[5] + u1.z * bbr[6] + u1.w * bbr[7]
                             + u2.x * bbr[8] + u2.y * bbr[9] + u2.z * bbr[10] + u2.w * bbr[11] + u3.x * bbr[12] + u3.y * bbr[13] + u3.z * bbr[14] + u3.w * bbr[15];
                    float ii = u0.x * bbi[0] + u0.y * bbi[1] + u0.z * bbi[2] + u0.w * bbi[3] + u1.x * bbi[4] + u1.y * bbi[5] + u1.z * bbi[6] + u1.w * bbi[7]
                             + u2.x * bbi[8] + u2.y * bbi[9] + u2.z * bbi[10] + u2.w * bbi[11] + u3.x * bbi[12] + u3.y * bbi[13] + u3.z * bbi[14] + u3.w * bbi[15];
                    const float nr = lbr * sr - lbi * si + ir, ni = lbr * si + lbi * sr + ii; sr = nr; si = ni;
                    if (MODE) { Sst[(tt * 64 + lane) * 2] = sr; Sst[(tt * 64 + lane) * 2 + 1] = si; }
                }
                if (MODE) {
                    LDS_WAIT();
                    const int h = lane & 15, tq = lane >> 4;
#pragma unroll
                    for (int j = 0; j < 4; ++j) { const int slot = tq * 4 + j; const float* sp = Sst + slot * 128; float y = 0.f;
#pragma unroll
                        for (int p = 0; p < 64; p += 2) { const f32x4 s4 = *(const f32x4*)(sp + 2 * p); y += s4.x * cr[p] - s4.y * ci[p] + s4.z * cr[p + 1] - s4.w * ci[p + 1]; }
                        const int tl = dir ? (SCH - 1 - (16 * b + slot)) : (16 * b + slot);
                        if (dir == 0) Yf[tl * 16 + h] = y; else Yf[tl * 16 + h] += y; }
                    LDS_WAIT();
                }
            }
            if (!MODE) { float* ep = E + ((((size_t)ch * 2 + dir) * 32 + g) * 64 + lane) * 2; ep[0] = sr; ep[1] = si; }
        }
        if (MODE) {
            LDS_WAIT();
            for (int i = 0; i < 32; ++i) { const int idx = lane + 64 * i, tl = idx >> 4, h = idx & 15; const size_t tok = (size_t)(tok0 + tl);
                const float xs = bf2f(Z[tok * ZW + ZXS + g * 16 + h]); const float y = Yf[tl * 16 + h] + a.in[I_SD][(size_t)l * 512 + g * 16 + h] * xs;
                YG[tok * 512 + g * 16 + h] = (bf16)f2bf(gelu_tanh(y)); }
            LDS_WAIT();
        }
    }
}

template <int MODE, int DIR> __device__ __forceinline__ void s5_dir(const Args& a, int l, int lane, int tok0, int gr, LAS unsigned char* st, bf16* yf) {
    const bf16* Z = (const bf16*)(a.ws + WS_ZR); bf16* YG = (bf16*)(a.ws + WS_YG);
    float* E = (float*)(a.ws + WS_SEND); const float* CIN = (const float*)(a.ws + WS_SCIN); const float* TLB = (const float*)(a.ws + WS_TLB);
    const int n = lane & 15, g = lane >> 4, dg = DIR * 32 + gr, ch = tok0 / SCH + g;
    pg8::bf16x8 bbf[8], cf[4];
    { const pg8::bf16x8* bp = (const pg8::bf16x8*)(a.ws + WS_TBBF) + (size_t)dg * 8 * 64 + lane;
#pragma unroll
      for (int c = 0; c < 8; ++c) bbf[c] = bp[c * 64]; }
    if (MODE) { const pg8::bf16x8* cp = (const pg8::bf16x8*)(a.ws + WS_TCF) + (size_t)dg * 4 * 64 + lane;
#pragma unroll
      for (int c = 0; c < 4; ++c) cf[c] = cp[c * 64]; }
    float lbr[4], lbi[4], sr[4], si[4];
#pragma unroll
    for (int cb = 0; cb < 4; ++cb) { const size_t ix = ((size_t)dg * 64 + 16 * cb + n) * 2; lbr[cb] = TLB[ix]; lbi[cb] = TLB[ix + 1];
        if (MODE) { const size_t cx = ((((size_t)ch * 2 + DIR) * 32 + gr) * 64 + 16 * cb + n) * 2; sr[cb] = CIN[cx]; si[cb] = CIN[cx + 1]; } else { sr[cb] = 0.f; si[cb] = 0.f; } }
    const float dsk = MODE ? a.in[I_SD][(size_t)l * 512 + 16 * gr + n] : 0.f;
    const bf16* ua = Z + (size_t)(tok0 + (n >> 2) * SCH + (n & 3)) * ZRW + RXS + 16 * gr + 8 * (g & 1);
    bf16* yo = YG + (size_t)(tok0 + g * SCH) * 512 + 16 * gr + n;
    const bf16* xo = Z + (size_t)(tok0 + g * SCH) * ZRW + RXS + 16 * gr + n;
    constexpr int NST = SCH / 4, T0 = DIR ? (SCH - 4) : 0, DT = DIR ? -4 : 4;
    pg8::bf16x8 un = *(const pg8::bf16x8*)(ua + (size_t)T0 * ZRW);
    unsigned short ygn[4], xsn[4];
    if (MODE && DIR) {
        VM_WAIT();
#pragma unroll
        for (int rg = 0; rg < 4; ++rg) { ygn[rg] = yf[((T0 >> 2) * 4 + rg) * 64 + lane]; xsn[rg] = xo[(size_t)(T0 + rg) * ZRW]; } }
#pragma unroll 1
    for (int step = 0; step < NST; ++step) {
        const int t4 = T0 + DT * step;
        const pg8::bf16x8 u8 = un; unsigned short ygc[4], xsc[4];
        if (MODE && DIR) {
#pragma unroll
            for (int rg = 0; rg < 4; ++rg) { ygc[rg] = ygn[rg]; xsc[rg] = xsn[rg]; } }
        if (step + 1 < NST) { un = *(const pg8::bf16x8*)(ua + (size_t)(t4 + DT) * ZRW);
            if (MODE && DIR) {
#pragma unroll
                for (int rg = 0; rg < 4; ++rg) { ygn[rg] = yf[(((t4 + DT) >> 2) * 4 + rg) * 64 + lane]; xsn[rg] = xo[(size_t)(t4 + DT + rg) * ZRW]; } } }
        f32x4 in[8];
#pragma unroll
        for (int c = 0; c < 8; ++c) in[c] = __builtin_amdgcn_mfma_f32_16x16x32_bf16(u8, bbf[c], (f32x4){0.f, 0.f, 0.f, 0.f}, 0, 0, 0);
        float str[4][4], sti[4][4];
#pragma unroll
        for (int rr = 0; rr < 4; ++rr) { const int rg = DIR ? 3 - rr : rr;
#pragma unroll
            for (int cb = 0; cb < 4; ++cb) { const float nr = lbr[cb] * sr[cb] - lbi[cb] * si[cb] + in[cb][rg], ni = lbr[cb] * si[cb] + lbi[cb] * sr[cb] + in[4 + cb][rg];
                sr[cb] = nr; si[cb] = ni; str[cb][rg] = nr; sti[cb][rg] = ni; } }
        if (MODE) {
            v4u w[4];
#pragma unroll
            for (int rg = 0; rg < 4; ++rg) {
#pragma unroll
                for (int cb = 0; cb < 4; ++cb) { float xr_ = str[cb][rg], xi_ = sti[cb][rg]; asm volatile("" : "+v"(xr_), "+v"(xi_));
                    w[rg][cb] = pk2(xr_, xi_); } }
            { const unsigned ta = (unsigned)(size_t)(st + (4 * g) * 272 + n * 16);
              asm volatile("s_nop 1\n\tds_write_b128 %0, %1\n\tds_write_b128 %0, %2 offset:272\n\tds_write_b128 %0, %3 offset:544\n\tds_write_b128 %0, %4 offset:816\n\ts_waitcnt lgkmcnt(0)"
                           :: "v"(ta), "v"(w[0]), "v"(w[1]), "v"(w[2]), "v"(w[3]) : "memory"); }
            f32x4 y = (f32x4){0.f, 0.f, 0.f, 0.f};
#pragma unroll
            for (int ks = 0; ks < 4; ++ks) { const pg8::bf16x8 sf = *(const LAS pg8::bf16x8*)(st + n * 272 + ks * 64 + g * 16); y = __builtin_amdgcn_mfma_f32_16x16x32_bf16(sf, cf[ks], y, 0, 0, 0); }
            LDS_WAIT();
#pragma unroll
            for (int rg = 0; rg < 4; ++rg) {
                if (DIR == 0) yf[((t4 >> 2) * 4 + rg) * 64 + lane] = (bf16)f2bf(y[rg]);
                else { const float v = y[rg] + bf2f(ygc[rg]) + dsk * bf2f(xsc[rg]); yo[(size_t)(t4 + rg) * 512] = (bf16)f2bf(gelu_tanh(v)); } }
        }
    }
    if (!MODE) {
#pragma unroll
        for (int cb = 0; cb < 4; ++cb) { const size_t cx = ((((size_t)ch * 2 + DIR) * 32 + gr) * 64 + 16 * cb + n) * 2; E[cx] = sr[cb]; E[cx + 1] = si[cb]; } }
}

template <int MODE, int DIR> __device__ __forceinline__ void lru_dir(const Args& a, int l, int lane, int tok0, int nb, int half, const LAS unsigned char* xt, bf16* hf) {
    const bf16* Z = (const bf16*)(a.ws + WS_ZR); bf16* Y = (bf16*)(a.ws + WS_Y);
    float* agg = (float*)(a.ws + WS_LAGG); const float* cin = (const float*)(a.ws + WS_LCIN);
    const int n = lane & 15, g = lane >> 4, ch = tok0 / LCH + g;
    pg8::bf16x8 wa[2][2], wx[2][2];
    { const pg8::bf16x8* wp = (const pg8::bf16x8*)(a.ws + WS_TWF) + (size_t)((DIR * 8 + nb) * 2) * 4 * 2 * 64 + lane;
#pragma unroll
      for (int c2 = 0; c2 < 2; ++c2)
#pragma unroll
          for (int ks = 0; ks < 2; ++ks) { wa[c2][ks] = wp[((2 * half + c2) * 2 + ks) * 64]; wx[c2][ks] = wp[(8 + (2 * half + c2) * 2 + ks) * 64]; } }
    pg8::bf16x8 idn[2];
#pragma unroll
    for (int hf = 0; hf < 2; ++hf) { v4u w;
#pragma unroll
        for (int jj = 0; jj < 4; ++jj) { const int k0 = 8 * g + 2 * jj; w[jj] = ((k0 == 16 * hf + n) ? 0x3f80u : 0u) | ((k0 + 1 == 16 * hf + n) ? 0x3f800000u : 0u); }
        idn[hf] = __builtin_bit_cast(pg8::bf16x8, w); }
    float ba[2], bx[2], ls8[2], h[2], P[2];
    const int cch = 64 * nb + 32 * half + n;
#pragma unroll
    for (int c2 = 0; c2 < 2; ++c2) { const int c = cch + 16 * c2; const size_t ix = (size_t)(l * 2 + DIR) * 512 + c;
        ba[c2] = -1.4426950408889634f * a.in[I_LBA][ix]; bx[c2] = -1.4426950408889634f * a.in[I_LBX][ix]; ls8[c2] = (-8.f * 1.4426950408889634f) * log1pf(__expf(-a.in[I_LAM][ix]));
        h[c2] = MODE ? cin[((size_t)ch * 2 + DIR) * 512 + c] : 0.f; P[c2] = 1.f; }
    const LAS unsigned char* xa = xt + ((n >> 2) * LCH + (n & 3)) * 128 + g * 16;
    bf16* yo = Y + (size_t)(tok0 + g * LCH) * DM + 1024 + cch;
    const bf16* go = Z + (size_t)(tok0 + g * LCH) * ZRW + RGT + cch;
    constexpr int NST = LCH / 4, T0 = DIR ? (LCH - 4) : 0, DT = DIR ? -4 : 4;
    unsigned short yn[2][4], gn[2][4];
    if (MODE && DIR) {
        VM_WAIT();
#pragma unroll
        for (int rg = 0; rg < 4; ++rg)
#pragma unroll
            for (int c2 = 0; c2 < 2; ++c2) { yn[c2][rg] = hf[(((T0 >> 2) * 4 + rg) * 2 + c2) * 64 + lane]; gn[c2][rg] = go[(size_t)(T0 + rg) * ZRW + 16 * c2]; } }
#pragma unroll 1
    for (int step = 0; step < NST; ++step) {
        const int t4 = T0 + DT * step;
        unsigned short yc[2][4], gc[2][4];
        if (MODE && DIR) {
#pragma unroll
            for (int rg = 0; rg < 4; ++rg)
#pragma unroll
                for (int c2 = 0; c2 < 2; ++c2) { yc[c2][rg] = yn[c2][rg]; gc[c2][rg] = gn[c2][rg]; }
            if (step + 1 < NST) {
#pragma unroll
                for (int rg = 0; rg < 4; ++rg)
#pragma unroll
                    for (int c2 = 0; c2 < 2; ++c2) { yn[c2][rg] = hf[((((t4 + DT) >> 2) * 4 + rg) * 2 + c2) * 64 + lane]; gn[c2][rg] = go[(size_t)(t4 + DT + rg) * ZRW + 16 * c2]; } } }
        const pg8::bf16x8 a0 = *(const LAS pg8::bf16x8*)(xa + t4 * 128), a1 = *(const LAS pg8::bf16x8*)(xa + t4 * 128 + 64);
        const pg8::bf16x8 ah = half ? a1 : a0;
        f32x4 pa[2], px[2], xd[2];
#pragma unroll
        for (int c2 = 0; c2 < 2; ++c2) { const f32x4 z4 = (f32x4){0.f, 0.f, 0.f, 0.f};
            pa[c2] = __builtin_amdgcn_mfma_f32_16x16x32_bf16(a0, wa[c2][0], z4, 0, 0, 0); pa[c2] = __builtin_amdgcn_mfma_f32_16x16x32_bf16(a1, wa[c2][1], pa[c2], 0, 0, 0);
            px[c2] = __builtin_amdgcn_mfma_f32_16x16x32_bf16(a0, wx[c2][0], z4, 0, 0, 0); px[c2] = __builtin_amdgcn_mfma_f32_16x16x32_bf16(a1, wx[c2][1], px[c2], 0, 0, 0);
            xd[c2] = __builtin_amdgcn_mfma_f32_16x16x32_bf16(ah, idn[c2], z4, 0, 0, 0); }
#pragma unroll
        for (int rr = 0; rr < 4; ++rr) { const int rg = DIR ? 3 - rr : rr;
#pragma unroll
            for (int c2 = 0; c2 < 2; ++c2) {
                const float r_ = frcp(1.f + __builtin_amdgcn_exp2f(__builtin_fmaf(pa[c2][rg], -1.4426950408889634f, ba[c2]))), i_ = frcp(1.f + __builtin_amdgcn_exp2f(__builtin_fmaf(px[c2][rg], -1.4426950408889634f, bx[c2])));
                const float av = __builtin_amdgcn_exp2f(ls8[c2] * r_), mult = fsqrt_(fmaxf(1.f - av * av, 0.f));
                h[c2] = av * h[c2] + mult * i_ * xd[c2][rg]; P[c2] *= av;
                if (MODE) {
                    if (DIR == 0) hf[(((t4 >> 2) * 4 + rg) * 2 + c2) * 64 + lane] = (bf16)f2bf(h[c2]);
                    else yo[(size_t)(t4 + rg) * DM + 16 * c2] = (bf16)f2bf((bf2f(yc[c2][rg]) + h[c2]) * gelu_tanh(bf2f(gc[c2][rg]))); } }
        }
    }
    if (!MODE) {
#pragma unroll
        for (int c2 = 0; c2 < 2; ++c2) { float* ag = agg + (((size_t)ch * 2 + DIR) * 512 + cch + 16 * c2) * 2; ag[0] = P[c2]; ag[1] = h[c2]; } }
}
__device__ __forceinline__ void lru_prepass(const Args& a, int l, int lane, int tok0, int nb, LAS unsigned char* xt) {
    const bf16* Z = (const bf16*)(a.ws + WS_ZR);
    int s0, T; seq_of(tok0, s0, T); const int s1 = s0 + T;
    const int oc = lane & 7, tg = lane >> 3, cbase = 64 * nb + 8 * oc; float cw[4][8], cbv[8];
    v4u x[19];
    const int tb = tok0 + 16 * tg - 2;
#pragma unroll
    for (int i = 0; i < 19; ++i) { const int tt = tb + i; x[i] = (v4u){0u, 0u, 0u, 0u}; if (tt >= s0 && tt < s1) x[i] = *(const v4u*)(Z + (size_t)tt * ZRW + RXR + cbase); }
#pragma unroll
    for (int tp = 0; tp < 4; ++tp) { const f32x4* wp = (const f32x4*)(a.in[I_CW] + ((size_t)l * 4 + tp) * 512 + cbase); const f32x4 w0 = wp[0], w1 = wp[1];
        cw[tp][0] = w0.x; cw[tp][1] = w0.y; cw[tp][2] = w0.z; cw[tp][3] = w0.w; cw[tp][4] = w1.x; cw[tp][5] = w1.y; cw[tp][6] = w1.z; cw[tp][7] = w1.w; }
    { const f32x4* bp = (const f32x4*)(a.in[I_CB] + (size_t)l * 512 + cbase); const f32x4 b0 = bp[0], b1 = bp[1]; cbv[0] = b0.x; cbv[1] = b0.y; cbv[2] = b0.z; cbv[3] = b0.w; cbv[4] = b1.x; cbv[5] = b1.y; cbv[6] = b1.z; cbv[7] = b1.w; }
    LDS_WAIT();
#pragma unroll
    for (int i = 0; i < 16; ++i) { float acc[8];
#pragma unroll
        for (int e = 0; e < 8; ++e) acc[e] = cbv[e];
#pragma unroll
        for (int tp = 0; tp < 4; ++tp) { const v4u xx = x[i + tp];
            acc[0] += cw[tp][0] * bflo(xx.x); acc[1] += cw[tp][1] * bfhi(xx.x); acc[2] += cw[tp][2] * bflo(xx.y); acc[3] += cw[tp][3] * bfhi(xx.y);
            acc[4] += cw[tp][4] * bflo(xx.z); acc[5] += cw[tp][5] * bfhi(xx.z); acc[6] += cw[tp][6] * bflo(xx.w); acc[7] += cw[tp][7] * bfhi(xx.w); }
        v4u o; o.x = pk2(acc[0], acc[1]); o.y = pk2(acc[2], acc[3]); o.z = pk2(acc[4], acc[5]); o.w = pk2(acc[6], acc[7]);
        *(LAS v4u*)(xt + (16 * tg + i) * 128 + oc * 16) = o; asm volatile("s_nop 1" ::: "memory"); }
    LDS_WAIT();
}
template <int MODE> __device__ __forceinline__ void ph_scan(const Args& a, const Frame& F, int l) {
    int tid = threadIdx.x; asm volatile("" : "+v"(tid)); int lane = tid & 63; (void)lane;
    LAS unsigned char* slab = F.lds + RING_OFF + F.wave * 16384;
    LAS int* ctr = (LAS int*)(F.lds + MISC_OFF + 64);
    __syncthreads(); if (tid == 0) *ctr = 0; __syncthreads();
    constexpr int NLU = (NLCH / 4) * 16, NSU = (NSCH / 4) * 32;
    const int l0 = (int)((long)NLU * F.vcu / F.G), l1 = (int)((long)NLU * (F.vcu + 1) / F.G), s0u = (int)((long)NSU * F.vcu / F.G), s1u = (int)((long)NSU * (F.vcu + 1) / F.G);
    const int nl = l1 - l0, ntot = nl + (s1u - s0u);
    for (;;) {
        int it = 0; if (lane == 0) it = __hip_atomic_fetch_add(ctr, 1, __ATOMIC_RELAXED, __HIP_MEMORY_SCOPE_WORKGROUP);
        it = __builtin_amdgcn_readfirstlane(it);
        if (it >= ntot) break;
        if (it < nl) { const int u = l0 + it, half = u & 1, nb = (u >> 1) & 7, cq = u >> 4, tok0 = cq * 4 * LCH;
            bf16* hf = (bf16*)(a.ws + WS_HF) + (size_t)u * 4096;
            lru_prepass(a, l, lane, tok0, nb, slab);
            lru_dir<MODE, 0>(a, l, lane, tok0, nb, half, slab, hf); lru_dir<MODE, 1>(a, l, lane, tok0, nb, half, slab, hf);
        } else { const int u = s0u + it - nl, gr = u & 31, cq = u >> 5, tok0 = cq * 4 * SCH;
            bf16* yf = (bf16*)(a.ws + WS_HF + 40 * MiB) + (size_t)u * 4096;
            s5_dir<MODE, 0>(a, l, lane, tok0, gr, slab, yf); s5_dir<MODE, 1>(a, l, lane, tok0, gr, slab, yf); }
    }
    LDS_WAIT();
}

__device__ __forceinline__ void ph_carries(const Args& a, const Frame& F, int l) {
    int tid = threadIdx.x; asm volatile("" : "+v"(tid)); int lane = tid & 63; (void)lane;
    constexpr int NL_LONG = 2 * 2 * 512 * (16384 / LCH / 16), NL_SHORT = 4 * 2 * 512 * (2048 / LCH / 16);
    constexpr int NS_LONG = 2 * 2 * 2048 * (16384 / SCH / 16), NS_SHORT = 4 * 2 * 2048 * (2048 / SCH / 16);
    constexpr int NITEM = NL_LONG + NL_SHORT + NS_LONG + NS_SHORT;
    static_assert(NL_LONG % 512 == 0 && NL_SHORT % 512 == 0 && NS_LONG % 512 == 0 && NS_SHORT % 512 == 0, "item classes are whole workgroups");
    for (int base = F.vcu * NTHR; base < NITEM; base += F.G * NTHR) {
        int it = base + tid;
        if (it < NL_LONG + NL_SHORT) {
            const bool lg = it < NL_LONG; if (!lg) it -= NL_LONG;
            const int W = lg ? (16384 / LCH / 16) : (2048 / LCH / 16); const int seg = it & (W - 1), chain = it / W;
            const int c = chain & 511, dir = (chain >> 9) & 1, sq = chain >> 10; const int s0 = lg ? 8192 + sq * 16384 : sq * 2048, T = lg ? 16384 : 2048; const int c0 = s0 / LCH, nc = T / LCH;
            const f32x2* agg = (const f32x2*)(a.ws + WS_LAGG); float* cin = (float*)(a.ws + WS_LCIN);
            f32x2 v[16]; float A = 1.f, B = 0.f;
#pragma unroll
            for (int j = 0; j < 16; ++j) { const int pos = seg * 16 + j, ch = c0 + (dir ? nc - 1 - pos : pos); v[j] = agg[((size_t)ch * 2 + dir) * 512 + c]; }
#pragma unroll
            for (int j = 0; j < 16; ++j) { B = v[j].x * B + v[j].y; A *= v[j].x; }
            for (int off = 1; off < W; off <<= 1) { const float Ap = __shfl_up(A, off, 64), Bp = __shfl_up(B, off, 64); if (seg >= off) { B = A * Bp + B; A = A * Ap; } }
            float carry = __shfl_up(B, 1, 64); if (seg == 0) carry = 0.f;
#pragma unroll
            for (int j = 0; j < 16; ++j) { const int pos = seg * 16 + j, ch = c0 + (dir ? nc - 1 - pos : pos); cin[((size_t)ch * 2 + dir) * 512 + c] = carry; carry = v[j].x * carry + v[j].y; }
        } else {
            it -= NL_LONG + NL_SHORT;
            const bool lg = it < NS_LONG; if (!lg) it -= NS_LONG;
            const int W = lg ? (16384 / SCH / 16) : (2048 / SCH / 16); const int seg = it & (W - 1), chain = it / W;
            const int p = chain & 63, g = (chain >> 6) & 31, dir = (chain >> 11) & 1, sq = chain >> 12; const int s0 = lg ? 8192 + sq * 16384 : sq * 2048, T = lg ? 16384 : 2048; const int c0 = s0 / SCH, nc = T / SCH;
            const float* TLB = (const float*)(a.ws + WS_TLB); const f32x2* E = (const f32x2*)(a.ws + WS_SEND); f32x2* CIN = (f32x2*)(a.ws + WS_SCIN);
            float pr = TLB[((size_t)(dir * 32 + g) * 64 + p) * 2], pi = TLB[((size_t)(dir * 32 + g) * 64 + p) * 2 + 1];
            static_assert(SCH == 64, "lb^SCH by 6 squarings");
#pragma unroll
            for (int i = 0; i < 6; ++i) { const float nr = pr * pr - pi * pi, ni = 2.f * pr * pi; pr = nr; pi = ni; }
            f32x2 v[16]; float Br = 0.f, Bi = 0.f;
#pragma unroll
            for (int j = 0; j < 16; ++j) { const int pos = seg * 16 + j, ch = c0 + (dir ? nc - 1 - pos : pos); v[j] = E[(((size_t)ch * 2 + dir) * 32 + g) * 64 + p]; }
#pragma unroll
            for (int j = 0; j < 16; ++j) { const float nr = pr * Br - pi * Bi + v[j].x, ni = pr * Bi + pi * Br + v[j].y; Br = nr; Bi = ni; }
            float Ar = pr, Ai = pi;
#pragma unroll
            for (int i = 0; i < 4; ++i) { const float nr = Ar * Ar - Ai * Ai, ni = 2.f * Ar * Ai; Ar = nr; Ai = ni; }
            for (int off = 1; off < W; off <<= 1) { const float Apr = __shfl_up(Ar, off, 64), Api = __shfl_up(Ai, off, 64), Bpr = __shfl_up(Br, off, 64), Bpi = __shfl_up(Bi, off, 64);
                if (seg >= off) { const float nbr = Ar * Bpr - Ai * Bpi + Br, nbi = Ar * Bpi + Ai * Bpr + Bi, nar = Ar * Apr - Ai * Api, nai = Ar * Api + Ai * Apr; Br = nbr; Bi = nbi; Ar = nar; Ai = nai; } }
            float cr = __shfl_up(Br, 1, 64), ci = __shfl_up(Bi, 1, 64); if (seg == 0) { cr = 0.f; ci = 0.f; }
#pragma unroll
            for (int j = 0; j < 16; ++j) { const int pos = seg * 16 + j, ch = c0 + (dir ? nc - 1 - pos : pos); CIN[(((size_t)ch * 2 + dir) * 32 + g) * 64 + p] = (f32x2){cr, ci};
                const float nr = pr * cr - pi * ci + v[j].x, ni = pr * ci + pi * cr + v[j].y; cr = nr; ci = ni; }
        }
    }
}

__device__ __forceinline__ void ph_groupnorm(const Args& a, const Frame& F, int l, bf16* dst = nullptr) {
    int tid = threadIdx.x; asm volatile("" : "+v"(tid)); int lane = tid & 63; (void)lane;
    bf16* Y = (bf16*)(a.ws + WS_Y); const float* g = a.in[I_GOUT] + (size_t)l * DM;
    const int gw = F.vcu * NWAVES + F.wave, NGW = F.G * NWAVES;
    static_assert(NTOK % (256 * NWAVES * 4) == 0 || true, "");
    for (int m0 = gw; m0 < NTOK; m0 += 4 * NGW) {
        v4u w[4][4];
#pragma unroll
        for (int r = 0; r < 4; ++r) { const int m = m0 + r * NGW; const v4u* yr = (const v4u*)(Y + (size_t)(m < NTOK ? m : m0) * DM) + lane;
#pragma unroll
            for (int j = 0; j < 4; ++j) w[r][j] = yr[64 * j]; }
        f32x4 g0[4], g1[4];
#pragma unroll
        for (int j = 0; j < 4; ++j) { const f32x4* gp = (const f32x4*)(g + 8 * (lane + 64 * j)); g0[j] = gp[0]; g1[j] = gp[1]; }
#pragma unroll
        for (int r = 0; r < 4; ++r) { const int m = m0 + r * NGW; float ss[4];
#pragma unroll
            for (int j = 0; j < 4; ++j) { float sq = 0.f;
#pragma unroll
                for (int q = 0; q < 4; ++q) { const float lo = bflo(w[r][j][q]), hi = bfhi(w[r][j][q]); sq += lo * lo + hi * hi; }
                ss[j] = sq; }
            const float sa = wave_sum(ss[0] + ss[1]), sb = wave_sum(ss[2]), sc = wave_sum(ss[3]);
            const float ra = 1.f / sqrtf(sa * (1.f / 1024.f) + EPS), rb = 1.f / sqrtf(sb * (1.f / 512.f) + EPS), rc = 1.f / sqrtf(sc * (1.f / 512.f) + EPS);
            if (m < NTOK) {
                v4u* yo = (dst ? (v4u*)(dst + (size_t)m * DM) : (v4u*)(Y + (size_t)m * DM)) + lane;
#pragma unroll
                for (int j = 0; j < 4; ++j) { const float rr = j < 2 ? ra : (j == 2 ? rb : rc);
                    v4u o; o.x = pk2(bflo(w[r][j].x) * rr * g0[j].x, bfhi(w[r][j].x) * rr * g0[j].y); o.y = pk2(bflo(w[r][j].y) * rr * g0[j].z, bfhi(w[r][j].y) * rr * g0[j].w);
                    o.z = pk2(bflo(w[r][j].z) * rr * g1[j].x, bfhi(w[r][j].z) * rr * g1[j].y); o.w = pk2(bflo(w[r][j].w) * rr * g1[j].z, bfhi(w[r][j].w) * rr * g1[j].w);
                    yo[64 * j] = o; } } }
    }
}

__device__ __forceinline__ void ph_norm2(const Args& a, const Frame& F, int l) {
    int tid = threadIdx.x; asm volatile("" : "+v"(tid)); int lane = tid & 63; (void)lane;
    const int gw = F.vcu * NWAVES + F.wave, NGW = F.G * NWAVES; const float* g = a.in[I_NLG] + (size_t)l * DM; bf16* H = (bf16*)(a.ws + WS_H);
    for (int m = gw; m < NTOK; m += NGW) norm_row_bf16(a.out + (size_t)m * DM, g, H + (size_t)m * DM, lane);
}
__device__ __forceinline__ void ph_final(const Args& a, const Frame& F, float* dst = nullptr) {
    int tid = threadIdx.x; asm volatile("" : "+v"(tid)); int lane = tid & 63; (void)lane;
    const int gw = F.vcu * NWAVES + F.wave, NGW = F.G * NWAVES; const f32x4* gr = (const f32x4*)a.in[I_FING] + lane;
    for (int m0 = gw; m0 < NTOK; m0 += 2 * NGW) {
        f32x4 v[2][8];
#pragma unroll
        for (int r = 0; r < 2; ++r) { const int m = m0 + r * NGW; const f32x4* xr = (const f32x4*)(a.out + (size_t)(m < NTOK ? m : m0) * DM) + lane;
#pragma unroll
            for (int j = 0; j < 8; ++j) v[r][j] = xr[64 * j]; }
#pragma unroll
        for (int r = 0; r < 2; ++r) { const int m = m0 + r * NGW; float sq = 0.f;
#pragma unroll
            for (int j = 0; j < 8; ++j) sq += (v[r][j].x * v[r][j].x + v[r][j].y * v[r][j].y) + (v[r][j].z * v[r][j].z + v[r][j].w * v[r][j].w);
            const float rstd = 1.f / sqrtf(wave_sum(sq) * (1.f / DM) + EPS);
            if (m < NTOK) { f32x4* xo = (dst ? (f32x4*)(dst + (size_t)m * DM) : (f32x4*)(a.out + (size_t)m * DM)) + lane;
#pragma unroll
                for (int j = 0; j < 8; ++j) xo[64 * j] = v[r][j] * rstd * gr[64 * j]; } }
    }
}

__global__ void __launch_bounds__(NTHR, 2) mk_fwd(Args args) {
    extern __shared__ __attribute__((aligned(16))) unsigned char lds[];
    Frame F; F.lds = (LAS unsigned char*)lds; F.ldsg = lds;
    F.tid = threadIdx.x; F.lane = F.tid & 63; F.wave = __builtin_amdgcn_readfirstlane(F.tid >> 6);
    F.G = gridDim.x; { const int bx = blockIdx.x; F.vcu = (F.G % 8 == 0) ? (bx % 8) * (F.G / 8) + bx / 8 : bx; }
    volatile LAS unsigned* MISC = (volatile LAS unsigned*)(F.lds + MISC_OFF);
    for (int u = F.tid; u < (LDS_BYTES - LDSCTL_OFF) / 4; u += NTHR) ((LAS unsigned*)(F.lds + LDSCTL_OFF))[u] = 0u;
    __syncthreads();
    unsigned char* ws = args.ws;
    XcdBarrier bar; bar.bar = (unsigned*)(ws + WS_CTL) + CW_BAR; bar.x = 0; bar.st = nullptr;
#if MK_ONE_LAUNCH
    bar = xcd_barrier_post((unsigned*)(ws + WS_CTL) + CW_BAR, MISC + 8);
#endif
    const int lo = args.ph_lo, hi = args.ph_hi;
#define IN(k) (lo <= (k) && (k) < hi)
#if MK_ONE_LAUNCH
#if PROBE_BAR2
#define SEAM(k) do { if (IN(k) && IN((k) + 1)) { xcd_barrier(bar); xcd_barrier(bar); } } while (0)
#else
#define SEAM(k) do { if (IN(k) && IN((k) + 1)) xcd_barrier(bar); } while (0)
#endif
#else
#define SEAM(k) do { } while (0)
#endif
    for (int l = 0; l < DEPTH; ++l) {
        const int pb = l * PH_PER_LAYER;
        if (IN(pb + 0)) { ph_prologue(args, F, l);
#if PROBE_PRO2
            __syncthreads(); ph_prologue(args, F, l);
#endif
        } SEAM(pb + 0);
        if (IN(pb + 1)) {
            pg8::Gemm g{(const bf16*)(ws + WS_H), (const bf16*)(ws + WS_WIN), NTOK, ZW, DM}; pg8::StaticOrder S; S.init(NTOK, ZW, F.G, (int)blockIdx.x);
            pg8::EpiBf16<2> E{(bf16*)(ws + WS_Z), NTOK, (const unsigned long long*)(ws + WS_SSQ) + (size_t)(l * 2) * NTOK, (LAS float*)(F.lds + XTRA_OFF)};
            pg8::gemm_phase<pg8::EpiBf16<2>, pg8::StaticOrder, true, true>(F.lds + RING_OFF, g, S, E);
#if PROBE_WIN2
            pg8::gemm_phase<pg8::EpiBf16<2>, pg8::StaticOrder, true, true>(F.lds + RING_OFF, g, S, E);
#endif
        } SEAM(pb + 1);
        if (IN(pb + 2)) { ph_na_mfma(args, F, l); ph_scan<0>(args, F, l);
#if PROBE_NA2
            __syncthreads(); ph_na_mfma(args, F, l);
#endif
#if PROBE_SCAN2
            ph_scan<0>(args, F, l);
#endif
        } SEAM(pb + 2);
        if (IN(pb + 3)) { ph_carries(args, F, l);
#if PROBE_SCAN2 || PROBE_CAR2
            ph_carries(args, F, l);
#endif
        } SEAM(pb + 3);
        if (IN(pb + 4)) { ph_scan<1>(args, F, l);
#if PROBE_SCAN2
            ph_scan<1>(args, F, l);
#endif
        } SEAM(pb + 4);
        if (IN(pb + 5)) {
            __syncthreads();
            pg8::Gemm g{(const bf16*)(ws + WS_YG), (const bf16*)(ws + WS_WGLU), NTOK, 512, 512}; pg8::StaticOrder S; S.init(NTOK, 512, F.G, (int)blockIdx.x);
            pg8::EpiGlu E{(const bf16*)(ws + WS_YG), (bf16*)(ws + WS_Y), args.in[I_BGLU] + (size_t)l * 512, DM, 1536};
            pg8::gemm_phase<pg8::EpiGlu, pg8::StaticOrder, true, true>(F.lds + RING_OFF, g, S, E);
#if PROBE_GLU2
            pg8::gemm_phase<pg8::EpiGlu, pg8::StaticOrder, true, true>(F.lds + RING_OFF, g, S, E);
#endif
        } SEAM(pb + 5);
        if (IN(pb + 6)) {
#if PROBE_GN2
            ph_groupnorm(args, F, l, (bf16*)(ws + WS_Z));
#endif
            ph_groupnorm(args, F, l); } SEAM(pb + 6);
        if (IN(pb + 7)) {
            pg8::Gemm g{(const bf16*)(ws + WS_Y), (const bf16*)(ws + WS_WOUT), NTOK, DM, DM}; pg8::StaticOrder S; S.init(NTOK, DM, F.G, (int)blockIdx.x);
#if PROBE_WOUT2
            { pg8::EpiResid E2{l == 0 ? args.in[I_XP] : nullptr, l == 0 ? args.in[I_XS] : nullptr, 8192, (float*)(ws + WS_Z), DM, (bf16*)(ws + WS_H), nullptr};
              pg8::gemm_phase<pg8::EpiResid, pg8::StaticOrder, true, true>(F.lds + RING_OFF, g, S, E2); }
#endif
            pg8::EpiResid E{l == 0 ? args.in[I_XP] : nullptr, l == 0 ? args.in[I_XS] : nullptr, 8192, nullptr, DM, (bf16*)(ws + WS_H), (unsigned long long*)(ws + WS_SSQ) + (size_t)(l * 2 + 1) * NTOK};
            pg8::gemm_phase<pg8::EpiResid, pg8::StaticOrder, true, true>(F.lds + RING_OFF, g, S, E);
        } SEAM(pb + 7);
        for (int s = 0; s <= NMLPC; ++s) {
            if (IN(pb + 8 + s)) {
                if (s > 0) {
                    const int c = s - 1;
                    pg8::Gemm g{(const bf16*)(ws + WS_Z + (size_t)(c & 1) * 128 * MiB), (const bf16*)(ws + WS_WDN), MLPC, DM, DFF}; pg8::StaticOrder S; S.init(MLPC, DM, F.G, (int)blockIdx.x);
                    pg8::EpiResid E{nullptr, nullptr, 1 << 30, l + 1 < DEPTH ? nullptr : args.out + (size_t)c * MLPC * DM, DM,
                                    (bf16*)(ws + WS_H) + (size_t)c * MLPC * DM, (unsigned long long*)(ws + WS_SSQ) + (size_t)((l + 1 < DEPTH ? l + 1 : 0) * 2) * NTOK + (size_t)c * MLPC};
#if PROBE_DN2
                    { pg8::EpiResid E2{nullptr, nullptr, 1 << 30, (float*)(ws + WS_Z + 256 * MiB), DM, (bf16*)(ws + WS_H) + (size_t)c * MLPC * DM, nullptr};
                      pg8::gemm_phase<pg8::EpiResid, pg8::StaticOrder, true, true>(F.lds + RING_OFF, g, S, E2); }
#endif
                    pg8::gemm_phase<pg8::EpiResid, pg8::StaticOrder, true, true>(F.lds + RING_OFF, g, S, E);
                }
                if (s < NMLPC) {
                    const int c = s;
                    pg8::Gemm g{(const bf16*)(ws + WS_H) + (size_t)c * MLPC * DM, (const bf16*)(ws + WS_WUP), MLPC, DFF, DM}; pg8::StaticOrder S; S.init(MLPC, DFF, F.G, (int)blockIdx.x);
                    pg8::EpiBf16<1> E{(bf16*)(ws + WS_Z + (size_t)(c & 1) * 128 * MiB), DFF, (const unsigned long long*)(ws + WS_SSQ) + (size_t)(l * 2 + 1) * NTOK + (size_t)c * MLPC, (LAS float*)(F.lds + XTRA_OFF)};
                    pg8::gemm_phase<pg8::EpiBf16<1>, pg8::StaticOrder, true, true>(F.lds + RING_OFF, g, S, E);
#if PROBE_UP2
                    pg8::gemm_phase<pg8::EpiBf16<1>, pg8::StaticOrder, true, true>(F.lds + RING_OFF, g, S, E);
#endif
                }
            } SEAM(pb + 8 + s);
        }
    }
    if (IN(NPHASE - 1)) {
#if PROBE_FIN2
        ph_final(args, F, (float*)(ws + WS_Z));
#endif
        ph_final(args, F); }
#undef IN
#undef SEAM
}

extern "C" void kernel_launch(void* const* d_in, const int* in_sizes, int n_in, void* d_out, int out_size, void* d_ws, size_t ws_size, hipStream_t stream) {
    static int grid = 0;
    if (grid == 0) {
        if (n_in != 28 || out_size != NTOK * DM || ws_size < WS_END) { fprintf(stderr, "kernel_launch: unexpected shapes (n_in %d out %d ws %zu)\n", n_in, out_size, ws_size); grid = -1; return; }
        int dev = 0, cus = 0, per_cu = 0;
        if (hipGetDevice(&dev) != hipSuccess || hipDeviceGetAttribute(&cus, hipDeviceAttributeMultiprocessorCount, dev) != hipSuccess) { grid = -1; return; }
        if (hipFuncSetAttribute((const void*)mk_fwd, hipFuncAttributeMaxDynamicSharedMemorySize, LDS_BYTES) != hipSuccess) { fprintf(stderr, "kernel_launch: hipFuncSetAttribute failed\n"); grid = -1; return; }
        if (hipOccupancyMaxActiveBlocksPerMultiprocessor(&per_cu, (const void*)mk_fwd, NTHR, LDS_BYTES) != hipSuccess || per_cu < 1) fprintf(stderr, "kernel_launch: occupancy query says %d\n", per_cu);
        (void)hipGetLastError();
        grid = cus;
    }
    if (grid < 0) return;
    if (hipMemsetAsync((char*)d_ws + WS_CTL, 0, CTL_ZERO_BYTES, stream) != hipSuccess) return;
    if (hipMemsetAsync((char*)d_ws + WS_SSQ, 0, SSQ_BYTES, stream) != hipSuccess) return;
    Args a{};
    for (int i = 0; i < 28; ++i) a.in[i] = (const float*)d_in[i];
    a.out = (float*)d_out; a.ws = (unsigned char*)d_ws;
#if MK_ONE_LAUNCH
    a.ph_lo = 0; a.ph_hi = NPHASE;
    hipLaunchKernelGGL(mk_fwd, dim3(grid), dim3(NTHR), LDS_BYTES, stream, a);
#else
    for (int ph = 0; ph < NPHASE; ++ph) { a.ph_lo = ph; a.ph_hi = ph + 1; hipLaunchKernelGGL(mk_fwd, dim3(grid), dim3(NTHR), LDS_BYTES, stream, a); }
#endif
}
```

```cpp
#include <hip/hip_runtime.h>
#include <cstdio>
#include <cstdint>
namespace pg8 {
#define PG8_LAS __attribute__((address_space(3)))
typedef unsigned short bf16_t;
typedef short bf16x8 __attribute__((ext_vector_type(8)));
typedef float f32x4 __attribute__((ext_vector_type(4)));
typedef unsigned u32x4 __attribute__((ext_vector_type(4)));
constexpr int BM = 256, BK = 64, HALF = 128, HTB = HALF * BK * 2  , STAGE_BYTES = 8 * HTB, NXCD = 8, WGM = 8;

__host__ __device__ __forceinline__ int lds_byte(int r, int c) { const int st = (r >> 4) * 2 + (c >> 5), rr = r & 15, cc = c & 31, ob = rr * 64 + cc * 2; return st * 1024 + (ob ^ (((ob >> 9) & 1) << 5)); }
__host__ __device__ __forceinline__ void stage_rc(int b, int& R, int& C) { const int st = b / 1024, sb = b % 1024, swz = sb ^ (((sb >> 9) & 1) << 5); R = (st >> 1) * 16 + swz / 64; C = (st & 1) * 32 + (swz % 64) / 2; }
__host__ __device__ __forceinline__ int perm32(int rho) { const int n = rho >> 4, i = rho & 15; return 8 * (i >> 2) + 4 * n + (i & 3); }

struct Unit { int pm, pn; };
struct Gemm { const bf16_t* A; const bf16_t* Bt; int M, N, K; };

struct StaticOrder {
    int nM, nN, nwg, G, c;
    __host__ __device__ void init(int M, int N, int G_, int c_) { nM = M / BM; nN = N / BM; nwg = nM * nN; G = G_; c = c_; }
    __host__ __device__ bool next(int i, Unit& u) const {
        const long L = (long)i * G + c; if (L >= nwg) return false;
        int wgid = (int)L; { const int q = nwg / NXCD, r = nwg % NXCD, xcd = wgid % NXCD, off = wgid / NXCD; wgid = (xcd < r ? xcd * (q + 1) : r * (q + 1) + (xcd - r) * q) + off; }
        const int nig = WGM * nN, gid = wgid / nig, fm = gid * WGM, gsz = (nM - fm) < WGM ? (nM - fm) : WGM;
        u.pm = fm + ((wgid % nig) % gsz); u.pn = (wgid % nig) / gsz; return true;
    }
    __device__ __forceinline__ void a_ready(const Unit&) const {}
    __device__ __forceinline__ void done(const Unit&) const {}
};
__device__ __forceinline__ unsigned cvt_pk_bf16(float lo, float hi) { unsigned r; asm volatile("v_cvt_pk_bf16_f32 %0, %1, %2" : "=v"(r) : "v"(lo), "v"(hi)); return r; }
template <int ACT> struct EpiBf16 {
    static constexpr bool PERM = true, AFTER_DRAIN = false, HAS_PRE = true;
    bf16_t* O; int ldc; const unsigned long long* SS; PG8_LAS float* tbl;
    template <class Sched> __device__ __forceinline__ void pre_all(const Sched& S, int tid) const {
        unsigned long long v[12]; Unit u;
#pragma unroll
        for (int i = 0; i < 12; ++i) { v[i] = 0ull; if (S.next(i, u)) v[i] = SS[u.pm * BM + (tid & 255)]; }
#pragma unroll
        for (int i = 0; i < 12; ++i) if (tid < 256 && S.next(i, u)) tbl[i * 256 + tid] = 1.f / sqrtf((float)v[i] * (1.f / 1048576.f / 2048.f) + 1e-6f);
    }
    __device__ __forceinline__ void operator()(const f32x4 (&acc)[2][2][4][2], const Unit& u, int wr, int wc, int fr, int fq, int slot) const {
        const int row0 = u.pm * BM + wr * 64 + fr; const int col0 = u.pn * BM + wc * 64 + 8 * fq;
        const unsigned ta = (unsigned)(size_t)(tbl + slot * 256 + wr * 64 + fr);
        float rs[2][4];
#pragma unroll
        for (int ai = 0; ai < 2; ++ai)
#pragma unroll
            for (int m = 0; m < 4; ++m) asm volatile("ds_read_b32 %0, %1 offset:%2" : "=v"(rs[ai][m]) : "v"(ta), "i"((ai * HALF + m * 16) * 4));
        asm volatile("s_waitcnt lgkmcnt(0)" : "+v"(rs[0][0]), "+v"(rs[0][1]), "+v"(rs[0][2]), "+v"(rs[0][3]), "+v"(rs[1][0]), "+v"(rs[1][1]), "+v"(rs[1][2]), "+v"(rs[1][3]));
#pragma unroll
        for (int ai = 0; ai < 2; ++ai)
#pragma unroll
            for (int m = 0; m < 4; ++m) { bf16_t* rowp = O + (size_t)(row0 + ai * HALF + m * 16) * ldc + col0; const float r = rs[ai][m];
                if (ACT == 2) {
                    const size_t row = (size_t)(row0 + ai * HALF + m * 16);
                    rowp = (u.pn < 12) ? O + ((size_t)((u.pn >> 2) * 16 + (u.pn & 3) * 4 + wc) * ldc + row) * 64 + 8 * fq
                                       : O + (size_t)48 * ldc * 64 + row * 1536 + (u.pn - 12) * 256 + wc * 64 + 8 * fq; }
#pragma unroll
                for (int bj = 0; bj < 2; ++bj) { f32x4 v0 = acc[ai][bj][m][0] * r, v1 = acc[ai][bj][m][1] * r;
                    if (ACT == 1) {
#pragma unroll
                        for (int j = 0; j < 4; ++j) { const float a = fmaxf(v0[j], 0.f), b = fmaxf(v1[j], 0.f); v0[j] = a * a; v1[j] = b * b; } }
                    u32x4 w; w.x = cvt_pk_bf16(v0[0], v0[1]); w.y = cvt_pk_bf16(v0[2], v0[3]); w.z = cvt_pk_bf16(v1[0], v1[1]); w.w = cvt_pk_bf16(v1[2], v1[3]);
                    *(u32x4*)(rowp + bj * 32) = w; } }
    }
};
struct EpiResid {
    static constexpr bool PERM = true, AFTER_DRAIN = false, HAS_PRE = false;
    const float* Xin0; const float* Xin1; int split; float* Xout; int ldc; bf16_t* XB; unsigned long long* SS;
    __device__ __forceinline__ void operator()(const f32x4 (&acc)[2][2][4][2], const Unit& u, int wr, int wc, int fr, int fq, int) const {
        const int row0 = u.pm * BM + wr * 64 + fr, col0 = u.pn * BM + wc * 64 + 8 * fq;
        const float* Xin = (u.pm * BM < split) ? Xin0 : Xin1 - (size_t)split * ldc;
#pragma unroll
        for (int am = 0; am < 4; ++am) { const int ai = am >> 1, m0 = (am & 1) * 2;
            f32x4 xf[2][2][2]; u32x4 xr[2][2];
            if (Xin0) {
#pragma unroll
                for (int mm = 0; mm < 2; ++mm) { const size_t ro = (size_t)(row0 + ai * HALF + (m0 + mm) * 16) * ldc + col0;
#pragma unroll
                    for (int bj = 0; bj < 2; ++bj) { xf[mm][bj][0] = *(const f32x4*)(Xin + ro + bj * 32); xf[mm][bj][1] = *(const f32x4*)(Xin + ro + bj * 32 + 4); } }
            } else {
#pragma unroll
                for (int mm = 0; mm < 2; ++mm)
#pragma unroll
                    for (int bj = 0; bj < 2; ++bj) xr[mm][bj] = *(const u32x4*)(XB + (size_t)(row0 + ai * HALF + (m0 + mm) * 16) * ldc + col0 + bj * 32);
            }
            asm volatile("" ::: "memory");
#pragma unroll
            for (int mm = 0; mm < 2; ++mm) { const int m = m0 + mm; const int row = row0 + ai * HALF + m * 16; const size_t ro = (size_t)row * ldc + col0; float ss = 0.f;
#pragma unroll
                for (int bj = 0; bj < 2; ++bj) { f32x4 x0, x1;
                    if (Xin0) { x0 = xf[mm][bj][0]; x1 = xf[mm][bj][1]; }
                    else { const u32x4 w = xr[mm][bj];
                        x0 = (f32x4){__uint_as_float(w.x << 16), __uint_as_float(w.x & 0xffff0000u), __uint_as_float(w.y << 16), __uint_as_float(w.y & 0xffff0000u)};
                        x1 = (f32x4){__uint_as_float(w.z << 16), __uint_as_float(w.z & 0xffff0000u), __uint_as_float(w.w << 16), __uint_as_float(w.w & 0xffff0000u)}; }
                    x0 = x0 + acc[ai][bj][m][0]; x1 = x1 + acc[ai][bj][m][1];
                    if (Xout) { *(f32x4*)(Xout + ro + bj * 32) = x0; *(f32x4*)(Xout + ro + bj * 32 + 4) = x1; }
                    else { u32x4 w; w.x = cvt_pk_bf16(x0[0], x0[1]); w.y = cvt_pk_bf16(x0[2], x0[3]); w.z = cvt_pk_bf16(x1[0], x1[1]); w.w = cvt_pk_bf16(x1[2], x1[3]); *(u32x4*)(XB + ro + bj * 32) = w;
#pragma unroll
                        for (int j = 0; j < 4; ++j) { const float lo = __uint_as_float(w[j] << 16), hi = __uint_as_float(w[j] & 0xffff0000u); ss += lo * lo + hi * hi; } } }
                if (!Xout) { ss += __shfl_xor(ss, 16); ss += __shfl_xor(ss, 32); if (fq == 0) atomicAdd(SS + row, (unsigned long long)(ss * 1048576.f + 0.5f)); } }
            asm volatile("" ::: "memory");
        }
    }
};
struct EpiGlu {
    static constexpr bool PERM = true, AFTER_DRAIN = false, HAS_PRE = false;
    const bf16_t* YG; bf16_t* Y; const float* bias; int ldy; int ycol0;
    __device__ __forceinline__ void operator()(const f32x4 (&acc)[2][2][4][2], const Unit& u, int wr, int wc, int fr, int fq, int) const {
        const int row0 = u.pm * BM + wr * 64 + fr; const int col0 = u.pn * BM + wc * 64 + 8 * fq;
        f32x4 bb[2][2];
#pragma unroll
        for (int bj = 0; bj < 2; ++bj) { bb[bj][0] = *(const f32x4*)(bias + col0 + bj * 32); bb[bj][1] = *(const f32x4*)(bias + col0 + bj * 32 + 4); }
#pragma unroll
        for (int ai = 0; ai < 2; ++ai) {
            u32x4 gl[4][2];
#pragma unroll
            for (int m = 0; m < 4; ++m)
#pragma unroll
                for (int bj = 0; bj < 2; ++bj) gl[m][bj] = *(const u32x4*)(YG + (size_t)(row0 + ai * HALF + m * 16) * 512 + col0 + bj * 32);
            asm volatile("" ::: "memory");
#pragma unroll
            for (int m = 0; m < 4; ++m) { const int row = row0 + ai * HALF + m * 16;
#pragma unroll
                for (int bj = 0; bj < 2; ++bj) { const int col = col0 + bj * 32; const u32x4 g = gl[m][bj];
                    const f32x4 v0 = acc[ai][bj][m][0] + bb[bj][0], v1 = acc[ai][bj][m][1] + bb[bj][1];
                    float o[8];
#pragma unroll
                    for (int j = 0; j < 4; ++j) { const unsigned gw0 = g[j >> 1], gw1 = g[2 + (j >> 1)];
                        const float y0 = __uint_as_float((j & 1) ? (gw0 & 0xffff0000u) : (gw0 << 16)), y1 = __uint_as_float((j & 1) ? (gw1 & 0xffff0000u) : (gw1 << 16));
                        o[j] = y0 * __builtin_amdgcn_rcpf(1.f + __expf(-v0[j])); o[4 + j] = y1 * __builtin_amdgcn_rcpf(1.f + __expf(-v1[j])); }
                    u32x4 w; w.x = cvt_pk_bf16(o[0], o[1]); w.y = cvt_pk_bf16(o[2], o[3]); w.z = cvt_pk_bf16(o[4], o[5]); w.w = cvt_pk_bf16(o[6], o[7]);
                    *(u32x4*)(Y + (size_t)row * ldy + ycol0 + col) = w; } }
            asm volatile("" ::: "memory");
        }
    }
};

template <class Epi, class Sched, bool ALIGN_EPI = false, bool SP2 = false>
__device__ __forceinline__ void gemm_phase(PG8_LAS unsigned char* lds, const Gemm g, const Sched& S, const Epi& E) {
    int tid_ = threadIdx.x; asm volatile("" : "+v"(tid_));
    const int tid = tid_, wid = __builtin_amdgcn_readfirstlane(tid >> 6), lane = tid & 63, wr = wid >> 2, wc = wid & 3, fr = lane & 15, fq = lane >> 4;
    const int K = g.K, nt = K / BK;
    unsigned voffA[2], voffB[2];
#pragma unroll
    for (int i = 0; i < 2; ++i) { int R, C; stage_rc(tid * 16 + i * 8192, R, C); const int Rb = Epi::PERM ? (64 * (R >> 5) + perm32(R & 31)) : R;
        voffA[i] = (unsigned)(R * K + C) * 2u; voffB[i] = (unsigned)(Rb * K + C) * 2u; }
    const size_t kstep = (size_t)(BK * 2);
    const size_t hstep = (size_t)HALF * K * 2;
    const size_t hstepB = Epi::PERM ? (size_t)32 * K * 2 : hstep;
    const size_t tstep = 2 * hstep;
    const unsigned ldsw = (unsigned)wid * 1024u;
    const int aoff = lds_byte(wr * 64 + fr, fq * 8), boff = lds_byte(wc * 32 + fr, fq * 8);
#define PG8_SA(b, h) (((b) * 2 + (h)) * HTB)
#define PG8_SB(b, h) ((4 + (b) * 2 + (h)) * HTB)
#define PG8_STAGE(bufoff, gbase, voff) do { _Pragma("unroll") for (int _i = 0; _i < 2; ++_i) \
        __builtin_amdgcn_global_load_lds((const unsigned*)((const char*)(gbase) + (voff)[_i]), (PG8_LAS unsigned*)(lds + (bufoff) + ldsw + _i * 8192), 16, 0, 0); } while (0)
#define PG8_LDA(dst, b, h) do { _Pragma("unroll") for (int m = 0; m < 4; ++m) _Pragma("unroll") for (int k = 0; k < 2; ++k) dst[m][k] = *(const PG8_LAS bf16x8*)(lds + PG8_SA(b, h) + aoff + m * 2048 + k * 1024); } while (0)
#define PG8_LDB(dst, b, h) do { _Pragma("unroll") for (int n = 0; n < 2; ++n) _Pragma("unroll") for (int k = 0; k < 2; ++k) dst[n][k] = *(const PG8_LAS bf16x8*)(lds + PG8_SB(b, h) + boff + n * 2048 + k * 1024); } while (0)
#define PG8_MMA(ai, bj, At, Bt) do { __builtin_amdgcn_s_setprio(1); _Pragma("unroll") for (int m = 0; m < 4; ++m) _Pragma("unroll") for (int n = 0; n < 2; ++n) _Pragma("unroll") for (int k = 0; k < 2; ++k) \
        acc[ai][bj][m][n] = __builtin_amdgcn_mfma_f32_16x16x32_bf16(Bt[n][k], At[m][k], acc[ai][bj][m][n], 0, 0, 0); __builtin_amdgcn_s_setprio(0); } while (0)
#define PG8_WAIT_V(n) asm volatile("s_waitcnt vmcnt(" #n ")" ::: "memory")
#define PG8_WAIT_L(n) asm volatile("s_waitcnt lgkmcnt(" #n ")" ::: "memory")
#define PG8_BAR __builtin_amdgcn_s_barrier()
#define PG8_SCHED __builtin_amdgcn_sched_barrier(0)
    Unit cur, nxt; int ui = 0;
    if (!S.next(0, cur)) return;
    if constexpr (Epi::HAS_PRE) E.pre_all(S, tid);
    f32x4 acc[2][2][4][2];
#pragma unroll
    for (int a = 0; a < 2; ++a)
#pragma unroll
        for (int b = 0; b < 2; ++b)
#pragma unroll
            for (int m = 0; m < 4; ++m)
#pragma unroll
                for (int n = 0; n < 2; ++n) acc[a][b][m][n] = (f32x4){0.f, 0.f, 0.f, 0.f};
    bf16x8 At[4][2], B0[2][2], B1[2][2];
    const char* cA = (const char*)g.A + (size_t)cur.pm * tstep; const char* cB = (const char*)g.Bt + (size_t)cur.pn * tstep;
    S.a_ready(cur);
    if constexpr (SP2) {
        PG8_STAGE(PG8_SB(0, 0), cB, voffB); PG8_STAGE(PG8_SB(0, 1), cB + hstepB, voffB); PG8_STAGE(PG8_SA(0, 0), cA, voffA); PG8_STAGE(PG8_SA(0, 1), cA + hstep, voffA);
        if (wr == 1) PG8_BAR;
        PG8_WAIT_V(2); PG8_BAR;
        PG8_STAGE(PG8_SB(1, 0), cB + kstep, voffB); PG8_STAGE(PG8_SA(1, 0), cA + kstep, voffA); PG8_STAGE(PG8_SB(1, 1), cB + hstepB + kstep, voffB);
        PG8_WAIT_V(6); PG8_BAR;
    } else {
        PG8_STAGE(PG8_SB(0, 0), cB, voffB); PG8_STAGE(PG8_SA(0, 0), cA, voffA); PG8_STAGE(PG8_SB(0, 1), cB + hstepB, voffB); PG8_STAGE(PG8_SA(0, 1), cA + hstep, voffA);
        if (wr == 1) PG8_BAR;
        PG8_WAIT_V(4); PG8_BAR;
        PG8_STAGE(PG8_SB(1, 0), cB + kstep, voffB); PG8_STAGE(PG8_SA(1, 0), cA + kstep, voffA); PG8_STAGE(PG8_SB(1, 1), cB + hstepB + kstep, voffB);
        PG8_WAIT_V(6); PG8_BAR;
    }
    for (;;) {
        const bool has_next = S.next(ui + 1, nxt);
        const char* nA = has_next ? (const char*)g.A + (size_t)nxt.pm * tstep : cA; const char* nB = has_next ? (const char*)g.Bt + (size_t)nxt.pn * tstep : cB;
        for (int t = 0; t < nt; t += 2) {
            const bool last = (t == nt - 2);
            const char* a1 = cA + (size_t)(t + 1) * kstep;
            const char* a2 = last ? nA : cA + (size_t)(t + 2) * kstep; const char* b2 = last ? nB : cB + (size_t)(t + 2) * kstep;
            const char* a3 = a2 + kstep; const char* b3 = b2 + kstep;
            if (last && has_next) S.a_ready(nxt);
            if constexpr (SP2) {
            PG8_LDB(B0, 0, 0); PG8_LDB(B1, 0, 1); PG8_SCHED; PG8_LDA(At, 0, 0); PG8_STAGE(PG8_SA(1, 1), a1 + hstep, voffA);
            PG8_WAIT_V(8); PG8_WAIT_L(0); PG8_BAR; PG8_MMA(0, 0, At, B0); PG8_MMA(0, 1, At, B1); PG8_BAR; PG8_SCHED;
            PG8_LDA(At, 0, 1); PG8_STAGE(PG8_SB(0, 0), b2, voffB); PG8_STAGE(PG8_SB(0, 1), b2 + hstepB, voffB); PG8_STAGE(PG8_SA(0, 0), a2, voffA);
            PG8_WAIT_V(8); PG8_WAIT_L(0); PG8_BAR; PG8_MMA(1, 0, At, B0); PG8_MMA(1, 1, At, B1); PG8_BAR; PG8_SCHED;
            PG8_LDB(B0, 1, 0); PG8_LDB(B1, 1, 1); PG8_SCHED; PG8_LDA(At, 1, 0); PG8_STAGE(PG8_SA(0, 1), a2 + hstep, voffA);
            PG8_WAIT_V(8); PG8_WAIT_L(0); PG8_BAR; PG8_MMA(0, 0, At, B0); PG8_MMA(0, 1, At, B1); PG8_BAR; PG8_SCHED;
            PG8_LDA(At, 1, 1); PG8_STAGE(PG8_SB(1, 0), b3, voffB); PG8_STAGE(PG8_SB(1, 1), b3 + hstepB, voffB); PG8_STAGE(PG8_SA(1, 0), a3, voffA);
            PG8_WAIT_V(8); PG8_WAIT_L(0); PG8_BAR; PG8_MMA(1, 0, At, B0); PG8_MMA(1, 1, At, B1); PG8_BAR; PG8_SCHED;
            } else {
            PG8_LDB(B0, 0, 0); PG8_SCHED; PG8_LDA(At, 0, 0); PG8_STAGE(PG8_SA(1, 1), a1 + hstep, voffA);
            PG8_WAIT_L(8); PG8_BAR; PG8_WAIT_L(0); PG8_MMA(0, 0, At, B0); PG8_BAR; PG8_SCHED;
            PG8_LDB(B1, 0, 1); PG8_STAGE(PG8_SB(0, 0), b2, voffB);
            PG8_BAR; PG8_WAIT_L(0); PG8_MMA(0, 1, At, B1); PG8_BAR;
            PG8_LDA(At, 0, 1); PG8_STAGE(PG8_SA(0, 0), a2, voffA);
            PG8_BAR; PG8_WAIT_L(0); PG8_MMA(1, 0, At, B0); PG8_BAR; PG8_SCHED;
            PG8_STAGE(PG8_SB(0, 1), b2 + hstepB, voffB);
            PG8_WAIT_V(6); PG8_BAR; PG8_MMA(1, 1, At, B1); PG8_BAR;
            PG8_LDB(B0, 1, 0); PG8_SCHED; PG8_LDA(At, 1, 0); PG8_STAGE(PG8_SA(0, 1), a2 + hstep, voffA);
            PG8_WAIT_L(8); PG8_BAR; PG8_WAIT_L(0); PG8_MMA(0, 0, At, B0); PG8_BAR; PG8_SCHED;
            PG8_LDB(B1, 1, 1); PG8_STAGE(PG8_SB(1, 0), b3, voffB);
            PG8_BAR; PG8_WAIT_L(0); PG8_MMA(0, 1, At, B1); PG8_BAR;
            PG8_LDA(At, 1, 1); PG8_STAGE(PG8_SA(1, 0), a3, voffA);
            PG8_BAR; PG8_WAIT_L(0); PG8_MMA(1, 0, At, B0); PG8_BAR; PG8_SCHED;
            PG8_STAGE(PG8_SB(1, 1), b3 + hstepB, voffB);
            PG8_WAIT_V(6); PG8_BAR; PG8_MMA(1, 1, At, B1); PG8_BAR;
            }
        }
        if constexpr (ALIGN_EPI) { if (wr == 0) PG8_BAR; }
        if constexpr (!Epi::AFTER_DRAIN) { E(acc, cur, wr, wc, fr, fq, ui); S.done(cur); }
        if (!has_next) break;
#pragma unroll
        for (int a = 0; a < 2; ++a)
#pragma unroll
            for (int b = 0; b < 2; ++b)
#pragma unroll
                for (int m = 0; m < 4; ++m)
#pragma unroll
                    for (int n = 0; n < 2; ++n) acc[a][b][m][n] = (f32x4){0.f, 0.f, 0.f, 0.f};
        cur = nxt; cA = nA; cB = nB; ++ui;
        if constexpr (ALIGN_EPI) { if (wr == 1) PG8_BAR; }
    }
    PG8_WAIT_V(0);
    if constexpr (!ALIGN_EPI) { if (wr == 0) PG8_BAR; }
    PG8_BAR;
    if constexpr (Epi::AFTER_DRAIN) { E.fused(acc, cur, wr, wc, fr, fq, lds, wid, lane); S.done(cur); }
#undef PG8_SA
#undef PG8_SB
#undef PG8_STAGE
#undef PG8_LDA
#undef PG8_LDB
#undef PG8_MMA
#undef PG8_WAIT_V
#undef PG8_WAIT_L
#undef PG8_BAR
#undef PG8_SCHED
}
}

#ifndef MK_ONE_LAUNCH
#define MK_ONE_LAUNCH 1
#endif
#ifndef PROBE_GN2
#define PROBE_GN2 0
#endif
#ifndef PROBE_FIN2
#define PROBE_FIN2 0
#endif
#ifndef PROBE_CAR2
#define PROBE_CAR2 0
#endif
#ifndef PROBE_BAR2
#define PROBE_BAR2 0
#endif
#ifndef PROBE_WIN2
#define PROBE_WIN2 0
#endif
#ifndef PROBE_GLU2
#define PROBE_GLU2 0
#endif
#ifndef PROBE_WOUT2
#define PROBE_WOUT2 0
#endif
#ifndef PROBE_DN2
#define PROBE_DN2 0
#endif
#ifndef PROBE_UP2
#define PROBE_UP2 0
#endif
#ifndef PROBE_PRO2
#define PROBE_PRO2 0
#endif
#ifndef PROBE_NA2
#define PROBE_NA2 0
#endif
#ifndef PROBE_SCAN2
#define PROBE_SCAN2 0
#endif
constexpr int NWAVES = 8, NTHR = 512;
constexpr int DM = 2048, NTOK = 40960, ZW = 4608, DFF = 8192, DEPTH = 4;
constexpr int ZK = 1024, ZV = 2048, ZXR = 3072, ZGT = 3584, ZXS = 4096;
constexpr int MLPC = 8192, NMLPC = NTOK / MLPC;
constexpr int LCH = 32, NLCH = NTOK / LCH;
constexpr int SCH = 64, NSCH = NTOK / SCH;
constexpr float EPS = 1e-6f;
constexpr int PH_PER_LAYER = 14, NPHASE = DEPTH * PH_PER_LAYER + 1;

constexpr size_t MiB = 1u << 20;
constexpr size_t WS_CTL = 0, CTL_ZERO_BYTES = 2 * MiB;
constexpr size_t WS_SS = 65536;
constexpr size_t WS_WIN = 2 * MiB, WS_WOUT = 20 * MiB, WS_WUP = 28 * MiB, WS_WDN = 60 * MiB, WS_WGLU = 92 * MiB;
constexpr size_t WS_TLB = 93 * MiB;
constexpr size_t WS_TBB = 93 * MiB + 65536;
constexpr size_t WS_H = 96 * MiB;
constexpr size_t WS_ZR = 256 * MiB + (size_t)48 * NTOK * 64 * 2;
constexpr int ZRW = 1536, RXR = 0, RGT = 512, RXS = 1024;
constexpr size_t WS_Z = 256 * MiB;
constexpr size_t WS_Y = 616 * MiB;
constexpr size_t WS_YG = 776 * MiB;
constexpr size_t WS_HF = 816 * MiB;
constexpr size_t WS_TBBF = 94 * MiB;
constexpr size_t WS_TCF = 94 * MiB + 524288;
constexpr size_t WS_TWF = 95 * MiB;
constexpr size_t WS_LAGG = 896 * MiB;
constexpr size_t WS_LCIN = 906 * MiB;
constexpr size_t WS_SEND = 912 * MiB;
constexpr size_t WS_SCIN = 932 * MiB;
constexpr size_t WS_SSQ = 952 * MiB, SSQ_BYTES = (size_t)DEPTH * 2 * NTOK * 8;
constexpr size_t WS_END = 956 * MiB;
constexpr int CW_BAR = 4096;

constexpr int RING_OFF = 0, RING_BYTES = 131072;
constexpr int XTRA_OFF = RING_BYTES, XTRA_BYTES = 12288;
constexpr int LDSCTL_OFF = 163840 - 1024, MISC_OFF = LDSCTL_OFF + 320;
constexpr int LDS_BYTES = 163840;
static_assert(MISC_OFF + 128 <= LDS_BYTES, "LDS map");

#define GAS __attribute__((address_space(1)))
#define LAS __attribute__((address_space(3)))
typedef unsigned short bf16;
typedef unsigned v4u __attribute__((ext_vector_type(4)));
typedef unsigned v2u __attribute__((ext_vector_type(2)));
typedef float f32x4 __attribute__((ext_vector_type(4)));
typedef float f32x2 __attribute__((ext_vector_type(2)));
#define LDS_WAIT() asm volatile("s_waitcnt lgkmcnt(0)" ::: "memory")
#define VM_WAIT() asm volatile("s_waitcnt vmcnt(0)" ::: "memory")
__device__ __forceinline__ unsigned f2bf(float f) { unsigned u = __builtin_bit_cast(unsigned, f); return (u + 0x7fffu + ((u >> 16) & 1u)) >> 16; }
typedef __bf16 bf16x2_t __attribute__((ext_vector_type(2)));
__device__ __forceinline__ unsigned pk2(float lo, float hi) { const f32x2 v = {lo, hi}; return __builtin_bit_cast(unsigned, __builtin_convertvector(v, bf16x2_t)); }
__device__ __forceinline__ unsigned pk2s(float lo, float hi) { return f2bf(lo) | (f2bf(hi) << 16); }
__device__ __forceinline__ float frcp(float x) { return __builtin_amdgcn_rcpf(x); }
__device__ __forceinline__ float fsqrt_(float x) { return __builtin_amdgcn_sqrtf(x); }
__device__ __forceinline__ float bf2f(unsigned b) { return __builtin_bit_cast(float, b << 16); }
__device__ __forceinline__ float bflo(unsigned w) { return __builtin_bit_cast(float, w << 16); }
__device__ __forceinline__ float bfhi(unsigned w) { return __builtin_bit_cast(float, w & 0xffff0000u); }
__device__ __forceinline__ float wave_sum(float v) {
#pragma unroll
    for (int o = 1; o < 64; o <<= 1) v += __shfl_xor(v, o);
    return v;
}
__device__ __forceinline__ float wave_max(float v) {
#pragma unroll
    for (int o = 1; o < 64; o <<= 1) v = fmaxf(v, __shfl_xor(v, o));
    return v;
}
__device__ __forceinline__ float sigmoidf_(float x) { return frcp(1.f + __expf(-x)); }
__device__ __forceinline__ float gelu_tanh(float x) { const float x2 = x * x; const float y2 = (2.302208198f * x) * __builtin_fmaf(0.044715f, x2, 1.f); const float e = __builtin_amdgcn_exp2f(y2); return x - x * frcp(e + 1.f); }
__device__ __forceinline__ void seq_of(int tok, int& s0, int& T) { if (tok < 8192) { s0 = tok & ~2047; T = 2048; } else { s0 = 8192 + ((tok - 8192) & ~16383); T = 16384; } }

#define XB_TMO      128
#define XB_XCNT(j)  (256  + 64 * (j))
#define XB_XSUB(j)  (1280 + 64 * (j))
#define XB_XGEN(j)  (2304 + 64 * (j))
#define XB_TOP      3328
#define XB_TOPGEN   3392
#define XCD_BAR_WORDS 3456
#define XB_SPIN_CAP (1u << 18)

__device__ __forceinline__ unsigned xb_ld(unsigned* p)              { return __hip_atomic_load(p, __ATOMIC_RELAXED, __HIP_MEMORY_SCOPE_AGENT); }
__device__ __forceinline__ unsigned xb_add(unsigned* p, unsigned v) { return __hip_atomic_fetch_add(p, v, __ATOMIC_RELAXED, __HIP_MEMORY_SCOPE_AGENT); }
__device__ __forceinline__ unsigned xb_xcc_id() { return (unsigned)__builtin_amdgcn_s_getreg((3 << 11) | 20) & 0xFu; }
#define XB_SPIN(cond, bar) do { unsigned _sp = 0; while (cond) { __builtin_amdgcn_s_sleep(1); \
    if ((++_sp & 255u) == 0u) { if (xb_ld(&(bar)[XB_TMO])) break; if (_sp > XB_SPIN_CAP) { atomicAdd(&(bar)[XB_TMO], 1u); break; } } } } while (0)

struct XcdBarrier {
    unsigned* bar; unsigned x;
    volatile LAS unsigned* st;
};

__device__ __forceinline__ XcdBarrier xcd_barrier_post(unsigned* bar, volatile LAS unsigned* st) {
    XcdBarrier b; b.bar = bar; b.x = xb_xcc_id(); b.st = st;
    if (threadIdx.x == 0) (void)xb_add(&bar[XB_XCNT(b.x)], 1u);
    return b;
}
__device__ __forceinline__ void xcd_barrier_complete(unsigned* bar, unsigned x, unsigned& nloc, unsigned& nx) {
    const unsigned G = gridDim.x * gridDim.y * gridDim.z;
    unsigned sum, cnt, mine, sp = 0u;
    for (;;) {
        sum = 0u; cnt = 0u; mine = 0u;
#pragma unroll
        for (unsigned j = 0; j < 16; ++j) { const unsigned c = xb_ld(&bar[XB_XCNT(j)]); sum += c; cnt += (c > 0u) ? 1u : 0u; mine = (j == x) ? c : mine; }
        if (sum == G) break;
        __builtin_amdgcn_s_sleep(1);
        if ((++sp & 255u) == 0u) { if (xb_ld(&bar[XB_TMO])) break; if (sp > XB_SPIN_CAP) { atomicAdd(&bar[XB_TMO], 1u); break; } }
    }
    nloc = mine > 0u ? mine : 1u; nx = cnt > 0u ? cnt : 1u;
}

__device__ __forceinline__ void xcd_barrier(const XcdBarrier& b) {
    asm volatile("s_waitcnt vmcnt(0)" ::: "memory");
    __syncthreads();
    if (threadIdx.x == 0) {
        unsigned* bar = b.bar;
        __builtin_amdgcn_s_waitcnt(0);
        unsigned nloc = b.st[0], nx = b.st[1];
        if (nloc == 0u) { xcd_barrier_complete(bar, b.x, nloc, nx); b.st[0] = nloc; b.st[1] = nx; }
        const unsigned old = xb_add(&bar[XB_XSUB(b.x)], 1u);
        const unsigned gen = old / nloc;
        if (old + 1u == (gen + 1u) * nloc) {
            __builtin_amdgcn_fence(__ATOMIC_RELEASE, "agent");
            asm volatile("s_waitcnt vmcnt(0)" ::: "memory");
            const unsigned og = xb_add(&bar[XB_TOP], 1u);
            const unsigned tg = og / nx;
            if (og + 1u == (tg + 1u) * nx) xb_add(&bar[XB_TOPGEN], 1u);
            else XB_SPIN(xb_ld(&bar[XB_TOPGEN]) == tg, bar);
            __builtin_amdgcn_fence(__ATOMIC_ACQUIRE, "agent");
            xb_add(&bar[XB_XGEN(b.x)], 1u);
            asm volatile("s_waitcnt vmcnt(0)" ::: "memory");
        } else {
            XB_SPIN(xb_ld(&bar[XB_XGEN(b.x)]) == gen, bar);
            __builtin_amdgcn_fence(__ATOMIC_ACQUIRE, "agent");
            asm volatile("s_waitcnt vmcnt(0)" ::: "memory");
        }
    }
    __syncthreads();
}


struct Args { const float* in[28]; float* out; unsigned char* ws; int ph_lo, ph_hi; };
struct Frame {
    LAS unsigned char* lds; unsigned char* ldsg;
    int tid, lane, wave, vcu, G;
};
enum { I_XP = 0, I_XS, I_NMG, I_WIN, I_RPB, I_CW, I_CB, I_LWA, I_LBA, I_LWX, I_LBX, I_LAM, I_ARE, I_AIM, I_LDT, I_BRE, I_BIM, I_CRE, I_CIM, I_SD, I_WGLU, I_BGLU, I_GOUT, I_WOUT, I_NLG, I_WUP, I_WDN, I_FING };

__device__ __forceinline__ void transpose_item(const float* W, int K, int N, bf16* WT, LAS float* scr, int item, int lane, const float* gk) {
    const int nblk = N / 32, kb = item / nblk, nb = item % nblk, k0 = 64 * kb, n0 = 32 * nb;
    float wv[32];
#pragma unroll
    for (int i = 0; i < 32; ++i) wv[i] = W[(size_t)(k0 + 2 * i + (lane >> 5)) * N + n0 + (lane & 31)];
    if (gk) {
#pragma unroll
        for (int i = 0; i < 32; ++i) wv[i] *= gk[k0 + 2 * i + (lane >> 5)]; }
#pragma unroll
    for (int i = 0; i < 32; ++i) scr[(2 * i + (lane >> 5)) * 33 + (lane & 31)] = wv[i];
    LDS_WAIT();
    const int c = lane & 7;
#pragma unroll
    for (int j = 0; j < 4; ++j) { const int n = (lane >> 3) + 8 * j; const LAS float* s = scr + (8 * c) * 33 + n;
        v4u o; o.x = pk2(s[0 * 33], s[1 * 33]); o.y = pk2(s[2 * 33], s[3 * 33]); o.z = pk2(s[4 * 33], s[5 * 33]); o.w = pk2(s[6 * 33], s[7 * 33]);
        *(v4u*)(WT + (size_t)(n0 + n) * K + k0 + 8 * c) = o; }
    LDS_WAIT();
}

__device__ __forceinline__ void xb_row(const float* xrow, bf16* orow, unsigned long long* ss, int lane) {
    const f32x4* xr = (const f32x4*)xrow + lane; f32x4 v[8]; float s = 0.f;
#pragma unroll
    for (int j = 0; j < 8; ++j) { v[j] = xr[64 * j]; s += (v[j].x * v[j].x + v[j].y * v[j].y) + (v[j].z * v[j].z + v[j].w * v[j].w); }
    s = wave_sum(s); if (lane == 0) *ss = (unsigned long long)(s * 1048576.f + 0.5f);
    v2u* o8 = (v2u*)orow + lane;
#pragma unroll
    for (int j = 0; j < 8; ++j) { v2u o; o.x = pk2(v[j].x, v[j].y); o.y = pk2(v[j].z, v[j].w); o8[64 * j] = o; }
}

__device__ __forceinline__ void norm_row_bf16(const float* xrow, const float* g, bf16* orow, int lane) {
    const f32x4* xr = (const f32x4*)xrow + lane; const f32x4* gr = (const f32x4*)g + lane;
    f32x4 v[8]; float s = 0.f;
#pragma unroll
    for (int j = 0; j < 8; ++j) { v[j] = xr[64 * j]; s += (v[j].x * v[j].x + v[j].y * v[j].y) + (v[j].z * v[j].z + v[j].w * v[j].w); }
    const float rstd = 1.f / sqrtf(wave_sum(s) * (1.f / DM) + EPS);
    v2u* o8 = (v2u*)orow + lane;
#pragma unroll
    for (int j = 0; j < 8; ++j) { const f32x4 gg = gr[64 * j]; v2u o; o.x = pk2(v[j].x * rstd * gg.x, v[j].y * rstd * gg.y); o.y = pk2(v[j].z * rstd * gg.z, v[j].w * rstd * gg.w); o8[64 * j] = o; }
}
__device__ __forceinline__ const float* x_row(const Args& a, int l, int row) {
    if (l == 0) return row < 8192 ? a.in[I_XP] + (size_t)row * DM : a.in[I_XS] + (size_t)(row - 8192) * DM;
    return a.out + (size_t)row * DM;
}

__device__ __forceinline__ void ph_prologue(const Args& a, const Frame& F, int l) {
    int tid = threadIdx.x; asm volatile("" : "+v"(tid)); int lane = tid & 63; (void)lane;
    LAS float* scr = (LAS float*)(F.lds + RING_OFF + F.wave * 16384);
    const int gw = F.vcu * NWAVES + F.wave, NGW = F.G * NWAVES;
    constexpr int I_IN = (DM / 64) * (ZW / 32), I_OUT = (DM / 64) * (DM / 32), I_UP = (DM / 64) * (DFF / 32), I_DN = (DFF / 64) * (DM / 32), I_GL = (512 / 64) * (512 / 32);
    constexpr int NITEMS = I_IN + I_OUT + I_UP + I_DN + I_GL;
    unsigned char* ws = a.ws;
    for (int it = gw; it < NITEMS; it += NGW) {
        int r = it;
        if (r < I_IN) { transpose_item(a.in[I_WIN] + (size_t)l * DM * ZW, DM, ZW, (bf16*)(ws + WS_WIN), scr, r, lane, a.in[I_NMG] + (size_t)l * DM); continue; } r -= I_IN;
        if (r < I_OUT) { transpose_item(a.in[I_WOUT] + (size_t)l * DM * DM, DM, DM, (bf16*)(ws + WS_WOUT), scr, r, lane, nullptr); continue; } r -= I_OUT;
        if (r < I_UP) { transpose_item(a.in[I_WUP] + (size_t)l * DM * DFF, DM, DFF, (bf16*)(ws + WS_WUP), scr, r, lane, a.in[I_NLG] + (size_t)l * DM); continue; } r -= I_UP;
        if (r < I_DN) { transpose_item(a.in[I_WDN] + (size_t)l * DFF * DM, DFF, DM, (bf16*)(ws + WS_WDN), scr, r, lane, nullptr); continue; } r -= I_DN;
        transpose_item(a.in[I_WGLU] + (size_t)l * 512 * 512, 512, 512, (bf16*)(ws + WS_WGLU), scr, r, lane, nullptr);
    }
    { const int gt = F.vcu * NTHR + tid;
      if (gt < 4096) {
        const int dir = gt >> 11, g = (gt >> 6) & 31, p = gt & 63; const size_t ix = ((size_t)(l * 2 + dir) * 32 + g) * 64 + p;
        const double are = (double)a.in[I_ARE][ix], aim = (double)a.in[I_AIM][ix]; const double ldt = (double)a.in[I_LDT][(l * 2 + dir) * 32 + g];
        double e = 1.0; { const double x8 = ldt * 0.125; for (int n = 20; n >= 1; --n) e = 1.0 + e * x8 / (double)n; e = e * e; e = e * e; e = e * e; }
        const double dt = e;
        double mag = 1.0; { const double x = are * dt; for (int n = 14; n >= 1; --n) mag = 1.0 + mag * x / (double)n; }
        const double th = aim * dt; const double kq = __builtin_rint(th * 0.15915494309189535); const double r = th - kq * 6.283185307179586476925;
        const double r2 = r * r; double c = 1.0, s = 1.0;
        for (int n = 15; n >= 1; --n) { c = 1.0 - c * r2 / (double)((2 * n - 1) * (2 * n)); s = 1.0 - s * r2 / (double)((2 * n) * (2 * n + 1)); }
        s *= r;
        const double lbr = mag * c, lbi = mag * s, den = are * are + aim * aim, nre = lbr - 1.0, nim = lbi;
        const double cor = (nre * are + nim * aim) / den, coi = (nim * are - nre * aim) / den;
        float* tlb = (float*)(ws + WS_TLB) + (size_t)gt * 2; tlb[0] = (float)lbr; tlb[1] = (float)lbi;
        float* tbb = (float*)(ws + WS_TBB) + (size_t)gt * 32; const float* bre = a.in[I_BRE] + ix * 16; const float* bim = a.in[I_BIM] + ix * 16;
        bf16* bbf = (bf16*)(ws + WS_TBBF);
        for (int h = 0; h < 16; ++h) { const double br = (double)bre[h], bi = (double)bim[h]; const float vr = (float)(cor * br - coi * bi), vi = (float)(cor * bi + coi * br); tbb[h] = vr; tbb[16 + h] = vi;
            const int n = p & 15, gk0 = h >> 3, j = h & 7;
            const unsigned hr = f2bf(vr), hi_ = f2bf(vi); const unsigned lr = f2bf(vr - bf2f(hr)), li = f2bf(vi - bf2f(hi_));
            const size_t fr = ((size_t)((dir * 32 + g) * 8 + (p >> 4)) * 64) * 8, fi = ((size_t)((dir * 32 + g) * 8 + 4 + (p >> 4)) * 64) * 8;
            bbf[fr + (size_t)(n + 16 * gk0) * 8 + j] = (bf16)hr; bbf[fr + (size_t)(n + 16 * (gk0 + 2)) * 8 + j] = (bf16)lr;
            bbf[fi + (size_t)(n + 16 * gk0) * 8 + j] = (bf16)hi_; bbf[fi + (size_t)(n + 16 * (gk0 + 2)) * 8 + j] = (bf16)li; }
      } else if (gt < 4096 + 16384) {
        const int e = gt - 4096, lane_ = e & 63, ks = (e >> 6) & 3, g = (e >> 8) & 31, dir = e >> 13; const int h = lane_ & 15, gk = lane_ >> 4;
        const float* cre = a.in[I_CRE] + (((size_t)(l * 2 + dir) * 32 + g) * 16 + h) * 64; const float* cim = a.in[I_CIM] + (((size_t)(l * 2 + dir) * 32 + g) * 16 + h) * 64;
        bf16* cf = (bf16*)(ws + WS_TCF) + (size_t)e * 8;
        for (int j = 0; j < 8; ++j) { const int P = 16 * (j >> 1) + 4 * ks + gk; cf[j] = (bf16)f2bf((j & 1) ? -cim[P] : cre[P]); }
      } else if (gt >= 20480 && gt < 20480 + 16384) {
        const int e = gt - 20480, lane_ = e & 63, ks = (e >> 6) & 1, cb = (e >> 7) & 3, mat = (e >> 9) & 1, nb = (e >> 10) & 7, dir = e >> 13; const int n = lane_ & 15, gk = lane_ >> 4;
        const float* W = a.in[mat ? I_LWX : I_LWA] + ((size_t)(l * 2 + dir) * 8 + nb) * 4096 + (size_t)(32 * ks + 8 * gk) * 64 + 16 * cb + n;
        bf16* wf = (bf16*)(ws + WS_TWF) + (size_t)e * 8;
        for (int j = 0; j < 8; ++j) wf[j] = (bf16)f2bf(W[j * 64]);
      } }
    if (l == 0) { bf16* XB = (bf16*)(ws + WS_H); unsigned long long* SS = (unsigned long long*)(ws + WS_SSQ);
        for (int m0 = gw; m0 < NTOK; m0 += 2 * NGW) {
            f32x4 v[2][8];
#pragma unroll
            for (int r = 0; r < 2; ++r) { const int m = m0 + r * NGW; const f32x4* xr = (const f32x4*)x_row(a, 0, m < NTOK ? m : m0) + lane;
#pragma unroll
                for (int j = 0; j < 8; ++j) v[r][j] = xr[64 * j]; }
#pragma unroll
            for (int r = 0; r < 2; ++r) { const int m = m0 + r * NGW; float sq = 0.f;
#pragma unroll
                for (int j = 0; j < 8; ++j) sq += (v[r][j].x * v[r][j].x + v[r][j].y * v[r][j].y) + (v[r][j].z * v[r][j].z + v[r][j].w * v[r][j].w);
                sq = wave_sum(sq);
                if (m < NTOK) { if (lane == 0) SS[m] = (unsigned long long)(sq * 1048576.f + 0.5f);
                    v2u* o8 = (v2u*)(XB + (size_t)m * DM) + lane;
#pragma unroll
                    for (int j = 0; j < 8; ++j) { v2u o; o.x = pk2(v[r][j].x, v[r][j].y); o.y = pk2(v[r][j].z, v[r][j].w); o8[64 * j] = o; } } } } }

}

__device__ __forceinline__ void ph_na_simple(const Args& a, const Frame& F, int l) {
    int tid = threadIdx.x; asm volatile("" : "+v"(tid)); int lane = tid & 63; (void)lane;
    const bf16* Z = (const bf16*)(a.ws + WS_Z); bf16* Y = (bf16*)(a.ws + WS_Y);
    const float* rpb = a.in[I_RPB] + (size_t)l * 16 * 15 * 31;
    float* qs = (float*)(F.ldsg + RING_OFF) + F.wave * 64;
    const long U = (long)NTOK * 16; const long u0 = U * F.vcu / F.G, u1 = U * (F.vcu + 1) / F.G;
    for (long u = u0 + F.wave; u < u1; u += NWAVES) {
        const int tok = (int)(u >> 4), h = (int)(u & 15);
        int s0, T; seq_of(tok, s0, T); const int pos = tok - s0, r = pos >> 6, c = pos & 63, R = T >> 6;
        const int rs = min(max(r - 4, 0), R - 8), cs = min(max(c - 8, 0), 48);
        LDS_WAIT();
        qs[lane] = bf2f(Z[(size_t)tok * ZW + h * 64 + lane]);
        LDS_WAIT();
        float sc[2];
#pragma unroll
        for (int i = 0; i < 2; ++i) {
            const int kk = lane + 64 * i, krow = rs + (kk >> 4), kcol = cs + (kk & 15); const int ktok = s0 + krow * 64 + kcol;
            const v4u* kp = (const v4u*)(Z + (size_t)ktok * ZW + ZK + h * 64);
            float d = 0.f;
#pragma unroll
            for (int j = 0; j < 8; ++j) { const v4u w = kp[j]; const f32x4 q0 = *(const f32x4*)(qs + 8 * j), q1 = *(const f32x4*)(qs + 8 * j + 4);
                d += bflo(w.x) * q0.x + bfhi(w.x) * q0.y + bflo(w.y) * q0.z + bfhi(w.y) * q0.w + bflo(w.z) * q1.x + bfhi(w.z) * q1.y + bflo(w.w) * q1.z + bfhi(w.w) * q1.w; }
            sc[i] = d * 0.125f + rpb[(h * 15 + (krow - r + 7)) * 31 + (kcol - c + 15)];
        }
        const float m = wave_max(fmaxf(sc[0], sc[1])); const float p0 = __expf(sc[0] - m), p1 = __expf(sc[1] - m); const float sum = wave_sum(p0 + p1);
        float acc = 0.f;
        for (int kk = 0; kk < 128; ++kk) {
            const float p = __shfl(kk < 64 ? p0 : p1, kk & 63);
            const int krow = rs + (kk >> 4), kcol = cs + (kk & 15); const int vtok = s0 + krow * 64 + kcol;
            acc += p * bf2f(Z[(size_t)vtok * ZW + ZV + h * 64 + lane]);
        }
        Y[(size_t)tok * DM + h * 64 + lane] = (bf16)f2bf(acc / sum);
    }
}

typedef short s16x4_t __attribute__((ext_vector_type(4)));
__device__ __forceinline__ pg8::bf16x8 v_tr_pair(const LAS unsigned char* p) {
    const s16x4_t lo = __builtin_amdgcn_ds_read_tr16_b64_v4i16((LAS s16x4_t*)p), hi = __builtin_amdgcn_ds_read_tr16_b64_v4i16((LAS s16x4_t*)(p + 512));
    return __builtin_shufflevector(lo, hi, 0, 1, 2, 3, 4, 5, 6, 7);
}
__device__ __forceinline__ void glds16_asm(const void* gsrc, unsigned lds_dst) {
    unsigned keep;
    asm volatile("s_mov_b32 %0, m0\n\ts_mov_b32 m0, %2\n\ts_nop 0\n\tglobal_load_lds_dwordx4 %1, off\n\ts_mov_b32 m0, %0" : "=&s"(keep) : "v"(gsrc), "s"(lds_dst) : "memory");
}
__device__ __forceinline__ void ph_na_mfma(const Args& a, const Frame& F, int l) {
    int tid = threadIdx.x; asm volatile("" : "+v"(tid)); int lane = tid & 63; (void)lane;
    const bf16* Z = (const bf16*)(a.ws + WS_Z); bf16* Y = (bf16*)(a.ws + WS_Y);
    constexpr int KR = 0, VR = 73728, BIAS = 147456, MRG = 149504;
    LAS unsigned char* L = F.lds;
    const int w = F.wave, qt = w & 3, half = w >> 2, q = lane & 15, g = lane >> 4;
    const int c0 = 16 * qt, kc0 = (qt == 0) ? 0 : (qt == 1 ? 8 : (qt == 2 ? 24 : 32)), c = c0 + q, cs = min(max(c - 8, 0), 48);
    const int NIT = (NTOK / 64) * 16; const int i0 = (int)((long)NIT * F.vcu / F.G), i1 = (int)((long)NIT * (F.vcu + 1) / F.G);
#define NA_ITEM(it_, s0_, R_, h_, r_) do { if ((it_) < 2048) { const int _col = (it_) >> 5; r_ = (it_) & 31; R_ = 32; s0_ = (_col >> 4) * 2048; h_ = _col & 15; } \
        else { const int _j = (it_) - 2048, _col = _j >> 8; r_ = _j & 255; R_ = 256; s0_ = 8192 + (_col >> 4) * 16384; h_ = _col & 15; } } while (0)
#define NA_SWZ(col_) (((((col_) >> 3) & 3) << 1) | (((col_) >> 1) & 1))
#define NA_ROW_DMA(zoff_, row_, slotbase_) do { \
        _Pragma("unroll") for (int _j = 0; _j < 2; ++_j) { const int _col = c0 + 8 * _j + (lane >> 3); \
            const bf16* _gp = Z + ((size_t)((zoff_) / 64 + h) * NTOK + (s0 + (row_) * 64 + _col)) * 64 + (((lane & 7) ^ NA_SWZ(_col)) * 8); \
            glds16_asm(_gp, (unsigned)(size_t)(L + (slotbase_) + (c0 + 8 * _j) * 128)); } } while (0)
#define NA_BAR() asm volatile("s_barrier" ::: "memory")
    pg8::bf16x8 qn0, qn1;
    { int s0, R, h, r; NA_ITEM(i0, s0, R, h, r); const bf16* qp = Z + ((size_t)h * NTOK + (s0 + r * 64 + c)) * 64 + 8 * g; qn0 = *(const pg8::bf16x8*)qp; qn1 = *(const pg8::bf16x8*)(qp + 32); }
    v2u st0, st1, st2, st3; bf16* stp = Y;
    st0 = st1 = st2 = st3 = (v2u){0u, 0u};
    int it = i0;
    while (it < i1) {
        int s0, R, h, r0; NA_ITEM(it, s0, R, h, r0);
        const int m = min(R - r0, i1 - it);
        {
            const int rs = min(max(r0 - 4, 0), R - 8);
#pragma unroll
            for (int i = 0; i < 16; ++i) { const int id = w * 16 + i, t = id >> 6, ri = (id >> 3) & 7, j8 = id & 7, row = rs + ri;
                const int colw = 8 * j8 + (lane >> 3);
                const bf16* gp = Z + ((size_t)((t ? 32 : 16) + h) * NTOK + (s0 + row * 64 + colw)) * 64 + (((lane & 7) ^ NA_SWZ(colw)) * 8);
                glds16_asm(gp, (unsigned)(size_t)(L + (t ? VR : KR) + (row % 9) * 8192 + j8 * 1024)); }
            if (tid < 465) ((LAS float*)(L + BIAS))[tid] = a.in[I_RPB][((size_t)l * 16 + h) * 465 + tid];
            VM_WAIT(); LDS_WAIT();
            __syncthreads();
        }
        float ti[4][2][4];
        { const LAS float* bt = (const LAS float*)(L + BIAS);
#pragma unroll
          for (int kk = 0; kk < 4; ++kk)
#pragma unroll
              for (int blk = 0; blk < 2; ++blk)
#pragma unroll
                  for (int rg = 0; rg < 4; ++rg) { const int col = kc0 + 8 * g + 4 * blk + rg; const int dc = min(max(col - c + 15, 0), 30); const bool valid = (unsigned)(col - cs) < 16u;
                      ti[kk][blk][rg] = valid ? 8.f * bt[(kk + 4 * half + 3) * 31 + dc] : -INFINITY; } }
        if (half == 1) NA_BAR();
        for (int j = 0; j < m; ++j) {
            const int r = r0 + j, rs = min(max(r - 4, 0), R - 8);
            pg8::bf16x8 qf0 = qn0, qf1 = qn1;
            asm volatile("" : "+v"(qf0), "+v"(qf1) :: "memory");
            if (half == 1 && j > 0) { *(v2u*)(stp) = st0; *(v2u*)(stp + 16) = st1; *(v2u*)(stp + 32) = st2; *(v2u*)(stp + 48) = st3; }
            if (it + j + 1 < i1) {
                int s0n, Rn, hn, rn; NA_ITEM(it + j + 1, s0n, Rn, hn, rn);
                if (half == 0 && j + 1 < m) { const int rsn = min(max(rn - 4, 0), Rn - 8); if (rsn > rs) { NA_ROW_DMA(ZK, rsn + 7, KR + ((rsn + 7) % 9) * 8192); NA_ROW_DMA(ZV, rsn + 7, VR + ((rsn + 7) % 9) * 8192); } }
                const bf16* qp = Z + ((size_t)hn * NTOK + (s0n + rn * 64 + c)) * 64 + 8 * g; qn0 = *(const pg8::bf16x8*)qp; qn1 = *(const pg8::bf16x8*)(qp + 32);
            }
            const int tokrow0 = s0 + r * 64;
            f32x4 sc[4][2];
            pg8::bf16x8 kf[4][2][2];
#pragma unroll
            for (int kk = 0; kk < 4; ++kk) { const int row = rs + 4 * half + kk; const LAS unsigned char* kb = L + KR + (row % 9) * 8192;
#pragma unroll
                for (int blk = 0; blk < 2; ++blk) { const int col = kc0 + 8 * (q >> 2) + 4 * blk + (q & 3); const int sw = NA_SWZ(col);
                    kf[kk][blk][0] = *(const LAS pg8::bf16x8*)(kb + col * 128 + ((g ^ sw) * 16)); kf[kk][blk][1] = *(const LAS pg8::bf16x8*)(kb + col * 128 + (((4 + g) ^ sw) * 16)); } }
            const bool interior = (rs == r - 4);
            __builtin_amdgcn_sched_barrier(0);
#pragma unroll
            for (int kk = 0; kk < 4; ++kk)
#pragma unroll
                for (int blk = 0; blk < 2; ++blk) { f32x4 ini = (f32x4){0.f, 0.f, 0.f, 0.f};
                    if (interior) ini = (f32x4){ti[kk][blk][0], ti[kk][blk][1], ti[kk][blk][2], ti[kk][blk][3]};
                    sc[kk][blk] = __builtin_amdgcn_mfma_f32_16x16x32_bf16(kf[kk][blk][0], qf0, ini, 0, 0, 0); }
#pragma unroll
            for (int kk = 0; kk < 4; ++kk)
#pragma unroll
                for (int blk = 0; blk < 2; ++blk) sc[kk][blk] = __builtin_amdgcn_mfma_f32_16x16x32_bf16(kf[kk][blk][1], qf1, sc[kk][blk], 0, 0, 0);
            __builtin_amdgcn_sched_barrier(0);
            if (!interior) {
                const LAS float* bh = (const LAS float*)(L + BIAS) + (rs + 4 * half - r + 7) * 31;
#pragma unroll
                for (int blk = 0; blk < 2; ++blk)
#pragma unroll
                    for (int rg = 0; rg < 4; ++rg) { const int col = kc0 + 8 * g + 4 * blk + rg; const int dc = min(max(col - c + 15, 0), 30); const bool valid = (unsigned)(col - cs) < 16u;
#pragma unroll
                        for (int kk = 0; kk < 4; ++kk) sc[kk][blk][rg] = valid ? sc[kk][blk][rg] + 8.f * bh[kk * 31 + dc] : -INFINITY; }
            }
            float mx = -INFINITY;
#pragma unroll
            for (int kk = 0; kk < 4; ++kk)
#pragma unroll
                for (int blk = 0; blk < 2; ++blk)
#pragma unroll
                    for (int rg = 0; rg < 4; ++rg) mx = fmaxf(mx, sc[kk][blk][rg]);
            mx = fmaxf(mx, __shfl_xor(mx, 16)); mx = fmaxf(mx, __shfl_xor(mx, 32));
            LDS_WAIT();
            __syncthreads();
            pg8::bf16x8 vfr[4][4];
#pragma unroll
            for (int kk = 0; kk < 4; ++kk) { const int row = rs + 4 * half + kk;
                const int colv = kc0 + 8 * g + ((lane & 15) >> 2), sw0 = NA_SWZ(colv), sw1 = NA_SWZ(colv + 4), pq = lane & 3;
                const LAS unsigned char* vb0 = L + VR + (row % 9) * 8192 + colv * 128 + (pq & 1) * 8; const LAS unsigned char* vb1 = vb0 + 512;
#pragma unroll
                for (int db = 0; db < 4; ++db) { const int ch = 2 * db + (pq >> 1);
                    const s16x4_t lo = __builtin_amdgcn_ds_read_tr16_b64_v4i16((LAS s16x4_t*)(vb0 + ((ch ^ sw0) * 16))), hi = __builtin_amdgcn_ds_read_tr16_b64_v4i16((LAS s16x4_t*)(vb1 + ((ch ^ sw1) * 16)));
                    vfr[kk][db] = __builtin_shufflevector(lo, hi, 0, 1, 2, 3, 4, 5, 6, 7); } }
            __builtin_amdgcn_sched_barrier(0);
            pg8::bf16x8 pf[4];
            constexpr float CS = 0.125f * 1.4426950408889634f;
            const float nm = -mx * CS;
#pragma unroll
            for (int kk = 0; kk < 4; ++kk) { float p[8];
#pragma unroll
                for (int blk = 0; blk < 2; ++blk)
#pragma unroll
                    for (int rg = 0; rg < 4; ++rg) p[4 * blk + rg] = __builtin_amdgcn_exp2f(__builtin_fmaf(sc[kk][blk][rg], CS, nm));
                v4u wv; wv.x = pk2(p[0], p[1]); wv.y = pk2(p[2], p[3]); wv.z = pk2(p[4], p[5]); wv.w = pk2(p[6], p[7]); pf[kk] = __builtin_bit_cast(pg8::bf16x8, wv); }
            f32x4 osum = (f32x4){0.f, 0.f, 0.f, 0.f};
            { const v4u onesw = (v4u){0x3f803f80u, 0x3f803f80u, 0x3f803f80u, 0x3f803f80u}; const pg8::bf16x8 ones = __builtin_bit_cast(pg8::bf16x8, onesw);
#pragma unroll
              for (int kk = 0; kk < 4; ++kk) osum = __builtin_amdgcn_mfma_f32_16x16x32_bf16(ones, pf[kk], osum, 0, 0, 0); }
            const float sum = osum[0];
            f32x4 o[4];
#pragma unroll
            for (int db = 0; db < 4; ++db) o[db] = (f32x4){0.f, 0.f, 0.f, 0.f};
#pragma unroll
            for (int kk = 0; kk < 4; ++kk)
#pragma unroll
                for (int db = 0; db < 4; ++db) o[db] = __builtin_amdgcn_mfma_f32_16x16x32_bf16(vfr[kk][db], pf[kk], o[db], 0, 0, 0);
            LAS unsigned char* mg = L + MRG + (qt * 64 + lane) * 48;
            if (half == 0) {
                v4u w0, w1; w0.x = pk2(o[0][0], o[0][1]); w0.y = pk2(o[0][2], o[0][3]); w0.z = pk2(o[1][0], o[1][1]); w0.w = pk2(o[1][2], o[1][3]);
                w1.x = pk2(o[2][0], o[2][1]); w1.y = pk2(o[2][2], o[2][3]); w1.z = pk2(o[3][0], o[3][1]); w1.w = pk2(o[3][2], o[3][3]);
                *(LAS v4u*)mg = w0; *(LAS v4u*)(mg + 16) = w1; *(LAS f32x2*)(mg + 32) = (f32x2){mx, sum};
                VM_WAIT();
            } else {
                const v4u w0 = *(const LAS v4u*)mg, w1 = *(const LAS v4u*)(mg + 16); const f32x2 ml = *(const LAS f32x2*)(mg + 32);
                const float mm = fmaxf(mx, ml.x), a0 = __builtin_amdgcn_exp2f((mx - mm) * CS), a1 = __builtin_amdgcn_exp2f((ml.x - mm) * CS); const float inv = frcp(sum * a0 + ml.y * a1);
                const float sa = a0 * inv, sb = a1 * inv;
                stp = Y + (size_t)(tokrow0 + c) * DM + h * 64 + 4 * g;
                st0.x = pk2(o[0][0] * sa + bflo(w0.x) * sb, o[0][1] * sa + bfhi(w0.x) * sb); st0.y = pk2(o[0][2] * sa + bflo(w0.y) * sb, o[0][3] * sa + bfhi(w0.y) * sb);
                st1.x = pk2(o[1][0] * sa + bflo(w0.z) * sb, o[1][1] * sa + bfhi(w0.z) * sb); st1.y = pk2(o[1][2] * sa + bflo(w0.w) * sb, o[1][3] * sa + bfhi(w0.w) * sb);
                st2.x = pk2(o[2][0] * sa + bflo(w1.x) * sb, o[2][1] * sa + bfhi(w1.x) * sb); st2.y = pk2(o[2][2] * sa + bflo(w1.y) * sb, o[2][3] * sa + bfhi(w1.y) * sb);
                st3.x = pk2(o[3][0] * sa + bflo(w1.z) * sb, o[3][1] * sa + bfhi(w1.z) * sb); st3.y = pk2(o[3][2] * sa + bflo(w1.w) * sb, o[3][3] * sa + bfhi(w1.w) * sb);
            }
            LDS_WAIT();
            __syncthreads();
        }
        if (half == 1) { *(v2u*)(stp) = st0; *(v2u*)(stp + 16) = st1; *(v2u*)(stp + 32) = st2; *(v2u*)(stp + 48) = st3; }
        if (half == 0) NA_BAR();
        it += m;
    }
#undef NA_BAR
#undef NA_ROW_DMA
#undef NA_SWZ
#undef NA_ITEM
    VM_WAIT(); LDS_WAIT();
    __syncthreads();
}

template <int MODE> __device__ __forceinline__ void ph_lru_simple(const Args& a, const Frame& F, int l) {
    int tid = threadIdx.x; asm volatile("" : "+v"(tid)); int lane = tid & 63; (void)lane;
    const bf16* Z = (const bf16*)(a.ws + WS_Z); bf16* Y = (bf16*)(a.ws + WS_Y); float* HF = (float*)(a.ws + WS_HF);
    float* agg = (float*)(a.ws + WS_LAGG); const float* cin = (const float*)(a.ws + WS_LCIN);
    float* xc = (float*)(F.ldsg + RING_OFF);
    const int c = tid, n = c >> 6, k = c & 63;
    float cw[4];
#pragma unroll
    for (int j = 0; j < 4; ++j) cw[j] = a.in[I_CW][((size_t)l * 4 + j) * 512 + c];
    const float cb = a.in[I_CB][(size_t)l * 512 + c];
    for (int ch = F.vcu; ch < NLCH; ch += F.G) {
        const int tok0 = ch * LCH; int s0, T; seq_of(tok0, s0, T); const int s1 = s0 + T;
        __syncthreads();
        for (int t = 0; t < LCH; ++t) { const int tok = tok0 + t; float v = cb;
#pragma unroll
            for (int j = 0; j < 4; ++j) { const int tt = tok + j - 2; if (tt >= s0 && tt < s1) v += cw[j] * bf2f(Z[(size_t)tt * ZW + ZXR + c]); }
            xc[t * 512 + c] = v; }
        __syncthreads();
        for (int dir = 0; dir < 2; ++dir) {
            float wa[64], wx[64];
            const float* pwa = a.in[I_LWA] + ((size_t)(l * 2 + dir) * 8 + n) * 4096 + k; const float* pwx = a.in[I_LWX] + ((size_t)(l * 2 + dir) * 8 + n) * 4096 + k;
#pragma unroll
            for (int j = 0; j < 64; ++j) { wa[j] = pwa[j * 64]; wx[j] = pwx[j * 64]; }
            const float ba = a.in[I_LBA][(size_t)(l * 2 + dir) * 512 + c], bx = a.in[I_LBX][(size_t)(l * 2 + dir) * 512 + c];
            const float lam = a.in[I_LAM][(size_t)(l * 2 + dir) * 512 + c]; const float ls8 = -8.f * log1pf(__expf(-lam));
            float h = MODE ? cin[((size_t)ch * 2 + dir) * 512 + c] : 0.f, P = 1.f;
            for (int st = 0; st < LCH; ++st) {
                const int t = dir ? (LCH - 1 - st) : st; const float* xr = xc + t * 512 + n * 64;
                float pa = ba, px = bx;
#pragma unroll
                for (int j = 0; j < 64; j += 4) { const f32x4 x4 = *(const f32x4*)(xr + j);
                    pa += x4.x * wa[j] + x4.y * wa[j + 1] + x4.z * wa[j + 2] + x4.w * wa[j + 3]; px += x4.x * wx[j] + x4.y * wx[j + 1] + x4.z * wx[j + 2] + x4.w * wx[j + 3]; }
                const float rr = sigmoidf_(pa), ii = sigmoidf_(px), loga = ls8 * rr, av = __expf(loga), mult = sqrtf(fmaxf(-expm1f(2.f * loga), 0.f));
                const float uu = mult * ii * xc[t * 512 + c];
                h = av * h + uu; P *= av;
                if (MODE) { const size_t tok = (size_t)(tok0 + t);
                    if (dir == 0) HF[tok * 512 + c] = h;
                    else { const float gt = bf2f(Z[tok * ZW + ZGT + c]); Y[tok * DM + 1024 + c] = (bf16)f2bf((HF[tok * 512 + c] + h) * gelu_tanh(gt)); } }
            }
            if (!MODE) { float* ag = agg + (((size_t)ch * 2 + dir) * 512 + c) * 2; ag[0] = P; ag[1] = h; }
        }
    }
}

template <int MODE> __device__ __forceinline__ void ph_s5_simple(const Args& a, const Frame& F, int l) {
    int tid = threadIdx.x; asm volatile("" : "+v"(tid)); int lane = tid & 63; (void)lane;
    const bf16* Z = (const bf16*)(a.ws + WS_Z); bf16* YG = (bf16*)(a.ws + WS_YG);
    float* E = (float*)(a.ws + WS_SEND); const float* CIN = (const float*)(a.ws + WS_SCIN);
    const float* TLB = (const float*)(a.ws + WS_TLB); const float* TBB = (const float*)(a.ws + WS_TBB);
    float* Sst = (float*)(F.ldsg + RING_OFF + F.wave * 16384);
    float* Yf = Sst + 2048;
    float* Ub = (float*)(F.ldsg + XTRA_OFF + F.wave * 1024);
    const int gw = F.vcu * NWAVES + F.wave, NGW = F.G * NWAVES;
    for (int u = gw; u < NSCH * 32; u += NGW) {
        const int ch = u >> 5, g = u & 31, tok0 = ch * SCH;
        for (int dir = 0; dir < 2; ++dir) {
            const int dg = dir * 32 + g;
            const float lbr = TLB[((size_t)dg * 64 + lane) * 2], lbi = TLB[((size_t)dg * 64 + lane) * 2 + 1];
            float bbr[16], bbi[16];
            { const f32x4* tb = (const f32x4*)(TBB + ((size_t)dg * 64 + lane) * 32);
#pragma unroll
              for (int q = 0; q < 4; ++q) { const f32x4 x = tb[q], y = tb[4 + q]; bbr[4 * q] = x.x; bbr[4 * q + 1] = x.y; bbr[4 * q + 2] = x.z; bbr[4 * q + 3] = x.w; bbi[4 * q] = y.x; bbi[4 * q + 1] = y.y; bbi[4 * q + 2] = y.z; bbi[4 * q + 3] = y.w; } }
            float cr[64], ci[64];
            if (MODE) { const int h = lane & 15; const f32x4* pr = (const f32x4*)(a.in[I_CRE] + (((size_t)(l * 2 + dir) * 32 + g) * 16 + h) * 64); const f32x4* pi = (const f32x4*)(a.in[I_CIM] + (((size_t)(l * 2 + dir) * 32 + g) * 16 + h) * 64);
#pragma unroll
              for (int q = 0; q < 16; ++q) { const f32x4 x = pr[q], y = pi[q]; cr[4 * q] = x.x; cr[4 * q + 1] = x.y; cr[4 * q + 2] = x.z; cr[4 * q + 3] = x.w; ci[4 * q] = y.x; ci[4 * q + 1] = y.y; ci[4 * q + 2] = y.z; ci[4 * q + 3] = y.w; } }
            float sr = 0.f, si = 0.f;
            if (MODE) { const float* cp = CIN + ((((size_t)ch * 2 + dir) * 32 + g) * 64 + lane) * 2; sr = cp[0]; si = cp[1]; }
            for (int b = 0; b < SCH / 16; ++b) {
                { const int tt = lane >> 2, hq = lane & 3; const int tl = dir ? (SCH - 1 - (16 * b + tt)) : (16 * b + tt);
                  const v2u w = *(const v2u*)(Z + (size_t)(tok0 + tl) * ZW + ZXS + g * 16 + hq * 4);
                  LDS_WAIT();
                  *(f32x4*)(Ub + tt * 16 + hq * 4) = (f32x4){bflo(w.x), bfhi(w.x), bflo(w.y), bfhi(w.y)};
                  LDS_WAIT(); }
                for (int tt = 0; tt < 16; ++tt) {
                    const f32x4 u0 = *(const f32x4*)(Ub + tt * 16), u1 = *(const f32x4*)(Ub + tt * 16 + 4), u2 = *(const f32x4*)(Ub + tt * 16 + 8), u3 = *(const f32x4*)(Ub + tt * 16 + 12);
                    float ir = u0.x * bbr[0] + u0.y * bbr[1] + u0.z * bbr[2] + u0.w * bbr[3] + u1.x * bbr[4] + u1.y * bbr[5] + u1.z * bbr[6] + u1.w * bbr[7]
                             + u2.x * bbr[8] + u2.y * bbr[9] + u2.z * bbr[10] + u2.w * bbr[11] + u3.x * bbr[12] + u3.y * bbr[13] + u3.z * bbr[14] + u3.w * bbr[15];
                    float ii = u0.x * bbi[0] + u0.y * bbi[1] + u0.z * bbi[2] + u0.w * bbi[3] + u1.x * bbi[4] + u1.y * bbi[5] + u1.z * bbi[6] + u1.w * bbi[7]
                             + u2.x * bbi[8] + u2.y * bbi[9] + u2.z * bbi[10] + u2.w * bbi[11] + u3.x * bbi[12] + u3.y * bbi[13] + u3.z * bbi[14] + u3.w * bbi[15];
                    const float nr = lbr * sr - lbi * si + ir, ni = lbr * si + lbi * sr + ii; sr = nr; si = ni;
                    if (MODE) { Sst[(tt * 64 + lane) * 2] = sr; Sst[(tt * 64 + lane) * 2 + 1] = si; }
                }
                if (MODE) {
                    LDS_WAIT();
                    const int h = lane & 15, tq = lane >> 4;
#pragma unroll
                    for (int j = 0; j < 4; ++j) { const int slot = tq * 4 + j; const float* sp = Sst + slot * 128; float y = 0.f;
#pragma unroll
                        for (int p = 0; p < 64; p += 2) { const f32x4 s4 = *(const f32x4*)(sp + 2 * p); y += s4.x * cr[p] - s4.y * ci[p] + s4.z * cr[p + 1] - s4.w * ci[p + 1]; }
                        const int tl = dir ? (SCH - 1 - (16 * b + slot)) : (16 * b + slot);
                        if (dir == 0) Yf[tl * 16 + h] = y; else Yf[tl * 16 + h] += y; }
                    LDS_WAIT();
                }
            }
            if (!MODE) { float* ep = E + ((((size_t)ch * 2 + dir) * 32 + g) * 64 + lane) * 2; ep[0] = sr; ep[1] = si; }
        }
        if (MODE) {
            LDS_WAIT();
            for (int i = 0; i < 32; ++i) { const int idx = lane + 64 * i, tl = idx >> 4, h = idx & 15; const size_t tok = (size_t)(tok0 + tl);
                const float xs = bf2f(Z[tok * ZW + ZXS + g * 16 + h]); const float y = Yf[tl * 16 + h] + a.in[I_SD][(size_t)l * 512 + g * 16 + h] * xs;
                YG[tok * 512 + g * 16 + h] = (bf16)f2bf(gelu_tanh(y)); }
            LDS_WAIT();
        }
    }
}

template <int MODE, int DIR> __device__ __forceinline__ void s5_dir(const Args& a, int l, int lane, int tok0, int gr, LAS unsigned char* st, bf16* yf) {
    const bf16* Z = (const bf16*)(a.ws + WS_ZR); bf16* YG = (bf16*)(a.ws + WS_YG);
    float* E = (float*)(a.ws + WS_SEND); const float* CIN = (const float*)(a.ws + WS_SCIN); const float* TLB = (const float*)(a.ws + WS_TLB);
    const int n = lane & 15, g = lane >> 4, dg = DIR * 32 + gr, ch = tok0 / SCH + g;
    pg8::bf16x8 bbf[8], cf[4];
    { const pg8::bf16x8* bp = (const pg8::bf16x8*)(a.ws + WS_TBBF) + (size_t)dg * 8 * 64 + lane;
#pragma unroll
      for (int c = 0; c < 8; ++c) bbf[c] = bp[c * 64]; }
    if (MODE) { const pg8::bf16x8* cp = (const pg8::bf16x8*)(a.ws + WS_TCF) + (size_t)dg * 4 * 64 + lane;
#pragma unroll
      for (int c = 0; c < 4; ++c) cf[c] = cp[c * 64]; }
    float lbr[4], lbi[4], sr[4], si[4];
#pragma unroll
    for (int cb = 0; cb < 4; ++cb) { const size_t ix = ((size_t)dg * 64 + 16 * cb + n) * 2; lbr[cb] = TLB[ix]; lbi[cb] = TLB[ix + 1];
        if (MODE) { const size_t cx = ((((size_t)ch * 2 + DIR) * 32 + gr) * 64 + 16 * cb + n) * 2; sr[cb] = CIN[cx]; si[cb] = CIN[cx + 1]; } else { sr[cb] = 0.f; si[cb] = 0.f; } }
    const float dsk = MODE ? a.in[I_SD][(size_t)l * 512 + 16 * gr + n] : 0.f;
    const bf16* ua = Z + (size_t)(tok0 + (n >> 2) * SCH + (n & 3)) * ZRW + RXS + 16 * gr + 8 * (g & 1);
    bf16* yo = YG + (size_t)(tok0 + g * SCH) * 512 + 16 * gr + n;
    const bf16* xo = Z + (size_t)(tok0 + g * SCH) * ZRW + RXS + 16 * gr + n;
    constexpr int NST = SCH / 4, T0 = DIR ? (SCH - 4) : 0, DT = DIR ? -4 : 4;
    pg8::bf16x8 un = *(const pg8::bf16x8*)(ua + (size_t)T0 * ZRW);
    unsigned short ygn[4], xsn[4];
    if (MODE && DIR) {
        VM_WAIT();
#pragma unroll
        for (int rg = 0; rg < 4; ++rg) { ygn[rg] = yf[((T0 >> 2) * 4 + rg) * 64 + lane]; xsn[rg] = xo[(size_t)(T0 + rg) * ZRW]; } }
#pragma unroll 1
    for (int step = 0; step < NST; ++step) {
        const int t4 = T0 + DT * step;
        const pg8::bf16x8 u8 = un; unsigned short ygc[4], xsc[4];
        if (MODE && DIR) {
#pragma unroll
            for (int rg = 0; rg < 4; ++rg) { ygc[rg] = ygn[rg]; xsc[rg] = xsn[rg]; } }
        if (step + 1 < NST) { un = *(const pg8::bf16x8*)(ua + (size_t)(t4 + DT) * ZRW);
            if (MODE && DIR) {
#pragma unroll
                for (int rg = 0; rg < 4; ++rg) { ygn[rg] = yf[(((t4 + DT) >> 2) * 4 + rg) * 64 + lane]; xsn[rg] = xo[(size_t)(t4 + DT + rg) * ZRW]; } } }
        f32x4 in[8];
#pragma unroll
        for (int c = 0; c < 8; ++c) in[c] = __builtin_amdgcn_mfma_f32_16x16x32_bf16(u8, bbf[c], (f32x4){0.f, 0.f, 0.f, 0.f}, 0, 0, 0);
        float str[4][4], sti[4][4];
#pragma unroll
        for (int rr = 0; rr < 4; ++rr) { const int rg = DIR ? 3 - rr : rr;
#pragma unroll
            for (int cb = 0; cb < 4; ++cb) { const float nr = lbr[cb] * sr[cb] - lbi[cb] * si[cb] + in[cb][rg], ni = lbr[cb] * si[cb] + lbi[cb] * sr[cb] + in[4 + cb][rg];
                sr[cb] = nr; si[cb] = ni; str[cb][rg] = nr; sti[cb][rg] = ni; } }
        if (MODE) {
            v4u w[4];
#pragma unroll
            for (int rg = 0; rg < 4; ++rg) {
#pragma unroll
                for (int cb = 0; cb < 4; ++cb) { unsigned pw; asm("v_cvt_pk_bf16_f32 %0, %1, %2" : "=v"(pw) : "v"(str[cb][rg]), "v"(sti[cb][rg]));
                    w[rg][cb] = pw; } }
            { const unsigned ta = (unsigned)(size_t)(st + (4 * g) * 272 + n * 16);
              asm volatile("s_nop 1\n\tds_write_b128 %0, %1\n\tds_write_b128 %0, %2 offset:272\n\tds_write_b128 %0, %3 offset:544\n\tds_write_b128 %0, %4 offset:816\n\ts_waitcnt lgkmcnt(0)"
                           :: "v"(ta), "v"(w[0]), "v"(w[1]), "v"(w[2]), "v"(w[3]) : "memory"); }
            f32x4 y = (f32x4){0.f, 0.f, 0.f, 0.f};
#pragma unroll
            for (int ks = 0; ks < 4; ++ks) { const pg8::bf16x8 sf = *(const LAS pg8::bf16x8*)(st + n * 272 + ks * 64 + g * 16); y = __builtin_amdgcn_mfma_f32_16x16x32_bf16(sf, cf[ks], y, 0, 0, 0); }
            LDS_WAIT();
#pragma unroll
            for (int rg = 0; rg < 4; ++rg) {
                if (DIR == 0) yf[((t4 >> 2) * 4 + rg) * 64 + lane] = (bf16)f2bf(y[rg]);
                else { const float v = y[rg] + bf2f(ygc[rg]) + dsk * bf2f(xsc[rg]); yo[(size_t)(t4 + rg) * 512] = (bf16)f2bf(gelu_tanh(v)); } }
        }
    }
    if (!MODE) {
#pragma unroll
        for (int cb = 0; cb < 4; ++cb) { const size_t cx = ((((size_t)ch * 2 + DIR) * 32 + gr) * 64 + 16 * cb + n) * 2; E[cx] = sr[cb]; E[cx + 1] = si[cb]; } }
}

template <int MODE, int DIR> __device__ __forceinline__ void lru_dir(const Args& a, int l, int lane, int tok0, int nb, int half, const LAS unsigned char* xt, bf16* hf) {
    const bf16* Z = (const bf16*)(a.ws + WS_ZR); bf16* Y = (bf16*)(a.ws + WS_Y);
    float* agg = (float*)(a.ws + WS_LAGG); const float* cin = (const float*)(a.ws + WS_LCIN);
    const int n = lane & 15, g = lane >> 4, ch = tok0 / LCH + g;
    pg8::bf16x8 wa[2][2], wx[2][2];
    { const pg8::bf16x8* wp = (const pg8::bf16x8*)(a.ws + WS_TWF) + (size_t)((DIR * 8 + nb) * 2) * 4 * 2 * 64 + lane;
#pragma unroll
      for (int c2 = 0; c2 < 2; ++c2)
#pragma unroll
          for (int ks = 0; ks < 2; ++ks) { wa[c2][ks] = wp[((2 * half + c2) * 2 + ks) * 64]; wx[c2][ks] = wp[(8 + (2 * half + c2) * 2 + ks) * 64]; } }
    pg8::bf16x8 idn[2];
#pragma unroll
    for (int hf = 0; hf < 2; ++hf) { v4u w;
#pragma unroll
        for (int jj = 0; jj < 4; ++jj) { const int k0 = 8 * g + 2 * jj; w[jj] = ((k0 == 16 * hf + n) ? 0x3f80u : 0u) | ((k0 + 1 == 16 * hf + n) ? 0x3f800000u : 0u); }
        idn[hf] = __builtin_bit_cast(pg8::bf16x8, w); }
    float ba[2], bx[2], ls8[2], h[2], P[2];
    const int cch = 64 * nb + 32 * half + n;
#pragma unroll
    for (int c2 = 0; c2 < 2; ++c2) { const int c = cch + 16 * c2; const size_t ix = (size_t)(l * 2 + DIR) * 512 + c;
        ba[c2] = -1.4426950408889634f * a.in[I_LBA][ix]; bx[c2] = -1.4426950408889634f * a.in[I_LBX][ix]; ls8[c2] = (-8.f * 1.4426950408889634f) * log1pf(__expf(-a.in[I_LAM][ix]));
        h[c2] = MODE ? cin[((size_t)ch * 2 + DIR) * 512 + c] : 0.f; P[c2] = 1.f; }
    const LAS unsigned char* xa = xt + ((n >> 2) * LCH + (n & 3)) * 128 + g * 16;
    bf16* yo = Y + (size_t)(tok0 + g * LCH) * DM + 1024 + cch;
    const bf16* go = Z + (size_t)(tok0 + g * LCH) * ZRW + RGT + cch;
    constexpr int NST = LCH / 4, T0 = DIR ? (LCH - 4) : 0, DT = DIR ? -4 : 4;
    unsigned short yn[2][4], gn[2][4];
    if (MODE && DIR) {
        VM_WAIT();
#pragma unroll
        for (int rg = 0; rg < 4; ++rg)
#pragma unroll
            for (int c2 = 0; c2 < 2; ++c2) { yn[c2][rg] = hf[(((T0 >> 2) * 4 + rg) * 2 + c2) * 64 + lane]; gn[c2][rg] = go[(size_t)(T0 + rg) * ZRW + 16 * c2]; } }
#pragma unroll 1
    for (int step = 0; step < NST; ++step) {
        const int t4 = T0 + DT * step;
        unsigned short yc[2][4], gc[2][4];
        if (MODE && DIR) {
#pragma unroll
            for (int rg = 0; rg < 4; ++rg)
#pragma unroll
                for (int c2 = 0; c2 < 2; ++c2) { yc[c2][rg] = yn[c2][rg]; gc[c2][rg] = gn[c2][rg]; }
            if (step + 1 < NST) {
#pragma unroll
                for (int rg = 0; rg < 4; ++rg)
#pragma unroll
                    for (int c2 = 0; c2 < 2; ++c2) { yn[c2][rg] = hf[((((t4 + DT) >> 2) * 4 + rg) * 2 + c2) * 64 + lane]; gn[c2][rg] = go[(size_t)(t4 + DT + rg) * ZRW + 16 * c2]; } } }
        const pg8::bf16x8 a0 = *(const LAS pg8::bf16x8*)(xa + t4 * 128), a1 = *(const LAS pg8::bf16x8*)(xa + t4 * 128 + 64);
        const pg8::bf16x8 ah = half ? a1 : a0;
        f32x4 pa[2], px[2], xd[2];
#pragma unroll
        for (int c2 = 0; c2 < 2; ++c2) { const f32x4 z4 = (f32x4){0.f, 0.f, 0.f, 0.f};
            pa[c2] = __builtin_amdgcn_mfma_f32_16x16x32_bf16(a0, wa[c2][0], z4, 0, 0, 0); pa[c2] = __builtin_amdgcn_mfma_f32_16x16x32_bf16(a1, wa[c2][1], pa[c2], 0, 0, 0);
            px[c2] = __builtin_amdgcn_mfma_f32_16x16x32_bf16(a0, wx[c2][0], z4, 0, 0, 0); px[c2] = __builtin_amdgcn_mfma_f32_16x16x32_bf16(a1, wx[c2][1], px[c2], 0, 0, 0);
            xd[c2] = __builtin_amdgcn_mfma_f32_16x16x32_bf16(ah, idn[c2], z4, 0, 0, 0); }
#pragma unroll
        for (int rr = 0; rr < 4; ++rr) { const int rg = DIR ? 3 - rr : rr;
#pragma unroll
            for (int c2 = 0; c2 < 2; ++c2) {
                const float r_ = frcp(1.f + __builtin_amdgcn_exp2f(__builtin_fmaf(pa[c2][rg], -1.4426950408889634f, ba[c2]))), i_ = frcp(1.f + __builtin_amdgcn_exp2f(__builtin_fmaf(px[c2][rg], -1.4426950408889634f, bx[c2])));
                const float av = __builtin_amdgcn_exp2f(ls8[c2] * r_), mult = fsqrt_(fmaxf(1.f - av * av, 0.f));
                h[c2] = av * h[c2] + mult * i_ * xd[c2][rg]; P[c2] *= av;
                if (MODE) {
                    if (DIR == 0) hf[(((t4 >> 2) * 4 + rg) * 2 + c2) * 64 + lane] = (bf16)f2bf(h[c2]);
                    else yo[(size_t)(t4 + rg) * DM + 16 * c2] = (bf16)f2bf((bf2f(yc[c2][rg]) + h[c2]) * gelu_tanh(bf2f(gc[c2][rg]))); } }
        }
    }
    if (!MODE) {
#pragma unroll
        for (int c2 = 0; c2 < 2; ++c2) { float* ag = agg + (((size_t)ch * 2 + DIR) * 512 + cch + 16 * c2) * 2; ag[0] = P[c2]; ag[1] = h[c2]; } }
}
__device__ __forceinline__ void lru_prepass(const Args& a, int l, int lane, int tok0, int nb, LAS unsigned char* xt) {
    const bf16* Z = (const bf16*)(a.ws + WS_ZR);
    int s0, T; seq_of(tok0, s0, T); const int s1 = s0 + T;
    const int oc = lane & 7, tg = lane >> 3, cbase = 64 * nb + 8 * oc; float cw[4][8], cbv[8];
    v4u x[19];
    const int tb = tok0 + 16 * tg - 2;
#pragma unroll
    for (int i = 0; i < 19; ++i) { const int tt = tb + i; x[i] = (v4u){0u, 0u, 0u, 0u}; if (tt >= s0 && tt < s1) x[i] = *(const v4u*)(Z + (size_t)tt * ZRW + RXR + cbase); }
#pragma unroll
    for (int tp = 0; tp < 4; ++tp) { const f32x4* wp = (const f32x4*)(a.in[I_CW] + ((size_t)l * 4 + tp) * 512 + cbase); const f32x4 w0 = wp[0], w1 = wp[1];
        cw[tp][0] = w0.x; cw[tp][1] = w0.y; cw[tp][2] = w0.z; cw[tp][3] = w0.w; cw[tp][4] = w1.x; cw[tp][5] = w1.y; cw[tp][6] = w1.z; cw[tp][7] = w1.w; }
    { const f32x4* bp = (const f32x4*)(a.in[I_CB] + (size_t)l * 512 + cbase); const f32x4 b0 = bp[0], b1 = bp[1]; cbv[0] = b0.x; cbv[1] = b0.y; cbv[2] = b0.z; cbv[3] = b0.w; cbv[4] = b1.x; cbv[5] = b1.y; cbv[6] = b1.z; cbv[7] = b1.w; }
    LDS_WAIT();
#pragma unroll
    for (int i = 0; i < 16; ++i) { float acc[8];
#pragma unroll
        for (int e = 0; e < 8; ++e) acc[e] = cbv[e];
#pragma unroll
        for (int tp = 0; tp < 4; ++tp) { const v4u xx = x[i + tp];
            acc[0] += cw[tp][0] * bflo(xx.x); acc[1] += cw[tp][1] * bfhi(xx.x); acc[2] += cw[tp][2] * bflo(xx.y); acc[3] += cw[tp][3] * bfhi(xx.y);
            acc[4] += cw[tp][4] * bflo(xx.z); acc[5] += cw[tp][5] * bfhi(xx.z); acc[6] += cw[tp][6] * bflo(xx.w); acc[7] += cw[tp][7] * bfhi(xx.w); }
        v4u o; o.x = pk2(acc[0], acc[1]); o.y = pk2(acc[2], acc[3]); o.z = pk2(acc[4], acc[5]); o.w = pk2(acc[6], acc[7]);
        *(LAS v4u*)(xt + (16 * tg + i) * 128 + oc * 16) = o; asm volatile("s_nop 1" ::: "memory"); }
    LDS_WAIT();
}
template <int MODE> __device__ __forceinline__ void ph_scan(const Args& a, const Frame& F, int l) {
    int tid = threadIdx.x; asm volatile("" : "+v"(tid)); int lane = tid & 63; (void)lane;
    LAS unsigned char* slab = F.lds + RING_OFF + F.wave * 16384;
    LAS int* ctr = (LAS int*)(F.lds + MISC_OFF + 64);
    __syncthreads(); if (tid == 0) *ctr = 0; __syncthreads();
    constexpr int NLU = (NLCH / 4) * 16, NSU = (NSCH / 4) * 32;
    const int l0 = (int)((long)NLU * F.vcu / F.G), l1 = (int)((long)NLU * (F.vcu + 1) / F.G), s0u = (int)((long)NSU * F.vcu / F.G), s1u = (int)((long)NSU * (F.vcu + 1) / F.G);
    const int nl = l1 - l0, ntot = nl + (s1u - s0u);
    for (;;) {
        int it = 0; if (lane == 0) it = __hip_atomic_fetch_add(ctr, 1, __ATOMIC_RELAXED, __HIP_MEMORY_SCOPE_WORKGROUP);
        it = __builtin_amdgcn_readfirstlane(it);
        if (it >= ntot) break;
        if (it < nl) { const int u = l0 + it, half = u & 1, nb = (u >> 1) & 7, cq = u >> 4, tok0 = cq * 4 * LCH;
            bf16* hf = (bf16*)(a.ws + WS_HF) + (size_t)u * 4096;
            lru_prepass(a, l, lane, tok0, nb, slab);
            lru_dir<MODE, 0>(a, l, lane, tok0, nb, half, slab, hf); lru_dir<MODE, 1>(a, l, lane, tok0, nb, half, slab, hf);
        } else { const int u = s0u + it - nl, gr = u & 31, cq = u >> 5, tok0 = cq * 4 * SCH;
            bf16* yf = (bf16*)(a.ws + WS_HF + 40 * MiB) + (size_t)u * 4096;
            s5_dir<MODE, 0>(a, l, lane, tok0, gr, slab, yf); s5_dir<MODE, 1>(a, l, lane, tok0, gr, slab, yf); }
    }
    LDS_WAIT();
}

__device__ __forceinline__ void ph_carries(const Args& a, const Frame& F, int l) {
    int tid = threadIdx.x; asm volatile("" : "+v"(tid)); int lane = tid & 63; (void)lane;
    constexpr int NL_LONG = 2 * 2 * 512 * (16384 / LCH / 16), NL_SHORT = 4 * 2 * 512 * (2048 / LCH / 16);
    constexpr int NS_LONG = 2 * 2 * 2048 * (16384 / SCH / 16), NS_SHORT = 4 * 2 * 2048 * (2048 / SCH / 16);
    constexpr int NITEM = NL_LONG + NL_SHORT + NS_LONG + NS_SHORT;
    static_assert(NL_LONG % 512 == 0 && NL_SHORT % 512 == 0 && NS_LONG % 512 == 0 && NS_SHORT % 512 == 0, "item classes are whole workgroups");
    for (int base = F.vcu * NTHR; base < NITEM; base += F.G * NTHR) {
        int it = base + tid;
        if (it < NL_LONG + NL_SHORT) {
            const bool lg = it < NL_LONG; if (!lg) it -= NL_LONG;
            const int W = lg ? (16384 / LCH / 16) : (2048 / LCH / 16); const int seg = it & (W - 1), chain = it / W;
            const int c = chain & 511, dir = (chain >> 9) & 1, sq = chain >> 10; const int s0 = lg ? 8192 + sq * 16384 : sq * 2048, T = lg ? 16384 : 2048; const int c0 = s0 / LCH, nc = T / LCH;
            const f32x2* agg = (const f32x2*)(a.ws + WS_LAGG); float* cin = (float*)(a.ws + WS_LCIN);
            f32x2 v[16]; float A = 1.f, B = 0.f;
#pragma unroll
            for (int j = 0; j < 16; ++j) { const int pos = seg * 16 + j, ch = c0 + (dir ? nc - 1 - pos : pos); v[j] = agg[((size_t)ch * 2 + dir) * 512 + c]; }
#pragma unroll
            for (int j = 0; j < 16; ++j) { B = v[j].x * B + v[j].y; A *= v[j].x; }
            for (int off = 1; off < W; off <<= 1) { const float Ap = __shfl_up(A, off, 64), Bp = __shfl_up(B, off, 64); if (seg >= off) { B = A * Bp + B; A = A * Ap; } }
            float carry = __shfl_up(B, 1, 64); if (seg == 0) carry = 0.f;
#pragma unroll
            for (int j = 0; j < 16; ++j) { const int pos = seg * 16 + j, ch = c0 + (dir ? nc - 1 - pos : pos); cin[((size_t)ch * 2 + dir) * 512 + c] = carry; carry = v[j].x * carry + v[j].y; }
        } else {
            it -= NL_LONG + NL_SHORT;
            const bool lg = it < NS_LONG; if (!lg) it -= NS_LONG;
            const int W = lg ? (16384 / SCH / 16) : (2048 / SCH / 16); const int seg = it & (W - 1), chain = it / W;
            const int p = chain & 63, g = (chain >> 6) & 31, dir = (chain >> 11) & 1, sq = chain >> 12; const int s0 = lg ? 8192 + sq * 16384 : sq * 2048, T = lg ? 16384 : 2048; const int c0 = s0 / SCH, nc = T / SCH;
            const float* TLB = (const float*)(a.ws + WS_TLB); const f32x2* E = (const f32x2*)(a.ws + WS_SEND); f32x2* CIN = (f32x2*)(a.ws + WS_SCIN);
            float pr = TLB[((size_t)(dir * 32 + g) * 64 + p) * 2], pi = TLB[((size_t)(dir * 32 + g) * 64 + p) * 2 + 1];
            static_assert(SCH == 64, "lb^SCH by 6 squarings");
#pragma unroll
            for (int i = 0; i < 6; ++i) { const float nr = pr * pr - pi * pi, ni = 2.f * pr * pi; pr = nr; pi = ni; }
            f32x2 v[16]; float Br = 0.f, Bi = 0.f;
#pragma unroll
            for (int j = 0; j < 16; ++j) { const int pos = seg * 16 + j, ch = c0 + (dir ? nc - 1 - pos : pos); v[j] = E[(((size_t)ch * 2 + dir) * 32 + g) * 64 + p]; }
#pragma unroll
            for (int j = 0; j < 16; ++j) { const float nr = pr * Br - pi * Bi + v[j].x, ni = pr * Bi + pi * Br + v[j].y; Br = nr; Bi = ni; }
            float Ar = pr, Ai = pi;
#pragma unroll
            for (int i = 0; i < 4; ++i) { const float nr = Ar * Ar - Ai * Ai, ni = 2.f * Ar * Ai; Ar = nr; Ai = ni; }
            for (int off = 1; off < W; off <<= 1) { const float Apr = __shfl_up(Ar, off, 64), Api = __shfl_up(Ai, off, 64), Bpr = __shfl_up(Br, off, 64), Bpi = __shfl_up(Bi, off, 64);
                if (seg >= off) { const float nbr = Ar * Bpr - Ai * Bpi + Br, nbi = Ar * Bpi + Ai * Bpr + Bi, nar = Ar * Apr - Ai * Api, nai = Ar * Api + Ai * Apr; Br = nbr; Bi = nbi; Ar = nar; Ai = nai; } }
            float cr = __shfl_up(Br, 1, 64), ci = __shfl_up(Bi, 1, 64); if (seg == 0) { cr = 0.f; ci = 0.f; }
#pragma unroll
            for (int j = 0; j < 16; ++j) { const int pos = seg * 16 + j, ch = c0 + (dir ? nc - 1 - pos : pos); CIN[(((size_t)ch * 2 + dir) * 32 + g) * 64 + p] = (f32x2){cr, ci};
                const float nr = pr * cr - pi * ci + v[j].x, ni = pr * ci + pi * cr + v[j].y; cr = nr; ci = ni; }
        }
    }
}

__device__ __forceinline__ void ph_groupnorm(const Args& a, const Frame& F, int l, bf16* dst = nullptr) {
    int tid = threadIdx.x; asm volatile("" : "+v"(tid)); int lane = tid & 63; (void)lane;
    bf16* Y = (bf16*)(a.ws + WS_Y); const float* g = a.in[I_GOUT] + (size_t)l * DM;
    const int gw = F.vcu * NWAVES + F.wave, NGW = F.G * NWAVES;
    static_assert(NTOK % (256 * NWAVES * 4) == 0 || true, "");
    for (int m0 = gw; m0 < NTOK; m0 += 4 * NGW) {
        v4u w[4][4];
#pragma unroll
        for (int r = 0; r < 4; ++r) { const int m = m0 + r * NGW; const v4u* yr = (const v4u*)(Y + (size_t)(m < NTOK ? m : m0) * DM) + lane;
#pragma unroll
            for (int j = 0; j < 4; ++j) w[r][j] = yr[64 * j]; }
        f32x4 g0[4], g1[4];
#pragma unroll
        for (int j = 0; j < 4; ++j) { const f32x4* gp = (const f32x4*)(g + 8 * (lane + 64 * j)); g0[j] = gp[0]; g1[j] = gp[1]; }
#pragma unroll
        for (int r = 0; r < 4; ++r) { const int m = m0 + r * NGW; float ss[4];
#pragma unroll
            for (int j = 0; j < 4; ++j) { float sq = 0.f;
#pragma unroll
                for (int q = 0; q < 4; ++q) { const float lo = bflo(w[r][j][q]), hi = bfhi(w[r][j][q]); sq += lo * lo + hi * hi; }
                ss[j] = sq; }
            const float sa = wave_sum(ss[0] + ss[1]), sb = wave_sum(ss[2]), sc = wave_sum(ss[3]);
            const float ra = 1.f / sqrtf(sa * (1.f / 1024.f) + EPS), rb = 1.f / sqrtf(sb * (1.f / 512.f) + EPS), rc = 1.f / sqrtf(sc * (1.f / 512.f) + EPS);
            if (m < NTOK) {
                v4u* yo = (dst ? (v4u*)(dst + (size_t)m * DM) : (v4u*)(Y + (size_t)m * DM)) + lane;
#pragma unroll
                for (int j = 0; j < 4; ++j) { const float rr = j < 2 ? ra : (j == 2 ? rb : rc);
                    v4u o; o.x = pk2(bflo(w[r][j].x) * rr * g0[j].x, bfhi(w[r][j].x) * rr * g0[j].y); o.y = pk2(bflo(w[r][j].y) * rr * g0[j].z, bfhi(w[r][j].y) * rr * g0[j].w);
                    o.z = pk2(bflo(w[r][j].z) * rr * g1[j].x, bfhi(w[r][j].z) * rr * g1[j].y); o.w = pk2(bflo(w[r][j].w) * rr * g1[j].z, bfhi(w[r][j].w) * rr * g1[j].w);
                    yo[64 * j] = o; } } }
    }
}

__device__ __forceinline__ void ph_norm2(const Args& a, const Frame& F, int l) {
    int tid = threadIdx.x; asm volatile("" : "+v"(tid)); int lane = tid & 63; (void)lane;
    const int gw = F.vcu * NWAVES + F.wave, NGW = F.G * NWAVES; const float* g = a.in[I_NLG] + (size_t)l * DM; bf16* H = (bf16*)(a.ws + WS_H);
    for (int m = gw; m < NTOK; m += NGW) norm_row_bf16(a.out + (size_t)m * DM, g, H + (size_t)m * DM, lane);
}
__device__ __forceinline__ void ph_final(const Args& a, const Frame& F, float* dst = nullptr) {
    int tid = threadIdx.x; asm volatile("" : "+v"(tid)); int lane = tid & 63; (void)lane;
    const int gw = F.vcu * NWAVES + F.wave, NGW = F.G * NWAVES; const f32x4* gr = (const f32x4*)a.in[I_FING] + lane;
    for (int m0 = gw; m0 < NTOK; m0 += 2 * NGW) {
        f32x4 v[2][8];
#pragma unroll
        for (int r = 0; r < 2; ++r) { const int m = m0 + r * NGW; const f32x4* xr = (const f32x4*)(a.out + (size_t)(m < NTOK ? m : m0) * DM) + lane;
#pragma unroll
            for (int j = 0; j < 8; ++j) v[r][j] = xr[64 * j]; }
#pragma unroll
        for (int r = 0; r < 2; ++r) { const int m = m0 + r * NGW; float sq = 0.f;
#pragma unroll
            for (int j = 0; j < 8; ++j) sq += (v[r][j].x * v[r][j].x + v[r][j].y * v[r][j].y) + (v[r][j].z * v[r][j].z + v[r][j].w * v[r][j].w);
            const float rstd = 1.f / sqrtf(wave_sum(sq) * (1.f / DM) + EPS);
            if (m < NTOK) { f32x4* xo = (dst ? (f32x4*)(dst + (size_t)m * DM) : (f32x4*)(a.out + (size_t)m * DM)) + lane;
#pragma unroll
                for (int j = 0; j < 8; ++j) xo[64 * j] = v[r][j] * rstd * gr[64 * j]; } }
    }
}

__global__ void __launch_bounds__(NTHR, 2) mk_fwd(Args args) {
    extern __shared__ __attribute__((aligned(16))) unsigned char lds[];
    Frame F; F.lds = (LAS unsigned char*)lds; F.ldsg = lds;
    F.tid = threadIdx.x; F.lane = F.tid & 63; F.wave = __builtin_amdgcn_readfirstlane(F.tid >> 6);
    F.G = gridDim.x; { const int bx = blockIdx.x; F.vcu = (F.G % 8 == 0) ? (bx % 8) * (F.G / 8) + bx / 8 : bx; }
    volatile LAS unsigned* MISC = (volatile LAS unsigned*)(F.lds + MISC_OFF);
    for (int u = F.tid; u < (LDS_BYTES - LDSCTL_OFF) / 4; u += NTHR) ((LAS unsigned*)(F.lds + LDSCTL_OFF))[u] = 0u;
    __syncthreads();
    unsigned char* ws = args.ws;
    XcdBarrier bar; bar.bar = (unsigned*)(ws + WS_CTL) + CW_BAR; bar.x = 0; bar.st = nullptr;
#if MK_ONE_LAUNCH
    bar = xcd_barrier_post((unsigned*)(ws + WS_CTL) + CW_BAR, MISC + 8);
#endif
    const int lo = args.ph_lo, hi = args.ph_hi;
#define IN(k) (lo <= (k) && (k) < hi)
#if MK_ONE_LAUNCH
#if PROBE_BAR2
#define SEAM(k) do { if (IN(k) && IN((k) + 1)) { xcd_barrier(bar); xcd_barrier(bar); } } while (0)
#else
#define SEAM(k) do { if (IN(k) && IN((k) + 1)) xcd_barrier(bar); } while (0)
#endif
#else
#define SEAM(k) do { } while (0)
#endif
    for (int l = 0; l < DEPTH; ++l) {
        const int pb = l * PH_PER_LAYER;
        if (IN(pb + 0)) { ph_prologue(args, F, l);
#if PROBE_PRO2
            __syncthreads(); ph_prologue(args, F, l);
#endif
        } SEAM(pb + 0);
        if (IN(pb + 1)) {
            pg8::Gemm g{(const bf16*)(ws + WS_H), (const bf16*)(ws + WS_WIN), NTOK, ZW, DM}; pg8::StaticOrder S; S.init(NTOK, ZW, F.G, (int)blockIdx.x);
            pg8::EpiBf16<2> E{(bf16*)(ws + WS_Z), NTOK, (const unsigned long long*)(ws + WS_SSQ) + (size_t)(l * 2) * NTOK, (LAS float*)(F.lds + XTRA_OFF)};
            pg8::gemm_phase<pg8::EpiBf16<2>, pg8::StaticOrder, true, true>(F.lds + RING_OFF, g, S, E);
#if PROBE_WIN2
            pg8::gemm_phase<pg8::EpiBf16<2>, pg8::StaticOrder, true, true>(F.lds + RING_OFF, g, S, E);
#endif
        } SEAM(pb + 1);
        if (IN(pb + 2)) { ph_na_mfma(args, F, l); ph_scan<0>(args, F, l);
#if PROBE_NA2
            __syncthreads(); ph_na_mfma(args, F, l);
#endif
#if PROBE_SCAN2
            ph_scan<0>(args, F, l);
#endif
        } SEAM(pb + 2);
        if (IN(pb + 3)) { ph_carries(args, F, l);
#if PROBE_SCAN2 || PROBE_CAR2
            ph_carries(args, F, l);
#endif
        } SEAM(pb + 3);
        if (IN(pb + 4)) { ph_scan<1>(args, F, l);
#if PROBE_SCAN2
            ph_scan<1>(args, F, l);
#endif
        } SEAM(pb + 4);
        if (IN(pb + 5)) {
            __syncthreads();
            pg8::Gemm g{(const bf16*)(ws + WS_YG), (const bf16*)(ws + WS_WGLU), NTOK, 512, 512}; pg8::StaticOrder S; S.init(NTOK, 512, F.G, (int)blockIdx.x);
            pg8::EpiGlu E{(const bf16*)(ws + WS_YG), (bf16*)(ws + WS_Y), args.in[I_BGLU] + (size_t)l * 512, DM, 1536};
            pg8::gemm_phase<pg8::EpiGlu, pg8::StaticOrder, true, true>(F.lds + RING_OFF, g, S, E);
#if PROBE_GLU2
            pg8::gemm_phase<pg8::EpiGlu, pg8::StaticOrder, true, true>(F.lds + RING_OFF, g, S, E);
#endif
        } SEAM(pb + 5);
        if (IN(pb + 6)) {
#if PROBE_GN2
            ph_groupnorm(args, F, l, (bf16*)(ws + WS_Z));
#endif
            ph_groupnorm(args, F, l); } SEAM(pb + 6);
        if (IN(pb + 7)) {
            pg8::Gemm g{(const bf16*)(ws + WS_Y), (const bf16*)(ws + WS_WOUT), NTOK, DM, DM}; pg8::StaticOrder S; S.init(NTOK, DM, F.G, (int)blockIdx.x);
#if PROBE_WOUT2
            { pg8::EpiResid E2{l == 0 ? args.in[I_XP] : nullptr, l == 0 ? args.in[I_XS] : nullptr, 8192, (float*)(ws + WS_Z), DM, (bf16*)(ws + WS_H), nullptr};
              pg8::gemm_phase<pg8::EpiResid, pg8::StaticOrder, true, true>(F.lds + RING_OFF, g, S, E2); }
#endif
            pg8::EpiResid E{l == 0 ? args.in[I_XP] : nullptr, l == 0 ? args.in[I_XS] : nullptr, 8192, nullptr, DM, (bf16*)(ws + WS_H), (unsigned long long*)(ws + WS_SSQ) + (size_t)(l * 2 + 1) * NTOK};
            pg8::gemm_phase<pg8::EpiResid, pg8::StaticOrder, true, true>(F.lds + RING_OFF, g, S, E);
        } SEAM(pb + 7);
        for (int s = 0; s <= NMLPC; ++s) {
            if (IN(pb + 8 + s)) {
                if (s > 0) {
                    const int c = s - 1;
                    pg8::Gemm g{(const bf16*)(ws + WS_Z + (size_t)(c & 1) * 128 * MiB), (const bf16*)(ws + WS_WDN), MLPC, DM, DFF}; pg8::StaticOrder S; S.init(MLPC, DM, F.G, (int)blockIdx.x);
                    pg8::EpiResid E{nullptr, nullptr, 1 << 30, l + 1 < DEPTH ? nullptr : args.out + (size_t)c * MLPC * DM, DM,
                                    (bf16*)(ws + WS_H) + (size_t)c * MLPC * DM, (unsigned long long*)(ws + WS_SSQ) + (size_t)((l + 1 < DEPTH ? l + 1 : 0) * 2) * NTOK + (size_t)c * MLPC};
#if PROBE_DN2
                    { pg8::EpiResid E2{nullptr, nullptr, 1 << 30, (float*)(ws + WS_Z + 256 * MiB), DM, (bf16*)(ws + WS_H) + (size_t)c * MLPC * DM, nullptr};
                      pg8::gemm_phase<pg8::EpiResid, pg8::StaticOrder, true, true>(F.lds + RING_OFF, g, S, E2); }
#endif
                    pg8::gemm_phase<pg8::EpiResid, pg8::StaticOrder, true, true>(F.lds + RING_OFF, g, S, E);
                }
                if (s < NMLPC) {
                    const int c = s;
                    pg8::Gemm g{(const bf16*)(ws + WS_H) + (size_t)c * MLPC * DM, (const bf16*)(ws + WS_WUP), MLPC, DFF, DM}; pg8::StaticOrder S; S.init(MLPC, DFF, F.G, (int)blockIdx.x);
                    pg8::EpiBf16<1> E{(bf16*)(ws + WS_Z + (size_t)(c & 1) * 128 * MiB), DFF, (const unsigned long long*)(ws + WS_SSQ) + (size_t)(l * 2 + 1) * NTOK + (size_t)c * MLPC, (LAS float*)(F.lds + XTRA_OFF)};
                    pg8::gemm_phase<pg8::EpiBf16<1>, pg8::StaticOrder, true, true>(F.lds + RING_OFF, g, S, E);
#if PROBE_UP2
                    pg8::gemm_phase<pg8::EpiBf16<1>, pg8::StaticOrder, true, true>(F.lds + RING_OFF, g, S, E);
#endif
                }
            } SEAM(pb + 8 + s);
        }
    }
    if (IN(NPHASE - 1)) {
#if PROBE_FIN2
        ph_final(args, F, (float*)(ws + WS_Z));
#endif
        ph_final(args, F); }
#undef IN
#undef SEAM
}

extern "C" void kernel_launch(void* const* d_in, const int* in_sizes, int n_in, void* d_out, int out_size, void* d_ws, size_t ws_size, hipStream_t stream) {
    static int grid = 0;
    if (grid == 0) {
        if (n_in != 28 || out_size != NTOK * DM || ws_size < WS_END) { fprintf(stderr, "kernel_launch: unexpected shapes (n_in %d out %d ws %zu)\n", n_in, out_size, ws_size); grid = -1; return; }
        int dev = 0, cus = 0, per_cu = 0;
        if (hipGetDevice(&dev) != hipSuccess || hipDeviceGetAttribute(&cus, hipDeviceAttributeMultiprocessorCount, dev) != hipSuccess) { grid = -1; return; }
        if (hipFuncSetAttribute((const void*)mk_fwd, hipFuncAttributeMaxDynamicSharedMemorySize, LDS_BYTES) != hipSuccess) { fprintf(stderr, "kernel_launch: hipFuncSetAttribute failed\n"); grid = -1; return; }
        if (hipOccupancyMaxActiveBlocksPerMultiprocessor(&per_cu, (const void*)mk_fwd, NTHR, LDS_BYTES) != hipSuccess || per_cu < 1) fprintf(stderr, "kernel_launch: occupancy query says %d\n", per_cu);
        (void)hipGetLastError();
        grid = cus;
    }
    if (grid < 0) return;
    if (hipMemsetAsync((char*)d_ws + WS_CTL, 0, CTL_ZERO_BYTES, stream) != hipSuccess) return;
    if (hipMemsetAsync((char*)d_ws + WS_SSQ, 0, SSQ_BYTES, stream) != hipSuccess) return;
    Args a{};
    for (int i = 0; i < 28; ++i) a.in[i] = (const float*)d_in[i];
    a.out = (float*)d_out; a.ws = (unsigned char*)d_ws;
#if MK_ONE_LAUNCH
    a.ph_lo = 0; a.ph_hi = NPHASE;
    hipLaunchKernelGGL(mk_fwd, dim3(grid), dim3(NTHR), LDS_BYTES, stream, a);
#else
    for (int ph = 0; ph < NPHASE; ++ph) { a.ph_lo = ph; a.ph_hi = ph + 1; hipLaunchKernelGGL(mk_fwd, dim3(grid), dim3(NTHR), LDS_BYTES, stream, a); }
#endif
}
```
